# Optimizing an MI355X kernel written in HIP

```python
import math
import jax
import jax.numpy as jnp
from jax import lax
import numpy as np

D_MODEL = 1024
BATCH = 16
SEQ = 2048
DEPTH = 4

HEAD_DIM = 64
N_GROUPS = 4
MIX_WIDTH = D_MODEL
GROUP_WIDTH = MIX_WIDTH // N_GROUPS
GROUP_HEADS = GROUP_WIDTH // HEAD_DIM
D_FF = 256 * ((8 * D_MODEL // 3 + 255) // 256)
PLE_DIM = 256
ROPE_THETA = 10000.0
EPS = 1e-6
NEG_INF = -1e30

GRID_W = 64
NA_HEADS = GROUP_HEADS
NA_ROWS = 8
NA_COLS = 16
SWA_HEADS = GROUP_HEADS
SWA_KV_HEADS = GROUP_HEADS // 2
SWA_GROUP = SWA_HEADS // SWA_KV_HEADS
SWA_HALF = 128
SWA_BLOCK = 128
DIL_HEADS = GROUP_HEADS
DIL_PATTERNS = ((128, 1), (512, 4), (2048, 16))
DIL_BLOCK = 64
MLA_HEADS = GROUP_HEADS
MLA_Q_LORA = D_MODEL // 4
MLA_KV_LORA = D_MODEL // 8
MLA_NOPE = HEAD_DIM
MLA_ROPE = HEAD_DIM // 2
MLA_V = GROUP_WIDTH // MLA_HEADS
DENSE_BLOCK = 128

NA_IN = 3 * NA_HEADS * HEAD_DIM
SWA_IN = (SWA_HEADS + 2 * SWA_KV_HEADS) * HEAD_DIM
DIL_IN = 3 * DIL_HEADS * HEAD_DIM
MLA_IN = MLA_Q_LORA + MLA_KV_LORA + MLA_ROPE
IN_COLS = NA_IN + SWA_IN + DIL_IN + MLA_IN
IN_SPLITS = (NA_IN, NA_IN + SWA_IN, NA_IN + SWA_IN + DIL_IN)

kernel_name = "hybrid_parallel_headgroup_encoder"


def rms_norm(x, g):
    xf = x.astype(jnp.float32)
    y = xf * lax.rsqrt(jnp.mean(xf * xf, axis=-1, keepdims=True) + EPS)
    return (y * g.astype(jnp.float32)).astype(x.dtype)


def rope(x, pos):
    half = x.shape[-1] // 2
    inv_freq = ROPE_THETA ** (-jnp.arange(half, dtype=jnp.float32) / half)
    ang = pos.astype(jnp.float32)[:, None] * inv_freq[None, :]
    cos, sin = jnp.cos(ang), jnp.sin(ang)
    xf = x.astype(jnp.float32)
    x1, x2 = xf[..., :half], xf[..., half:]
    return jnp.concatenate([x1 * cos - x2 * sin, x2 * cos + x1 * sin], axis=-1).astype(x.dtype)


def swiglu(u, w_gate, w_up, w_down):
    return (jax.nn.silu(u @ w_gate) * (u @ w_up)) @ w_down


def split_heads(t, n):
    b, s, _ = t.shape
    return t.reshape(b, s, n, -1).transpose(0, 2, 1, 3)


def merge_heads(t):
    b, h, s, d = t.shape
    return t.transpose(0, 2, 1, 3).reshape(b, s, h * d)


def band_attention_stats(q, k, v, half_width, block, scale):
    L = q.shape[-2]
    qb_len = math.gcd(L, block)
    nb = L // qb_len
    kw = qb_len + 2 * half_width
    pad = [(0, 0)] * (k.ndim - 2) + [(half_width, half_width), (0, 0)]
    kp = jnp.pad(k, pad)
    vp = jnp.pad(v, pad)
    starts = jnp.arange(nb) * qb_len
    idx = starts[:, None] + jnp.arange(kw)[None, :]
    kb = jnp.take(kp, idx, axis=-2)
    vb = jnp.take(vp, idx, axis=-2)
    qb = q.reshape(q.shape[:-2] + (nb, qb_len, q.shape[-1]))
    s = jnp.einsum("...gnqd,...nkd->...gnqk", qb, kb).astype(jnp.float32) * scale
    qpos = starts[:, None, None] + jnp.arange(qb_len)[None, :, None]
    kpos = starts[:, None, None] - half_width + jnp.arange(kw)[None, None, :]
    valid = (jnp.abs(kpos - qpos) <= half_width) & (kpos >= 0) & (kpos < L)
    s = jnp.where(valid, s, NEG_INF)
    m = jnp.max(s, axis=-1)
    p = jnp.exp(s - m[..., None])
    l = jnp.sum(p, axis=-1)
    o = jnp.einsum("...gnqk,...nkd->...gnqd", p, vb)
    lead = q.shape[:-2]
    return (m.reshape(lead + (L,)), l.reshape(lead + (L,)), o.reshape(lead + (L, o.shape[-1])))


def neighbourhood_attention(q, k, v, bias_table):
    b, h, t, dh = q.shape
    rows = t // GRID_W
    kr = min(NA_ROWS, rows)
    n_cb = GRID_W // NA_COLS
    kc = 2 * NA_COLS
    r = jnp.arange(rows)
    key_row = jnp.clip(r - kr // 2, 0, rows - kr)[:, None] + jnp.arange(kr)[None, :]
    c0 = jnp.arange(n_cb) * NA_COLS
    key_col = jnp.clip(c0 - NA_COLS // 2, 0, GRID_W - kc)[:, None] + jnp.arange(kc)[None, :]
    key_idx = (key_row[:, None, :, None] * GRID_W + key_col[None, :, None, :]).reshape(rows, n_cb, kr * kc)
    kb = jnp.take(k, key_idx, axis=2)
    vb = jnp.take(v, key_idx, axis=2)
    qb = q.reshape(b, h, rows, n_cb, NA_COLS, dh)
    s = jnp.einsum("bhrcqd,bhrckd->bhrcqk", qb, kb).astype(jnp.float32) * dh ** -0.5
    q_col = c0[:, None] + jnp.arange(NA_COLS)[None, :]
    win_start = jnp.clip(q_col - NA_COLS // 2, 0, GRID_W - NA_COLS)
    kcol = key_col[:, None, None, :]
    ws = win_start[:, :, None, None]
    valid = (kcol >= ws) & (kcol < ws + NA_COLS)
    valid = jnp.broadcast_to(valid, (n_cb, NA_COLS, kr, kc)).reshape(n_cb, NA_COLS, kr * kc)
    d_row = (key_row - r[:, None] + NA_ROWS - 1)[:, None, None, :, None]
    d_col = (jnp.clip(kcol - q_col[:, :, None, None], 1 - NA_COLS, NA_COLS - 1) + NA_COLS - 1)[None]
    bias = bias_table[:, d_row, d_col].reshape(h, rows, n_cb, NA_COLS, kr * kc)
    s = jnp.where(valid, s + bias.astype(jnp.float32), NEG_INF)
    p = jax.nn.softmax(s, axis=-1)
    o = jnp.einsum("bhrcqk,bhrckd->bhrcqd", p.astype(v.dtype), vb)
    return o.reshape(b, h, t, dh)


def na_mixer(z, bias_table):
    q, k, v = jnp.split(z, 3, axis=-1)
    o = neighbourhood_attention(split_heads(q, NA_HEADS), split_heads(k, NA_HEADS),
                                split_heads(v, NA_HEADS), bias_table)
    return merge_heads(o)


def swa_mixer(z, sink, pos):
    b, t, _ = z.shape
    q, k, v = jnp.split(z, [SWA_HEADS * HEAD_DIM, (SWA_HEADS + SWA_KV_HEADS) * HEAD_DIM], axis=-1)
    q = rope(split_heads(q, SWA_HEADS), pos).reshape(b, SWA_KV_HEADS, SWA_GROUP, t, HEAD_DIM)
    k = rope(split_heads(k, SWA_KV_HEADS), pos)
    v = split_heads(v, SWA_KV_HEADS)
    m, l, o = band_attention_stats(q, k, v, SWA_HALF, SWA_BLOCK, HEAD_DIM ** -0.5)
    sk = sink.reshape(SWA_KV_HEADS, SWA_GROUP)[:, :, None].astype(jnp.float32)
    m2 = jnp.maximum(m, sk)
    a = jnp.exp(m - m2)
    o = o * (a / (l * a + jnp.exp(sk - m2)))[..., None]
    return merge_heads(o.reshape(b, SWA_HEADS, t, HEAD_DIM).astype(z.dtype))


def to_residue(x, dil):
    t, d = x.shape[-2], x.shape[-1]
    return jnp.swapaxes(x.reshape(x.shape[:-2] + (t // dil, dil, d)), -3, -2)


def from_residue(x):
    y = jnp.swapaxes(x, -3, -2)
    return y.reshape(y.shape[:-3] + (y.shape[-3] * y.shape[-2], y.shape[-1]))


def dil_mixer(z, pos):
    b, t, _ = z.shape
    q, k, v = jnp.split(z, 3, axis=-1)
    q = rope(split_heads(q, DIL_HEADS), pos)
    k = rope(split_heads(k, DIL_HEADS), pos)
    v = split_heads(v, DIL_HEADS)
    ms, ls, os_ = [], [], []
    for window, dil in DIL_PATTERNS:
        steps = window // 2 // dil
        m, l, o = band_attention_stats(to_residue(q, dil)[..., None, :, :], to_residue(k, dil),
                                       to_residue(v, dil), steps, DIL_BLOCK, HEAD_DIM ** -0.5)
        ms.append(from_residue(m[..., 0, :, None])[..., 0])
        ls.append(from_residue(l[..., 0, :, None])[..., 0])
        os_.append(from_residue(o[..., 0, :, :]))
    m_all = jnp.stack(ms)
    w = jnp.exp(m_all - jnp.max(m_all, axis=0))
    den = jnp.sum(jnp.stack(ls) * w, axis=0)
    num = jnp.sum(jnp.stack(os_) * w[..., None], axis=0)
    return merge_heads((num / den[..., None]).astype(z.dtype))


def dense_block_attention(q, k, v, scale):
    b, h, t, dk = q.shape
    qb_len = math.gcd(t, DENSE_BLOCK)
    qb = q.reshape(b, h, t // qb_len, qb_len, dk).transpose(2, 0, 1, 3, 4)

    def one_block(q_blk):
        s = jnp.einsum("bhqd,bhkd->bhqk", q_blk, k).astype(jnp.float32) * scale
        p = jax.nn.softmax(s, axis=-1)
        return jnp.einsum("bhqk,bhkd->bhqd", p.astype(v.dtype), v)

    o = lax.map(one_block, qb)
    return o.transpose(1, 2, 0, 3, 4).reshape(b, h, t, v.shape[-1])


def mla_mixer(z, q_norm, w_uq, kv_norm, w_ukv, pos):
    b, t, _ = z.shape
    cq, ckv, kpe = jnp.split(z, [MLA_Q_LORA, MLA_Q_LORA + MLA_KV_LORA], axis=-1)
    qf = (rms_norm(cq, q_norm) @ w_uq).reshape(b, t, MLA_HEADS, MLA_NOPE + MLA_ROPE).transpose(0, 2, 1, 3)
    q = jnp.concatenate([qf[..., :MLA_NOPE], rope(qf[..., MLA_NOPE:], pos)], axis=-1)
    kv = (rms_norm(ckv, kv_norm) @ w_ukv).reshape(b, t, MLA_HEADS, MLA_NOPE + MLA_V).transpose(0, 2, 1, 3)
    k_pe = rope(kpe, pos)[:, None]
    k = jnp.concatenate([kv[..., :MLA_NOPE], jnp.broadcast_to(k_pe, (b, MLA_HEADS, t, MLA_ROPE))], axis=-1)
    v = kv[..., MLA_NOPE:]
    o = dense_block_attention(q, k, v, (MLA_NOPE + MLA_ROPE) ** -0.5)
    return merge_heads(o)


def setup_inputs(seed: int = 0) -> dict:
    key = jax.random.key(seed)
    ks = jax.random.split(key, 26)
    f32 = jnp.float32

    def w(k, shape, fan_in):
        return jax.random.normal(k, shape, f32) * (fan_in ** -0.5)

    def g(k, shape):
        return 1.0 + 0.02 * jax.random.normal(k, shape, f32)

    L = DEPTH
    return {
        "x": jax.random.normal(ks[0], (BATCH, SEQ, D_MODEL), f32),
        "p": jax.random.normal(ks[1], (DEPTH, BATCH, SEQ, PLE_DIM), f32),
        "ffn1_norm": g(ks[2], (L, D_MODEL)),
        "ffn1_w_gate": w(ks[3], (L, D_MODEL, D_FF), D_MODEL),
        "ffn1_w_up": w(ks[4], (L, D_MODEL, D_FF), D_MODEL),
        "ffn1_w_down": w(ks[5], (L, D_FF, D_MODEL), D_FF),
        "mix_norm": g(ks[6], (L, D_MODEL)),
        "w_in": w(ks[7], (L, D_MODEL, IN_COLS), D_MODEL),
        "na_bias": 0.1 * jax.random.normal(ks[8], (L, NA_HEADS, 2 * NA_ROWS - 1, 2 * NA_COLS - 1), f32),
        "swa_sink": 0.5 * jax.random.normal(ks[9], (L, SWA_HEADS), f32),
        "mla_q_norm": g(ks[10], (L, MLA_Q_LORA)),
        "mla_w_uq": w(ks[11], (L, MLA_Q_LORA, MLA_HEADS * (MLA_NOPE + MLA_ROPE)), MLA_Q_LORA),
        "mla_kv_norm": g(ks[12], (L, MLA_KV_LORA)),
        "mla_w_ukv": w(ks[13], (L, MLA_KV_LORA, MLA_HEADS * (MLA_NOPE + MLA_V)), MLA_KV_LORA),
        "group_norm": g(ks[14], (L, N_GROUPS, GROUP_WIDTH)),
        "w_out": w(ks[15], (L, MIX_WIDTH, D_MODEL), MIX_WIDTH),
        "ffn2_norm": g(ks[16], (L, D_MODEL)),
        "ffn2_w_gate": w(ks[17], (L, D_MODEL, D_FF), D_MODEL),
        "ffn2_w_up": w(ks[18], (L, D_MODEL, D_FF), D_MODEL),
        "ffn2_w_down": w(ks[19], (L, D_FF, D_MODEL), D_FF),
        "ple_norm": g(ks[20], (L, D_MODEL)),
        "ple_w_gate": w(ks[21], (L, D_MODEL, D_MODEL), D_MODEL),
        "ple_w_proj": w(ks[22], (L, PLE_DIM, D_MODEL), PLE_DIM),
        "final_norm": g(ks[23], (D_MODEL,)),
    }


def reference(x, p, ffn1_norm, ffn1_w_gate, ffn1_w_up, ffn1_w_down, mix_norm, w_in, na_bias,
              swa_sink, mla_q_norm, mla_w_uq, mla_kv_norm, mla_w_ukv, group_norm, w_out,
              ffn2_norm, ffn2_w_gate, ffn2_w_up, ffn2_w_down, ple_norm, ple_w_gate, ple_w_proj,
              final_norm):
    t = x.shape[1]
    pos = jnp.arange(t, dtype=jnp.int32)
    for i in range(DEPTH):
        x = x + 0.5 * swiglu(rms_norm(x, ffn1_norm[i]), ffn1_w_gate[i], ffn1_w_up[i], ffn1_w_down[i])
        z = rms_norm(x, mix_norm[i]) @ w_in[i]
        z_na, z_swa, z_dil, z_mla = jnp.split(z, IN_SPLITS, axis=-1)
        y_na = na_mixer(z_na, na_bias[i])
        y_swa = swa_mixer(z_swa, swa_sink[i], pos)
        y_dil = dil_mixer(z_dil, pos)
        y_mla = mla_mixer(z_mla, mla_q_norm[i], mla_w_uq[i], mla_kv_norm[i], mla_w_ukv[i], pos)
        y = jnp.concatenate([rms_norm(y_na, group_norm[i, 0]), rms_norm(y_swa, group_norm[i, 1]),
                             rms_norm(y_dil, group_norm[i, 2]), rms_norm(y_mla, group_norm[i, 3])], axis=-1)
        x = x + y @ w_out[i]
        x = x + 0.5 * swiglu(rms_norm(x, ffn2_norm[i]), ffn2_w_gate[i], ffn2_w_up[i], ffn2_w_down[i])
        gate = jax.nn.sigmoid(rms_norm(x, ple_norm[i]) @ ple_w_gate[i])
        x = x + gate * (p[i] @ ple_w_proj[i])
    return rms_norm(x, final_norm)
```

```cpp
#include <hip/hip_runtime.h>
#include <hip/hip_cooperative_groups.h>
#include <cstdio>
#include <cstdint>
namespace cg = cooperative_groups;

#ifndef MULTI_LAUNCH
#define MULTI_LAUNCH 1
#endif

#ifndef PRO_PARTS
#define PRO_PARTS 7
#endif
#ifndef PHM
#define PHM 0xffff
#endif
#define PH_ON(b) (((PHM) >> (b)) & 1)
#define LAS __attribute__((address_space(3)))
typedef unsigned short bf16_t;
typedef short bf16x8 __attribute__((ext_vector_type(8)));
typedef float f32x4 __attribute__((ext_vector_type(4)));
typedef float f32x16 __attribute__((ext_vector_type(16)));
typedef unsigned u32x4 __attribute__((ext_vector_type(4)));
typedef unsigned u32x2 __attribute__((ext_vector_type(2)));

constexpr int M = 32768, T = 2048, D = 1024, FF = 2816, DEPTH = 4, PLE = 256;
constexpr int ZLD = 2048, QLD = 384, KNLD = 256;
constexpr float EPS = 1e-6f;
constexpr float LOG2E = 1.4426950408889634f;

constexpr size_t WL_GU1 = 0, WL_D1 = WL_GU1 + (size_t)5632 * 1024, WL_IN = WL_D1 + (size_t)1024 * 2816, WL_UQ = WL_IN + (size_t)2816 * 1024,
                 WL_UKV = WL_UQ + (size_t)512 * 256, WL_O = WL_UKV + (size_t)512 * 128, WL_GU2 = WL_O + (size_t)1024 * 1024, WL_D2 = WL_GU2 + (size_t)5632 * 1024,
                 WL_PG = WL_D2 + (size_t)1024 * 2816, WL_PP = WL_PG + (size_t)1024 * 1024, WL_SIZE = WL_PP + (size_t)1024 * 256;
constexpr size_t OFF_W = 0;
constexpr size_t OFF_XBA = OFF_W + WL_SIZE * 2 * DEPTH;
constexpr size_t OFF_XBB = OFF_XBA + (size_t)M * D * 2;
constexpr size_t OFF_H = OFF_XBB + (size_t)M * D * 2;
constexpr size_t OFF_QM = OFF_H + (size_t)M * ZLD * 2;
constexpr size_t OFF_KN = OFF_QM + (size_t)M * QLD * 2;
constexpr size_t OFF_VT = OFF_H + (size_t)M * FF * 2;
constexpr size_t OFF_VT4 = OFF_VT + (size_t)640 * M * 2;
constexpr size_t OFF_VT16 = OFF_VT4 + (size_t)256 * M * 2;
constexpr size_t OFF_VTM = OFF_VT16 + (size_t)256 * M * 2;
constexpr size_t OFF_SSA = OFF_VTM + (size_t)256 * M * 2;
constexpr size_t OFF_SSB = OFF_SSA + (size_t)M * 16 * 4;
constexpr size_t OFF_MST = OFF_SSB + (size_t)M * 16 * 4;
constexpr size_t OFF_CS64 = OFF_MST + (size_t)M * 8 * 4;
constexpr size_t OFF_CS32 = OFF_CS64 + (size_t)T * 64 * 4;
constexpr size_t OFF_BAR = OFF_CS32 + (size_t)T * 32 * 4;
constexpr size_t WS_END = OFF_BAR + 256;
static_assert(OFF_KN + (size_t)M * KNLD * 2 <= OFF_VT, "z|qm|kn inside the H region");

constexpr int LDS_BYTES = 147456;
constexpr int NPH = 2 + 9 * DEPTH;

__device__ __forceinline__ unsigned cvt_pk_bf16(float lo, float hi) { unsigned r; asm("v_cvt_pk_bf16_f32 %0, %1, %2" : "=v"(r) : "v"(lo), "v"(hi)); return r; }
__device__ __forceinline__ float bf_lo(unsigned u) { return __uint_as_float(u << 16); }
__device__ __forceinline__ float bf_hi(unsigned u) { return __uint_as_float(u & 0xffff0000u); }
__device__ __forceinline__ float sum4(f32x4 a) { return (a.x + a.y) + (a.z + a.w); }
__device__ __forceinline__ float dot4(f32x4 a) { return (a.x * a.x + a.y * a.y) + (a.z * a.z + a.w * a.w); }
__device__ __forceinline__ float rs16(const float* ss, int row) {
    const f32x4* p = (const f32x4*)(ss + (size_t)row * 16);
    const f32x4 a = p[0], b = p[1], c = p[2], d = p[3];
    return rsqrtf(((sum4(a) + sum4(b)) + (sum4(c) + sum4(d))) * (1.0f / 1024.0f) + EPS);
}
__device__ __forceinline__ int vlane() { int l; asm volatile("v_mbcnt_lo_u32_b32 %0, -1, 0\n\tv_mbcnt_hi_u32_b32 %0, -1, %0" : "=v"(l)); return l; }
__device__ __forceinline__ int ltid(int wv) { return (wv << 6) | vlane(); }
__device__ __forceinline__ int lbid() { int b = blockIdx.x; asm volatile("" : "+s"(b)); return b; }
__device__ __forceinline__ int lgrid() { int g = gridDim.x; asm volatile("" : "+s"(g)); return g; }
__device__ __forceinline__ float sigmoidf_(float v) { return __builtin_amdgcn_rcpf(1.0f + __expf(-v)); }

namespace pg8 {
constexpr int BM = 256, BK = 64, HALF = 128, HTB = HALF * BK * 2, STAGE_BYTES = 8 * HTB, NXCD = 8, WGM = 8;
__host__ __device__ __forceinline__ int lds_byte(int r, int c) { const int st = (r >> 4) * 2 + (c >> 5), rr = r & 15, cc = c & 31, ob = rr * 64 + cc * 2; return st * 1024 + (ob ^ (((ob >> 9) & 1) << 5)); }
__host__ __device__ __forceinline__ void stage_rc(int b, int& R, int& C) { const int st = b / 1024, sb = b % 1024, swz = sb ^ (((sb >> 9) & 1) << 5); R = (st >> 1) * 16 + swz / 64; C = (st & 1) * 32 + (swz % 64) / 2; }
__host__ __device__ __forceinline__ int perm32(int rho) { const int n = rho >> 4, i = rho & 15; return 8 * (i >> 2) + 4 * n + (i & 3); }

struct Unit { int pm, pn; };
struct Gemm { const bf16_t* A; const bf16_t* Bt; int lda, ldb, K; };

struct StaticOrder {
    int nM, nN, nwg, G, c;
    __device__ void init(int Mr, int Nc, int G_, int c_) { nM = Mr / BM; nN = Nc / BM; nwg = nM * nN; G = G_; c = c_; }
    __device__ bool next(int i, Unit& u) const {
        const long L = (long)i * G + c; if (L >= nwg) return false;
        int wgid = (int)L; { const int q = nwg / NXCD, r = nwg % NXCD, xcd = wgid % NXCD, off = wgid / NXCD; wgid = (xcd < r ? xcd * (q + 1) : r * (q + 1) + (xcd - r) * q) + off; }
        const int nig = WGM * nN, gid = wgid / nig, fm = gid * WGM, gsz = (nM - fm) < WGM ? (nM - fm) : WGM;
        u.pm = fm + ((wgid % nig) % gsz); u.pn = (wgid % nig) / gsz; return true;
    }
};

template <class Epi>
__device__ __forceinline__ void gemm_phase(LAS unsigned char* lds, const Gemm g, const StaticOrder& S, const Epi& E, int wv) {
    const int tid = ltid(wv);
    const int wid = wv, lane = tid & 63, wr = wid >> 2, wc = wid & 3, fr = lane & 15, fq = lane >> 4;
    const int K = g.K, nt = K / BK;
    unsigned voffA[2], voffB[2];
#pragma unroll
    for (int i = 0; i < 2; ++i) { int R, C; stage_rc(tid * 16 + i * 8192, R, C); const int Rb = (R & ~31) + perm32(R & 31);
        voffA[i] = (unsigned)(R * g.lda + C) * 2u; voffB[i] = (unsigned)(Rb * g.ldb + C) * 2u; }
    const size_t kstep = (size_t)(BK * 2);
    const size_t hstepA = (size_t)HALF * g.lda * 2, hstepB = (size_t)HALF * g.ldb * 2;
    const size_t tstepA = 2 * hstepA, tstepB = 2 * hstepB;
    const unsigned ldsw = (unsigned)wid * 1024u;
    const int aoff = lds_byte(wr * 64 + fr, fq * 8), boff = lds_byte(wc * 32 + fr, fq * 8);
#define PG8_SA(b, h) (((b) * 2 + (h)) * HTB)
#define PG8_SB(b, h) ((4 + (b) * 2 + (h)) * HTB)
#define PG8_STAGE(bufoff, gbase, voff) do { _Pragma("unroll") for (int _i = 0; _i < 2; ++_i) \
        __builtin_amdgcn_global_load_lds((const unsigned*)((const char*)(gbase) + (voff)[_i]), (LAS unsigned*)(lds + (bufoff) + ldsw + _i * 8192), 16, 0, 0); } while (0)
#define PG8_LDA(dst, b, h) do { _Pragma("unroll") for (int m = 0; m < 4; ++m) _Pragma("unroll") for (int k = 0; k < 2; ++k) dst[m][k] = *(const LAS bf16x8*)(lds + PG8_SA(b, h) + aoff + m * 2048 + k * 1024); } while (0)
#define PG8_LDB(dst, b, h) do { _Pragma("unroll") for (int n = 0; n < 2; ++n) _Pragma("unroll") for (int k = 0; k < 2; ++k) dst[n][k] = *(const LAS bf16x8*)(lds + PG8_SB(b, h) + boff + n * 2048 + k * 1024); } while (0)
#define PG8_MMA(ai, bj, At, Bt) do { __builtin_amdgcn_s_setprio(1); _Pragma("unroll") for (int m = 0; m < 4; ++m) _Pragma("unroll") for (int n = 0; n < 2; ++n) _Pragma("unroll") for (int k = 0; k < 2; ++k) \
        acc[ai][bj][m][n] = __builtin_amdgcn_mfma_f32_16x16x32_bf16(Bt[n][k], At[m][k], acc[ai][bj][m][n], 0, 0, 0); __builtin_amdgcn_s_setprio(0); } while (0)
#define PG8_WAIT_V(n) asm volatile("s_waitcnt vmcnt(" #n ")" ::: "memory")
#define PG8_WAIT_L(n) asm volatile("s_waitcnt lgkmcnt(" #n ")" ::: "memory")
#define PG8_BAR __builtin_amdgcn_s_barrier()
#define PG8_SCHED __builtin_amdgcn_sched_barrier(0)
    Unit cur, nxt; int ui = 0;
    if (!S.next(0, cur)) return;
    f32x4 acc[2][2][4][2];
#pragma unroll
    for (int a = 0; a < 2; ++a)
#pragma unroll
        for (int b = 0; b < 2; ++b)
#pragma unroll
            for (int m = 0; m < 4; ++m)
#pragma unroll
                for (int n = 0; n < 2; ++n) acc[a][b][m][n] = (f32x4){0.f, 0.f, 0.f, 0.f};
    bf16x8 At[4][2], B0[2][2], B1[2][2];
    const char* cA = (const char*)g.A + (size_t)cur.pm * tstepA; const char* cB = (const char*)g.Bt + (size_t)cur.pn * tstepB;
    PG8_STAGE(PG8_SB(0, 0), cB, voffB); PG8_STAGE(PG8_SB(0, 1), cB + hstepB, voffB); PG8_STAGE(PG8_SA(0, 0), cA, voffA); PG8_STAGE(PG8_SA(0, 1), cA + hstepA, voffA);
    if (wr == 1) PG8_BAR;
    PG8_WAIT_V(2); PG8_BAR;
    PG8_STAGE(PG8_SB(1, 0), cB + kstep, voffB); PG8_STAGE(PG8_SA(1, 0), cA + kstep, voffA); PG8_STAGE(PG8_SB(1, 1), cB + hstepB + kstep, voffB);
    PG8_WAIT_V(6); PG8_BAR;
    for (;;) {
        const bool has_next = S.next(ui + 1, nxt);
        const char* nA = has_next ? (const char*)g.A + (size_t)nxt.pm * tstepA : cA; const char* nB = has_next ? (const char*)g.Bt + (size_t)nxt.pn * tstepB : cB;
        for (int t = 0; t < nt; t += 2) {
            const bool last = (t == nt - 2);
            const char* a1 = cA + (size_t)(t + 1) * kstep;
            const char* a2 = last ? nA : cA + (size_t)(t + 2) * kstep; const char* b2 = last ? nB : cB + (size_t)(t + 2) * kstep;
            const char* a3 = a2 + kstep; const char* b3 = b2 + kstep;
            PG8_LDB(B0, 0, 0); PG8_LDB(B1, 0, 1); PG8_SCHED; PG8_LDA(At, 0, 0); PG8_STAGE(PG8_SA(1, 1), a1 + hstepA, voffA);
            PG8_WAIT_V(8); PG8_WAIT_L(0); PG8_BAR; PG8_MMA(0, 0, At, B0); PG8_MMA(0, 1, At, B1); PG8_BAR; PG8_SCHED;
            PG8_LDA(At, 0, 1); PG8_STAGE(PG8_SB(0, 0), b2, voffB); PG8_STAGE(PG8_SB(0, 1), b2 + hstepB, voffB); PG8_STAGE(PG8_SA(0, 0), a2, voffA);
            PG8_WAIT_V(8); PG8_WAIT_L(0); PG8_BAR; PG8_MMA(1, 0, At, B0); PG8_MMA(1, 1, At, B1); PG8_BAR; PG8_SCHED;
            PG8_LDB(B0, 1, 0); PG8_LDB(B1, 1, 1); PG8_SCHED; PG8_LDA(At, 1, 0); PG8_STAGE(PG8_SA(0, 1), a2 + hstepA, voffA);
            PG8_WAIT_V(8); PG8_WAIT_L(0); PG8_BAR; PG8_MMA(0, 0, At, B0); PG8_MMA(0, 1, At, B1); PG8_BAR; PG8_SCHED;
            PG8_LDA(At, 1, 1); PG8_STAGE(PG8_SB(1, 0), b3, voffB); PG8_STAGE(PG8_SB(1, 1), b3 + hstepB, voffB); PG8_STAGE(PG8_SA(1, 0), a3, voffA);
            PG8_WAIT_V(8); PG8_WAIT_L(0); PG8_BAR; PG8_MMA(1, 0, At, B0); PG8_MMA(1, 1, At, B1); PG8_BAR; PG8_SCHED;
        }
        if (wr == 0) PG8_BAR;
        E(acc, cur, wr, wc, fr, fq);
        if (!has_next) break;
#pragma unroll
        for (int a = 0; a < 2; ++a)
#pragma unroll
            for (int b = 0; b < 2; ++b)
#pragma unroll
                for (int m = 0; m < 4; ++m)
#pragma unroll
                    for (int n = 0; n < 2; ++n) acc[a][b][m][n] = (f32x4){0.f, 0.f, 0.f, 0.f};
        cur = nxt; cA = nA; cB = nB; ++ui;
        if (wr == 1) PG8_BAR;
    }
    PG8_WAIT_V(0);
    PG8_BAR;
#undef PG8_SA
#undef PG8_SB
#undef PG8_STAGE
#undef PG8_LDA
#undef PG8_LDB
#undef PG8_MMA
#undef PG8_WAIT_V
#undef PG8_WAIT_L
#undef PG8_BAR
#undef PG8_SCHED
}
}
using pg8::Unit;
typedef const f32x4 (&AccRef)[2][2][4][2];

struct EpiGU {
    const float* ss; bf16_t* H;
    __device__ __forceinline__ void operator()(AccRef acc, const Unit& u, int wr, int wc, int, int) const { const int lane_ = vlane(); const int fr = lane_ & 15, fq = lane_ >> 4;
#pragma unroll
        for (int ai = 0; ai < 2; ++ai)
#pragma unroll
            for (int m = 0; m < 4; ++m) {
                const int row = u.pm * 256 + ai * 128 + wr * 64 + m * 16 + fr;
                asm volatile("" ::: "memory");
                const float r = rs16(ss, row);
#pragma unroll
                for (int bj = 0; bj < 2; ++bj) {
                    const f32x4 g = acc[ai][bj][m][0] * r, v = acc[ai][bj][m][1] * r;
                    const float h0 = g.x * sigmoidf_(g.x) * v.x, h1 = g.y * sigmoidf_(g.y) * v.y, h2 = g.z * sigmoidf_(g.z) * v.z, h3 = g.w * sigmoidf_(g.w) * v.w;
                    u32x2 w; w.x = cvt_pk_bf16(h0, h1); w.y = cvt_pk_bf16(h2, h3);
                    *(u32x2*)(H + (size_t)row * FF + u.pn * 128 + bj * 64 + wc * 16 + fq * 4) = w;
                }
            }
    }
};
struct EpiRes {
    float* X; bf16_t* xb; float* ssOut; float alpha;
    __device__ __forceinline__ void operator()(AccRef acc, const Unit& u, int wr, int wc, int, int) const { const int lane_ = vlane(); const int fr = lane_ & 15, fq = lane_ >> 4;
#pragma unroll
        for (int ai = 0; ai < 2; ++ai)
#pragma unroll
            for (int m = 0; m < 4; ++m) {
                const int row = u.pm * 256 + ai * 128 + wr * 64 + m * 16 + fr;
                asm volatile("" ::: "memory");
                float sq = 0.f;
#pragma unroll
                for (int bj = 0; bj < 2; ++bj) {
                    const size_t off = (size_t)row * D + u.pn * 256 + bj * 128 + wc * 32 + fq * 8;
                    f32x4 x0 = *(const f32x4*)(X + off), x1 = *(const f32x4*)(X + off + 4);
                    x0 += acc[ai][bj][m][0] * alpha; x1 += acc[ai][bj][m][1] * alpha;
                    *(f32x4*)(X + off) = x0; *(f32x4*)(X + off + 4) = x1;
                    sq += dot4(x0) + dot4(x1);
                    u32x4 w; w.x = cvt_pk_bf16(x0.x, x0.y); w.y = cvt_pk_bf16(x0.z, x0.w); w.z = cvt_pk_bf16(x1.x, x1.y); w.w = cvt_pk_bf16(x1.z, x1.w);
                    *(u32x4*)(xb + off) = w;
                }
                sq += __shfl_xor(sq, 16); sq += __shfl_xor(sq, 32);
                if (fq == 0) ssOut[(size_t)row * 16 + u.pn * 4 + wc] = sq;
            }
    }
};
struct EpiGate {
    float* X; const float* ssIn; bf16_t* ppxb; float* ssOut;
    __device__ __forceinline__ void operator()(AccRef acc, const Unit& u, int wr, int wc, int, int) const { const int lane_ = vlane(); const int fr = lane_ & 15, fq = lane_ >> 4;
#pragma unroll
        for (int ai = 0; ai < 2; ++ai)
#pragma unroll
            for (int m = 0; m < 4; ++m) {
                const int row = u.pm * 256 + ai * 128 + wr * 64 + m * 16 + fr;
                asm volatile("" ::: "memory");
                const float r = rs16(ssIn, row);
                float sq = 0.f;
#pragma unroll
                for (int bj = 0; bj < 2; ++bj) {
                    const size_t off = (size_t)row * D + u.pn * 256 + bj * 128 + wc * 32 + fq * 8;
                    f32x4 x0 = *(const f32x4*)(X + off), x1 = *(const f32x4*)(X + off + 4);
                    const u32x4 pp = *(const u32x4*)(ppxb + off);
                    const f32x4 a0 = acc[ai][bj][m][0] * r, a1 = acc[ai][bj][m][1] * r;
                    x0.x += sigmoidf_(a0.x) * bf_lo(pp.x); x0.y += sigmoidf_(a0.y) * bf_hi(pp.x); x0.z += sigmoidf_(a0.z) * bf_lo(pp.y); x0.w += sigmoidf_(a0.w) * bf_hi(pp.y);
                    x1.x += sigmoidf_(a1.x) * bf_lo(pp.z); x1.y += sigmoidf_(a1.y) * bf_hi(pp.z); x1.z += sigmoidf_(a1.z) * bf_lo(pp.w); x1.w += sigmoidf_(a1.w) * bf_hi(pp.w);
                    *(f32x4*)(X + off) = x0; *(f32x4*)(X + off + 4) = x1;
                    sq += dot4(x0) + dot4(x1);
                    u32x4 w; w.x = cvt_pk_bf16(x0.x, x0.y); w.y = cvt_pk_bf16(x0.z, x0.w); w.z = cvt_pk_bf16(x1.x, x1.y); w.w = cvt_pk_bf16(x1.z, x1.w);
                    *(u32x4*)(ppxb + off) = w;
                }
                sq += __shfl_xor(sq, 16); sq += __shfl_xor(sq, 32);
                if (fq == 0) ssOut[(size_t)row * 16 + u.pn * 4 + wc] = sq;
            }
    }
};
__device__ __forceinline__ void rope_rot(f32x4& v0, f32x4& v1, const float* cs) {
    const f32x4 c = *(const f32x4*)cs, s = *(const f32x4*)(cs + 4);
    const f32x4 a = v0 * c - v1 * s, b = v1 * c + v0 * s; v0 = a; v1 = b;
}
struct EpiIn {
    const float* ss; bf16_t* z; float* mst; const float* cs64; const float* cs32;
    __device__ __forceinline__ void operator()(AccRef acc, const Unit& u, int wr, int wc, int, int) const { const int lane_ = vlane(); const int fr = lane_ & 15, fq = lane_ >> 4;
#pragma unroll
        for (int ai = 0; ai < 2; ++ai)
#pragma unroll
            for (int m = 0; m < 4; ++m) {
                const int row = u.pm * 256 + ai * 128 + wr * 64 + m * 16 + fr;
                asm volatile("" ::: "memory");
                const float r = rs16(ss, row);
                const int pos = row & (T - 1);
                float sq = 0.f;
#pragma unroll
                for (int bj = 0; bj < 2; ++bj) {
                    const int gcol = u.pn * 256 + bj * 128 + wc * 32;
                    f32x4 v0 = acc[ai][bj][m][0] * r, v1 = acc[ai][bj][m][1] * r;
                    const bool r64 = (gcol >= 512 && gcol < 896) || (gcol >= 1024 && gcol < 1536);
                    if (r64) rope_rot(v0, v1, cs64 + ((size_t)pos * 8 + 4 * ((gcol >> 5) & 1) + fq) * 8);
                    if (gcol == 1920) rope_rot(v0, v1, cs32 + ((size_t)pos * 4 + fq) * 8);
                    if (u.pn == 6 || (u.pn == 7 && bj == 0)) sq += dot4(v0) + dot4(v1);
                    u32x4 w; w.x = cvt_pk_bf16(v0.x, v0.y); w.y = cvt_pk_bf16(v0.z, v0.w); w.z = cvt_pk_bf16(v1.x, v1.y); w.w = cvt_pk_bf16(v1.z, v1.w);
                    *(u32x4*)(z + (size_t)row * ZLD + gcol + fq * 8) = w;
                }
                if (u.pn >= 6) {
                    sq += __shfl_xor(sq, 16); sq += __shfl_xor(sq, 32);
                    if (fq == 0) mst[(size_t)row * 8 + (u.pn - 6) * 4 + wc] = sq;
                }
            }
    }
};
struct EpiVT {
    const float* ss; bf16_t* vt; bf16_t* vt4; bf16_t* vt16;
    __device__ __forceinline__ void operator()(AccRef acc, const Unit& u, int wr, int wc, int, int) const { const int lane_ = vlane(); const int fr = lane_ & 15, fq = lane_ >> 4;
#pragma unroll
        for (int bj = 0; bj < 2; ++bj) {
            const int tok0 = u.pn * 256 + bj * 128 + wc * 32 + fq * 8;
            float rs[8];
#pragma unroll
            for (int e = 0; e < 8; ++e) rs[e] = rs16(ss, tok0 + e);
#pragma unroll
            for (int ai = 0; ai < 2; ++ai) {
                const int rbase = u.pm * 256 + ai * 128;
                if (rbase >= 640) continue;
                const bool dil = rbase >= 384;
#pragma unroll
                for (int m = 0; m < 4; ++m) {
                    const int row = rbase + wr * 64 + m * 16 + fr;
                    asm volatile("" ::: "memory");
                    const f32x4 a0 = acc[ai][bj][m][0], a1 = acc[ai][bj][m][1];
                    u32x4 w; w.x = cvt_pk_bf16(a0.x * rs[0], a0.y * rs[1]); w.y = cvt_pk_bf16(a0.z * rs[2], a0.w * rs[3]);
                    w.z = cvt_pk_bf16(a1.x * rs[4], a1.y * rs[5]); w.w = cvt_pk_bf16(a1.z * rs[6], a1.w * rs[7]);
                    *(u32x4*)(vt + (size_t)row * M + tok0) = w;
                    if (dil) {
                        const int dr = row - 384; const int bb = tok0 & ~(T - 1), t0 = tok0 & (T - 1);
                        bf16_t* p4 = vt4 + (size_t)dr * M + bb; bf16_t* p16 = vt16 + (size_t)dr * M + bb;
                        const unsigned ww[4] = {w.x, w.y, w.z, w.w};
#pragma unroll
                        for (int e = 0; e < 8; ++e) {
                            const int t = t0 + e; const bf16_t val = (bf16_t)((e & 1) ? (ww[e >> 1] >> 16) : (ww[e >> 1] & 0xffffu));
                            p4[(t & 3) * 512 + (t >> 2)] = val; p16[(t & 15) * 128 + (t >> 4)] = val;
                        }
                    }
                }
            }
        }
    }
};
struct EpiQ {
    const float* mst; bf16_t* qm; const float* cs32;
    __device__ __forceinline__ void operator()(AccRef acc, const Unit& u, int wr, int wc, int, int) const { const int lane_ = vlane(); const int fr = lane_ & 15, fq = lane_ >> 4;
#pragma unroll
        for (int ai = 0; ai < 2; ++ai)
#pragma unroll
            for (int m = 0; m < 4; ++m) {
                const int row = u.pm * 256 + ai * 128 + wr * 64 + m * 16 + fr;
                asm volatile("" ::: "memory");
                const f32x4 st = *(const f32x4*)(mst + (size_t)row * 8);
                const float r = rsqrtf(sum4(st) * (1.0f / 256.0f) + EPS);
                const int pos = row & (T - 1);
#pragma unroll
                for (int bj = 0; bj < 2; ++bj) {
                    const int gcol = u.pn * 256 + bj * 128 + wc * 32;
                    if (gcol >= 384) continue;
                    f32x4 v0 = acc[ai][bj][m][0] * r, v1 = acc[ai][bj][m][1] * r;
                    if (((gcol >> 5) % 3) == 2) rope_rot(v0, v1, cs32 + ((size_t)pos * 4 + fq) * 8);
                    u32x4 w; w.x = cvt_pk_bf16(v0.x, v0.y); w.y = cvt_pk_bf16(v0.z, v0.w); w.z = cvt_pk_bf16(v1.x, v1.y); w.w = cvt_pk_bf16(v1.z, v1.w);
                    *(u32x4*)(qm + (size_t)row * QLD + gcol + fq * 8) = w;
                }
            }
    }
};
struct EpiK {
    const float* mst; bf16_t* kn;
    __device__ __forceinline__ void operator()(AccRef acc, const Unit& u, int wr, int wc, int, int) const { const int lane_ = vlane(); const int fr = lane_ & 15, fq = lane_ >> 4;
#pragma unroll
        for (int ai = 0; ai < 2; ++ai)
#pragma unroll
            for (int m = 0; m < 4; ++m) {
                const int row = u.pm * 256 + ai * 128 + wr * 64 + m * 16 + fr;
                asm volatile("" ::: "memory");
                const f32x4 st = *(const f32x4*)(mst + (size_t)row * 8 + 4);
                const float r = rsqrtf(sum4(st) * (1.0f / 128.0f) + EPS);
#pragma unroll
                for (int bj = 0; bj < 2; ++bj) {
                    const f32x4 v0 = acc[ai][bj][m][0] * r, v1 = acc[ai][bj][m][1] * r;
                    u32x4 w; w.x = cvt_pk_bf16(v0.x, v0.y); w.y = cvt_pk_bf16(v0.z, v0.w); w.z = cvt_pk_bf16(v1.x, v1.y); w.w = cvt_pk_bf16(v1.z, v1.w);
                    *(u32x4*)(kn + (size_t)row * KNLD + bj * 128 + wc * 32 + fq * 8) = w;
                }
            }
    }
};
struct EpiVTM {
    const float* mst; bf16_t* vtm;
    __device__ __forceinline__ void operator()(AccRef acc, const Unit& u, int wr, int wc, int, int) const { const int lane_ = vlane(); const int fr = lane_ & 15, fq = lane_ >> 4;
#pragma unroll
        for (int bj = 0; bj < 2; ++bj) {
            const int tok0 = u.pn * 256 + bj * 128 + wc * 32 + fq * 8;
            float rs[8];
#pragma unroll
            for (int e = 0; e < 8; ++e) { const f32x4 st = *(const f32x4*)(mst + (size_t)(tok0 + e) * 8 + 4); rs[e] = rsqrtf(sum4(st) * (1.0f / 128.0f) + EPS); }
#pragma unroll
            for (int ai = 0; ai < 2; ++ai)
#pragma unroll
                for (int m = 0; m < 4; ++m) {
                    const int row = ai * 128 + wr * 64 + m * 16 + fr;
                    asm volatile("" ::: "memory");
                    const f32x4 a0 = acc[ai][bj][m][0], a1 = acc[ai][bj][m][1];
                    u32x4 w; w.x = cvt_pk_bf16(a0.x * rs[0], a0.y * rs[1]); w.y = cvt_pk_bf16(a0.z * rs[2], a0.w * rs[3]);
                    w.z = cvt_pk_bf16(a1.x * rs[4], a1.y * rs[5]); w.w = cvt_pk_bf16(a1.z * rs[6], a1.w * rs[7]);
                    *(u32x4*)(vtm + (size_t)row * M + tok0) = w;
                }
        }
    }
};
struct EpiPP {
    bf16_t* O;
    __device__ __forceinline__ void operator()(AccRef acc, const Unit& u, int wr, int wc, int, int) const { const int lane_ = vlane(); const int fr = lane_ & 15, fq = lane_ >> 4;
#pragma unroll
        for (int ai = 0; ai < 2; ++ai)
#pragma unroll
            for (int m = 0; m < 4; ++m) {
                const int row = u.pm * 256 + ai * 128 + wr * 64 + m * 16 + fr;
                asm volatile("" ::: "memory");
#pragma unroll
                for (int bj = 0; bj < 2; ++bj) {
                    const f32x4 v0 = acc[ai][bj][m][0], v1 = acc[ai][bj][m][1];
                    u32x4 w; w.x = cvt_pk_bf16(v0.x, v0.y); w.y = cvt_pk_bf16(v0.z, v0.w); w.z = cvt_pk_bf16(v1.x, v1.y); w.w = cvt_pk_bf16(v1.z, v1.w);
                    *(u32x4*)(O + (size_t)row * D + u.pn * 256 + bj * 128 + wc * 32 + fq * 8) = w;
                }
            }
    }
};

template <class Epi>
__device__ __forceinline__ void run_gemm(int wv, LAS unsigned char* lds, const bf16_t* A, int lda, int rows, const bf16_t* Bt, int ldb, int cols, int K, int cshift, const Epi& E) {
    pg8::Gemm g{A, Bt, lda, ldb, K};
    pg8::StaticOrder S; const int G_ = lgrid(); S.init(rows, cols, G_, (lbid() + cshift) % G_);
    pg8::gemm_phase<Epi>(lds, g, S, E, wv);
}

__device__ __forceinline__ int p64(int d) { return d < 32 ? 8 * (d >> 2) + (d & 3) : 8 * ((d - 32) >> 2) + 4 + (d & 3); }
__device__ __forceinline__ int p32(int d) { return d < 16 ? 8 * (d >> 2) + (d & 3) : 8 * ((d - 16) >> 2) + 4 + (d & 3); }
__device__ __forceinline__ int maprow(int mapid, int c) {
    switch (mapid) {
        case 0: return c;
        case 1: return (c >> 2) * 8 + (c & 3);
        case 2: return (c >> 2) * 8 + 4 + (c & 3);
        case 3: {
            if (c < 768) return c < 512 ? c : 2048 + (c - 512);
            c -= 768;
            if (c < 512) return c < 384 ? 512 + (c >> 6) * 64 + p64(c & 63) : 2048 + 256 + (c - 384);
            c -= 512;
            if (c < 768) return c < 512 ? 1024 + (c >> 6) * 64 + p64(c & 63) : 2048 + 384 + (c - 512);
            c -= 768;
            if (c < 256) return 1536 + c;
            if (c < 384) return 1792 + (c - 256);
            return 1920 + p32(c - 384);
        }
        case 4: { const int h = c / 96, e = c % 96; return e < 64 ? 96 * h + e : 96 * h + 64 + p32(e - 64); }
        default: { const int h = c >> 7, e = c & 127; return e < 64 ? 64 * h + e : 256 + 64 * h + (e - 64); }
    }
}
__device__ __forceinline__ void tr_item(const float* W, int K, int N, const float* gain, bf16_t* dst, int mapid, int item, LAS float* s, int wv) {
    const int tid = ltid(wv);
    const int ncb = (N + 255) >> 8, kb = item / ncb, cb = item % ncb, k0 = kb * 64, c0 = cb * 256;
#pragma unroll
    for (int i = 0; i < 8; ++i) {
        const int kk = i * 8 + (tid >> 6), col = (tid & 63) * 4;
        f32x4 v = (f32x4){0.f, 0.f, 0.f, 0.f};
        if (c0 + col < N) v = *(const f32x4*)(W + (size_t)(k0 + kk) * N + c0 + col);
        if (gain) v *= gain[k0 + kk];
        *(LAS f32x4*)(s + kk * 260 + col) = v;
    }
    __syncthreads();
    const int cc = tid & 255, kh = tid >> 8, c = c0 + cc;
    if (c < N) {
        const int drow = maprow(mapid, c);
        bf16_t* o = dst + (size_t)drow * K + k0 + kh * 32;
#pragma unroll
        for (int q = 0; q < 4; ++q) {
            const LAS float* sp = s + (kh * 32 + q * 8) * 260 + cc;
            u32x4 w; w.x = cvt_pk_bf16(sp[0], sp[260]); w.y = cvt_pk_bf16(sp[2 * 260], sp[3 * 260]); w.z = cvt_pk_bf16(sp[4 * 260], sp[5 * 260]); w.w = cvt_pk_bf16(sp[6 * 260], sp[7 * 260]);
            *(u32x4*)(o + q * 8) = w;
        }
    }
    __syncthreads();
}

struct Args { const float* in[24]; float* out; unsigned char* ws; int ph_lo, ph_hi, coop, pad; };
typedef const __attribute__((address_space(4))) Args* KA;
__device__ __forceinline__ KA kargs() { KA p = (KA)__builtin_amdgcn_kernarg_segment_ptr(); asm volatile("" : "+s"(p)); return p; }

__device__ __forceinline__ void zero_rows(bf16_t* base, int row0, int nrows, int K, int gt, int ngt) {
    const size_t n16 = (size_t)nrows * K / 8; u32x4* p = (u32x4*)(base + (size_t)row0 * K);
    for (size_t i = gt; i < n16; i += ngt) p[i] = (u32x4){0u, 0u, 0u, 0u};
}

__device__ __forceinline__ void prologue(KA a, LAS unsigned char* lds, int wv) {
    LAS float* s = (LAS float*)lds;
    const int G = lgrid(), bid = lbid(), tid = ltid(wv);
    bf16_t* Wbase = (bf16_t*)(a->ws + OFF_W);
#if PRO_PARTS & 1
    constexpr int I_FFN = 16 * 11, I_DN = 44 * 4, I_IN = 16 * 10, I_UQ = 4 * 2, I_UKV = 2 * 2, I_O = 16 * 4, I_PP = 4 * 4;
    constexpr int I_LAYER = 4 * I_FFN + 2 * I_DN + I_IN + I_UQ + I_UKV + 2 * I_O + I_PP;
    for (int it = bid; it < I_LAYER * DEPTH; it += G) {
        const int l = it / I_LAYER; int r = it % I_LAYER;
        int sel = 0;
        if (r >= I_FFN) { r -= I_FFN; sel = 1;
        if (r >= I_FFN) { r -= I_FFN; sel = 2;
        if (r >= I_DN) { r -= I_DN; sel = 3;
        if (r >= I_IN) { r -= I_IN; sel = 4;
        if (r >= I_UQ) { r -= I_UQ; sel = 5;
        if (r >= I_UKV) { r -= I_UKV; sel = 6;
        if (r >= I_O) { r -= I_O; sel = 7;
        if (r >= I_FFN) { r -= I_FFN; sel = 8;
        if (r >= I_FFN) { r -= I_FFN; sel = 9;
        if (r >= I_DN) { r -= I_DN; sel = 10;
        if (r >= I_O) { r -= I_O; sel = 11; } } } } } } } } } } }
        const float* W0; const float* g0 = nullptr; int K, N, mapid; size_t doff;
        switch (sel) {
            case 0: W0 = a->in[3]; g0 = a->in[2]; K = D; N = FF; doff = WL_GU1; mapid = 1; break;
            case 1: W0 = a->in[4]; g0 = a->in[2]; K = D; N = FF; doff = WL_GU1; mapid = 2; break;
            case 2: W0 = a->in[5]; K = FF; N = D; doff = WL_D1; mapid = 0; break;
            case 3: W0 = a->in[7]; g0 = a->in[6]; K = D; N = 2464; doff = WL_IN; mapid = 3; break;
            case 4: W0 = a->in[11]; g0 = a->in[10]; K = 256; N = 384; doff = WL_UQ; mapid = 4; break;
            case 5: W0 = a->in[13]; g0 = a->in[12]; K = 128; N = 512; doff = WL_UKV; mapid = 5; break;
            case 6: W0 = a->in[15]; g0 = a->in[14]; K = D; N = D; doff = WL_O; mapid = 0; break;
            case 7: W0 = a->in[17]; g0 = a->in[16]; K = D; N = FF; doff = WL_GU2; mapid = 1; break;
            case 8: W0 = a->in[18]; g0 = a->in[16]; K = D; N = FF; doff = WL_GU2; mapid = 2; break;
            case 9: W0 = a->in[19]; K = FF; N = D; doff = WL_D2; mapid = 0; break;
            case 10: W0 = a->in[21]; g0 = a->in[20]; K = D; N = D; doff = WL_PG; mapid = 0; break;
            default: W0 = a->in[22]; K = PLE; N = D; doff = WL_PP; mapid = 0; break;
        }
        const float* W = W0 + (size_t)l * K * N;
        const float* gain = g0 ? g0 + (size_t)l * K : nullptr;
        tr_item(W, K, N, gain, Wbase + (size_t)l * WL_SIZE + doff, mapid, r, s, wv);
    }
#endif
    const int gt = bid * 512 + tid, ngt = G * 512;
    for (int l = 0; l < DEPTH; ++l) {
        bf16_t* WL = Wbase + (size_t)l * WL_SIZE;
        zero_rows(WL + WL_IN, 896, 128, D, gt, ngt); zero_rows(WL + WL_IN, 1952, 96, D, gt, ngt); zero_rows(WL + WL_IN, 2048 + 640, 128, D, gt, ngt);
        zero_rows(WL + WL_UQ, 384, 128, 256, gt, ngt);
    }
#if PRO_PARTS & 2
    float* cs64 = (float*)(a->ws + OFF_CS64); float* cs32 = (float*)(a->ws + OFF_CS32);
    for (int i = gt; i < T * 32; i += ngt) {
        const int pos = i >> 5, j = i & 31;
        const float inv = __builtin_amdgcn_exp2f(-(float)j * (13.287712379549449f / 32.0f)); const float ang = (float)pos * inv;
        const float rev = ang * 0.15915494309189535f, fr_ = rev - floorf(rev);
        float* p = cs64 + ((size_t)pos * 8 + (j >> 2)) * 8 + (j & 3);
        p[0] = __builtin_amdgcn_cosf(fr_); p[4] = __builtin_amdgcn_sinf(fr_);
    }
    for (int i = gt; i < T * 16; i += ngt) {
        const int pos = i >> 4, j = i & 15;
        const float inv = __builtin_amdgcn_exp2f(-(float)j * (13.287712379549449f / 16.0f)); const float ang = (float)pos * inv;
        const float rev = ang * 0.15915494309189535f, fr_ = rev - floorf(rev);
        float* p = cs32 + ((size_t)pos * 4 + (j >> 2)) * 8 + (j & 3);
        p[0] = __builtin_amdgcn_cosf(fr_); p[4] = __builtin_amdgcn_sinf(fr_);
    }
#endif
#if PRO_PARTS & 4
    const int lane = tid & 63, gw = bid * 8 + (tid >> 6), ngw = G * 8;
    bf16_t* xb = (bf16_t*)(a->ws + OFF_XBA); float* ss = (float*)(a->ws + OFF_SSA);
    for (int row = gw; row < M; row += ngw) {
        const f32x4* xr = (const f32x4*)(a->in[0] + (size_t)row * D) + lane; f32x4* orow = (f32x4*)(a->out + (size_t)row * D) + lane;
        float sq = 0.f;
#pragma unroll
        for (int j = 0; j < 4; ++j) {
            const f32x4 v = xr[64 * j]; orow[64 * j] = v; sq += dot4(v);
            u32x2 w; w.x = cvt_pk_bf16(v.x, v.y); w.y = cvt_pk_bf16(v.z, v.w);
            *(u32x2*)(xb + (size_t)row * D + 256 * j + lane * 4) = w;
        }
#pragma unroll
        for (int o = 1; o < 64; o <<= 1) sq += __shfl_xor(sq, o);
        if (lane < 16) ss[(size_t)row * 16 + lane] = lane == 0 ? sq : 0.f;
    }
#endif
}

__device__ __forceinline__ void convert_p(KA a, int layer, int wv) {
    const f32x4* src = (const f32x4*)(a->in[1] + (size_t)layer * M * PLE); u32x2* dst = (u32x2*)(a->ws + OFF_VT);
    const size_t n = (size_t)M * PLE / 4;
    const int tid_ = ltid(wv), bid_ = lbid(), G_ = lgrid();
    for (size_t i = (size_t)bid_ * 512 + tid_; i < n; i += (size_t)G_ * 512) {
        const f32x4 v = src[i]; u32x2 w; w.x = cvt_pk_bf16(v.x, v.y); w.y = cvt_pk_bf16(v.z, v.w); dst[i] = w;
    }
}

__device__ __forceinline__ void final_norm(KA a, int wv) {
    const int tid_ = ltid(wv); const int lane = tid_ & 63, gw = lbid() * 8 + (tid_ >> 6), ngw = lgrid() * 8;
    const float* ss = (const float*)(a->ws + OFF_SSA);
    f32x4 g[4];
#pragma unroll
    for (int j = 0; j < 4; ++j) g[j] = ((const f32x4*)a->in[23])[64 * j + lane];
    for (int row = gw; row < M; row += ngw) {
        const float r = rs16(ss, row);
        f32x4* orow = (f32x4*)(a->out + (size_t)row * D) + lane;
#pragma unroll
        for (int j = 0; j < 4; ++j) orow[64 * j] = orow[64 * j] * r * g[j];
    }
}

struct AttnP { const unsigned char* ws; const float* nab; const float* sink; };

template <int MODE>
__device__ __forceinline__ void attn_unit(const AttnP& P0, int unit, LAS float* xch, int wv) {
    const unsigned char* ws = P0.ws; asm volatile("" : "+s"(ws));
    const bf16_t* Pz = (const bf16_t*)(ws + OFF_H);
    constexpr int NS = MODE == 0 ? 6 : 4;
    const int lane = vlane(), w = wv, qs = w >> 2, h = w & 3, ql = lane & 31, hh = lane >> 5;
    const int b = unit >> 5, rem = unit & 31;
    int qt, T0 = 0, rr = 0;
    if (MODE == 1) { T0 = 512 * (rem >> 3); rr = 2 * (rem & 7) + qs; qt = T0 + rr + 16 * ql; }
    else qt = 64 * rem + 32 * qs + ql;
    const size_t tokbase = (size_t)b * T;
    const bf16_t* qrow; const bf16_t* kbase_p; int ldk; const bf16_t* vnat; int group;
    if (MODE == 0) { qrow = (const bf16_t*)(ws + OFF_QM) + (tokbase + qt) * QLD + 96 * h; kbase_p = (const bf16_t*)(ws + OFF_KN) + tokbase * KNLD + 64 * h; ldk = KNLD; vnat = (const bf16_t*)(ws + OFF_VTM) + (size_t)(64 * h) * M + tokbase; group = 3; }
    else if (MODE == 1) { qrow = Pz + (tokbase + qt) * ZLD + 1024 + 64 * h; kbase_p = Pz + tokbase * ZLD + 1280 + 64 * h; ldk = ZLD; vnat = (const bf16_t*)(ws + OFF_VT) + (size_t)(384 + 64 * h) * M + tokbase; group = 2; }
    else if (MODE == 2) { qrow = Pz + (tokbase + qt) * ZLD + 64 * h; kbase_p = Pz + tokbase * ZLD + 256 + 64 * h; ldk = ZLD; vnat = (const bf16_t*)(ws + OFF_VT) + (size_t)(64 * h) * M + tokbase; group = 0; }
    else { qrow = Pz + (tokbase + qt) * ZLD + 512 + 64 * h; kbase_p = Pz + tokbase * ZLD + 768 + 64 * (h >> 1); ldk = ZLD; vnat = (const bf16_t*)(ws + OFF_VT) + (size_t)(256 + 64 * (h >> 1)) * M + tokbase; group = 1; }
    bf16x8 qf[NS];
#pragma unroll
    for (int s = 0; s < NS; ++s) qf[s] = *(const bf16x8*)(qrow + 16 * s + 8 * hh);
    const float sc = (MODE == 0 ? 0.10206207261596577f : 0.125f) * LOG2E;
    f32x16 o0, o1;
#pragma unroll
    for (int e = 0; e < 16; ++e) { o0[e] = 0.f; o1[e] = 0.f; }
    float mrun = -1e20f, lrun = 0.f;
    if (MODE == 3) { mrun = P0.sink[h] * LOG2E; lrun = hh == 0 ? 1.f : 0.f; }
    const int qrow_g = qt >> 6, qcol = qt & 63;
    const int nseg = MODE == 1 ? 3 : 1;
    for (int seg = 0; seg < nseg; ++seg) {
        int ntile, kb0, kstr, vb0, win; const bf16_t* vt = vnat;
        if (MODE == 0) { ntile = 64; kb0 = 0; kstr = 1; vb0 = 0; win = 1 << 20; }
        else if (MODE == 2) { ntile = 16; kb0 = 0; kstr = 1; vb0 = 0; win = 0; }
        else if (MODE == 3) { ntile = 9; kb0 = 64 * rem + 32 * qs - 128; kstr = 1; vb0 = kb0; win = 128; }
        else {
            if (seg == 0) { ntile = 20; kb0 = T0 - 64; kstr = 1; vb0 = kb0; win = 64; }
            else if (seg == 1) { ntile = 8; const int us = (T0 >> 2) - 64, r4 = rr & 3; kb0 = 4 * us + r4; kstr = 4; vb0 = r4 * 512 + us; win = 256; vt = (const bf16_t*)(ws + OFF_VT4) + (size_t)(64 * h) * M + tokbase; }
            else { ntile = 5; const int nst = (T0 >> 4) - 64; kb0 = 16 * nst + rr; kstr = 16; vb0 = rr * 128 + nst; win = 1024; vt = (const bf16_t*)(ws + OFF_VT16) + (size_t)(64 * h) * M + tokbase; }
        }
        for (int tau = 0; tau < ntile; ++tau) {
            int kb, vb;
            if (MODE == 2) { const int r0 = min(max(qrow_g - 4, 0), 24); kb = 64 * (r0 + (tau >> 1)) + 32 * (tau & 1); vb = kb; }
            else { kb = kb0 + 32 * kstr * tau; vb = vb0 + 32 * tau; }
            if (MODE == 1 || MODE == 3) { if (kb + 31 * kstr < 0 || kb >= T) continue; }
            const int ktl = min(max(kb + kstr * ql, 0), T - 1);
            const bf16_t* krow = kbase_p + (size_t)ktl * ldk;
            bf16x8 kf[NS];
#pragma unroll
            for (int s = 0; s < NS; ++s) {
                if (MODE == 0 && s >= 4) kf[s] = *(const bf16x8*)(Pz + (tokbase + ktl) * ZLD + 1920 + 16 * (s - 4) + 8 * hh);
                else kf[s] = *(const bf16x8*)(krow + 16 * s + 8 * hh);
            }
            bf16x8 vf[2][2];
#pragma unroll
            for (int t = 0; t < 2; ++t) {
                const int p0 = min(max(vb + 16 * t + 4 * hh, 0), T - 4), p1 = min(max(vb + 16 * t + 8 + 4 * hh, 0), T - 4);
#pragma unroll
                for (int db = 0; db < 2; ++db) {
                    const bf16_t* vr = vt + (size_t)(32 * db + ql) * M;
                    const u32x2 lo = *(const u32x2*)(vr + p0), hi = *(const u32x2*)(vr + p1);
                    u32x4 v; v.x = lo.x; v.y = lo.y; v.z = hi.x; v.w = hi.y;
                    vf[db][t] = __builtin_bit_cast(bf16x8, v);
                }
            }
            f32x16 sacc;
#pragma unroll
            for (int e = 0; e < 16; ++e) sacc[e] = 0.f;
#pragma unroll
            for (int s = 0; s < NS; ++s) sacc = __builtin_amdgcn_mfma_f32_32x32x16_bf16(kf[s], qf[s], sacc, 0, 0, 0);
            float tmax = -1e30f;
#pragma unroll
            for (int e = 0; e < 16; ++e) {
                const int kt = kb + kstr * (8 * (e >> 2) + 4 * hh + (e & 3));
                float v = sacc[e] * sc;
                if (MODE == 2) {
                    const int kcol = kt & 63, wsx = min(max(qcol - 8, 0), 48);
                    const bool ok = kcol >= wsx && kcol < wsx + 16;
                    const int drow = (kt >> 6) - qrow_g + 7, dcol = min(max(kcol - qcol, -15), 15) + 15;
                    const float bias = P0.nab[(h * 15 + drow) * 31 + dcol] * LOG2E;
                    v = ok ? v + bias : -1e30f;
                } else if (MODE != 0) {
                    const int dlt = kt - qt;
                    const bool ok = (unsigned)kt < (unsigned)T && dlt <= win && dlt >= -win;
                    v = ok ? v : -1e30f;
                }
                sacc[e] = v; tmax = fmaxf(tmax, v);
            }
            tmax = fmaxf(tmax, __shfl_xor(tmax, 32));
            const float mnew = fmaxf(mrun, tmax), alpha = __builtin_amdgcn_exp2f(mrun - mnew);
            mrun = mnew;
            float psum = 0.f;
#pragma unroll
            for (int e = 0; e < 16; ++e) { const float p = __builtin_amdgcn_exp2f(sacc[e] - mnew); sacc[e] = p; psum += p; }
            lrun = lrun * alpha + psum;
#pragma unroll
            for (int e = 0; e < 16; ++e) { o0[e] *= alpha; o1[e] *= alpha; }
            bf16x8 pb[2];
#pragma unroll
            for (int t = 0; t < 2; ++t) {
                u32x4 v; v.x = cvt_pk_bf16(sacc[8 * t + 0], sacc[8 * t + 1]); v.y = cvt_pk_bf16(sacc[8 * t + 2], sacc[8 * t + 3]);
                v.z = cvt_pk_bf16(sacc[8 * t + 4], sacc[8 * t + 5]); v.w = cvt_pk_bf16(sacc[8 * t + 6], sacc[8 * t + 7]);
                pb[t] = __builtin_bit_cast(bf16x8, v);
            }
            o0 = __builtin_amdgcn_mfma_f32_32x32x16_bf16(vf[0][0], pb[0], o0, 0, 0, 0);
            o0 = __builtin_amdgcn_mfma_f32_32x32x16_bf16(vf[0][1], pb[1], o0, 0, 0, 0);
            o1 = __builtin_amdgcn_mfma_f32_32x32x16_bf16(vf[1][0], pb[0], o1, 0, 0, 0);
            o1 = __builtin_amdgcn_mfma_f32_32x32x16_bf16(vf[1][1], pb[1], o1, 0, 0, 0);
        }
    }
    lrun += __shfl_xor(lrun, 32);
    const float inv = 1.0f / lrun;
    float sq = 0.f;
#pragma unroll
    for (int e = 0; e < 16; ++e) { o0[e] *= inv; o1[e] *= inv; sq += o0[e] * o0[e] + o1[e] * o1[e]; }
    sq += __shfl_xor(sq, 32);
    if (hh == 0) xch[w * 32 + ql] = sq;
    __syncthreads();
    const float tot = (xch[(qs * 4 + 0) * 32 + ql] + xch[(qs * 4 + 1) * 32 + ql]) + (xch[(qs * 4 + 2) * 32 + ql] + xch[(qs * 4 + 3) * 32 + ql]);
    const float rg = rsqrtf(tot * (1.0f / 256.0f) + EPS);
    bf16_t* yrow = (bf16_t*)(ws + OFF_XBA) + (tokbase + qt) * D + group * 256 + h * 64 + 4 * hh;
#pragma unroll
    for (int j = 0; j < 4; ++j) {
        u32x2 w0; w0.x = cvt_pk_bf16(o0[4 * j] * rg, o0[4 * j + 1] * rg); w0.y = cvt_pk_bf16(o0[4 * j + 2] * rg, o0[4 * j + 3] * rg);
        u32x2 w1; w1.x = cvt_pk_bf16(o1[4 * j] * rg, o1[4 * j + 1] * rg); w1.y = cvt_pk_bf16(o1[4 * j + 2] * rg, o1[4 * j + 3] * rg);
        *(u32x2*)(yrow + 8 * j) = w0; *(u32x2*)(yrow + 32 + 8 * j) = w1;
    }
}

__device__ __forceinline__ void attn_phase(KA a, int layer, LAS unsigned char* lds, int wv) {
    AttnP P; P.ws = a->ws; P.nab = a->in[8] + (size_t)layer * 4 * 15 * 31; P.sink = a->in[9] + layer * 4;
    LAS float* xch = (LAS float*)lds;
    int it = 0;
    const int G_ = lgrid();
    for (int u = lbid(); u < 2048; u += G_, ++it) {
        LAS float* x = xch + (it & 1) * 256;
        const int mode = u >> 9, unit = u & 511;
        if (mode == 0) attn_unit<0>(P, unit, x, wv);
        else if (mode == 1) attn_unit<1>(P, unit, x, wv);
        else if (mode == 2) attn_unit<2>(P, unit, x, wv);
        else attn_unit<3>(P, unit, x, wv);
    }
    __syncthreads();
}

__device__ __forceinline__ void grid_bar(unsigned* ctr, unsigned target, int wv) {
    asm volatile("s_waitcnt vmcnt(0) lgkmcnt(0)" ::: "memory");
    __builtin_amdgcn_s_barrier();
    if (wv == 0) {
        if (vlane() == 0) {
            __builtin_amdgcn_fence(__ATOMIC_RELEASE, "agent");
            asm volatile("s_waitcnt vmcnt(0)" ::: "memory");
            __hip_atomic_fetch_add(ctr, 1u, __ATOMIC_RELAXED, __HIP_MEMORY_SCOPE_AGENT);
            unsigned spins = 0;
            while (__hip_atomic_load(ctr, __ATOMIC_RELAXED, __HIP_MEMORY_SCOPE_AGENT) < target) { __builtin_amdgcn_s_sleep(2); if (++spins > (1u << 26)) break; }
            __builtin_amdgcn_fence(__ATOMIC_ACQUIRE, "agent");
            asm volatile("s_waitcnt vmcnt(0)" ::: "memory");
        }
    }
    __builtin_amdgcn_s_barrier();
    asm volatile("" ::: "memory");
}

template <int PH>
__device__ __forceinline__ void run_phase(LAS unsigned char* lds, int wv) {
    KA a = kargs();
    unsigned char* ws = a->ws; asm volatile("" : "+s"(ws));
    bf16_t* Wbase = (bf16_t*)(ws + OFF_W);
    bf16_t* xbA = (bf16_t*)(ws + OFF_XBA); bf16_t* xbB = (bf16_t*)(ws + OFF_XBB);
    bf16_t* Hb = (bf16_t*)(ws + OFF_H); bf16_t* zb = Hb; bf16_t* qm = (bf16_t*)(ws + OFF_QM); bf16_t* kn = (bf16_t*)(ws + OFF_KN);
    bf16_t* vt = (bf16_t*)(ws + OFF_VT); bf16_t* vt4 = (bf16_t*)(ws + OFF_VT4); bf16_t* vt16 = (bf16_t*)(ws + OFF_VT16); bf16_t* vtm = (bf16_t*)(ws + OFF_VTM);
    bf16_t* pb = (bf16_t*)(ws + OFF_VT);
    float* ssA = (float*)(ws + OFF_SSA); float* ssB = (float*)(ws + OFF_SSB); float* mst = (float*)(ws + OFF_MST);
    const float* cs64 = (const float*)(ws + OFF_CS64); const float* cs32 = (const float*)(ws + OFF_CS32);
    if constexpr (PH == 0) { if (PH_ON(0)) prologue(a, lds, wv); }
    else if constexpr (PH == NPH - 1) { if (PH_ON(1)) final_norm(a, wv); }
    else {
        constexpr int l = (PH - 1) / 9, k = (PH - 1) % 9;
        bf16_t* WL = Wbase + (size_t)l * WL_SIZE;
        if constexpr (k == 0) { if (PH_ON(2)) { EpiGU E{ssA, Hb}; run_gemm(wv, lds, xbA, D, M, WL + WL_GU1, D, 5632, D, 0, E); } }
        else if constexpr (k == 1) { if (PH_ON(3)) { EpiRes E{a->out, xbB, ssB, 0.5f}; run_gemm(wv, lds, Hb, FF, M, WL + WL_D1, FF, D, FF, 0, E); } }
        else if constexpr (k == 2) {
            if (PH_ON(4)) { EpiIn E{ssB, zb, mst, cs64, cs32}; run_gemm(wv, lds, xbB, D, M, WL + WL_IN, D, 2048, D, 0, E); }
            if (PH_ON(5)) { EpiVT E{ssB, vt, vt4, vt16}; run_gemm(wv, lds, WL + WL_IN + (size_t)2048 * D, D, 768, xbB, D, M, D, 0, E); }
        }
        else if constexpr (k == 3) {
            if (PH_ON(6)) { EpiQ E{mst, qm, cs32}; run_gemm(wv, lds, zb + 1536, ZLD, M, WL + WL_UQ, 256, 512, 256, 0, E); }
            if (PH_ON(7)) { EpiK E{mst, kn}; run_gemm(wv, lds, zb + 1792, ZLD, M, WL + WL_UKV, 128, 256, 128, 0, E); }
            if (PH_ON(8)) { EpiVTM E{mst, vtm}; run_gemm(wv, lds, WL + WL_UKV + (size_t)256 * 128, 128, 256, zb + 1792, ZLD, M, 128, 128, E); }
        }
        else if constexpr (k == 4) { if (PH_ON(9)) attn_phase(a, l, lds, wv); }
        else if constexpr (k == 5) { if (PH_ON(3)) { EpiRes E{a->out, xbB, ssB, 1.0f}; run_gemm(wv, lds, xbA, D, M, WL + WL_O, D, D, D, 0, E); } }
        else if constexpr (k == 6) { if (PH_ON(2)) { convert_p(a, l, wv); EpiGU E{ssB, Hb}; run_gemm(wv, lds, xbB, D, M, WL + WL_GU2, D, 5632, D, 0, E); } }
        else if constexpr (k == 7) {
            if (PH_ON(3)) { EpiRes E{a->out, xbB, ssB, 0.5f}; run_gemm(wv, lds, Hb, FF, M, WL + WL_D2, FF, D, FF, 0, E); }
            if (PH_ON(10)) { EpiPP E{xbA}; run_gemm(wv, lds, pb, PLE, M, WL + WL_PP, PLE, D, PLE, 0, E); }
        }
        else { if (PH_ON(11)) { EpiGate E{a->out, ssB, xbA, ssA}; run_gemm(wv, lds, xbB, D, M, WL + WL_PG, D, D, D, 0, E); } }
    }
}
template <int PH>
__device__ __forceinline__ void run_from(LAS unsigned char* lds, int ph_lo, int ph_hi, int wv) {
    if constexpr (PH < NPH) {
        if (PH >= ph_lo && PH < ph_hi) {
            run_phase<PH>(lds, wv);
            if (PH + 1 < ph_hi && kargs()->coop) {
                if constexpr (PH == 0) cg::this_grid().sync();
                else grid_bar((unsigned*)(kargs()->ws + OFF_BAR), (unsigned)PH * (unsigned)lgrid(), wv);
            }
        }
        run_from<PH + 1>(lds, ph_lo, ph_hi, wv);
    }
}
__global__ void __launch_bounds__(512, 2) mega(Args a_unused) {
    extern __shared__ __attribute__((aligned(16))) unsigned char lds_raw[];
    LAS unsigned char* lds = (LAS unsigned char*)lds_raw;
    const int ph_lo = kargs()->ph_lo, ph_hi = kargs()->ph_hi;
    const int wv = __builtin_amdgcn_readfirstlane((int)threadIdx.x >> 6);
    run_from<0>(lds, ph_lo, ph_hi, wv);
}

extern "C" void kernel_launch(void* const* d_in, const int* in_sizes, int n_in, void* d_out, int out_size, void* d_ws, size_t ws_size, hipStream_t stream) {
    static int grid = 0;
    if (grid == 0) {
        if (n_in != 24 || ws_size < WS_END) { fprintf(stderr, "kernel_launch: n_in %d ws %zu (need %zu)\n", n_in, ws_size, (size_t)WS_END); grid = -1; return; }
        int dev = 0, cus = 0, per_cu = 0;
        hipGetDevice(&dev); hipDeviceGetAttribute(&cus, hipDeviceAttributeMultiprocessorCount, dev);
        if (hipFuncSetAttribute((const void*)mega, hipFuncAttributeMaxDynamicSharedMemorySize, LDS_BYTES) != hipSuccess) { fprintf(stderr, "hipFuncSetAttribute failed\n"); grid = -1; return; }
        if (hipOccupancyMaxActiveBlocksPerMultiprocessor(&per_cu, (const void*)mega, 512, LDS_BYTES) != hipSuccess || per_cu < 1) per_cu = 1;
        (void)hipGetLastError();
        grid = cus * per_cu;
    }
    if (grid < 0) return;
    (void)hipMemsetAsync((char*)d_ws + OFF_BAR, 0, 256, stream);
    Args a{};
    for (int i = 0; i < 24; ++i) a.in[i] = (const float*)d_in[i];
    a.out = (float*)d_out; a.ws = (unsigned char*)d_ws;
#if MULTI_LAUNCH
    for (int ph = 0; ph < NPH; ++ph) {
        a.ph_lo = ph; a.ph_hi = ph + 1; a.coop = 0;
        hipLaunchKernelGGL(mega, dim3(grid), dim3(512), LDS_BYTES, stream, a);
    }
#else
    a.ph_lo = 0; a.ph_hi = NPH; a.coop = 1;
    void* args[] = {&a};
    hipError_t e = hipLaunchCooperativeKernel((void*)mega, dim3(grid), dim3(512), args, LDS_BYTES, stream);
    if (e != hipSuccess) fprintf(stderr, "cooperative launch failed: %s (grid %d)\n", hipGetErrorString(e), grid);
#endif
}
```

```cpp
#include <hip/hip_runtime.h>
#include <hip/hip_cooperative_groups.h>
#include <cstdio>
#include <cstdint>
namespace cg = cooperative_groups;

#ifndef MULTI_LAUNCH
#define MULTI_LAUNCH 0
#endif

#ifndef PRO_PARTS
#define PRO_PARTS 7
#endif
#ifndef PHM
#define PHM 0xffff
#endif
#define PH_ON(b) (((PHM) >> (b)) & 1)
#define LAS __attribute__((address_space(3)))
typedef unsigned short bf16_t;
typedef short bf16x8 __attribute__((ext_vector_type(8)));
typedef float f32x4 __attribute__((ext_vector_type(4)));
typedef float f32x16 __attribute__((ext_vector_type(16)));
typedef unsigned u32x4 __attribute__((ext_vector_type(4)));
typedef unsigned u32x2 __attribute__((ext_vector_type(2)));

constexpr int M = 32768, T = 2048, D = 1024, FF = 2816, DEPTH = 4, PLE = 256;
constexpr int ZLD = 2048, QLD = 384, KNLD = 256;
constexpr float EPS = 1e-6f;
constexpr float LOG2E = 1.4426950408889634f;

constexpr size_t WL_GU1 = 0, WL_D1 = WL_GU1 + (size_t)5632 * 1024, WL_IN = WL_D1 + (size_t)1024 * 2816, WL_UQ = WL_IN + (size_t)2816 * 1024,
                 WL_UKV = WL_UQ + (size_t)512 * 256, WL_O = WL_UKV + (size_t)512 * 128, WL_GU2 = WL_O + (size_t)1024 * 1024, WL_D2 = WL_GU2 + (size_t)5632 * 1024,
                 WL_PG = WL_D2 + (size_t)1024 * 2816, WL_PP = WL_PG + (size_t)1024 * 1024, WL_SIZE = WL_PP + (size_t)1024 * 256;
constexpr size_t OFF_W = 0;
constexpr size_t OFF_XBA = OFF_W + WL_SIZE * 2 * DEPTH;
constexpr size_t OFF_XBB = OFF_XBA + (size_t)M * D * 2;
constexpr size_t OFF_H = OFF_XBB + (size_t)M * D * 2;
constexpr size_t OFF_QM = OFF_H + (size_t)M * ZLD * 2;
constexpr size_t OFF_KN = OFF_QM + (size_t)M * QLD * 2;
constexpr size_t OFF_VT = OFF_H + (size_t)M * FF * 2;
constexpr size_t OFF_VT4 = OFF_VT + (size_t)640 * M * 2;
constexpr size_t OFF_VT16 = OFF_VT4 + (size_t)256 * M * 2;
constexpr size_t OFF_VTM = OFF_VT16 + (size_t)256 * M * 2;
constexpr size_t OFF_SSA = OFF_VTM + (size_t)256 * M * 2;
constexpr size_t OFF_SSB = OFF_SSA + (size_t)M * 16 * 4;
constexpr size_t OFF_MST = OFF_SSB + (size_t)M * 16 * 4;
constexpr size_t OFF_CS64 = OFF_MST + (size_t)M * 8 * 4;
constexpr size_t OFF_CS32 = OFF_CS64 + (size_t)T * 64 * 4;
constexpr size_t OFF_BAR = OFF_CS32 + (size_t)T * 32 * 4;
constexpr size_t WS_END = OFF_BAR + 256;
static_assert(OFF_KN + (size_t)M * KNLD * 2 <= OFF_VT, "z|qm|kn inside the H region");

constexpr int LDS_BYTES = 147456;
constexpr int NPH = 2 + 9 * DEPTH;

__device__ __forceinline__ unsigned cvt_pk_bf16(float lo, float hi) { unsigned r; asm("v_cvt_pk_bf16_f32 %0, %1, %2" : "=v"(r) : "v"(lo), "v"(hi)); return r; }
__device__ __forceinline__ float bf_lo(unsigned u) { return __uint_as_float(u << 16); }
__device__ __forceinline__ float bf_hi(unsigned u) { return __uint_as_float(u & 0xffff0000u); }
__device__ __forceinline__ float sum4(f32x4 a) { return (a.x + a.y) + (a.z + a.w); }
__device__ __forceinline__ float dot4(f32x4 a) { return (a.x * a.x + a.y * a.y) + (a.z * a.z + a.w * a.w); }
__device__ __forceinline__ float rs16(const float* ss, int row) {
    const f32x4* p = (const f32x4*)(ss + (size_t)row * 16);
    const f32x4 a = p[0], b = p[1], c = p[2], d = p[3];
    return rsqrtf(((sum4(a) + sum4(b)) + (sum4(c) + sum4(d))) * (1.0f / 1024.0f) + EPS);
}
__device__ __forceinline__ int vlane() { int l; asm volatile("v_mbcnt_lo_u32_b32 %0, -1, 0\n\tv_mbcnt_hi_u32_b32 %0, -1, %0" : "=v"(l)); return l; }
__device__ __forceinline__ int ltid(int wv) { return (wv << 6) | vlane(); }
__device__ __forceinline__ int lbid() { int b = blockIdx.x; asm volatile("" : "+s"(b)); return b; }
__device__ __forceinline__ int lgrid() { int g = gridDim.x; asm volatile("" : "+s"(g)); return g; }
__device__ __forceinline__ float sigmoidf_(float v) { return __builtin_amdgcn_rcpf(1.0f + __expf(-v)); }

namespace pg8 {
constexpr int BM = 256, BK = 64, HALF = 128, HTB = HALF * BK * 2, STAGE_BYTES = 8 * HTB, NXCD = 8, WGM = 8;
__host__ __device__ __forceinline__ int lds_byte(int r, int c) { const int st = (r >> 4) * 2 + (c >> 5), rr = r & 15, cc = c & 31, ob = rr * 64 + cc * 2; return st * 1024 + (ob ^ (((ob >> 9) & 1) << 5)); }
__host__ __device__ __forceinline__ void stage_rc(int b, int& R, int& C) { const int st = b / 1024, sb = b % 1024, swz = sb ^ (((sb >> 9) & 1) << 5); R = (st >> 1) * 16 + swz / 64; C = (st & 1) * 32 + (swz % 64) / 2; }
__host__ __device__ __forceinline__ int perm32(int rho) { const int n = rho >> 4, i = rho & 15; return 8 * (i >> 2) + 4 * n + (i & 3); }

struct Unit { int pm, pn; };
struct Gemm { const bf16_t* A; const bf16_t* Bt; int lda, ldb, K; };

struct StaticOrder {
    int nM, nN, nwg, G, c;
    __device__ void init(int Mr, int Nc, int G_, int c_) { nM = Mr / BM; nN = Nc / BM; nwg = nM * nN; G = G_; c = c_; }
    __device__ bool next(int i, Unit& u) const {
        const long L = (long)i * G + c; if (L >= nwg) return false;
        int wgid = (int)L; { const int q = nwg / NXCD, r = nwg % NXCD, xcd = wgid % NXCD, off = wgid / NXCD; wgid = (xcd < r ? xcd * (q + 1) : r * (q + 1) + (xcd - r) * q) + off; }
        const int nig = WGM * nN, gid = wgid / nig, fm = gid * WGM, gsz = (nM - fm) < WGM ? (nM - fm) : WGM;
        u.pm = fm + ((wgid % nig) % gsz); u.pn = (wgid % nig) / gsz; return true;
    }
};

template <class Epi>
__device__ __forceinline__ void gemm_phase(LAS unsigned char* lds, const Gemm g, const StaticOrder& S, const Epi& E, int wv) {
    const int tid = ltid(wv);
    const int wid = wv, lane = tid & 63, wr = wid >> 2, wc = wid & 3, fr = lane & 15, fq = lane >> 4;
    const int K = g.K, nt = K / BK;
    unsigned voffA[2], voffB[2];
#pragma unroll
    for (int i = 0; i < 2; ++i) { int R, C; stage_rc(tid * 16 + i * 8192, R, C); const int Rb = (R & ~31) + perm32(R & 31);
        voffA[i] = (unsigned)(R * g.lda + C) * 2u; voffB[i] = (unsigned)(Rb * g.ldb + C) * 2u; }
    const size_t kstep = (size_t)(BK * 2);
    const size_t hstepA = (size_t)HALF * g.lda * 2, hstepB = (size_t)HALF * g.ldb * 2;
    const size_t tstepA = 2 * hstepA, tstepB = 2 * hstepB;
    const unsigned ldsw = (unsigned)wid * 1024u;
    const int aoff = lds_byte(wr * 64 + fr, fq * 8), boff = lds_byte(wc * 32 + fr, fq * 8);
#define PG8_SA(b, h) (((b) * 2 + (h)) * HTB)
#define PG8_SB(b, h) ((4 + (b) * 2 + (h)) * HTB)
#define PG8_STAGE(bufoff, gbase, voff) do { _Pragma("unroll") for (int _i = 0; _i < 2; ++_i) \
        __builtin_amdgcn_global_load_lds((const unsigned*)((const char*)(gbase) + (voff)[_i]), (LAS unsigned*)(lds + (bufoff) + ldsw + _i * 8192), 16, 0, 0); } while (0)
#define PG8_LDA(dst, b, h) do { _Pragma("unroll") for (int m = 0; m < 4; ++m) _Pragma("unroll") for (int k = 0; k < 2; ++k) dst[m][k] = *(const LAS bf16x8*)(lds + PG8_SA(b, h) + aoff + m * 2048 + k * 1024); } while (0)
#define PG8_LDB(dst, b, h) do { _Pragma("unroll") for (int n = 0; n < 2; ++n) _Pragma("unroll") for (int k = 0; k < 2; ++k) dst[n][k] = *(const LAS bf16x8*)(lds + PG8_SB(b, h) + boff + n * 2048 + k * 1024); } while (0)
#define PG8_MMA(ai, bj, At, Bt) do { __builtin_amdgcn_s_setprio(1); _Pragma("unroll") for (int m = 0; m < 4; ++m) _Pragma("unroll") for (int n = 0; n < 2; ++n) _Pragma("unroll") for (int k = 0; k < 2; ++k) \
        acc[ai][bj][m][n] = __builtin_amdgcn_mfma_f32_16x16x32_bf16(Bt[n][k], At[m][k], acc[ai][bj][m][n], 0, 0, 0); __builtin_amdgcn_s_setprio(0); } while (0)
#define PG8_WAIT_V(n) asm volatile("s_waitcnt vmcnt(" #n ")" ::: "memory")
#define PG8_WAIT_L(n) asm volatile("s_waitcnt lgkmcnt(" #n ")" ::: "memory")
#define PG8_BAR __builtin_amdgcn_s_barrier()
#define PG8_SCHED __builtin_amdgcn_sched_barrier(0)
    Unit cur, nxt; int ui = 0;
    if (!S.next(0, cur)) return;
    f32x4 acc[2][2][4][2];
#pragma unroll
    for (int a = 0; a < 2; ++a)
#pragma unroll
        for (int b = 0; b < 2; ++b)
#pragma unroll
            for (int m = 0; m < 4; ++m)
#pragma unroll
                for (int n = 0; n < 2; ++n) acc[a][b][m][n] = (f32x4){0.f, 0.f, 0.f, 0.f};
    bf16x8 At[4][2], B0[2][2], B1[2][2];
    const char* cA = (const char*)g.A + (size_t)cur.pm * tstepA; const char* cB = (const char*)g.Bt + (size_t)cur.pn * tstepB;
    PG8_STAGE(PG8_SB(0, 0), cB, voffB); PG8_STAGE(PG8_SB(0, 1), cB + hstepB, voffB); PG8_STAGE(PG8_SA(0, 0), cA, voffA); PG8_STAGE(PG8_SA(0, 1), cA + hstepA, voffA);
    if (wr == 1) PG8_BAR;
    PG8_WAIT_V(2); PG8_BAR;
    PG8_STAGE(PG8_SB(1, 0), cB + kstep, voffB); PG8_STAGE(PG8_SA(1, 0), cA + kstep, voffA); PG8_STAGE(PG8_SB(1, 1), cB + hstepB + kstep, voffB);
    PG8_WAIT_V(6); PG8_BAR;
    for (;;) {
        const bool has_next = S.next(ui + 1, nxt);
        const char* nA = has_next ? (const char*)g.A + (size_t)nxt.pm * tstepA : cA; const char* nB = has_next ? (const char*)g.Bt + (size_t)nxt.pn * tstepB : cB;
        for (int t = 0; t < nt; t += 2) {
            const bool last = (t == nt - 2);
            const char* a1 = cA + (size_t)(t + 1) * kstep;
            const char* a2 = last ? nA : cA + (size_t)(t + 2) * kstep; const char* b2 = last ? nB : cB + (size_t)(t + 2) * kstep;
            const char* a3 = a2 + kstep; const char* b3 = b2 + kstep;
            PG8_LDB(B0, 0, 0); PG8_LDB(B1, 0, 1); PG8_SCHED; PG8_LDA(At, 0, 0); PG8_STAGE(PG8_SA(1, 1), a1 + hstepA, voffA);
            PG8_WAIT_V(8); PG8_WAIT_L(0); PG8_BAR; PG8_MMA(0, 0, At, B0); PG8_MMA(0, 1, At, B1); PG8_BAR; PG8_SCHED;
            PG8_LDA(At, 0, 1); PG8_STAGE(PG8_SB(0, 0), b2, voffB); PG8_STAGE(PG8_SB(0, 1), b2 + hstepB, voffB); PG8_STAGE(PG8_SA(0, 0), a2, voffA);
            PG8_WAIT_V(8); PG8_WAIT_L(0); PG8_BAR; PG8_MMA(1, 0, At, B0); PG8_MMA(1, 1, At, B1); PG8_BAR; PG8_SCHED;
            PG8_LDB(B0, 1, 0); PG8_LDB(B1, 1, 1); PG8_SCHED; PG8_LDA(At, 1, 0); PG8_STAGE(PG8_SA(0, 1), a2 + hstepA, voffA);
            PG8_WAIT_V(8); PG8_WAIT_L(0); PG8_BAR; PG8_MMA(0, 0, At, B0); PG8_MMA(0, 1, At, B1); PG8_BAR; PG8_SCHED;
            PG8_LDA(At, 1, 1); PG8_STAGE(PG8_SB(1, 0), b3, voffB); PG8_STAGE(PG8_SB(1, 1), b3 + hstepB, voffB); PG8_STAGE(PG8_SA(1, 0), a3, voffA);
            PG8_WAIT_V(8); PG8_WAIT_L(0); PG8_BAR; PG8_MMA(1, 0, At, B0); PG8_MMA(1, 1, At, B1); PG8_BAR; PG8_SCHED;
        }
        if (wr == 0) PG8_BAR;
        E(acc, cur, wr, wc, fr, fq);
        if (!has_next) break;
#pragma unroll
        for (int a = 0; a < 2; ++a)
#pragma unroll
            for (int b = 0; b < 2; ++b)
#pragma unroll
                for (int m = 0; m < 4; ++m)
#pragma unroll
                    for (int n = 0; n < 2; ++n) acc[a][b][m][n] = (f32x4){0.f, 0.f, 0.f, 0.f};
        cur = nxt; cA = nA; cB = nB; ++ui;
        if (wr == 1) PG8_BAR;
    }
    PG8_WAIT_V(0);
    PG8_BAR;
#undef PG8_SA
#undef PG8_SB
#undef PG8_STAGE
#undef PG8_LDA
#undef PG8_LDB
#undef PG8_MMA
#undef PG8_WAIT_V
#undef PG8_WAIT_L
#undef PG8_BAR
#undef PG8_SCHED
}
}
using pg8::Unit;
typedef const f32x4 (&AccRef)[2][2][4][2];

struct EpiGU {
    const float* ss; bf16_t* H;
    __device__ __forceinline__ void operator()(AccRef acc, const Unit& u, int wr, int wc, int, int) const { const int lane_ = vlane(); const int fr = lane_ & 15, fq = lane_ >> 4;
#pragma unroll
        for (int ai = 0; ai < 2; ++ai)
#pragma unroll
            for (int m = 0; m < 4; ++m) {
                const int row = u.pm * 256 + ai * 128 + wr * 64 + m * 16 + fr;
                asm volatile("" ::: "memory");
                const float r = rs16(ss, row);
#pragma unroll
                for (int bj = 0; bj < 2; ++bj) {
                    const f32x4 g = acc[ai][bj][m][0] * r, v = acc[ai][bj][m][1] * r;
                    const float h0 = g.x * sigmoidf_(g.x) * v.x, h1 = g.y * sigmoidf_(g.y) * v.y, h2 = g.z * sigmoidf_(g.z) * v.z, h3 = g.w * sigmoidf_(g.w) * v.w;
                    u32x2 w; w.x = cvt_pk_bf16(h0, h1); w.y = cvt_pk_bf16(h2, h3);
                    *(u32x2*)(H + (size_t)row * FF + u.pn * 128 + bj * 64 + wc * 16 + fq * 4) = w;
                }
            }
    }
};
struct EpiRes {
    float* X; bf16_t* xb; float* ssOut; float alpha;
    __device__ __forceinline__ void operator()(AccRef acc, const Unit& u, int wr, int wc, int, int) const { const int lane_ = vlane(); const int fr = lane_ & 15, fq = lane_ >> 4;
#pragma unroll
        for (int ai = 0; ai < 2; ++ai)
#pragma unroll
            for (int m = 0; m < 4; ++m) {
                const int row = u.pm * 256 + ai * 128 + wr * 64 + m * 16 + fr;
                asm volatile("" ::: "memory");
                float sq = 0.f;
#pragma unroll
                for (int bj = 0; bj < 2; ++bj) {
                    const size_t off = (size_t)row * D + u.pn * 256 + bj * 128 + wc * 32 + fq * 8;
                    f32x4 x0 = *(const f32x4*)(X + off), x1 = *(const f32x4*)(X + off + 4);
                    x0 += acc[ai][bj][m][0] * alpha; x1 += acc[ai][bj][m][1] * alpha;
                    *(f32x4*)(X + off) = x0; *(f32x4*)(X + off + 4) = x1;
                    sq += dot4(x0) + dot4(x1);
                    u32x4 w; w.x = cvt_pk_bf16(x0.x, x0.y); w.y = cvt_pk_bf16(x0.z, x0.w); w.z = cvt_pk_bf16(x1.x, x1.y); w.w = cvt_pk_bf16(x1.z, x1.w);
                    *(u32x4*)(xb + off) = w;
                }
                sq += __shfl_xor(sq, 16); sq += __shfl_xor(sq, 32);
                if (fq == 0) ssOut[(size_t)row * 16 + u.pn * 4 + wc] = sq;
            }
    }
};
struct EpiGate {
    float* X; const float* ssIn; bf16_t* ppxb; float* ssOut;
    __device__ __forceinline__ void operator()(AccRef acc, const Unit& u, int wr, int wc, int, int) const { const int lane_ = vlane(); const int fr = lane_ & 15, fq = lane_ >> 4;
#pragma unroll
        for (int ai = 0; ai < 2; ++ai)
#pragma unroll
            for (int m = 0; m < 4; ++m) {
                const int row = u.pm * 256 + ai * 128 + wr * 64 + m * 16 + fr;
                asm volatile("" ::: "memory");
                const float r = rs16(ssIn, row);
                float sq = 0.f;
#pragma unroll
                for (int bj = 0; bj < 2; ++bj) {
                    const size_t off = (size_t)row * D + u.pn * 256 + bj * 128 + wc * 32 + fq * 8;
                    f32x4 x0 = *(const f32x4*)(X + off), x1 = *(const f32x4*)(X + off + 4);
                    const u32x4 pp = *(const u32x4*)(ppxb + off);
                    const f32x4 a0 = acc[ai][bj][m][0] * r, a1 = acc[ai][bj][m][1] * r;
                    x0.x += sigmoidf_(a0.x) * bf_lo(pp.x); x0.y += sigmoidf_(a0.y) * bf_hi(pp.x); x0.z += sigmoidf_(a0.z) * bf_lo(pp.y); x0.w += sigmoidf_(a0.w) * bf_hi(pp.y);
                    x1.x += sigmoidf_(a1.x) * bf_lo(pp.z); x1.y += sigmoidf_(a1.y) * bf_hi(pp.z); x1.z += sigmoidf_(a1.z) * bf_lo(pp.w); x1.w += sigmoidf_(a1.w) * bf_hi(pp.w);
                    *(f32x4*)(X + off) = x0; *(f32x4*)(X + off + 4) = x1;
                    sq += dot4(x0) + dot4(x1);
                    u32x4 w; w.x = cvt_pk_bf16(x0.x, x0.y); w.y = cvt_pk_bf16(x0.z, x0.w); w.z = cvt_pk_bf16(x1.x, x1.y); w.w = cvt_pk_bf16(x1.z, x1.w);
                    *(u32x4*)(ppxb + off) = w;
                }
                sq += __shfl_xor(sq, 16); sq += __shfl_xor(sq, 32);
                if (fq == 0) ssOut[(size_t)row * 16 + u.pn * 4 + wc] = sq;
            }
    }
};
__device__ __forceinline__ void rope_rot(f32x4& v0, f32x4& v1, const float* cs) {
    const f32x4 c = *(const f32x4*)cs, s = *(const f32x4*)(cs + 4);
    const f32x4 a = v0 * c - v1 * s, b = v1 * c + v0 * s; v0 = a; v1 = b;
}
struct EpiIn {
    const float* ss; bf16_t* z; float* mst; const float* cs64; const float* cs32;
    __device__ __forceinline__ void operator()(AccRef acc, const Unit& u, int wr, int wc, int, int) const { const int lane_ = vlane(); const int fr = lane_ & 15, fq = lane_ >> 4;
#pragma unroll
        for (int ai = 0; ai < 2; ++ai)
#pragma unroll
            for (int m = 0; m < 4; ++m) {
                const int row = u.pm * 256 + ai * 128 + wr * 64 + m * 16 + fr;
                asm volatile("" ::: "memory");
                const float r = rs16(ss, row);
                const int pos = row & (T - 1);
                float sq = 0.f;
#pragma unroll
                for (int bj = 0; bj < 2; ++bj) {
                    const int gcol = u.pn * 256 + bj * 128 + wc * 32;
                    f32x4 v0 = acc[ai][bj][m][0] * r, v1 = acc[ai][bj][m][1] * r;
                    const bool r64 = (gcol >= 512 && gcol < 896) || (gcol >= 1024 && gcol < 1536);
                    if (r64) rope_rot(v0, v1, cs64 + ((size_t)pos * 8 + 4 * ((gcol >> 5) & 1) + fq) * 8);
                    if (gcol == 1920) rope_rot(v0, v1, cs32 + ((size_t)pos * 4 + fq) * 8);
                    if (u.pn == 6 || (u.pn == 7 && bj == 0)) sq += dot4(v0) + dot4(v1);
                    u32x4 w; w.x = cvt_pk_bf16(v0.x, v0.y); w.y = cvt_pk_bf16(v0.z, v0.w); w.z = cvt_pk_bf16(v1.x, v1.y); w.w = cvt_pk_bf16(v1.z, v1.w);
                    *(u32x4*)(z + (size_t)row * ZLD + gcol + fq * 8) = w;
                }
                if (u.pn >= 6) {
                    sq += __shfl_xor(sq, 16); sq += __shfl_xor(sq, 32);
                    if (fq == 0) mst[(size_t)row * 8 + (u.pn - 6) * 4 + wc] = sq;
                }
            }
    }
};
struct EpiVT {
    const float* ss; bf16_t* vt; bf16_t* vt4; bf16_t* vt16;
    __device__ __forceinline__ void operator()(AccRef acc, const Unit& u, int wr, int wc, int, int) const { const int lane_ = vlane(); const int fr = lane_ & 15, fq = lane_ >> 4;
#pragma unroll
        for (int bj = 0; bj < 2; ++bj) {
            const int tok0 = u.pn * 256 + bj * 128 + wc * 32 + fq * 8;
            float rs[8];
#pragma unroll
            for (int e = 0; e < 8; ++e) rs[e] = rs16(ss, tok0 + e);
#pragma unroll
            for (int ai = 0; ai < 2; ++ai) {
                const int rbase = u.pm * 256 + ai * 128;
                if (rbase >= 640) continue;
                const bool dil = rbase >= 384;
#pragma unroll
                for (int m = 0; m < 4; ++m) {
                    const int row = rbase + wr * 64 + m * 16 + fr;
                    asm volatile("" ::: "memory");
                    const f32x4 a0 = acc[ai][bj][m][0], a1 = acc[ai][bj][m][1];
                    u32x4 w; w.x = cvt_pk_bf16(a0.x * rs[0], a0.y * rs[1]); w.y = cvt_pk_bf16(a0.z * rs[2], a0.w * rs[3]);
                    w.z = cvt_pk_bf16(a1.x * rs[4], a1.y * rs[5]); w.w = cvt_pk_bf16(a1.z * rs[6], a1.w * rs[7]);
                    *(u32x4*)(vt + (size_t)row * M + tok0) = w;
                    if (dil) {
                        const int dr = row - 384; const int bb = tok0 & ~(T - 1), t0 = tok0 & (T - 1);
                        bf16_t* p4 = vt4 + (size_t)dr * M + bb; bf16_t* p16 = vt16 + (size_t)dr * M + bb;
                        const unsigned ww[4] = {w.x, w.y, w.z, w.w};
#pragma unroll
                        for (int e = 0; e < 8; ++e) {
                            const int t = t0 + e; const bf16_t val = (bf16_t)((e & 1) ? (ww[e >> 1] >> 16) : (ww[e >> 1] & 0xffffu));
                            p4[(t & 3) * 512 + (t >> 2)] = val; p16[(t & 15) * 128 + (t >> 4)] = val;
                        }
                    }
                }
            }
        }
    }
};
struct EpiQ {
    const float* mst; bf16_t* qm; const float* cs32;
    __device__ __forceinline__ void operator()(AccRef acc, const Unit& u, int wr, int wc, int, int) const { const int lane_ = vlane(); const int fr = lane_ & 15, fq = lane_ >> 4;
#pragma unroll
        for (int ai = 0; ai < 2; ++ai)
#pragma unroll
            for (int m = 0; m < 4; ++m) {
                const int row = u.pm * 256 + ai * 128 + wr * 64 + m * 16 + fr;
                asm volatile("" ::: "memory");
                const f32x4 st = *(const f32x4*)(mst + (size_t)row * 8);
                const float r = rsqrtf(sum4(st) * (1.0f / 256.0f) + EPS);
                const int pos = row & (T - 1);
#pragma unroll
                for (int bj = 0; bj < 2; ++bj) {
                    const int gcol = u.pn * 256 + bj * 128 + wc * 32;
                    if (gcol >= 384) continue;
                    f32x4 v0 = acc[ai][bj][m][0] * r, v1 = acc[ai][bj][m][1] * r;
                    if (((gcol >> 5) % 3) == 2) rope_rot(v0, v1, cs32 + ((size_t)pos * 4 + fq) * 8);
                    u32x4 w; w.x = cvt_pk_bf16(v0.x, v0.y); w.y = cvt_pk_bf16(v0.z, v0.w); w.z = cvt_pk_bf16(v1.x, v1.y); w.w = cvt_pk_bf16(v1.z, v1.w);
                    *(u32x4*)(qm + (size_t)row * QLD + gcol + fq * 8) = w;
                }
            }
    }
};
struct EpiK {
    const float* mst; bf16_t* kn;
    __device__ __forceinline__ void operator()(AccRef acc, const Unit& u, int wr, int wc, int, int) const { const int lane_ = vlane(); const int fr = lane_ & 15, fq = lane_ >> 4;
#pragma unroll
        for (int ai = 0; ai < 2; ++ai)
#pragma unroll
            for (int m = 0; m < 4; ++m) {
                const int row = u.pm * 256 + ai * 128 + wr * 64 + m * 16 + fr;
                asm volatile("" ::: "memory");
                const f32x4 st = *(const f32x4*)(mst + (size_t)row * 8 + 4);
                const float r = rsqrtf(sum4(st) * (1.0f / 128.0f) + EPS);
#pragma unroll
                for (int bj = 0; bj < 2; ++bj) {
                    const f32x4 v0 = acc[ai][bj][m][0] * r, v1 = acc[ai][bj][m][1] * r;
                    u32x4 w; w.x = cvt_pk_bf16(v0.x, v0.y); w.y = cvt_pk_bf16(v0.z, v0.w); w.z = cvt_pk_bf16(v1.x, v1.y); w.w = cvt_pk_bf16(v1.z, v1.w);
                    *(u32x4*)(kn + (size_t)row * KNLD + bj * 128 + wc * 32 + fq * 8) = w;
                }
            }
    }
};
struct EpiVTM {
    const float* mst; bf16_t* vtm;
    __device__ __forceinline__ void operator()(AccRef acc, const Unit& u, int wr, int wc, int, int) const { const int lane_ = vlane(); const int fr = lane_ & 15, fq = lane_ >> 4;
#pragma unroll
        for (int bj = 0; bj < 2; ++bj) {
            const int tok0 = u.pn * 256 + bj * 128 + wc * 32 + fq * 8;
            float rs[8];
#pragma unroll
            for (int e = 0; e < 8; ++e) { const f32x4 st = *(const f32x4*)(mst + (size_t)(tok0 + e) * 8 + 4); rs[e] = rsqrtf(sum4(st) * (1.0f / 128.0f) + EPS); }
#pragma unroll
            for (int ai = 0; ai < 2; ++ai)
#pragma unroll
                for (int m = 0; m < 4; ++m) {
                    const int row = ai * 128 + wr * 64 + m * 16 + fr;
                    asm volatile("" ::: "memory");
                    const f32x4 a0 = acc[ai][bj][m][0], a1 = acc[ai][bj][m][1];
                    u32x4 w; w.x = cvt_pk_bf16(a0.x * rs[0], a0.y * rs[1]); w.y = cvt_pk_bf16(a0.z * rs[2], a0.w * rs[3]);
                    w.z = cvt_pk_bf16(a1.x * rs[4], a1.y * rs[5]); w.w = cvt_pk_bf16(a1.z * rs[6], a1.w * rs[7]);
                    *(u32x4*)(vtm + (size_t)row * M + tok0) = w;
                }
        }
    }
};
struct EpiPP {
    bf16_t* O;
    __device__ __forceinline__ void operator()(AccRef acc, const Unit& u, int wr, int wc, int, int) const { const int lane_ = vlane(); const int fr = lane_ & 15, fq = lane_ >> 4;
#pragma unroll
        for (int ai = 0; ai < 2; ++ai)
#pragma unroll
            for (int m = 0; m < 4; ++m) {
                const int row = u.pm * 256 + ai * 128 + wr * 64 + m * 16 + fr;
                asm volatile("" ::: "memory");
#pragma unroll
                for (int bj = 0; bj < 2; ++bj) {
                    const f32x4 v0 = acc[ai][bj][m][0], v1 = acc[ai][bj][m][1];
                    u32x4 w; w.x = cvt_pk_bf16(v0.x, v0.y); w.y = cvt_pk_bf16(v0.z, v0.w); w.z = cvt_pk_bf16(v1.x, v1.y); w.w = cvt_pk_bf16(v1.z, v1.w);
                    *(u32x4*)(O + (size_t)row * D + u.pn * 256 + bj * 128 + wc * 32 + fq * 8) = w;
                }
            }
    }
};

template <class Epi>
__device__ __forceinline__ void run_gemm(int wv, LAS unsigned char* lds, const bf16_t* A, int lda, int rows, const bf16_t* Bt, int ldb, int cols, int K, int cshift, const Epi& E) {
    pg8::Gemm g{A, Bt, lda, ldb, K};
    pg8::StaticOrder S; const int G_ = lgrid(); S.init(rows, cols, G_, (lbid() + cshift) % G_);
    pg8::gemm_phase<Epi>(lds, g, S, E, wv);
}

__device__ __forceinline__ int p64(int d) { return d < 32 ? 8 * (d >> 2) + (d & 3) : 8 * ((d - 32) >> 2) + 4 + (d & 3); }
__device__ __forceinline__ int p32(int d) { return d < 16 ? 8 * (d >> 2) + (d & 3) : 8 * ((d - 16) >> 2) + 4 + (d & 3); }
__device__ __forceinline__ int maprow(int mapid, int c) {
    switch (mapid) {
        case 0: return c;
        case 1: return (c >> 2) * 8 + (c & 3);
        case 2: return (c >> 2) * 8 + 4 + (c & 3);
        case 3: {
            if (c < 768) return c < 512 ? c : 2048 + (c - 512);
            c -= 768;
            if (c < 512) return c < 384 ? 512 + (c >> 6) * 64 + p64(c & 63) : 2048 + 256 + (c - 384);
            c -= 512;
            if (c < 768) return c < 512 ? 1024 + (c >> 6) * 64 + p64(c & 63) : 2048 + 384 + (c - 512);
            c -= 768;
            if (c < 256) return 1536 + c;
            if (c < 384) return 1792 + (c - 256);
            return 1920 + p32(c - 384);
        }
        case 4: { const int h = c / 96, e = c % 96; return e < 64 ? 96 * h + e : 96 * h + 64 + p32(e - 64); }
        default: { const int h = c >> 7, e = c & 127; return e < 64 ? 64 * h + e : 256 + 64 * h + (e - 64); }
    }
}
__device__ __forceinline__ void tr_item(const float* W, int K, int N, const float* gain, bf16_t* dst, int mapid, int item, LAS float* s, int wv) {
    const int tid = ltid(wv);
    const int ncb = (N + 255) >> 8, kb = item / ncb, cb = item % ncb, k0 = kb * 64, c0 = cb * 256;
#pragma unroll
    for (int i = 0; i < 8; ++i) {
        const int kk = i * 8 + (tid >> 6), col = (tid & 63) * 4;
        f32x4 v = (f32x4){0.f, 0.f, 0.f, 0.f};
        if (c0 + col < N) v = *(const f32x4*)(W + (size_t)(k0 + kk) * N + c0 + col);
        if (gain) v *= gain[k0 + kk];
        *(LAS f32x4*)(s + kk * 260 + col) = v;
    }
    __syncthreads();
    const int cc = tid & 255, kh = tid >> 8, c = c0 + cc;
    if (c < N) {
        const int drow = maprow(mapid, c);
        bf16_t* o = dst + (size_t)drow * K + k0 + kh * 32;
#pragma unroll
        for (int q = 0; q < 4; ++q) {
            const LAS float* sp = s + (kh * 32 + q * 8) * 260 + cc;
            u32x4 w; w.x = cvt_pk_bf16(sp[0], sp[260]); w.y = cvt_pk_bf16(sp[2 * 260], sp[3 * 260]); w.z = cvt_pk_bf16(sp[4 * 260], sp[5 * 260]); w.w = cvt_pk_bf16(sp[6 * 260], sp[7 * 260]);
            *(u32x4*)(o + q * 8) = w;
        }
    }
    __syncthreads();
}

struct Args { const float* in[24]; float* out; unsigned char* ws; int ph_lo, ph_hi, coop, pad; };
typedef const __attribute__((address_space(4))) Args* KA;
__device__ __forceinline__ KA kargs() { KA p = (KA)__builtin_amdgcn_kernarg_segment_ptr(); asm volatile("" : "+s"(p)); return p; }

__device__ __forceinline__ void zero_rows(bf16_t* base, int row0, int nrows, int K, int gt, int ngt) {
    const size_t n16 = (size_t)nrows * K / 8; u32x4* p = (u32x4*)(base + (size_t)row0 * K);
    for (size_t i = gt; i < n16; i += ngt) p[i] = (u32x4){0u, 0u, 0u, 0u};
}

__device__ __forceinline__ void prologue(KA a, LAS unsigned char* lds, int wv) {
    LAS float* s = (LAS float*)lds;
    const int G = lgrid(), bid = lbid(), tid = ltid(wv);
    bf16_t* Wbase = (bf16_t*)(a->ws + OFF_W);
#if PRO_PARTS & 1
    constexpr int I_FFN = 16 * 11, I_DN = 44 * 4, I_IN = 16 * 10, I_UQ = 4 * 2, I_UKV = 2 * 2, I_O = 16 * 4, I_PP = 4 * 4;
    constexpr int I_LAYER = 4 * I_FFN + 2 * I_DN + I_IN + I_UQ + I_UKV + 2 * I_O + I_PP;
    for (int it = bid; it < I_LAYER * DEPTH; it += G) {
        const int l = it / I_LAYER; int r = it % I_LAYER;
        int sel = 0;
        if (r >= I_FFN) { r -= I_FFN; sel = 1;
        if (r >= I_FFN) { r -= I_FFN; sel = 2;
        if (r >= I_DN) { r -= I_DN; sel = 3;
        if (r >= I_IN) { r -= I_IN; sel = 4;
        if (r >= I_UQ) { r -= I_UQ; sel = 5;
        if (r >= I_UKV) { r -= I_UKV; sel = 6;
        if (r >= I_O) { r -= I_O; sel = 7;
        if (r >= I_FFN) { r -= I_FFN; sel = 8;
        if (r >= I_FFN) { r -= I_FFN; sel = 9;
        if (r >= I_DN) { r -= I_DN; sel = 10;
        if (r >= I_O) { r -= I_O; sel = 11; } } } } } } } } } } }
        const float* W0; const float* g0 = nullptr; int K, N, mapid; size_t doff;
        switch (sel) {
            case 0: W0 = a->in[3]; g0 = a->in[2]; K = D; N = FF; doff = WL_GU1; mapid = 1; break;
            case 1: W0 = a->in[4]; g0 = a->in[2]; K = D; N = FF; doff = WL_GU1; mapid = 2; break;
            case 2: W0 = a->in[5]; K = FF; N = D; doff = WL_D1; mapid = 0; break;
            case 3: W0 = a->in[7]; g0 = a->in[6]; K = D; N = 2464; doff = WL_IN; mapid = 3; break;
            case 4: W0 = a->in[11]; g0 = a->in[10]; K = 256; N = 384; doff = WL_UQ; mapid = 4; break;
            case 5: W0 = a->in[13]; g0 = a->in[12]; K = 128; N = 512; doff = WL_UKV; mapid = 5; break;
            case 6: W0 = a->in[15]; g0 = a->in[14]; K = D; N = D; doff = WL_O; mapid = 0; break;
            case 7: W0 = a->in[17]; g0 = a->in[16]; K = D; N = FF; doff = WL_GU2; mapid = 1; break;
            case 8: W0 = a->in[18]; g0 = a->in[16]; K = D; N = FF; doff = WL_GU2; mapid = 2; break;
            case 9: W0 = a->in[19]; K = FF; N = D; doff = WL_D2; mapid = 0; break;
            case 10: W0 = a->in[21]; g0 = a->in[20]; K = D; N = D; doff = WL_PG; mapid = 0; break;
            default: W0 = a->in[22]; K = PLE; N = D; doff = WL_PP; mapid = 0; break;
        }
        const float* W = W0 + (size_t)l * K * N;
        const float* gain = g0 ? g0 + (size_t)l * K : nullptr;
        tr_item(W, K, N, gain, Wbase + (size_t)l * WL_SIZE + doff, mapid, r, s, wv);
    }
#endif
    const int gt = bid * 512 + tid, ngt = G * 512;
    for (int l = 0; l < DEPTH; ++l) {
        bf16_t* WL = Wbase + (size_t)l * WL_SIZE;
        zero_rows(WL + WL_IN, 896, 128, D, gt, ngt); zero_rows(WL + WL_IN, 1952, 96, D, gt, ngt); zero_rows(WL + WL_IN, 2048 + 640, 128, D, gt, ngt);
        zero_rows(WL + WL_UQ, 384, 128, 256, gt, ngt);
    }
#if PRO_PARTS & 2
    float* cs64 = (float*)(a->ws + OFF_CS64); float* cs32 = (float*)(a->ws + OFF_CS32);
    for (int i = gt; i < T * 32; i += ngt) {
        const int pos = i >> 5, j = i & 31;
        const float inv = __builtin_amdgcn_exp2f(-(float)j * (13.287712379549449f / 32.0f)); const float ang = (float)pos * inv;
        const float rev = ang * 0.15915494309189535f, fr_ = rev - floorf(rev);
        float* p = cs64 + ((size_t)pos * 8 + (j >> 2)) * 8 + (j & 3);
        p[0] = __builtin_amdgcn_cosf(fr_); p[4] = __builtin_amdgcn_sinf(fr_);
    }
    for (int i = gt; i < T * 16; i += ngt) {
        const int pos = i >> 4, j = i & 15;
        const float inv = __builtin_amdgcn_exp2f(-(float)j * (13.287712379549449f / 16.0f)); const float ang = (float)pos * inv;
        const float rev = ang * 0.15915494309189535f, fr_ = rev - floorf(rev);
        float* p = cs32 + ((size_t)pos * 4 + (j >> 2)) * 8 + (j & 3);
        p[0] = __builtin_amdgcn_cosf(fr_); p[4] = __builtin_amdgcn_sinf(fr_);
    }
#endif
#if PRO_PARTS & 4
    const int lane = tid & 63, gw = bid * 8 + (tid >> 6), ngw = G * 8;
    bf16_t* xb = (bf16_t*)(a->ws + OFF_XBA); float* ss = (float*)(a->ws + OFF_SSA);
    for (int row = gw; row < M; row += ngw) {
        const f32x4* xr = (const f32x4*)(a->in[0] + (size_t)row * D) + lane; f32x4* orow = (f32x4*)(a->out + (size_t)row * D) + lane;
        float sq = 0.f;
#pragma unroll
        for (int j = 0; j < 4; ++j) {
            const f32x4 v = xr[64 * j]; orow[64 * j] = v; sq += dot4(v);
            u32x2 w; w.x = cvt_pk_bf16(v.x, v.y); w.y = cvt_pk_bf16(v.z, v.w);
            *(u32x2*)(xb + (size_t)row * D + 256 * j + lane * 4) = w;
        }
#pragma unroll
        for (int o = 1; o < 64; o <<= 1) sq += __shfl_xor(sq, o);
        if (lane < 16) ss[(size_t)row * 16 + lane] = lane == 0 ? sq : 0.f;
    }
#endif
}

__device__ __forceinline__ void convert_p(KA a, int layer, int wv) {
    const f32x4* src = (const f32x4*)(a->in[1] + (size_t)layer * M * PLE); u32x2* dst = (u32x2*)(a->ws + OFF_VT);
    const size_t n = (size_t)M * PLE / 4;
    const int tid_ = ltid(wv), bid_ = lbid(), G_ = lgrid();
    for (size_t i = (size_t)bid_ * 512 + tid_; i < n; i += (size_t)G_ * 512) {
        const f32x4 v = src[i]; u32x2 w; w.x = cvt_pk_bf16(v.x, v.y); w.y = cvt_pk_bf16(v.z, v.w); dst[i] = w;
    }
}

__device__ __forceinline__ void final_norm(KA a, int wv) {
    const int tid_ = ltid(wv); const int lane = tid_ & 63, gw = lbid() * 8 + (tid_ >> 6), ngw = lgrid() * 8;
    const float* ss = (const float*)(a->ws + OFF_SSA);
    f32x4 g[4];
#pragma unroll
    for (int j = 0; j < 4; ++j) g[j] = ((const f32x4*)a->in[23])[64 * j + lane];
    for (int row = gw; row < M; row += ngw) {
        const float r = rs16(ss, row);
        f32x4* orow = (f32x4*)(a->out + (size_t)row * D) + lane;
#pragma unroll
        for (int j = 0; j < 4; ++j) orow[64 * j] = orow[64 * j] * r * g[j];
    }
}

struct AttnP { const unsigned char* ws; const float* nab; const float* sink; };

template <int MODE>
__device__ __forceinline__ void attn_unit(const AttnP& P0, int unit, LAS float* xch, int wv) {
    const unsigned char* ws = P0.ws; asm volatile("" : "+s"(ws));
    const bf16_t* Pz = (const bf16_t*)(ws + OFF_H);
    constexpr int NS = MODE == 0 ? 6 : 4;
    const int lane = vlane(), w = wv, qs = w >> 2, h = w & 3, ql = lane & 31, hh = lane >> 5;
    const int b = unit >> 5, rem = unit & 31;
    int qt, T0 = 0, rr = 0;
    if (MODE == 1) { T0 = 512 * (rem >> 3); rr = 2 * (rem & 7) + qs; qt = T0 + rr + 16 * ql; }
    else qt = 64 * rem + 32 * qs + ql;
    const size_t tokbase = (size_t)b * T;
    const bf16_t* qrow; const bf16_t* kbase_p; int ldk; const bf16_t* vnat; int group;
    if (MODE == 0) { qrow = (const bf16_t*)(ws + OFF_QM) + (tokbase + qt) * QLD + 96 * h; kbase_p = (const bf16_t*)(ws + OFF_KN) + tokbase * KNLD + 64 * h; ldk = KNLD; vnat = (const bf16_t*)(ws + OFF_VTM) + (size_t)(64 * h) * M + tokbase; group = 3; }
    else if (MODE == 1) { qrow = Pz + (tokbase + qt) * ZLD + 1024 + 64 * h; kbase_p = Pz + tokbase * ZLD + 1280 + 64 * h; ldk = ZLD; vnat = (const bf16_t*)(ws + OFF_VT) + (size_t)(384 + 64 * h) * M + tokbase; group = 2; }
    else if (MODE == 2) { qrow = Pz + (tokbase + qt) * ZLD + 64 * h; kbase_p = Pz + tokbase * ZLD + 256 + 64 * h; ldk = ZLD; vnat = (const bf16_t*)(ws + OFF_VT) + (size_t)(64 * h) * M + tokbase; group = 0; }
    else { qrow = Pz + (tokbase + qt) * ZLD + 512 + 64 * h; kbase_p = Pz + tokbase * ZLD + 768 + 64 * (h >> 1); ldk = ZLD; vnat = (const bf16_t*)(ws + OFF_VT) + (size_t)(256 + 64 * (h >> 1)) * M + tokbase; group = 1; }
    bf16x8 qf[NS];
#pragma unroll
    for (int s = 0; s < NS; ++s) qf[s] = *(const bf16x8*)(qrow + 16 * s + 8 * hh);
    const float sc = (MODE == 0 ? 0.10206207261596577f : 0.125f) * LOG2E;
    f32x16 o0, o1;
#pragma unroll
    for (int e = 0; e < 16; ++e) { o0[e] = 0.f; o1[e] = 0.f; }
    float mrun = -1e20f, lrun = 0.f;
    if (MODE == 3) { mrun = P0.sink[h] * LOG2E; lrun = hh == 0 ? 1.f : 0.f; }
    const int qrow_g = qt >> 6, qcol = qt & 63;
    const int nseg = MODE == 1 ? 3 : 1;
    for (int seg = 0; seg < nseg; ++seg) {
        int ntile, kb0, kstr, vb0, win; const bf16_t* vt = vnat;
        if (MODE == 0) { ntile = 64; kb0 = 0; kstr = 1; vb0 = 0; win = 1 << 20; }
        else if (MODE == 2) { ntile = 16; kb0 = 0; kstr = 1; vb0 = 0; win = 0; }
        else if (MODE == 3) { ntile = 9; kb0 = 64 * rem + 32 * qs - 128; kstr = 1; vb0 = kb0; win = 128; }
        else {
            if (seg == 0) { ntile = 20; kb0 = T0 - 64; kstr = 1; vb0 = kb0; win = 64; }
            else if (seg == 1) { ntile = 8; const int us = (T0 >> 2) - 64, r4 = rr & 3; kb0 = 4 * us + r4; kstr = 4; vb0 = r4 * 512 + us; win = 256; vt = (const bf16_t*)(ws + OFF_VT4) + (size_t)(64 * h) * M + tokbase; }
            else { ntile = 5; const int nst = (T0 >> 4) - 64; kb0 = 16 * nst + rr; kstr = 16; vb0 = rr * 128 + nst; win = 1024; vt = (const bf16_t*)(ws + OFF_VT16) + (size_t)(64 * h) * M + tokbase; }
        }
        for (int tau = 0; tau < ntile; ++tau) {
            int kb, vb;
            if (MODE == 2) { const int r0 = min(max(qrow_g - 4, 0), 24); kb = 64 * (r0 + (tau >> 1)) + 32 * (tau & 1); vb = kb; }
            else { kb = kb0 + 32 * kstr * tau; vb = vb0 + 32 * tau; }
            if (MODE == 1 || MODE == 3) { if (kb + 31 * kstr < 0 || kb >= T) continue; }
            const int ktl = min(max(kb + kstr * ql, 0), T - 1);
            const bf16_t* krow = kbase_p + (size_t)ktl * ldk;
            bf16x8 kf[NS];
#pragma unroll
            for (int s = 0; s < NS; ++s) {
                if (MODE == 0 && s >= 4) kf[s] = *(const bf16x8*)(Pz + (tokbase + ktl) * ZLD + 1920 + 16 * (s - 4) + 8 * hh);
                else kf[s] = *(const bf16x8*)(krow + 16 * s + 8 * hh);
            }
            bf16x8 vf[2][2];
#pragma unroll
            for (int t = 0; t < 2; ++t) {
                const int p0 = min(max(vb + 16 * t + 4 * hh, 0), T - 4), p1 = min(max(vb + 16 * t + 8 + 4 * hh, 0), T - 4);
#pragma unroll
                for (int db = 0; db < 2; ++db) {
                    const bf16_t* vr = vt + (size_t)(32 * db + ql) * M;
                    const u32x2 lo = *(const u32x2*)(vr + p0), hi = *(const u32x2*)(vr + p1);
                    u32x4 v; v.x = lo.x; v.y = lo.y; v.z = hi.x; v.w = hi.y;
                    vf[db][t] = __builtin_bit_cast(bf16x8, v);
                }
            }
            f32x16 sacc;
#pragma unroll
            for (int e = 0; e < 16; ++e) sacc[e] = 0.f;
#pragma unroll
            for (int s = 0; s < NS; ++s) sacc = __builtin_amdgcn_mfma_f32_32x32x16_bf16(kf[s], qf[s], sacc, 0, 0, 0);
            float tmax = -1e30f;
#pragma unroll
            for (int e = 0; e < 16; ++e) {
                const int kt = kb + kstr * (8 * (e >> 2) + 4 * hh + (e & 3));
                float v = sacc[e] * sc;
                if (MODE == 2) {
                    const int kcol = kt & 63, wsx = min(max(qcol - 8, 0), 48);
                    const bool ok = kcol >= wsx && kcol < wsx + 16;
                    const int drow = (kt >> 6) - qrow_g + 7, dcol = min(max(kcol - qcol, -15), 15) + 15;
                    const float bias = P0.nab[(h * 15 + drow) * 31 + dcol] * LOG2E;
                    v = ok ? v + bias : -1e30f;
                } else if (MODE != 0) {
                    const int dlt = kt - qt;
                    const bool ok = (unsigned)kt < (unsigned)T && dlt <= win && dlt >= -win;
                    v = ok ? v : -1e30f;
                }
                sacc[e] = v; tmax = fmaxf(tmax, v);
            }
            tmax = fmaxf(tmax, __shfl_xor(tmax, 32));
            const float mnew = fmaxf(mrun, tmax), alpha = __builtin_amdgcn_exp2f(mrun - mnew);
            mrun = mnew;
            float psum = 0.f;
#pragma unroll
            for (int e = 0; e < 16; ++e) { const float p = __builtin_amdgcn_exp2f(sacc[e] - mnew); sacc[e] = p; psum += p; }
            lrun = lrun * alpha + psum;
#pragma unroll
            for (int e = 0; e < 16; ++e) { o0[e] *= alpha; o1[e] *= alpha; }
            bf16x8 pb[2];
#pragma unroll
            for (int t = 0; t < 2; ++t) {
                u32x4 v; v.x = cvt_pk_bf16(sacc[8 * t + 0], sacc[8 * t + 1]); v.y = cvt_pk_bf16(sacc[8 * t + 2], sacc[8 * t + 3]);
                v.z = cvt_pk_bf16(sacc[8 * t + 4], sacc[8 * t + 5]); v.w = cvt_pk_bf16(sacc[8 * t + 6], sacc[8 * t + 7]);
                pb[t] = __builtin_bit_cast(bf16x8, v);
            }
            o0 = __builtin_amdgcn_mfma_f32_32x32x16_bf16(vf[0][0], pb[0], o0, 0, 0, 0);
            o0 = __builtin_amdgcn_mfma_f32_32x32x16_bf16(vf[0][1], pb[1], o0, 0, 0, 0);
            o1 = __builtin_amdgcn_mfma_f32_32x32x16_bf16(vf[1][0], pb[0], o1, 0, 0, 0);
            o1 = __builtin_amdgcn_mfma_f32_32x32x16_bf16(vf[1][1], pb[1], o1, 0, 0, 0);
        }
    }
    lrun += __shfl_xor(lrun, 32);
    const float inv = 1.0f / lrun;
    float sq = 0.f;
#pragma unroll
    for (int e = 0; e < 16; ++e) { o0[e] *= inv; o1[e] *= inv; sq += o0[e] * o0[e] + o1[e] * o1[e]; }
    sq += __shfl_xor(sq, 32);
    if (hh == 0) xch[w * 32 + ql] = sq;
    __syncthreads();
    const float tot = (xch[(qs * 4 + 0) * 32 + ql] + xch[(qs * 4 + 1) * 32 + ql]) + (xch[(qs * 4 + 2) * 32 + ql] + xch[(qs * 4 + 3) * 32 + ql]);
    const float rg = rsqrtf(tot * (1.0f / 256.0f) + EPS);
    bf16_t* yrow = (bf16_t*)(ws + OFF_XBA) + (tokbase + qt) * D + group * 256 + h * 64 + 4 * hh;
#pragma unroll
    for (int j = 0; j < 4; ++j) {
        u32x2 w0; w0.x = cvt_pk_bf16(o0[4 * j] * rg, o0[4 * j + 1] * rg); w0.y = cvt_pk_bf16(o0[4 * j + 2] * rg, o0[4 * j + 3] * rg);
        u32x2 w1; w1.x = cvt_pk_bf16(o1[4 * j] * rg, o1[4 * j + 1] * rg); w1.y = cvt_pk_bf16(o1[4 * j + 2] * rg, o1[4 * j + 3] * rg);
        *(u32x2*)(yrow + 8 * j) = w0; *(u32x2*)(yrow + 32 + 8 * j) = w1;
    }
}

__device__ __forceinline__ void attn_phase(KA a, int layer, LAS unsigned char* lds, int wv) {
    AttnP P; P.ws = a->ws; P.nab = a->in[8] + (size_t)layer * 4 * 15 * 31; P.sink = a->in[9] + layer * 4;
    LAS float* xch = (LAS float*)lds;
    int it = 0;
    const int G_ = lgrid();
    for (int u = lbid(); u < 2048; u += G_, ++it) {
        LAS float* x = xch + (it & 1) * 256;
        const int mode = u >> 9, unit = u & 511;
        if (mode == 0) attn_unit<0>(P, unit, x, wv);
        else if (mode == 1) attn_unit<1>(P, unit, x, wv);
        else if (mode == 2) attn_unit<2>(P, unit, x, wv);
        else attn_unit<3>(P, unit, x, wv);
    }
    __syncthreads();
}

__device__ __forceinline__ void grid_bar(unsigned* ctr, unsigned target, int wv) {
    asm volatile("s_waitcnt vmcnt(0) lgkmcnt(0)" ::: "memory");
    __builtin_amdgcn_s_barrier();
    if (wv == 0) {
        if (vlane() == 0) {
            __builtin_amdgcn_fence(__ATOMIC_RELEASE, "agent");
            asm volatile("s_waitcnt vmcnt(0)" ::: "memory");
            __hip_atomic_fetch_add(ctr, 1u, __ATOMIC_RELAXED, __HIP_MEMORY_SCOPE_AGENT);
            unsigned spins = 0;
            while (__hip_atomic_load(ctr, __ATOMIC_RELAXED, __HIP_MEMORY_SCOPE_AGENT) < target) { __builtin_amdgcn_s_sleep(2); if (++spins > (1u << 26)) break; }
            __builtin_amdgcn_fence(__ATOMIC_ACQUIRE, "agent");
            asm volatile("s_waitcnt vmcnt(0)" ::: "memory");
        }
    }
    __builtin_amdgcn_s_barrier();
    asm volatile("" ::: "memory");
}

template <int PH>
__device__ __forceinline__ void run_phase(LAS unsigned char* lds, int wv) {
    KA a = kargs();
    unsigned char* ws = a->ws; asm volatile("" : "+s"(ws));
    bf16_t* Wbase = (bf16_t*)(ws + OFF_W);
    bf16_t* xbA = (bf16_t*)(ws + OFF_XBA); bf16_t* xbB = (bf16_t*)(ws + OFF_XBB);
    bf16_t* Hb = (bf16_t*)(ws + OFF_H); bf16_t* zb = Hb; bf16_t* qm = (bf16_t*)(ws + OFF_QM); bf16_t* kn = (bf16_t*)(ws + OFF_KN);
    bf16_t* vt = (bf16_t*)(ws + OFF_VT); bf16_t* vt4 = (bf16_t*)(ws + OFF_VT4); bf16_t* vt16 = (bf16_t*)(ws + OFF_VT16); bf16_t* vtm = (bf16_t*)(ws + OFF_VTM);
    bf16_t* pb = (bf16_t*)(ws + OFF_VT);
    float* ssA = (float*)(ws + OFF_SSA); float* ssB = (float*)(ws + OFF_SSB); float* mst = (float*)(ws + OFF_MST);
    const float* cs64 = (const float*)(ws + OFF_CS64); const float* cs32 = (const float*)(ws + OFF_CS32);
    if constexpr (PH == 0) { if (PH_ON(0)) prologue(a, lds, wv); }
    else if constexpr (PH == NPH - 1) { if (PH_ON(1)) final_norm(a, wv); }
    else {
        constexpr int l = (PH - 1) / 9, k = (PH - 1) % 9;
        bf16_t* WL = Wbase + (size_t)l * WL_SIZE;
        if constexpr (k == 0) { if (PH_ON(2)) { EpiGU E{ssA, Hb}; run_gemm(wv, lds, xbA, D, M, WL + WL_GU1, D, 5632, D, 0, E); } }
        else if constexpr (k == 1) { if (PH_ON(3)) { EpiRes E{a->out, xbB, ssB, 0.5f}; run_gemm(wv, lds, Hb, FF, M, WL + WL_D1, FF, D, FF, 0, E); } }
        else if constexpr (k == 2) {
            if (PH_ON(4)) { EpiIn E{ssB, zb, mst, cs64, cs32}; run_gemm(wv, lds, xbB, D, M, WL + WL_IN, D, 2048, D, 0, E); }
            if (PH_ON(5)) { EpiVT E{ssB, vt, vt4, vt16}; run_gemm(wv, lds, WL + WL_IN + (size_t)2048 * D, D, 768, xbB, D, M, D, 0, E); }
        }
        else if constexpr (k == 3) {
            if (PH_ON(6)) { EpiQ E{mst, qm, cs32}; run_gemm(wv, lds, zb + 1536, ZLD, M, WL + WL_UQ, 256, 512, 256, 0, E); }
            if (PH_ON(7)) { EpiK E{mst, kn}; run_gemm(wv, lds, zb + 1792, ZLD, M, WL + WL_UKV, 128, 256, 128, 0, E); }
            if (PH_ON(8)) { EpiVTM E{mst, vtm}; run_gemm(wv, lds, WL + WL_UKV + (size_t)256 * 128, 128, 256, zb + 1792, ZLD, M, 128, 128, E); }
        }
        else if constexpr (k == 4) { if (PH_ON(9)) attn_phase(a, l, lds, wv); }
        else if constexpr (k == 5) { if (PH_ON(3)) { EpiRes E{a->out, xbB, ssB, 1.0f}; run_gemm(wv, lds, xbA, D, M, WL + WL_O, D, D, D, 0, E); } }
        else if constexpr (k == 6) { if (PH_ON(2)) { convert_p(a, l, wv); EpiGU E{ssB, Hb}; run_gemm(wv, lds, xbB, D, M, WL + WL_GU2, D, 5632, D, 0, E); } }
        else if constexpr (k == 7) {
            if (PH_ON(3)) { EpiRes E{a->out, xbB, ssB, 0.5f}; run_gemm(wv, lds, Hb, FF, M, WL + WL_D2, FF, D, FF, 0, E); }
            if (PH_ON(10)) { EpiPP E{xbA}; run_gemm(wv, lds, pb, PLE, M, WL + WL_PP, PLE, D, PLE, 0, E); }
        }
        else { if (PH_ON(11)) { EpiGate E{a->out, ssB, xbA, ssA}; run_gemm(wv, lds, xbB, D, M, WL + WL_PG, D, D, D, 0, E); } }
    }
}
template <int PH>
__device__ __forceinline__ void run_from(LAS unsigned char* lds, int ph_lo, int ph_hi, int wv) {
    if constexpr (PH < NPH) {
        if (PH >= ph_lo && PH < ph_hi) {
            run_phase<PH>(lds, wv);
            if (PH + 1 < ph_hi && kargs()->coop) {
                if constexpr (PH == 0) cg::this_grid().sync();
                else grid_bar((unsigned*)(kargs()->ws + OFF_BAR), (unsigned)PH * (unsigned)lgrid(), wv);
            }
        }
        run_from<PH + 1>(lds, ph_lo, ph_hi, wv);
    }
}
__global__ void __launch_bounds__(512, 2) mega(Args a_unused) {
    extern __shared__ __attribute__((aligned(16))) unsigned char lds_raw[];
    LAS unsigned char* lds = (LAS unsigned char*)lds_raw;
    const int ph_lo = kargs()->ph_lo, ph_hi = kargs()->ph_hi;
    const int wv = __builtin_amdgcn_readfirstlane((int)threadIdx.x >> 6);
    run_from<0>(lds, ph_lo, ph_hi, wv);
}

extern "C" void kernel_launch(void* const* d_in, const int* in_sizes, int n_in, void* d_out, int out_size, void* d_ws, size_t ws_size, hipStream_t stream) {
    static int grid = 0;
    if (grid == 0) {
        if (n_in != 24 || ws_size < WS_END) { fprintf(stderr, "kernel_launch: n_in %d ws %zu (need %zu)\n", n_in, ws_size, (size_t)WS_END); grid = -1; return; }
        int dev = 0, cus = 0, per_cu = 0;
        hipGetDevice(&dev); hipDeviceGetAttribute(&cus, hipDeviceAttributeMultiprocessorCount, dev);
        if (hipFuncSetAttribute((const void*)mega, hipFuncAttributeMaxDynamicSharedMemorySize, LDS_BYTES) != hipSuccess) { fprintf(stderr, "hipFuncSetAttribute failed\n"); grid = -1; return; }
        if (hipOccupancyMaxActiveBlocksPerMultiprocessor(&per_cu, (const void*)mega, 512, LDS_BYTES) != hipSuccess || per_cu < 1) per_cu = 1;
        (void)hipGetLastError();
        grid = cus * per_cu;
    }
    if (grid < 0) return;
    (void)hipMemsetAsync((char*)d_ws + OFF_BAR, 0, 256, stream);
    Args a{};
    for (int i = 0; i < 24; ++i) a.in[i] = (const float*)d_in[i];
    a.out = (float*)d_out; a.ws = (unsigned char*)d_ws;
#if MULTI_LAUNCH
    for (int ph = 0; ph < NPH; ++ph) {
        a.ph_lo = ph; a.ph_hi = ph + 1; a.coop = 0;
        hipLaunchKernelGGL(mega, dim3(grid), dim3(512), LDS_BYTES, stream, a);
    }
#else
    a.ph_lo = 0; a.ph_hi = NPH; a.coop = 1;
    void* args[] = {&a};
    hipError_t e = hipLaunchCooperativeKernel((void*)mega, dim3(grid), dim3(512), args, LDS_BYTES, stream);
    if (e != hipSuccess) fprintf(stderr, "cooperative launch failed: %s (grid %d)\n", hipGetErrorString(e), grid);
#endif
}
```

```cpp
#include <hip/hip_runtime.h>
#include <hip/hip_cooperative_groups.h>
#include <cstdio>
#include <cstdint>
namespace cg = cooperative_groups;

#ifndef MULTI_LAUNCH
#define MULTI_LAUNCH 0
#endif

#ifndef DUPM
#define DUPM 0
#endif
#ifndef PRO_PARTS
#define PRO_PARTS 7
#endif
#ifndef PHM
#define PHM 0xffff
#endif
#define PH_ON(b) (((PHM) >> (b)) & 1)
#define LAS __attribute__((address_space(3)))
typedef unsigned short bf16_t;
typedef short bf16x8 __attribute__((ext_vector_type(8)));
typedef float f32x4 __attribute__((ext_vector_type(4)));
typedef float f32x16 __attribute__((ext_vector_type(16)));
typedef unsigned u32x4 __attribute__((ext_vector_type(4)));
typedef unsigned u32x2 __attribute__((ext_vector_type(2)));

constexpr int M = 32768, T = 2048, D = 1024, FF = 2816, DEPTH = 4, PLE = 256;
constexpr int ZQLD = 768, ZLLD = 384, QLD = 384;
constexpr size_t HEADB = (size_t)16 * 64 * 4096;
constexpr float EPS = 1e-6f;
constexpr float LOG2E = 1.4426950408889634f;

constexpr size_t WL_GU1 = 0, WL_D1 = WL_GU1 + (size_t)5632 * 1024, WL_IN = WL_D1 + (size_t)1024 * 2816, WL_UQ = WL_IN + (size_t)2816 * 1024,
                 WL_UKV = WL_UQ + (size_t)512 * 256, WL_O = WL_UKV + (size_t)512 * 128, WL_GU2 = WL_O + (size_t)1024 * 1024, WL_D2 = WL_GU2 + (size_t)5632 * 1024,
                 WL_PG = WL_D2 + (size_t)1024 * 2816, WL_PP = WL_PG + (size_t)1024 * 1024, WL_SIZE = WL_PP + (size_t)1024 * 256;
constexpr size_t OFF_W = 0;
constexpr size_t OFF_XBA = OFF_W + WL_SIZE * 2 * DEPTH;
constexpr size_t OFF_XBB = OFF_XBA + (size_t)M * D * 2;
constexpr size_t OFF_H = OFF_XBB + (size_t)M * D * 2;
constexpr size_t OFF_ZQ = OFF_H;
constexpr size_t OFF_ZL = OFF_ZQ + (size_t)M * ZQLD * 2;
constexpr size_t OFF_KF = OFF_ZL + (size_t)M * ZLLD * 2;
constexpr size_t OFF_KPE = OFF_KF + 22 * HEADB;
constexpr size_t OFF_VT = OFF_H + (size_t)M * FF * 2;
constexpr size_t OFF_SSA = OFF_VT + 22 * HEADB;
constexpr size_t OFF_SSB = OFF_SSA + (size_t)M * 16 * 4;
constexpr size_t OFF_MST = OFF_SSB + (size_t)M * 16 * 4;
constexpr size_t OFF_CS64 = OFF_MST + (size_t)M * 8 * 4;
constexpr size_t OFF_CS32 = OFF_CS64 + (size_t)T * 64 * 4;
constexpr size_t OFF_BAR = OFF_CS32 + (size_t)T * 32 * 4;
constexpr size_t OFF_QM = OFF_BAR + 256;
constexpr size_t WS_END = OFF_QM + (size_t)M * QLD * 2;
static_assert(OFF_KPE + (size_t)16 * 64 * 2048 <= OFF_VT, "zq|zl|KF|KPE inside the H region");
static_assert(WS_END <= 626121856, "workspace budget");

constexpr int LDS_BYTES = 147456;
constexpr int NPH = 2 + 9 * DEPTH;

__device__ __forceinline__ unsigned cvt_pk_bf16(float lo, float hi) { unsigned r; asm("v_cvt_pk_bf16_f32 %0, %1, %2" : "=v"(r) : "v"(lo), "v"(hi)); return r; }
__device__ __forceinline__ float bf_lo(unsigned u) { return __uint_as_float(u << 16); }
__device__ __forceinline__ float bf_hi(unsigned u) { return __uint_as_float(u & 0xffff0000u); }
__device__ __forceinline__ float sum4(f32x4 a) { return (a.x + a.y) + (a.z + a.w); }
__device__ __forceinline__ float dot4(f32x4 a) { return (a.x * a.x + a.y * a.y) + (a.z * a.z + a.w * a.w); }
__device__ __forceinline__ float rs16(const float* ss, int row) {
    const f32x4* p = (const f32x4*)(ss + (size_t)row * 16);
    const f32x4 a = p[0], b = p[1], c = p[2], d = p[3];
    return rsqrtf(((sum4(a) + sum4(b)) + (sum4(c) + sum4(d))) * (1.0f / 1024.0f) + EPS);
}
__device__ __forceinline__ int vlane() { int l; asm volatile("v_mbcnt_lo_u32_b32 %0, -1, 0\n\tv_mbcnt_hi_u32_b32 %0, -1, %0" : "=v"(l)); return l; }
__device__ __forceinline__ int ltid(int wv) { return (wv << 6) | vlane(); }
__device__ __forceinline__ int lbid() { int b = blockIdx.x; asm volatile("" : "+s"(b)); return b; }
__device__ __forceinline__ int lgrid() { int g = gridDim.x; asm volatile("" : "+s"(g)); return g; }
__device__ __forceinline__ float sigmoidf_(float v) { return __builtin_amdgcn_rcpf(1.0f + __expf(-v)); }

namespace pg8 {
constexpr int BM = 256, BK = 64, HALF = 128, HTB = HALF * BK * 2, STAGE_BYTES = 8 * HTB, NXCD = 8, WGM = 8;
__host__ __device__ __forceinline__ int lds_byte(int r, int c) { const int st = (r >> 4) * 2 + (c >> 5), rr = r & 15, cc = c & 31, ob = rr * 64 + cc * 2; return st * 1024 + (ob ^ (((ob >> 9) & 1) << 5)); }
__host__ __device__ __forceinline__ void stage_rc(int b, int& R, int& C) { const int st = b / 1024, sb = b % 1024, swz = sb ^ (((sb >> 9) & 1) << 5); R = (st >> 1) * 16 + swz / 64; C = (st & 1) * 32 + (swz % 64) / 2; }
__host__ __device__ __forceinline__ int perm32(int rho) { const int n = rho >> 4, i = rho & 15; return 8 * (i >> 2) + 4 * n + (i & 3); }

struct Unit { int pm, pn; };
struct Gemm { const bf16_t* A; const bf16_t* Bt; int lda, ldb, K; };

struct StaticOrder {
    int nM, nN, nwg, G, c;
    __device__ void init(int Mr, int Nc, int G_, int c_) { nM = Mr / BM; nN = Nc / BM; nwg = nM * nN; G = G_; c = c_; }
    __device__ bool next(int i, Unit& u) const {
        const long L = (long)i * G + c; if (L >= nwg) return false;
        int wgid = (int)L; { const int q = nwg / NXCD, r = nwg % NXCD, xcd = wgid % NXCD, off = wgid / NXCD; wgid = (xcd < r ? xcd * (q + 1) : r * (q + 1) + (xcd - r) * q) + off; }
        const int nig = WGM * nN, gid = wgid / nig, fm = gid * WGM, gsz = (nM - fm) < WGM ? (nM - fm) : WGM;
        u.pm = fm + ((wgid % nig) % gsz); u.pn = (wgid % nig) / gsz; return true;
    }
};

template <class Epi>
__device__ __forceinline__ void gemm_phase(LAS unsigned char* lds, const Gemm g, const StaticOrder& S, const Epi& E, int wv) {
    const int tid = ltid(wv);
    const int wid = wv, lane = tid & 63, wr = wid >> 2, wc = wid & 3, fr = lane & 15, fq = lane >> 4;
    const int K = g.K, nt = K / BK;
    unsigned voffA[2], voffB[2];
#pragma unroll
    for (int i = 0; i < 2; ++i) { int R, C; stage_rc(tid * 16 + i * 8192, R, C); const int Rb = (R & ~31) + perm32(R & 31);
        voffA[i] = (unsigned)(R * g.lda + C) * 2u; voffB[i] = (unsigned)(Rb * g.ldb + C) * 2u; }
    const size_t kstep = (size_t)(BK * 2);
    const size_t hstepA = (size_t)HALF * g.lda * 2, hstepB = (size_t)HALF * g.ldb * 2;
    const size_t tstepA = 2 * hstepA, tstepB = 2 * hstepB;
    const unsigned ldsw = (unsigned)wid * 1024u;
    const int aoff = lds_byte(wr * 64 + fr, fq * 8), boff = lds_byte(wc * 32 + fr, fq * 8);
#define PG8_SA(b, h) (((b) * 2 + (h)) * HTB)
#define PG8_SB(b, h) ((4 + (b) * 2 + (h)) * HTB)
#define PG8_STAGE(bufoff, gbase, voff) do { _Pragma("unroll") for (int _i = 0; _i < 2; ++_i) \
        __builtin_amdgcn_global_load_lds((const unsigned*)((const char*)(gbase) + (voff)[_i]), (LAS unsigned*)(lds + (bufoff) + ldsw + _i * 8192), 16, 0, 0); } while (0)
#define PG8_LDA(dst, b, h) do { _Pragma("unroll") for (int m = 0; m < 4; ++m) _Pragma("unroll") for (int k = 0; k < 2; ++k) dst[m][k] = *(const LAS bf16x8*)(lds + PG8_SA(b, h) + aoff + m * 2048 + k * 1024); } while (0)
#define PG8_LDB(dst, b, h) do { _Pragma("unroll") for (int n = 0; n < 2; ++n) _Pragma("unroll") for (int k = 0; k < 2; ++k) dst[n][k] = *(const LAS bf16x8*)(lds + PG8_SB(b, h) + boff + n * 2048 + k * 1024); } while (0)
#define PG8_MMA(ai, bj, At, Bt) do { __builtin_amdgcn_s_setprio(1); _Pragma("unroll") for (int m = 0; m < 4; ++m) _Pragma("unroll") for (int n = 0; n < 2; ++n) _Pragma("unroll") for (int k = 0; k < 2; ++k) \
        acc[ai][bj][m][n] = __builtin_amdgcn_mfma_f32_16x16x32_bf16(Bt[n][k], At[m][k], acc[ai][bj][m][n], 0, 0, 0); __builtin_amdgcn_s_setprio(0); } while (0)
#define PG8_WAIT_V(n) asm volatile("s_waitcnt vmcnt(" #n ")" ::: "memory")
#define PG8_WAIT_L(n) asm volatile("s_waitcnt lgkmcnt(" #n ")" ::: "memory")
#define PG8_BAR __builtin_amdgcn_s_barrier()
#define PG8_SCHED __builtin_amdgcn_sched_barrier(0)
    Unit cur, nxt; int ui = 0;
    if (!S.next(0, cur)) return;
    f32x4 acc[2][2][4][2];
#pragma unroll
    for (int a = 0; a < 2; ++a)
#pragma unroll
        for (int b = 0; b < 2; ++b)
#pragma unroll
            for (int m = 0; m < 4; ++m)
#pragma unroll
                for (int n = 0; n < 2; ++n) acc[a][b][m][n] = (f32x4){0.f, 0.f, 0.f, 0.f};
    bf16x8 At[4][2], B0[2][2], B1[2][2];
    const char* cA = (const char*)g.A + (size_t)cur.pm * tstepA; const char* cB = (const char*)g.Bt + (size_t)cur.pn * tstepB;
    PG8_STAGE(PG8_SB(0, 0), cB, voffB); PG8_STAGE(PG8_SB(0, 1), cB + hstepB, voffB); PG8_STAGE(PG8_SA(0, 0), cA, voffA); PG8_STAGE(PG8_SA(0, 1), cA + hstepA, voffA);
    if (wr == 1) PG8_BAR;
    PG8_WAIT_V(2); PG8_BAR;
    PG8_STAGE(PG8_SB(1, 0), cB + kstep, voffB); PG8_STAGE(PG8_SA(1, 0), cA + kstep, voffA); PG8_STAGE(PG8_SB(1, 1), cB + hstepB + kstep, voffB);
    PG8_WAIT_V(6); PG8_BAR;
    for (;;) {
        const bool has_next = S.next(ui + 1, nxt);
        const char* nA = has_next ? (const char*)g.A + (size_t)nxt.pm * tstepA : cA; const char* nB = has_next ? (const char*)g.Bt + (size_t)nxt.pn * tstepB : cB;
        for (int t = 0; t < nt; t += 2) {
            const bool last = (t == nt - 2);
            const char* a1 = cA + (size_t)(t + 1) * kstep;
            const char* a2 = last ? nA : cA + (size_t)(t + 2) * kstep; const char* b2 = last ? nB : cB + (size_t)(t + 2) * kstep;
            const char* a3 = a2 + kstep; const char* b3 = b2 + kstep;
            PG8_LDB(B0, 0, 0); PG8_LDB(B1, 0, 1); PG8_SCHED; PG8_LDA(At, 0, 0); PG8_STAGE(PG8_SA(1, 1), a1 + hstepA, voffA);
            PG8_WAIT_V(8); PG8_WAIT_L(0); PG8_BAR; PG8_MMA(0, 0, At, B0); PG8_MMA(0, 1, At, B1); PG8_BAR; PG8_SCHED;
            PG8_LDA(At, 0, 1); PG8_STAGE(PG8_SB(0, 0), b2, voffB); PG8_STAGE(PG8_SB(0, 1), b2 + hstepB, voffB); PG8_STAGE(PG8_SA(0, 0), a2, voffA);
            PG8_WAIT_V(8); PG8_WAIT_L(0); PG8_BAR; PG8_MMA(1, 0, At, B0); PG8_MMA(1, 1, At, B1); PG8_BAR; PG8_SCHED;
            PG8_LDB(B0, 1, 0); PG8_LDB(B1, 1, 1); PG8_SCHED; PG8_LDA(At, 1, 0); PG8_STAGE(PG8_SA(0, 1), a2 + hstepA, voffA);
            PG8_WAIT_V(8); PG8_WAIT_L(0); PG8_BAR; PG8_MMA(0, 0, At, B0); PG8_MMA(0, 1, At, B1); PG8_BAR; PG8_SCHED;
            PG8_LDA(At, 1, 1); PG8_STAGE(PG8_SB(1, 0), b3, voffB); PG8_STAGE(PG8_SB(1, 1), b3 + hstepB, voffB); PG8_STAGE(PG8_SA(1, 0), a3, voffA);
            PG8_WAIT_V(8); PG8_WAIT_L(0); PG8_BAR; PG8_MMA(1, 0, At, B0); PG8_MMA(1, 1, At, B1); PG8_BAR; PG8_SCHED;
        }
        if (wr == 0) PG8_BAR;
        E(acc, cur, wr, wc, fr, fq);
        if (!has_next) break;
#pragma unroll
        for (int a = 0; a < 2; ++a)
#pragma unroll
            for (int b = 0; b < 2; ++b)
#pragma unroll
                for (int m = 0; m < 4; ++m)
#pragma unroll
                    for (int n = 0; n < 2; ++n) acc[a][b][m][n] = (f32x4){0.f, 0.f, 0.f, 0.f};
        cur = nxt; cA = nA; cB = nB; ++ui;
        if (wr == 1) PG8_BAR;
    }
    PG8_WAIT_V(0);
    PG8_BAR;
#undef PG8_SA
#undef PG8_SB
#undef PG8_STAGE
#undef PG8_LDA
#undef PG8_LDB
#undef PG8_MMA
#undef PG8_WAIT_V
#undef PG8_WAIT_L
#undef PG8_BAR
#undef PG8_SCHED
}
}
using pg8::Unit;
typedef const f32x4 (&AccRef)[2][2][4][2];

struct EpiGU {
    const float* ss; bf16_t* H;
    __device__ __forceinline__ void operator()(AccRef acc, const Unit& u, int wr, int wc, int, int) const { const int lane_ = vlane(); const int fr = lane_ & 15, fq = lane_ >> 4;
#pragma unroll
        for (int ai = 0; ai < 2; ++ai)
#pragma unroll
            for (int m = 0; m < 4; ++m) {
                const int row = u.pm * 256 + ai * 128 + wr * 64 + m * 16 + fr;
                asm volatile("" ::: "memory");
                const float r = rs16(ss, row);
#pragma unroll
                for (int bj = 0; bj < 2; ++bj) {
                    const f32x4 g = acc[ai][bj][m][0] * r, v = acc[ai][bj][m][1] * r;
                    const float h0 = g.x * sigmoidf_(g.x) * v.x, h1 = g.y * sigmoidf_(g.y) * v.y, h2 = g.z * sigmoidf_(g.z) * v.z, h3 = g.w * sigmoidf_(g.w) * v.w;
                    u32x2 w; w.x = cvt_pk_bf16(h0, h1); w.y = cvt_pk_bf16(h2, h3);
                    *(u32x2*)(H + (size_t)row * FF + u.pn * 128 + bj * 64 + wc * 16 + fq * 4) = w;
                }
            }
    }
};
struct EpiRes {
    float* X; bf16_t* xb; float* ssOut; float alpha;
    __device__ __forceinline__ void operator()(AccRef acc, const Unit& u, int wr, int wc, int, int) const { const int lane_ = vlane(); const int fr = lane_ & 15, fq = lane_ >> 4;
#pragma unroll
        for (int ai = 0; ai < 2; ++ai)
#pragma unroll
            for (int m = 0; m < 4; ++m) {
                const int row = u.pm * 256 + ai * 128 + wr * 64 + m * 16 + fr;
                asm volatile("" ::: "memory");
                float sq = 0.f;
#pragma unroll
                for (int bj = 0; bj < 2; ++bj) {
                    const size_t off = (size_t)row * D + u.pn * 256 + bj * 128 + wc * 32 + fq * 8;
                    f32x4 x0 = *(const f32x4*)(X + off), x1 = *(const f32x4*)(X + off + 4);
                    x0 += acc[ai][bj][m][0] * alpha; x1 += acc[ai][bj][m][1] * alpha;
                    *(f32x4*)(X + off) = x0; *(f32x4*)(X + off + 4) = x1;
                    sq += dot4(x0) + dot4(x1);
                    u32x4 w; w.x = cvt_pk_bf16(x0.x, x0.y); w.y = cvt_pk_bf16(x0.z, x0.w); w.z = cvt_pk_bf16(x1.x, x1.y); w.w = cvt_pk_bf16(x1.z, x1.w);
                    *(u32x4*)(xb + off) = w;
                }
                sq += __shfl_xor(sq, 16); sq += __shfl_xor(sq, 32);
                if (fq == 0) ssOut[(size_t)row * 16 + u.pn * 4 + wc] = sq;
            }
    }
};
struct EpiGate {
    float* X; const float* ssIn; bf16_t* ppxb; float* ssOut;
    __device__ __forceinline__ void operator()(AccRef acc, const Unit& u, int wr, int wc, int, int) const { const int lane_ = vlane(); const int fr = lane_ & 15, fq = lane_ >> 4;
#pragma unroll
        for (int ai = 0; ai < 2; ++ai)
#pragma unroll
            for (int m = 0; m < 4; ++m) {
                const int row = u.pm * 256 + ai * 128 + wr * 64 + m * 16 + fr;
                asm volatile("" ::: "memory");
                const float r = rs16(ssIn, row);
                float sq = 0.f;
#pragma unroll
                for (int bj = 0; bj < 2; ++bj) {
                    const size_t off = (size_t)row * D + u.pn * 256 + bj * 128 + wc * 32 + fq * 8;
                    f32x4 x0 = *(const f32x4*)(X + off), x1 = *(const f32x4*)(X + off + 4);
                    const u32x4 pp = *(const u32x4*)(ppxb + off);
                    const f32x4 a0 = acc[ai][bj][m][0] * r, a1 = acc[ai][bj][m][1] * r;
                    x0.x += sigmoidf_(a0.x) * bf_lo(pp.x); x0.y += sigmoidf_(a0.y) * bf_hi(pp.x); x0.z += sigmoidf_(a0.z) * bf_lo(pp.y); x0.w += sigmoidf_(a0.w) * bf_hi(pp.y);
                    x1.x += sigmoidf_(a1.x) * bf_lo(pp.z); x1.y += sigmoidf_(a1.y) * bf_hi(pp.z); x1.z += sigmoidf_(a1.z) * bf_lo(pp.w); x1.w += sigmoidf_(a1.w) * bf_hi(pp.w);
                    *(f32x4*)(X + off) = x0; *(f32x4*)(X + off + 4) = x1;
                    sq += dot4(x0) + dot4(x1);
                    u32x4 w; w.x = cvt_pk_bf16(x0.x, x0.y); w.y = cvt_pk_bf16(x0.z, x0.w); w.z = cvt_pk_bf16(x1.x, x1.y); w.w = cvt_pk_bf16(x1.z, x1.w);
                    *(u32x4*)(ppxb + off) = w;
                }
                sq += __shfl_xor(sq, 16); sq += __shfl_xor(sq, 32);
                if (fq == 0) ssOut[(size_t)row * 16 + u.pn * 4 + wc] = sq;
            }
    }
};
__device__ __forceinline__ void rope_rot(f32x4& v0, f32x4& v1, const float* cs) {
    const f32x4 c = *(const f32x4*)cs, s = *(const f32x4*)(cs + 4);
    const f32x4 a = v0 * c - v1 * s, b = v1 * c + v0 * s; v0 = a; v1 = b;
}
struct EpiIn {
    const float* ss; unsigned char* ws; float* mst; const float* cs64; const float* cs32;
    __device__ __forceinline__ void operator()(AccRef acc, const Unit& u, int wr, int wc, int, int) const { const int lane_ = vlane(); const int fr = lane_ & 15, fq = lane_ >> 4;
#pragma unroll
        for (int ai = 0; ai < 2; ++ai)
#pragma unroll
            for (int m = 0; m < 4; ++m) {
                const int row = u.pm * 256 + ai * 128 + wr * 64 + m * 16 + fr;
                asm volatile("" ::: "memory");
                const float r = rs16(ss, row);
                const int pos = row & (T - 1), b = row >> 11;
                float sq = 0.f;
#pragma unroll
                for (int bj = 0; bj < 2; ++bj) {
                    const int gcol = u.pn * 256 + bj * 128 + wc * 32;
                    f32x4 v0 = acc[ai][bj][m][0] * r, v1 = acc[ai][bj][m][1] * r;
                    const bool r64 = (gcol >= 512 && gcol < 896) || (gcol >= 1024 && gcol < 1536);
                    if (r64) rope_rot(v0, v1, cs64 + ((size_t)pos * 8 + 4 * ((gcol >> 5) & 1) + fq) * 8);
                    if (gcol == 1920) rope_rot(v0, v1, cs32 + ((size_t)pos * 4 + fq) * 8);
                    if (u.pn == 6 || (u.pn == 7 && bj == 0)) sq += dot4(v0) + dot4(v1);
                    u32x4 w; w.x = cvt_pk_bf16(v0.x, v0.y); w.y = cvt_pk_bf16(v0.z, v0.w); w.z = cvt_pk_bf16(v1.x, v1.y); w.w = cvt_pk_bf16(v1.z, v1.w);
                    const int c8 = ((gcol & 63) >> 3) + fq;
                    const size_t frag = (size_t)(c8 >> 1) * 1024 + (size_t)((pos & 31) + 32 * (c8 & 1)) * 16;
                    const size_t rec = ((size_t)b * 64 + (pos >> 5)) * 4096;
                    if (gcol < 256) *(u32x4*)(ws + OFF_ZQ + ((size_t)row * ZQLD + gcol + fq * 8) * 2) = w;
                    else if (gcol < 512) *(u32x4*)(ws + OFF_KF + (size_t)((gcol - 256) >> 6) * HEADB + rec + frag) = w;
                    else if (gcol < 768) *(u32x4*)(ws + OFF_ZQ + ((size_t)row * ZQLD + (gcol - 256) + fq * 8) * 2) = w;
                    else if (gcol < 896) *(u32x4*)(ws + OFF_KF + (size_t)(4 + ((gcol - 768) >> 6)) * HEADB + rec + frag) = w;
                    else if (gcol < 1024) { }
                    else if (gcol < 1280) *(u32x4*)(ws + OFF_ZQ + ((size_t)row * ZQLD + (gcol - 512) + fq * 8) * 2) = w;
                    else if (gcol < 1536) {
                        const int hd = (gcol - 1280) >> 6;
                        *(u32x4*)(ws + OFF_KF + (size_t)(6 + hd) * HEADB + rec + frag) = w;
                        const int p4 = (pos & 3) * 512 + (pos >> 2), p16 = (pos & 15) * 128 + (pos >> 4);
                        *(u32x4*)(ws + OFF_KF + (size_t)(10 + hd) * HEADB + ((size_t)b * 64 + (p4 >> 5)) * 4096 + (size_t)(c8 >> 1) * 1024 + (size_t)((p4 & 31) + 32 * (c8 & 1)) * 16) = w;
                        *(u32x4*)(ws + OFF_KF + (size_t)(14 + hd) * HEADB + ((size_t)b * 64 + (p16 >> 5)) * 4096 + (size_t)(c8 >> 1) * 1024 + (size_t)((p16 & 31) + 32 * (c8 & 1)) * 16) = w;
                    }
                    else if (gcol < 1920) *(u32x4*)(ws + OFF_ZL + ((size_t)row * ZLLD + (gcol - 1536) + fq * 8) * 2) = w;
                    else if (gcol == 1920) *(u32x4*)(ws + OFF_KPE + ((size_t)b * 64 + (pos >> 5)) * 2048 + (size_t)(fq >> 1) * 1024 + (size_t)((pos & 31) + 32 * (fq & 1)) * 16) = w;
                }
                if (u.pn >= 6) {
                    sq += __shfl_xor(sq, 16); sq += __shfl_xor(sq, 32);
                    if (fq == 0) mst[(size_t)row * 8 + (u.pn - 6) * 4 + wc] = sq;
                }
            }
    }
};
__device__ __forceinline__ void vstore8(unsigned char* vf, int vhead, int dd, int tok0, u32x4 w) {
    const int b = tok0 >> 11, pos0 = tok0 & (T - 1), idx0 = pos0 & 31;
    unsigned char* p = vf + (size_t)vhead * HEADB + ((size_t)b * 64 + (pos0 >> 5)) * 4096 + (size_t)((dd >> 5) * 2 + (idx0 >> 4)) * 1024 + (size_t)(dd & 31) * 16 + ((idx0 >> 3) & 1) * 8;
    u32x2 lo; lo.x = w.x; lo.y = w.y; u32x2 hi; hi.x = w.z; hi.y = w.w;
    *(u32x2*)p = lo; *(u32x2*)(p + 512) = hi;
}
__device__ __forceinline__ void vstore1(unsigned char* vf, int vhead, int dd, int b, int ppos, bf16_t val) {
    const int idx = ppos & 31, r16 = idx & 15;
    unsigned char* p = vf + (size_t)vhead * HEADB + ((size_t)b * 64 + (ppos >> 5)) * 4096 + (size_t)((dd >> 5) * 2 + (idx >> 4)) * 1024 + (size_t)((dd & 31) + 32 * ((r16 >> 2) & 1)) * 16 + (r16 >> 3) * 8 + (r16 & 3) * 2;
    *(bf16_t*)p = val;
}
struct EpiVT {
    const float* ss; unsigned char* vf;
    __device__ __forceinline__ void operator()(AccRef acc, const Unit& u, int wr, int wc, int, int) const { const int lane_ = vlane(); const int fr = lane_ & 15, fq = lane_ >> 4;
#pragma unroll
        for (int bj = 0; bj < 2; ++bj) {
            const int tok0 = u.pn * 256 + bj * 128 + wc * 32 + fq * 8;
            float rs[8];
#pragma unroll
            for (int e = 0; e < 8; ++e) rs[e] = rs16(ss, tok0 + e);
#pragma unroll
            for (int ai = 0; ai < 2; ++ai) {
                const int rbase = u.pm * 256 + ai * 128;
                if (rbase >= 640) continue;
                const bool dil = rbase >= 384;
#pragma unroll
                for (int m = 0; m < 4; ++m) {
                    const int row = rbase + wr * 64 + m * 16 + fr;
                    asm volatile("" ::: "memory");
                    const f32x4 a0 = acc[ai][bj][m][0], a1 = acc[ai][bj][m][1];
                    u32x4 w; w.x = cvt_pk_bf16(a0.x * rs[0], a0.y * rs[1]); w.y = cvt_pk_bf16(a0.z * rs[2], a0.w * rs[3]);
                    w.z = cvt_pk_bf16(a1.x * rs[4], a1.y * rs[5]); w.w = cvt_pk_bf16(a1.z * rs[6], a1.w * rs[7]);
                    const int vhead = row >> 6, dd = row & 63;
                    vstore8(vf, vhead, dd, tok0, w);
                    if (dil) {
                        const int b = tok0 >> 11, t0 = tok0 & (T - 1);
                        const unsigned ww[4] = {w.x, w.y, w.z, w.w};
#pragma unroll
                        for (int e = 0; e < 8; ++e) {
                            const int t = t0 + e; const bf16_t val = (bf16_t)((e & 1) ? (ww[e >> 1] >> 16) : (ww[e >> 1] & 0xffffu));
                            vstore1(vf, vhead + 4, dd, b, (t & 3) * 512 + (t >> 2), val);
                            vstore1(vf, vhead + 8, dd, b, (t & 15) * 128 + (t >> 4), val);
                        }
                    }
                }
            }
        }
    }
};
struct EpiQ {
    const float* mst; bf16_t* qm; const float* cs32;
    __device__ __forceinline__ void operator()(AccRef acc, const Unit& u, int wr, int wc, int, int) const { const int lane_ = vlane(); const int fr = lane_ & 15, fq = lane_ >> 4;
#pragma unroll
        for (int ai = 0; ai < 2; ++ai)
#pragma unroll
            for (int m = 0; m < 4; ++m) {
                const int row = u.pm * 256 + ai * 128 + wr * 64 + m * 16 + fr;
                asm volatile("" ::: "memory");
                const f32x4 st = *(const f32x4*)(mst + (size_t)row * 8);
                const float r = rsqrtf(sum4(st) * (1.0f / 256.0f) + EPS);
                const int pos = row & (T - 1);
#pragma unroll
                for (int bj = 0; bj < 2; ++bj) {
                    const int gcol = u.pn * 256 + bj * 128 + wc * 32;
                    if (gcol >= 384) continue;
                    f32x4 v0 = acc[ai][bj][m][0] * r, v1 = acc[ai][bj][m][1] * r;
                    if (((gcol >> 5) % 3) == 2) rope_rot(v0, v1, cs32 + ((size_t)pos * 4 + fq) * 8);
                    u32x4 w; w.x = cvt_pk_bf16(v0.x, v0.y); w.y = cvt_pk_bf16(v0.z, v0.w); w.z = cvt_pk_bf16(v1.x, v1.y); w.w = cvt_pk_bf16(v1.z, v1.w);
                    *(u32x4*)(qm + (size_t)row * QLD + gcol + fq * 8) = w;
                }
            }
    }
};
struct EpiK {
    const float* mst; unsigned char* ws;
    __device__ __forceinline__ void operator()(AccRef acc, const Unit& u, int wr, int wc, int, int) const { const int lane_ = vlane(); const int fr = lane_ & 15, fq = lane_ >> 4;
#pragma unroll
        for (int ai = 0; ai < 2; ++ai)
#pragma unroll
            for (int m = 0; m < 4; ++m) {
                const int row = u.pm * 256 + ai * 128 + wr * 64 + m * 16 + fr;
                asm volatile("" ::: "memory");
                const f32x4 st = *(const f32x4*)(mst + (size_t)row * 8 + 4);
                const float r = rsqrtf(sum4(st) * (1.0f / 128.0f) + EPS);
#pragma unroll
                for (int bj = 0; bj < 2; ++bj) {
                    const f32x4 v0 = acc[ai][bj][m][0] * r, v1 = acc[ai][bj][m][1] * r;
                    u32x4 w; w.x = cvt_pk_bf16(v0.x, v0.y); w.y = cvt_pk_bf16(v0.z, v0.w); w.z = cvt_pk_bf16(v1.x, v1.y); w.w = cvt_pk_bf16(v1.z, v1.w);
                    const int col0 = bj * 128 + wc * 32, c8 = ((col0 & 63) >> 3) + fq, pos = row & (T - 1);
                    *(u32x4*)(ws + OFF_KF + (size_t)(18 + (col0 >> 6)) * HEADB + ((size_t)(row >> 11) * 64 + (pos >> 5)) * 4096 + (size_t)(c8 >> 1) * 1024 + (size_t)((pos & 31) + 32 * (c8 & 1)) * 16) = w;
                }
            }
    }
};
struct EpiVTM {
    const float* mst; unsigned char* vf;
    __device__ __forceinline__ void operator()(AccRef acc, const Unit& u, int wr, int wc, int, int) const { const int lane_ = vlane(); const int fr = lane_ & 15, fq = lane_ >> 4;
#pragma unroll
        for (int bj = 0; bj < 2; ++bj) {
            const int tok0 = u.pn * 256 + bj * 128 + wc * 32 + fq * 8;
            float rs[8];
#pragma unroll
            for (int e = 0; e < 8; ++e) { const f32x4 st = *(const f32x4*)(mst + (size_t)(tok0 + e) * 8 + 4); rs[e] = rsqrtf(sum4(st) * (1.0f / 128.0f) + EPS); }
#pragma unroll
            for (int ai = 0; ai < 2; ++ai)
#pragma unroll
                for (int m = 0; m < 4; ++m) {
                    const int row = ai * 128 + wr * 64 + m * 16 + fr;
                    asm volatile("" ::: "memory");
                    const f32x4 a0 = acc[ai][bj][m][0], a1 = acc[ai][bj][m][1];
                    u32x4 w; w.x = cvt_pk_bf16(a0.x * rs[0], a0.y * rs[1]); w.y = cvt_pk_bf16(a0.z * rs[2], a0.w * rs[3]);
                    w.z = cvt_pk_bf16(a1.x * rs[4], a1.y * rs[5]); w.w = cvt_pk_bf16(a1.z * rs[6], a1.w * rs[7]);
                    vstore8(vf, 18 + (row >> 6), row & 63, tok0, w);
                }
        }
    }
};
struct EpiPP {
    bf16_t* O;
    __device__ __forceinline__ void operator()(AccRef acc, const Unit& u, int wr, int wc, int, int) const { const int lane_ = vlane(); const int fr = lane_ & 15, fq = lane_ >> 4;
#pragma unroll
        for (int ai = 0; ai < 2; ++ai)
#pragma unroll
            for (int m = 0; m < 4; ++m) {
                const int row = u.pm * 256 + ai * 128 + wr * 64 + m * 16 + fr;
                asm volatile("" ::: "memory");
#pragma unroll
                for (int bj = 0; bj < 2; ++bj) {
                    const f32x4 v0 = acc[ai][bj][m][0], v1 = acc[ai][bj][m][1];
                    u32x4 w; w.x = cvt_pk_bf16(v0.x, v0.y); w.y = cvt_pk_bf16(v0.z, v0.w); w.z = cvt_pk_bf16(v1.x, v1.y); w.w = cvt_pk_bf16(v1.z, v1.w);
                    *(u32x4*)(O + (size_t)row * D + u.pn * 256 + bj * 128 + wc * 32 + fq * 8) = w;
                }
            }
    }
};

template <class Epi>
__device__ __forceinline__ void run_gemm(int wv, LAS unsigned char* lds, const bf16_t* A, int lda, int rows, const bf16_t* Bt, int ldb, int cols, int K, int cshift, const Epi& E) {
    pg8::Gemm g{A, Bt, lda, ldb, K};
    pg8::StaticOrder S; const int G_ = lgrid(); S.init(rows, cols, G_, (lbid() + cshift) % G_);
    pg8::gemm_phase<Epi>(lds, g, S, E, wv);
}

__device__ __forceinline__ int p64(int d) { return d < 32 ? 8 * (d >> 2) + (d & 3) : 8 * ((d - 32) >> 2) + 4 + (d & 3); }
__device__ __forceinline__ int p32(int d) { return d < 16 ? 8 * (d >> 2) + (d & 3) : 8 * ((d - 16) >> 2) + 4 + (d & 3); }
__device__ __forceinline__ int maprow(int mapid, int c) {
    switch (mapid) {
        case 0: return c;
        case 1: return (c >> 2) * 8 + (c & 3);
        case 2: return (c >> 2) * 8 + 4 + (c & 3);
        case 3: {
            if (c < 768) return c < 512 ? c : 2048 + (c - 512);
            c -= 768;
            if (c < 512) return c < 384 ? 512 + (c >> 6) * 64 + p64(c & 63) : 2048 + 256 + (c - 384);
            c -= 512;
            if (c < 768) return c < 512 ? 1024 + (c >> 6) * 64 + p64(c & 63) : 2048 + 384 + (c - 512);
            c -= 768;
            if (c < 256) return 1536 + c;
            if (c < 384) return 1792 + (c - 256);
            return 1920 + p32(c - 384);
        }
        case 4: { const int h = c / 96, e = c % 96; return e < 64 ? 96 * h + e : 96 * h + 64 + p32(e - 64); }
        default: { const int h = c >> 7, e = c & 127; return e < 64 ? 64 * h + e : 256 + 64 * h + (e - 64); }
    }
}
__device__ __forceinline__ void tr_item(const float* W, int K, int N, const float* gain, bf16_t* dst, int mapid, int item, LAS float* s, int wv) {
    const int tid = ltid(wv);
    const int ncb = (N + 255) >> 8, kb = item / ncb, cb = item % ncb, k0 = kb * 64, c0 = cb * 256;
#pragma unroll
    for (int i = 0; i < 8; ++i) {
        const int kk = i * 8 + (tid >> 6), col = (tid & 63) * 4;
        f32x4 v = (f32x4){0.f, 0.f, 0.f, 0.f};
        if (c0 + col < N) v = *(const f32x4*)(W + (size_t)(k0 + kk) * N + c0 + col);
        if (gain) v *= gain[k0 + kk];
        *(LAS f32x4*)(s + kk * 260 + col) = v;
    }
    __syncthreads();
    const int cc = tid & 255, kh = tid >> 8, c = c0 + cc;
    if (c < N) {
        const int drow = maprow(mapid, c);
        bf16_t* o = dst + (size_t)drow * K + k0 + kh * 32;
#pragma unroll
        for (int q = 0; q < 4; ++q) {
            const LAS float* sp = s + (kh * 32 + q * 8) * 260 + cc;
            u32x4 w; w.x = cvt_pk_bf16(sp[0], sp[260]); w.y = cvt_pk_bf16(sp[2 * 260], sp[3 * 260]); w.z = cvt_pk_bf16(sp[4 * 260], sp[5 * 260]); w.w = cvt_pk_bf16(sp[6 * 260], sp[7 * 260]);
            *(u32x4*)(o + q * 8) = w;
        }
    }
    __syncthreads();
}

struct Args { const float* in[24]; float* out; unsigned char* ws; int ph_lo, ph_hi, coop, pad; };
typedef const __attribute__((address_space(4))) Args* KA;
__device__ __forceinline__ KA kargs() { KA p = (KA)__builtin_amdgcn_kernarg_segment_ptr(); asm volatile("" : "+s"(p)); return p; }

__device__ __forceinline__ void zero_rows(bf16_t* base, int row0, int nrows, int K, int gt, int ngt) {
    const size_t n16 = (size_t)nrows * K / 8; u32x4* p = (u32x4*)(base + (size_t)row0 * K);
    for (size_t i = gt; i < n16; i += ngt) p[i] = (u32x4){0u, 0u, 0u, 0u};
}

__device__ __forceinline__ void prologue(KA a, LAS unsigned char* lds, int wv) {
    LAS float* s = (LAS float*)lds;
    const int G = lgrid(), bid = lbid(), tid = ltid(wv);
    bf16_t* Wbase = (bf16_t*)(a->ws + OFF_W);
#if PRO_PARTS & 1
    constexpr int I_FFN = 16 * 11, I_DN = 44 * 4, I_IN = 16 * 10, I_UQ = 4 * 2, I_UKV = 2 * 2, I_O = 16 * 4, I_PP = 4 * 4;
    constexpr int I_LAYER = 4 * I_FFN + 2 * I_DN + I_IN + I_UQ + I_UKV + 2 * I_O + I_PP;
    for (int it = bid; it < I_LAYER * DEPTH; it += G) {
        const int l = it / I_LAYER; int r = it % I_LAYER;
        int sel = 0;
        if (r >= I_FFN) { r -= I_FFN; sel = 1;
        if (r >= I_FFN) { r -= I_FFN; sel = 2;
        if (r >= I_DN) { r -= I_DN; sel = 3;
        if (r >= I_IN) { r -= I_IN; sel = 4;
        if (r >= I_UQ) { r -= I_UQ; sel = 5;
        if (r >= I_UKV) { r -= I_UKV; sel = 6;
        if (r >= I_O) { r -= I_O; sel = 7;
        if (r >= I_FFN) { r -= I_FFN; sel = 8;
        if (r >= I_FFN) { r -= I_FFN; sel = 9;
        if (r >= I_DN) { r -= I_DN; sel = 10;
        if (r >= I_O) { r -= I_O; sel = 11; } } } } } } } } } } }
        const float* W0; const float* g0 = nullptr; int K, N, mapid; size_t doff;
        switch (sel) {
            case 0: W0 = a->in[3]; g0 = a->in[2]; K = D; N = FF; doff = WL_GU1; mapid = 1; break;
            case 1: W0 = a->in[4]; g0 = a->in[2]; K = D; N = FF; doff = WL_GU1; mapid = 2; break;
            case 2: W0 = a->in[5]; K = FF; N = D; doff = WL_D1; mapid = 0; break;
            case 3: W0 = a->in[7]; g0 = a->in[6]; K = D; N = 2464; doff = WL_IN; mapid = 3; break;
            case 4: W0 = a->in[11]; g0 = a->in[10]; K = 256; N = 384; doff = WL_UQ; mapid = 4; break;
            case 5: W0 = a->in[13]; g0 = a->in[12]; K = 128; N = 512; doff = WL_UKV; mapid = 5; break;
            case 6: W0 = a->in[15]; g0 = a->in[14]; K = D; N = D; doff = WL_O; mapid = 0; break;
            case 7: W0 = a->in[17]; g0 = a->in[16]; K = D; N = FF; doff = WL_GU2; mapid = 1; break;
            case 8: W0 = a->in[18]; g0 = a->in[16]; K = D; N = FF; doff = WL_GU2; mapid = 2; break;
            case 9: W0 = a->in[19]; K = FF; N = D; doff = WL_D2; mapid = 0; break;
            case 10: W0 = a->in[21]; g0 = a->in[20]; K = D; N = D; doff = WL_PG; mapid = 0; break;
            default: W0 = a->in[22]; K = PLE; N = D; doff = WL_PP; mapid = 0; break;
        }
        const float* W = W0 + (size_t)l * K * N;
        const float* gain = g0 ? g0 + (size_t)l * K : nullptr;
        tr_item(W, K, N, gain, Wbase + (size_t)l * WL_SIZE + doff, mapid, r, s, wv);
    }
#endif
    const int gt = bid * 512 + tid, ngt = G * 512;
    for (int l = 0; l < DEPTH; ++l) {
        bf16_t* WL = Wbase + (size_t)l * WL_SIZE;
        zero_rows(WL + WL_IN, 896, 128, D, gt, ngt); zero_rows(WL + WL_IN, 1952, 96, D, gt, ngt); zero_rows(WL + WL_IN, 2048 + 640, 128, D, gt, ngt);
        zero_rows(WL + WL_UQ, 384, 128, 256, gt, ngt);
    }
#if PRO_PARTS & 2
    float* cs64 = (float*)(a->ws + OFF_CS64); float* cs32 = (float*)(a->ws + OFF_CS32);
    for (int i = gt; i < T * 32; i += ngt) {
        const int pos = i >> 5, j = i & 31;
        const float inv = __builtin_amdgcn_exp2f(-(float)j * (13.287712379549449f / 32.0f)); const float ang = (float)pos * inv;
        const float rev = ang * 0.15915494309189535f, fr_ = rev - floorf(rev);
        float* p = cs64 + ((size_t)pos * 8 + (j >> 2)) * 8 + (j & 3);
        p[0] = __builtin_amdgcn_cosf(fr_); p[4] = __builtin_amdgcn_sinf(fr_);
    }
    for (int i = gt; i < T * 16; i += ngt) {
        const int pos = i >> 4, j = i & 15;
        const float inv = __builtin_amdgcn_exp2f(-(float)j * (13.287712379549449f / 16.0f)); const float ang = (float)pos * inv;
        const float rev = ang * 0.15915494309189535f, fr_ = rev - floorf(rev);
        float* p = cs32 + ((size_t)pos * 4 + (j >> 2)) * 8 + (j & 3);
        p[0] = __builtin_amdgcn_cosf(fr_); p[4] = __builtin_amdgcn_sinf(fr_);
    }
#endif
#if PRO_PARTS & 4
    const int lane = tid & 63, gw = bid * 8 + (tid >> 6), ngw = G * 8;
    bf16_t* xb = (bf16_t*)(a->ws + OFF_XBA); float* ss = (float*)(a->ws + OFF_SSA);
    for (int row = gw; row < M; row += ngw) {
        const f32x4* xr = (const f32x4*)(a->in[0] + (size_t)row * D) + lane; f32x4* orow = (f32x4*)(a->out + (size_t)row * D) + lane;
        float sq = 0.f;
#pragma unroll
        for (int j = 0; j < 4; ++j) {
            const f32x4 v = xr[64 * j]; orow[64 * j] = v; sq += dot4(v);
            u32x2 w; w.x = cvt_pk_bf16(v.x, v.y); w.y = cvt_pk_bf16(v.z, v.w);
            *(u32x2*)(xb + (size_t)row * D + 256 * j + lane * 4) = w;
        }
#pragma unroll
        for (int o = 1; o < 64; o <<= 1) sq += __shfl_xor(sq, o);
        if (lane < 16) ss[(size_t)row * 16 + lane] = lane == 0 ? sq : 0.f;
    }
#endif
}

__device__ __forceinline__ void convert_p(KA a, int layer, int wv) {
    const f32x4* src = (const f32x4*)(a->in[1] + (size_t)layer * M * PLE); u32x2* dst = (u32x2*)(a->ws + OFF_VT);
    const size_t n = (size_t)M * PLE / 4;
    const int tid_ = ltid(wv), bid_ = lbid(), G_ = lgrid();
    for (size_t i = (size_t)bid_ * 512 + tid_; i < n; i += (size_t)G_ * 512) {
        const f32x4 v = src[i]; u32x2 w; w.x = cvt_pk_bf16(v.x, v.y); w.y = cvt_pk_bf16(v.z, v.w); dst[i] = w;
    }
}

__device__ __forceinline__ void final_norm(KA a, int wv) {
    const int tid_ = ltid(wv); const int lane = tid_ & 63, gw = lbid() * 8 + (tid_ >> 6), ngw = lgrid() * 8;
    const float* ss = (const float*)(a->ws + OFF_SSA);
    f32x4 g[4];
#pragma unroll
    for (int j = 0; j < 4; ++j) g[j] = ((const f32x4*)a->in[23])[64 * j + lane];
    for (int row = gw; row < M; row += ngw) {
        const float r = rs16(ss, row);
        f32x4* orow = (f32x4*)(a->out + (size_t)row * D) + lane;
#pragma unroll
        for (int j = 0; j < 4; ++j) orow[64 * j] = orow[64 * j] * r * g[j];
    }
}

struct AttnP { const unsigned char* ws; const float* nab; const float* sink; };

template <int MODE>
__device__ __forceinline__ void attn_unit(const AttnP& P0, int unit, LAS float* xch, const LAS float* nabl, int wv) {
    const unsigned char* ws = P0.ws; asm volatile("" : "+s"(ws));
    constexpr int NS = MODE == 0 ? 6 : 4;
    const int lane = vlane(), w = wv, qs = w >> 2, h = w & 3, ql = lane & 31, hh = lane >> 5;
    const int lane16 = lane * 16;
    const int b = unit >> 5, rem = unit & 31;
    int qt, T0 = 0, rr = 0;
    if (MODE == 1) { T0 = 512 * (rem >> 3); rr = 2 * (rem & 7) + qs; qt = T0 + rr + 16 * ql; }
    else qt = 64 * rem + 32 * qs + ql;
    const size_t tokbase = (size_t)b * T;
    const bf16_t* qrow; int khead, group;
    if (MODE == 0) { qrow = (const bf16_t*)(ws + OFF_QM) + (tokbase + qt) * QLD + 96 * h; khead = 18 + h; group = 3; }
    else if (MODE == 1) { qrow = (const bf16_t*)(ws + OFF_ZQ) + (tokbase + qt) * ZQLD + 512 + 64 * h; khead = 6 + h; group = 2; }
    else if (MODE == 2) { qrow = (const bf16_t*)(ws + OFF_ZQ) + (tokbase + qt) * ZQLD + 64 * h; khead = h; group = 0; }
    else { qrow = (const bf16_t*)(ws + OFF_ZQ) + (tokbase + qt) * ZQLD + 256 + 64 * h; khead = 4 + (h >> 1); group = 1; }
    const unsigned char* kfb = ws + OFF_KF + (size_t)b * 64 * 4096 + lane16;
    const unsigned char* vfb = ws + OFF_VT + (size_t)b * 64 * 4096 + lane16;
    const unsigned char* kpe = ws + OFF_KPE + (size_t)b * 64 * 2048 + lane16;
    bf16x8 qf[NS];
#pragma unroll
    for (int s = 0; s < NS; ++s) qf[s] = *(const bf16x8*)(qrow + 16 * s + 8 * hh);
    const float sc = (MODE == 0 ? 0.10206207261596577f : 0.125f) * LOG2E;
    f32x16 o0, o1;
#pragma unroll
    for (int e = 0; e < 16; ++e) { o0[e] = 0.f; o1[e] = 0.f; }
    float mrun = -1e20f, lrun = 0.f;
    if (MODE == 3) { mrun = P0.sink[h] * LOG2E; lrun = hh == 0 ? 1.f : 0.f; }
    const int qrow_g = qt >> 6, qcol = qt & 63;
    const int nseg = MODE == 1 ? 3 : 1;
    for (int seg = 0; seg < nseg; ++seg) {
        int ntile, kb0, kstr, vb0, win, hd = khead;
        if (MODE == 0) { ntile = 64; kb0 = 0; kstr = 1; vb0 = 0; win = 1 << 20; }
        else if (MODE == 2) { ntile = 16; kb0 = 0; kstr = 1; vb0 = 0; win = 0; }
        else if (MODE == 3) { ntile = 9; kb0 = 64 * rem + 32 * qs - 128; kstr = 1; vb0 = kb0; win = 128; }
        else {
            if (seg == 0) { ntile = 20; kb0 = T0 - 64; kstr = 1; vb0 = kb0; win = 64; }
            else if (seg == 1) { ntile = 8; const int us = (T0 >> 2) - 64, r4 = rr & 3; kb0 = 4 * us + r4; kstr = 4; vb0 = r4 * 512 + us; win = 256; hd = khead + 4; }
            else { ntile = 5; const int nst = (T0 >> 4) - 64; kb0 = 16 * nst + rr; kstr = 16; vb0 = rr * 128 + nst; win = 1024; hd = khead + 8; }
        }
        const unsigned char* kfh = kfb + (size_t)hd * HEADB; const unsigned char* vfh = vfb + (size_t)hd * HEADB;
        for (int tau = 0; tau < ntile; ++tau) {
            int kb, vb;
            if (MODE == 2) { const int r0 = min(max(qrow_g - 4, 0), 24); kb = 64 * (r0 + (tau >> 1)) + 32 * (tau & 1); vb = kb; }
            else { kb = kb0 + 32 * kstr * tau; vb = vb0 + 32 * tau; }
            if (MODE == 1 || MODE == 3) { if (kb < 0 || kb >= T) continue; }
            const int ptile = vb >> 5;
            bf16x8 kf[NS];
#pragma unroll
            for (int s = 0; s < NS; ++s) {
                if (MODE == 0 && s >= 4) kf[s] = *(const bf16x8*)(kpe + (size_t)ptile * 2048 + (s - 4) * 1024);
                else kf[s] = *(const bf16x8*)(kfh + (size_t)ptile * 4096 + s * 1024);
            }
            bf16x8 vf[2][2];
#pragma unroll
            for (int db = 0; db < 2; ++db)
#pragma unroll
                for (int t = 0; t < 2; ++t) vf[db][t] = *(const bf16x8*)(vfh + (size_t)ptile * 4096 + (db * 2 + t) * 1024);
            f32x16 sacc;
#pragma unroll
            for (int e = 0; e < 16; ++e) sacc[e] = 0.f;
#pragma unroll
            for (int s = 0; s < NS; ++s) sacc = __builtin_amdgcn_mfma_f32_32x32x16_bf16(kf[s], qf[s], sacc, 0, 0, 0);
            float tmax = -1e30f;
#pragma unroll
            for (int e = 0; e < 16; ++e) {
                const int kt = kb + kstr * (8 * (e >> 2) + 4 * hh + (e & 3));
                float v = sacc[e] * sc;
                if (MODE == 2) {
                    const int kcol = kt & 63, wsx = min(max(qcol - 8, 0), 48);
                    const bool ok = kcol >= wsx && kcol < wsx + 16;
                    const int drow = (kt >> 6) - qrow_g + 7, dcol = min(max(kcol - qcol, -15), 15) + 15;
                    const float bias = nabl[(h * 15 + drow) * 31 + dcol];
                    v = ok ? v + bias : -1e30f;
                } else if (MODE != 0) {
                    const int dlt = kt - qt;
                    const bool ok = (unsigned)kt < (unsigned)T && dlt <= win && dlt >= -win;
                    v = ok ? v : -1e30f;
                }
                sacc[e] = v; tmax = fmaxf(tmax, v);
            }
            tmax = fmaxf(tmax, __shfl_xor(tmax, 32));
            const float mnew = fmaxf(mrun, tmax), alpha = __builtin_amdgcn_exp2f(mrun - mnew);
            mrun = mnew;
            float psum = 0.f;
#pragma unroll
            for (int e = 0; e < 16; ++e) { const float p = __builtin_amdgcn_exp2f(sacc[e] - mnew); sacc[e] = p; psum += p; }
            lrun = lrun * alpha + psum;
#pragma unroll
            for (int e = 0; e < 16; ++e) { o0[e] *= alpha; o1[e] *= alpha; }
            bf16x8 pb[2];
#pragma unroll
            for (int t = 0; t < 2; ++t) {
                u32x4 v; v.x = cvt_pk_bf16(sacc[8 * t + 0], sacc[8 * t + 1]); v.y = cvt_pk_bf16(sacc[8 * t + 2], sacc[8 * t + 3]);
                v.z = cvt_pk_bf16(sacc[8 * t + 4], sacc[8 * t + 5]); v.w = cvt_pk_bf16(sacc[8 * t + 6], sacc[8 * t + 7]);
                pb[t] = __builtin_bit_cast(bf16x8, v);
            }
            o0 = __builtin_amdgcn_mfma_f32_32x32x16_bf16(vf[0][0], pb[0], o0, 0, 0, 0);
            o0 = __builtin_amdgcn_mfma_f32_32x32x16_bf16(vf[0][1], pb[1], o0, 0, 0, 0);
            o1 = __builtin_amdgcn_mfma_f32_32x32x16_bf16(vf[1][0], pb[0], o1, 0, 0, 0);
            o1 = __builtin_amdgcn_mfma_f32_32x32x16_bf16(vf[1][1], pb[1], o1, 0, 0, 0);
        }
    }
    lrun += __shfl_xor(lrun, 32);
    const float inv = 1.0f / lrun;
    float sq = 0.f;
#pragma unroll
    for (int e = 0; e < 16; ++e) { o0[e] *= inv; o1[e] *= inv; sq += o0[e] * o0[e] + o1[e] * o1[e]; }
    sq += __shfl_xor(sq, 32);
    if (hh == 0) xch[w * 32 + ql] = sq;
    __syncthreads();
    const float tot = (xch[(qs * 4 + 0) * 32 + ql] + xch[(qs * 4 + 1) * 32 + ql]) + (xch[(qs * 4 + 2) * 32 + ql] + xch[(qs * 4 + 3) * 32 + ql]);
    const float rg = rsqrtf(tot * (1.0f / 256.0f) + EPS);
    bf16_t* yrow = (bf16_t*)(ws + OFF_XBA) + (tokbase + qt) * D + group * 256 + h * 64 + 4 * hh;
#pragma unroll
    for (int j = 0; j < 4; ++j) {
        u32x2 w0; w0.x = cvt_pk_bf16(o0[4 * j] * rg, o0[4 * j + 1] * rg); w0.y = cvt_pk_bf16(o0[4 * j + 2] * rg, o0[4 * j + 3] * rg);
        u32x2 w1; w1.x = cvt_pk_bf16(o1[4 * j] * rg, o1[4 * j + 1] * rg); w1.y = cvt_pk_bf16(o1[4 * j + 2] * rg, o1[4 * j + 3] * rg);
        *(u32x2*)(yrow + 8 * j) = w0; *(u32x2*)(yrow + 32 + 8 * j) = w1;
    }
}

__device__ __forceinline__ void attn_phase(KA a, int layer, LAS unsigned char* lds, int wv) {
    AttnP P; P.ws = a->ws; P.nab = a->in[8] + (size_t)layer * 4 * 15 * 31; P.sink = a->in[9] + layer * 4;
    LAS float* xch = (LAS float*)lds;
    for (int i = ltid(wv); i < 4 * 15 * 31; i += 512) xch[1024 + i] = P.nab[i] * LOG2E;
    __syncthreads();
    int it = 0;
    const int G_ = lgrid();
    for (int u = lbid(); u < 2048; u += G_, ++it) {
        LAS float* x = xch + (it & 1) * 256;
        const int mode = u >> 9, unit = u & 511;
        if (mode == 0) attn_unit<0>(P, unit, x, xch + 1024, wv);
        else if (mode == 1) attn_unit<1>(P, unit, x, xch + 1024, wv);
        else if (mode == 2) attn_unit<2>(P, unit, x, xch + 1024, wv);
        else attn_unit<3>(P, unit, x, xch + 1024, wv);
    }
    __syncthreads();
}

__device__ __forceinline__ void grid_bar(unsigned* ctr, unsigned target, int wv) {
    asm volatile("s_waitcnt vmcnt(0) lgkmcnt(0)" ::: "memory");
    __builtin_amdgcn_s_barrier();
    if (wv == 0) {
        if (vlane() == 0) {
            __builtin_amdgcn_fence(__ATOMIC_RELEASE, "agent");
            asm volatile("s_waitcnt vmcnt(0)" ::: "memory");
            __hip_atomic_fetch_add(ctr, 1u, __ATOMIC_RELAXED, __HIP_MEMORY_SCOPE_AGENT);
            unsigned spins = 0;
            while (__hip_atomic_load(ctr, __ATOMIC_RELAXED, __HIP_MEMORY_SCOPE_AGENT) < target) { __builtin_amdgcn_s_sleep(2); if (++spins > (1u << 26)) break; }
            __builtin_amdgcn_fence(__ATOMIC_ACQUIRE, "agent");
            asm volatile("s_waitcnt vmcnt(0)" ::: "memory");
        }
    }
    __builtin_amdgcn_s_barrier();
    asm volatile("" ::: "memory");
}

template <int PH>
__device__ __forceinline__ void run_phase(LAS unsigned char* lds, int wv) {
    KA a = kargs();
    unsigned char* ws = a->ws; asm volatile("" : "+s"(ws));
    bf16_t* Wbase = (bf16_t*)(ws + OFF_W);
    bf16_t* xbA = (bf16_t*)(ws + OFF_XBA); bf16_t* xbB = (bf16_t*)(ws + OFF_XBB);
    bf16_t* Hb = (bf16_t*)(ws + OFF_H); bf16_t* zl = (bf16_t*)(ws + OFF_ZL); bf16_t* qm = (bf16_t*)(ws + OFF_QM);
    unsigned char* vf = ws + OFF_VT;
    bf16_t* pb = (bf16_t*)(ws + OFF_VT);
    float* ssA = (float*)(ws + OFF_SSA); float* ssB = (float*)(ws + OFF_SSB); float* mst = (float*)(ws + OFF_MST);
    const float* cs64 = (const float*)(ws + OFF_CS64); const float* cs32 = (const float*)(ws + OFF_CS32);
    if constexpr (PH == 0) { if (PH_ON(0)) prologue(a, lds, wv); }
    else if constexpr (PH == NPH - 1) { if (PH_ON(1)) final_norm(a, wv); }
    else {
        constexpr int l = (PH - 1) / 9, k = (PH - 1) % 9;
        bf16_t* WL = Wbase + (size_t)l * WL_SIZE;
        if constexpr (k == 0) { if (PH_ON(2)) { EpiGU E{ssA, Hb}; run_gemm(wv, lds, xbA, D, M, WL + WL_GU1, D, 5632, D, 0, E); } }
        else if constexpr (k == 1) { if (PH_ON(3)) { EpiRes E{a->out, xbB, ssB, 0.5f}; run_gemm(wv, lds, Hb, FF, M, WL + WL_D1, FF, D, FF, 0, E); } }
        else if constexpr (k == 2) {
            if (PH_ON(4)) { EpiIn E{ssB, ws, mst, cs64, cs32}; run_gemm(wv, lds, xbB, D, M, WL + WL_IN, D, 2048, D, 0, E); }
            if (PH_ON(5)) { EpiVT E{ssB, vf}; run_gemm(wv, lds, WL + WL_IN + (size_t)2048 * D, D, 768, xbB, D, M, D, 0, E); }
        }
        else if constexpr (k == 3) {
            if (PH_ON(6)) { EpiQ E{mst, qm, cs32}; run_gemm(wv, lds, zl, ZLLD, M, WL + WL_UQ, 256, 512, 256, 0, E); }
            if (PH_ON(7)) { EpiK E{mst, ws}; run_gemm(wv, lds, zl + 256, ZLLD, M, WL + WL_UKV, 128, 256, 128, 0, E); }
            if (PH_ON(8)) { EpiVTM E{mst, vf}; run_gemm(wv, lds, WL + WL_UKV + (size_t)256 * 128, 128, 256, zl + 256, ZLLD, M, 128, 128, E); }
        }
        else if constexpr (k == 4) { if (PH_ON(9)) attn_phase(a, l, lds, wv); }
        else if constexpr (k == 5) { if (PH_ON(3)) { EpiRes E{a->out, xbB, ssB, 1.0f}; run_gemm(wv, lds, xbA, D, M, WL + WL_O, D, D, D, 0, E); } }
        else if constexpr (k == 6) { if (PH_ON(2)) { convert_p(a, l, wv); EpiGU E{ssB, Hb}; run_gemm(wv, lds, xbB, D, M, WL + WL_GU2, D, 5632, D, 0, E); } }
        else if constexpr (k == 7) {
            if (PH_ON(3)) { EpiRes E{a->out, xbB, ssB, 0.5f}; run_gemm(wv, lds, Hb, FF, M, WL + WL_D2, FF, D, FF, 0, E); }
            if (PH_ON(10)) { EpiPP E{xbA}; run_gemm(wv, lds, pb, PLE, M, WL + WL_PP, PLE, D, PLE, 0, E); }
        }
        else { if (PH_ON(11)) { EpiGate E{a->out, ssB, xbA, ssA}; run_gemm(wv, lds, xbB, D, M, WL + WL_PG, D, D, D, 0, E); } }
    }
}
template <int PH>
__device__ __forceinline__ void run_from(LAS unsigned char* lds, int ph_lo, int ph_hi, int wv) {
    if constexpr (PH < NPH) {
        if (PH >= ph_lo && PH < ph_hi) {
            run_phase<PH>(lds, wv);
            if constexpr (PH > 0 && PH < NPH - 1) { if constexpr ((DUPM >> ((PH - 1) % 9)) & 1) { __syncthreads(); run_phase<PH>(lds, wv); } }
            if constexpr (PH == 0 && ((DUPM >> 9) & 1)) { __syncthreads(); run_phase<PH>(lds, wv); }
            if (PH + 1 < ph_hi && kargs()->coop) {
                if constexpr (PH == 0) cg::this_grid().sync();
                else grid_bar((unsigned*)(kargs()->ws + OFF_BAR), (unsigned)PH * (unsigned)lgrid(), wv);
            }
        }
        run_from<PH + 1>(lds, ph_lo, ph_hi, wv);
    }
}
__global__ void __launch_bounds__(512, 2) mega(Args a_unused) {
    extern __shared__ __attribute__((aligned(16))) unsigned char lds_raw[];
    LAS unsigned char* lds = (LAS unsigned char*)lds_raw;
    const int ph_lo = kargs()->ph_lo, ph_hi = kargs()->ph_hi;
    const int wv = __builtin_amdgcn_readfirstlane((int)threadIdx.x >> 6);
    run_from<0>(lds, ph_lo, ph_hi, wv);
}

extern "C" void kernel_launch(void* const* d_in, const int* in_sizes, int n_in, void* d_out, int out_size, void* d_ws, size_t ws_size, hipStream_t stream) {
    static int grid = 0;
    if (grid == 0) {
        if (n_in != 24 || ws_size < WS_END) { fprintf(stderr, "kernel_launch: n_in %d ws %zu (need %zu)\n", n_in, ws_size, (size_t)WS_END); grid = -1; return; }
        int dev = 0, cus = 0, per_cu = 0;
        hipGetDevice(&dev); hipDeviceGetAttribute(&cus, hipDeviceAttributeMultiprocessorCount, dev);
        if (hipFuncSetAttribute((const void*)mega, hipFuncAttributeMaxDynamicSharedMemorySize, LDS_BYTES) != hipSuccess) { fprintf(stderr, "hipFuncSetAttribute failed\n"); grid = -1; return; }
        if (hipOccupancyMaxActiveBlocksPerMultiprocessor(&per_cu, (const void*)mega, 512, LDS_BYTES) != hipSuccess || per_cu < 1) per_cu = 1;
        (void)hipGetLastError();
        grid = cus * per_cu;
    }
    if (grid < 0) return;
    (void)hipMemsetAsync((char*)d_ws + OFF_BAR, 0, 256, stream);
    Args a{};
    for (int i = 0; i < 24; ++i) a.in[i] = (const float*)d_in[i];
    a.out = (float*)d_out; a.ws = (unsigned char*)d_ws;
#if MULTI_LAUNCH
    for (int ph = 0; ph < NPH; ++ph) {
        a.ph_lo = ph; a.ph_hi = ph + 1; a.coop = 0;
        hipLaunchKernelGGL(mega, dim3(grid), dim3(512), LDS_BYTES, stream, a);
    }
#else
    a.ph_lo = 0; a.ph_hi = NPH; a.coop = 1;
    void* args[] = {&a};
    hipError_t e = hipLaunchCooperativeKernel((void*)mega, dim3(grid), dim3(512), args, LDS_BYTES, stream);
    if (e != hipSuccess) fprintf(stderr, "cooperative launch failed: %s (grid %d)\n", hipGetErrorString(e), grid);
#endif
}
```

```cpp
#include <hip/hip_runtime.h>
#include <hip/hip_cooperative_groups.h>
#include <cstdio>
#include <cstdint>
namespace cg = cooperative_groups;

#ifndef MULTI_LAUNCH
#define MULTI_LAUNCH 0
#endif

#ifndef DUPM
#define DUPM 0
#endif
#ifndef PRO_PARTS
#define PRO_PARTS 7
#endif
#ifndef PHM
#define PHM 0xffff
#endif
#define PH_ON(b) (((PHM) >> (b)) & 1)
#define LAS __attribute__((address_space(3)))
typedef unsigned short bf16_t;
typedef short bf16x8 __attribute__((ext_vector_type(8)));
typedef float f32x4 __attribute__((ext_vector_type(4)));
typedef float f32x16 __attribute__((ext_vector_type(16)));
typedef unsigned u32x4 __attribute__((ext_vector_type(4)));
typedef unsigned u32x2 __attribute__((ext_vector_type(2)));

constexpr int M = 32768, T = 2048, D = 1024, FF = 2816, DEPTH = 4, PLE = 256;
constexpr int ZQLD = 768, ZLLD = 384, QLD = 384;
constexpr size_t HEADB = (size_t)16 * 64 * 4096;
constexpr float EPS = 1e-6f;
constexpr float LOG2E = 1.4426950408889634f;

constexpr size_t WL_GU1 = 0, WL_D1 = WL_GU1 + (size_t)5632 * 1024, WL_IN = WL_D1 + (size_t)1024 * 2816, WL_UQ = WL_IN + (size_t)2816 * 1024,
                 WL_UKV = WL_UQ + (size_t)512 * 256, WL_O = WL_UKV + (size_t)512 * 128, WL_GU2 = WL_O + (size_t)1024 * 1024, WL_D2 = WL_GU2 + (size_t)5632 * 1024,
                 WL_PG = WL_D2 + (size_t)1024 * 2816, WL_PP = WL_PG + (size_t)1024 * 1024, WL_SIZE = WL_PP + (size_t)1024 * 256;
constexpr size_t OFF_W = 0;
constexpr size_t OFF_XBA = OFF_W + WL_SIZE * 2 * DEPTH;
constexpr size_t OFF_XBB = OFF_XBA + (size_t)M * D * 2;
constexpr size_t OFF_H = OFF_XBB + (size_t)M * D * 2;
constexpr size_t OFF_ZQ = OFF_H;
constexpr size_t OFF_ZL = OFF_ZQ + (size_t)M * ZQLD * 2;
constexpr size_t OFF_KF = OFF_ZL + (size_t)M * ZLLD * 2;
constexpr size_t OFF_KPE = OFF_KF + 22 * HEADB;
constexpr size_t OFF_VT = OFF_H + (size_t)M * FF * 2;
constexpr size_t OFF_SSA = OFF_VT + 22 * HEADB;
constexpr size_t OFF_SSB = OFF_SSA + (size_t)M * 16 * 4;
constexpr size_t OFF_MST = OFF_SSB + (size_t)M * 16 * 4;
constexpr size_t OFF_CS64 = OFF_MST + (size_t)M * 8 * 4;
constexpr size_t OFF_CS32 = OFF_CS64 + (size_t)T * 64 * 4;
constexpr size_t OFF_BAR = OFF_CS32 + (size_t)T * 32 * 4;
constexpr size_t OFF_QM = OFF_BAR + 256;
constexpr size_t WS_END = OFF_QM + (size_t)M * QLD * 2;
static_assert(OFF_KPE + (size_t)16 * 64 * 2048 <= OFF_VT, "zq|zl|KF|KPE inside the H region");
static_assert(WS_END <= 626121856, "workspace budget");

constexpr int LDS_BYTES = 147456;
constexpr int NPH = 2 + 9 * DEPTH;

__device__ __forceinline__ unsigned cvt_pk_bf16(float lo, float hi) { unsigned r; asm("v_cvt_pk_bf16_f32 %0, %1, %2" : "=v"(r) : "v"(lo), "v"(hi)); return r; }
__device__ __forceinline__ float bf_lo(unsigned u) { return __uint_as_float(u << 16); }
__device__ __forceinline__ float bf_hi(unsigned u) { return __uint_as_float(u & 0xffff0000u); }
__device__ __forceinline__ float sum4(f32x4 a) { return (a.x + a.y) + (a.z + a.w); }
__device__ __forceinline__ float dot4(f32x4 a) { return (a.x * a.x + a.y * a.y) + (a.z * a.z + a.w * a.w); }
__device__ __forceinline__ float rs16(const float* ss, int row) {
    const f32x4* p = (const f32x4*)(ss + (size_t)row * 16);
    const f32x4 a = p[0], b = p[1], c = p[2], d = p[3];
    return rsqrtf(((sum4(a) + sum4(b)) + (sum4(c) + sum4(d))) * (1.0f / 1024.0f) + EPS);
}
__device__ __forceinline__ int vlane() { int l; asm volatile("v_mbcnt_lo_u32_b32 %0, -1, 0\n\tv_mbcnt_hi_u32_b32 %0, -1, %0" : "=v"(l)); return l; }
__device__ __forceinline__ int ltid(int wv) { return (wv << 6) | vlane(); }
__device__ __forceinline__ int lbid() { int b = blockIdx.x; asm volatile("" : "+s"(b)); return b; }
__device__ __forceinline__ int lgrid() { int g = gridDim.x; asm volatile("" : "+s"(g)); return g; }
__device__ __forceinline__ float sigmoidf_(float v) { return __builtin_amdgcn_rcpf(1.0f + __expf(-v)); }

namespace pg8 {
constexpr int BM = 256, BK = 64, HALF = 128, HTB = HALF * BK * 2, STAGE_BYTES = 8 * HTB, NXCD = 8, WGM = 8;
__host__ __device__ __forceinline__ int lds_byte(int r, int c) { const int st = (r >> 4) * 2 + (c >> 5), rr = r & 15, cc = c & 31, ob = rr * 64 + cc * 2; return st * 1024 + (ob ^ (((ob >> 9) & 1) << 5)); }
__host__ __device__ __forceinline__ void stage_rc(int b, int& R, int& C) { const int st = b / 1024, sb = b % 1024, swz = sb ^ (((sb >> 9) & 1) << 5); R = (st >> 1) * 16 + swz / 64; C = (st & 1) * 32 + (swz % 64) / 2; }
__host__ __device__ __forceinline__ int perm32(int rho) { const int n = rho >> 4, i = rho & 15; return 8 * (i >> 2) + 4 * n + (i & 3); }

struct Unit { int pm, pn; };
struct Gemm { const bf16_t* A; const bf16_t* Bt; int lda, ldb, K; };

struct StaticOrder {
    int nM, nN, nwg, G, c;
    __device__ void init(int Mr, int Nc, int G_, int c_) { nM = Mr / BM; nN = Nc / BM; nwg = nM * nN; G = G_; c = c_; }
    __device__ bool next(int i, Unit& u) const {
        const long L = (long)i * G + c; if (L >= nwg) return false;
        int wgid = (int)L; { const int q = nwg / NXCD, r = nwg % NXCD, xcd = wgid % NXCD, off = wgid / NXCD; wgid = (xcd < r ? xcd * (q + 1) : r * (q + 1) + (xcd - r) * q) + off; }
        const int nig = WGM * nN, gid = wgid / nig, fm = gid * WGM, gsz = (nM - fm) < WGM ? (nM - fm) : WGM;
        u.pm = fm + ((wgid % nig) % gsz); u.pn = (wgid % nig) / gsz; return true;
    }
};

template <class Epi>
__device__ __forceinline__ void gemm_phase(LAS unsigned char* lds, const Gemm g, const StaticOrder& S, const Epi& E, int wv) {
    const int tid = ltid(wv);
    const int wid = wv, lane = tid & 63, wr = wid >> 2, wc = wid & 3, fr = lane & 15, fq = lane >> 4;
    const int K = g.K, nt = K / BK;
    unsigned voffA[2], voffB[2];
#pragma unroll
    for (int i = 0; i < 2; ++i) { int R, C; stage_rc(tid * 16 + i * 8192, R, C); const int Rb = (R & ~31) + perm32(R & 31);
        voffA[i] = (unsigned)(R * g.lda + C) * 2u; voffB[i] = (unsigned)(Rb * g.ldb + C) * 2u; }
    const size_t kstep = (size_t)(BK * 2);
    const size_t hstepA = (size_t)HALF * g.lda * 2, hstepB = (size_t)HALF * g.ldb * 2;
    const size_t tstepA = 2 * hstepA, tstepB = 2 * hstepB;
    const unsigned ldsw = (unsigned)wid * 1024u;
    const int aoff = lds_byte(wr * 64 + fr, fq * 8), boff = lds_byte(wc * 32 + fr, fq * 8);
#define PG8_SA(b, h) (((b) * 2 + (h)) * HTB)
#define PG8_SB(b, h) ((4 + (b) * 2 + (h)) * HTB)
#define PG8_STAGE(bufoff, gbase, voff) do { _Pragma("unroll") for (int _i = 0; _i < 2; ++_i) \
        __builtin_amdgcn_global_load_lds((const unsigned*)((const char*)(gbase) + (voff)[_i]), (LAS unsigned*)(lds + (bufoff) + ldsw + _i * 8192), 16, 0, 0); } while (0)
#define PG8_LDA(dst, b, h) do { _Pragma("unroll") for (int m = 0; m < 4; ++m) _Pragma("unroll") for (int k = 0; k < 2; ++k) dst[m][k] = *(const LAS bf16x8*)(lds + PG8_SA(b, h) + aoff + m * 2048 + k * 1024); } while (0)
#define PG8_LDB(dst, b, h) do { _Pragma("unroll") for (int n = 0; n < 2; ++n) _Pragma("unroll") for (int k = 0; k < 2; ++k) dst[n][k] = *(const LAS bf16x8*)(lds + PG8_SB(b, h) + boff + n * 2048 + k * 1024); } while (0)
#define PG8_MMA(ai, bj, At, Bt) do { __builtin_amdgcn_s_setprio(1); _Pragma("unroll") for (int m = 0; m < 4; ++m) _Pragma("unroll") for (int n = 0; n < 2; ++n) _Pragma("unroll") for (int k = 0; k < 2; ++k) \
        acc[ai][bj][m][n] = __builtin_amdgcn_mfma_f32_16x16x32_bf16(Bt[n][k], At[m][k], acc[ai][bj][m][n], 0, 0, 0); __builtin_amdgcn_s_setprio(0); } while (0)
#define PG8_WAIT_V(n) asm volatile("s_waitcnt vmcnt(" #n ")" ::: "memory")
#define PG8_WAIT_L(n) asm volatile("s_waitcnt lgkmcnt(" #n ")" ::: "memory")
#define PG8_BAR __builtin_amdgcn_s_barrier()
#define PG8_SCHED __builtin_amdgcn_sched_barrier(0)
    Unit cur, nxt; int ui = 0;
    if (!S.next(0, cur)) return;
    f32x4 acc[2][2][4][2];
#pragma unroll
    for (int a = 0; a < 2; ++a)
#pragma unroll
        for (int b = 0; b < 2; ++b)
#pragma unroll
            for (int m = 0; m < 4; ++m)
#pragma unroll
                for (int n = 0; n < 2; ++n) acc[a][b][m][n] = (f32x4){0.f, 0.f, 0.f, 0.f};
    bf16x8 At[4][2], B0[2][2], B1[2][2];
    const char* cA = (const char*)g.A + (size_t)cur.pm * tstepA; const char* cB = (const char*)g.Bt + (size_t)cur.pn * tstepB;
    PG8_STAGE(PG8_SB(0, 0), cB, voffB); PG8_STAGE(PG8_SB(0, 1), cB + hstepB, voffB); PG8_STAGE(PG8_SA(0, 0), cA, voffA); PG8_STAGE(PG8_SA(0, 1), cA + hstepA, voffA);
    if (wr == 1) PG8_BAR;
    PG8_WAIT_V(2); PG8_BAR;
    PG8_STAGE(PG8_SB(1, 0), cB + kstep, voffB); PG8_STAGE(PG8_SA(1, 0), cA + kstep, voffA); PG8_STAGE(PG8_SB(1, 1), cB + hstepB + kstep, voffB);
    PG8_WAIT_V(6); PG8_BAR;
    for (;;) {
        const bool has_next = S.next(ui + 1, nxt);
        const char* nA = has_next ? (const char*)g.A + (size_t)nxt.pm * tstepA : cA; const char* nB = has_next ? (const char*)g.Bt + (size_t)nxt.pn * tstepB : cB;
        for (int t = 0; t < nt; t += 2) {
            const bool last = (t == nt - 2);
            const char* a1 = cA + (size_t)(t + 1) * kstep;
            const char* a2 = last ? nA : cA + (size_t)(t + 2) * kstep; const char* b2 = last ? nB : cB + (size_t)(t + 2) * kstep;
            const char* a3 = a2 + kstep; const char* b3 = b2 + kstep;
            PG8_LDB(B0, 0, 0); PG8_LDB(B1, 0, 1); PG8_SCHED; PG8_LDA(At, 0, 0); PG8_STAGE(PG8_SA(1, 1), a1 + hstepA, voffA);
            PG8_WAIT_V(8); PG8_WAIT_L(0); PG8_BAR; PG8_MMA(0, 0, At, B0); PG8_MMA(0, 1, At, B1); PG8_BAR; PG8_SCHED;
            PG8_LDA(At, 0, 1); PG8_STAGE(PG8_SB(0, 0), b2, voffB); PG8_STAGE(PG8_SB(0, 1), b2 + hstepB, voffB); PG8_STAGE(PG8_SA(0, 0), a2, voffA);
            PG8_WAIT_V(8); PG8_WAIT_L(0); PG8_BAR; PG8_MMA(1, 0, At, B0); PG8_MMA(1, 1, At, B1); PG8_BAR; PG8_SCHED;
            PG8_LDB(B0, 1, 0); PG8_LDB(B1, 1, 1); PG8_SCHED; PG8_LDA(At, 1, 0); PG8_STAGE(PG8_SA(0, 1), a2 + hstepA, voffA);
            PG8_WAIT_V(8); PG8_WAIT_L(0); PG8_BAR; PG8_MMA(0, 0, At, B0); PG8_MMA(0, 1, At, B1); PG8_BAR; PG8_SCHED;
            PG8_LDA(At, 1, 1); PG8_STAGE(PG8_SB(1, 0), b3, voffB); PG8_STAGE(PG8_SB(1, 1), b3 + hstepB, voffB); PG8_STAGE(PG8_SA(1, 0), a3, voffA);
            PG8_WAIT_V(8); PG8_WAIT_L(0); PG8_BAR; PG8_MMA(1, 0, At, B0); PG8_MMA(1, 1, At, B1); PG8_BAR; PG8_SCHED;
        }
        if (wr == 0) PG8_BAR;
        E(acc, cur, wr, wc, fr, fq);
        if (!has_next) break;
#pragma unroll
        for (int a = 0; a < 2; ++a)
#pragma unroll
            for (int b = 0; b < 2; ++b)
#pragma unroll
                for (int m = 0; m < 4; ++m)
#pragma unroll
                    for (int n = 0; n < 2; ++n) acc[a][b][m][n] = (f32x4){0.f, 0.f, 0.f, 0.f};
        cur = nxt; cA = nA; cB = nB; ++ui;
        if (wr == 1) PG8_BAR;
    }
    PG8_WAIT_V(0);
    PG8_BAR;
#undef PG8_SA
#undef PG8_SB
#undef PG8_STAGE
#undef PG8_LDA
#undef PG8_LDB
#undef PG8_MMA
#undef PG8_WAIT_V
#undef PG8_WAIT_L
#undef PG8_BAR
#undef PG8_SCHED
}
}
using pg8::Unit;
typedef const f32x4 (&AccRef)[2][2][4][2];

struct EpiGU {
    const float* ss; bf16_t* H;
    __device__ __forceinline__ void operator()(AccRef acc, const Unit& u, int wr, int wc, int, int) const { const int lane_ = vlane(); const int fr = lane_ & 15, fq = lane_ >> 4;
#pragma unroll
        for (int ai = 0; ai < 2; ++ai)
#pragma unroll
            for (int m = 0; m < 4; ++m) {
                const int row = u.pm * 256 + ai * 128 + wr * 64 + m * 16 + fr;
                asm volatile("" ::: "memory");
                const float r = rs16(ss, row);
#pragma unroll
                for (int bj = 0; bj < 2; ++bj) {
                    const f32x4 g = acc[ai][bj][m][0] * r, v = acc[ai][bj][m][1] * r;
                    const float h0 = g.x * sigmoidf_(g.x) * v.x, h1 = g.y * sigmoidf_(g.y) * v.y, h2 = g.z * sigmoidf_(g.z) * v.z, h3 = g.w * sigmoidf_(g.w) * v.w;
                    u32x2 w; w.x = cvt_pk_bf16(h0, h1); w.y = cvt_pk_bf16(h2, h3);
                    *(u32x2*)(H + (size_t)row * FF + u.pn * 128 + bj * 64 + wc * 16 + fq * 4) = w;
                }
            }
    }
};
struct EpiRes {
    float* X; bf16_t* xb; float* ssOut; float alpha;
    __device__ __forceinline__ void operator()(AccRef acc, const Unit& u, int wr, int wc, int, int) const { const int lane_ = vlane(); const int fr = lane_ & 15, fq = lane_ >> 4;
#pragma unroll
        for (int ai = 0; ai < 2; ++ai)
#pragma unroll
            for (int m = 0; m < 4; ++m) {
                const int row = u.pm * 256 + ai * 128 + wr * 64 + m * 16 + fr;
                asm volatile("" ::: "memory");
                float sq = 0.f;
#pragma unroll
                for (int bj = 0; bj < 2; ++bj) {
                    const size_t off = (size_t)row * D + u.pn * 256 + bj * 128 + wc * 32 + fq * 8;
                    f32x4 x0 = *(const f32x4*)(X + off), x1 = *(const f32x4*)(X + off + 4);
                    x0 += acc[ai][bj][m][0] * alpha; x1 += acc[ai][bj][m][1] * alpha;
                    *(f32x4*)(X + off) = x0; *(f32x4*)(X + off + 4) = x1;
                    sq += dot4(x0) + dot4(x1);
                    u32x4 w; w.x = cvt_pk_bf16(x0.x, x0.y); w.y = cvt_pk_bf16(x0.z, x0.w); w.z = cvt_pk_bf16(x1.x, x1.y); w.w = cvt_pk_bf16(x1.z, x1.w);
                    *(u32x4*)(xb + off) = w;
                }
                sq += __shfl_xor(sq, 16); sq += __shfl_xor(sq, 32);
                if (fq == 0) ssOut[(size_t)row * 16 + u.pn * 4 + wc] = sq;
            }
    }
};
struct EpiGate {
    float* X; const float* ssIn; bf16_t* ppxb; float* ssOut;
    __device__ __forceinline__ void operator()(AccRef acc, const Unit& u, int wr, int wc, int, int) const { const int lane_ = vlane(); const int fr = lane_ & 15, fq = lane_ >> 4;
#pragma unroll
        for (int ai = 0; ai < 2; ++ai)
#pragma unroll
            for (int m = 0; m < 4; ++m) {
                const int row = u.pm * 256 + ai * 128 + wr * 64 + m * 16 + fr;
                asm volatile("" ::: "memory");
                const float r = rs16(ssIn, row);
                float sq = 0.f;
#pragma unroll
                for (int bj = 0; bj < 2; ++bj) {
                    const size_t off = (size_t)row * D + u.pn * 256 + bj * 128 + wc * 32 + fq * 8;
                    f32x4 x0 = *(const f32x4*)(X + off), x1 = *(const f32x4*)(X + off + 4);
                    const u32x4 pp = *(const u32x4*)(ppxb + off);
                    const f32x4 a0 = acc[ai][bj][m][0] * r, a1 = acc[ai][bj][m][1] * r;
                    x0.x += sigmoidf_(a0.x) * bf_lo(pp.x); x0.y += sigmoidf_(a0.y) * bf_hi(pp.x); x0.z += sigmoidf_(a0.z) * bf_lo(pp.y); x0.w += sigmoidf_(a0.w) * bf_hi(pp.y);
                    x1.x += sigmoidf_(a1.x) * bf_lo(pp.z); x1.y += sigmoidf_(a1.y) * bf_hi(pp.z); x1.z += sigmoidf_(a1.z) * bf_lo(pp.w); x1.w += sigmoidf_(a1.w) * bf_hi(pp.w);
                    *(f32x4*)(X + off) = x0; *(f32x4*)(X + off + 4) = x1;
                    sq += dot4(x0) + dot4(x1);
                    u32x4 w; w.x = cvt_pk_bf16(x0.x, x0.y); w.y = cvt_pk_bf16(x0.z, x0.w); w.z = cvt_pk_bf16(x1.x, x1.y); w.w = cvt_pk_bf16(x1.z, x1.w);
                    *(u32x4*)(ppxb + off) = w;
                }
                sq += __shfl_xor(sq, 16); sq += __shfl_xor(sq, 32);
                if (fq == 0) ssOut[(size_t)row * 16 + u.pn * 4 + wc] = sq;
            }
    }
};
__device__ __forceinline__ void rope_rot(f32x4& v0, f32x4& v1, const float* cs) {
    const f32x4 c = *(const f32x4*)cs, s = *(const f32x4*)(cs + 4);
    const f32x4 a = v0 * c - v1 * s, b = v1 * c + v0 * s; v0 = a; v1 = b;
}
struct EpiIn {
    const float* ss; unsigned char* ws; float* mst; const float* cs64; const float* cs32;
    __device__ __forceinline__ void operator()(AccRef acc, const Unit& u, int wr, int wc, int, int) const { const int lane_ = vlane(); const int fr = lane_ & 15, fq = lane_ >> 4;
#pragma unroll
        for (int ai = 0; ai < 2; ++ai)
#pragma unroll
            for (int m = 0; m < 4; ++m) {
                const int row = u.pm * 256 + ai * 128 + wr * 64 + m * 16 + fr;
                asm volatile("" ::: "memory");
                const float r = rs16(ss, row);
                const int pos = row & (T - 1), b = row >> 11;
                float sq = 0.f;
#pragma unroll
                for (int bj = 0; bj < 2; ++bj) {
                    const int gcol = u.pn * 256 + bj * 128 + wc * 32;
                    f32x4 v0 = acc[ai][bj][m][0] * r, v1 = acc[ai][bj][m][1] * r;
                    const bool r64 = (gcol >= 512 && gcol < 896) || (gcol >= 1024 && gcol < 1536);
                    if (r64) rope_rot(v0, v1, cs64 + ((size_t)pos * 8 + 4 * ((gcol >> 5) & 1) + fq) * 8);
                    if (gcol == 1920) rope_rot(v0, v1, cs32 + ((size_t)pos * 4 + fq) * 8);
                    if (u.pn == 6 || (u.pn == 7 && bj == 0)) sq += dot4(v0) + dot4(v1);
                    u32x4 w; w.x = cvt_pk_bf16(v0.x, v0.y); w.y = cvt_pk_bf16(v0.z, v0.w); w.z = cvt_pk_bf16(v1.x, v1.y); w.w = cvt_pk_bf16(v1.z, v1.w);
                    const int c8 = ((gcol & 63) >> 3) + fq;
                    const size_t frag = (size_t)(c8 >> 1) * 1024 + (size_t)((pos & 31) + 32 * (c8 & 1)) * 16;
                    const size_t rec = ((size_t)b * 64 + (pos >> 5)) * 4096;
                    if (gcol < 256) *(u32x4*)(ws + OFF_ZQ + ((size_t)row * ZQLD + gcol + fq * 8) * 2) = w;
                    else if (gcol < 512) *(u32x4*)(ws + OFF_KF + (size_t)((gcol - 256) >> 6) * HEADB + rec + frag) = w;
                    else if (gcol < 768) *(u32x4*)(ws + OFF_ZQ + ((size_t)row * ZQLD + (gcol - 256) + fq * 8) * 2) = w;
                    else if (gcol < 896) *(u32x4*)(ws + OFF_KF + (size_t)(4 + ((gcol - 768) >> 6)) * HEADB + rec + frag) = w;
                    else if (gcol < 1024) { }
                    else if (gcol < 1280) *(u32x4*)(ws + OFF_ZQ + ((size_t)row * ZQLD + (gcol - 512) + fq * 8) * 2) = w;
                    else if (gcol < 1536) {
                        const int hd = (gcol - 1280) >> 6;
                        *(u32x4*)(ws + OFF_KF + (size_t)(6 + hd) * HEADB + rec + frag) = w;
                        const int p4 = (pos & 3) * 512 + (pos >> 2), p16 = (pos & 15) * 128 + (pos >> 4);
                        *(u32x4*)(ws + OFF_KF + (size_t)(10 + hd) * HEADB + ((size_t)b * 64 + (p4 >> 5)) * 4096 + (size_t)(c8 >> 1) * 1024 + (size_t)((p4 & 31) + 32 * (c8 & 1)) * 16) = w;
                        *(u32x4*)(ws + OFF_KF + (size_t)(14 + hd) * HEADB + ((size_t)b * 64 + (p16 >> 5)) * 4096 + (size_t)(c8 >> 1) * 1024 + (size_t)((p16 & 31) + 32 * (c8 & 1)) * 16) = w;
                    }
                    else if (gcol < 1920) *(u32x4*)(ws + OFF_ZL + ((size_t)row * ZLLD + (gcol - 1536) + fq * 8) * 2) = w;
                    else if (gcol == 1920) *(u32x4*)(ws + OFF_KPE + ((size_t)b * 64 + (pos >> 5)) * 2048 + (size_t)(fq >> 1) * 1024 + (size_t)((pos & 31) + 32 * (fq & 1)) * 16) = w;
                }
                if (u.pn >= 6) {
                    sq += __shfl_xor(sq, 16); sq += __shfl_xor(sq, 32);
                    if (fq == 0) mst[(size_t)row * 8 + (u.pn - 6) * 4 + wc] = sq;
                }
            }
    }
};
__device__ __forceinline__ void vstore8(unsigned char* vf, int vhead, int dd, int tok0, u32x4 w) {
    const int b = tok0 >> 11, pos0 = tok0 & (T - 1), idx0 = pos0 & 31;
    unsigned char* p = vf + (size_t)vhead * HEADB + ((size_t)b * 64 + (pos0 >> 5)) * 4096 + (size_t)((dd >> 5) * 2 + (idx0 >> 4)) * 1024 + (size_t)(dd & 31) * 16 + ((idx0 >> 3) & 1) * 8;
    u32x2 lo; lo.x = w.x; lo.y = w.y; u32x2 hi; hi.x = w.z; hi.y = w.w;
    *(u32x2*)p = lo; *(u32x2*)(p + 512) = hi;
}
__device__ __forceinline__ void vstore1(unsigned char* vf, int vhead, int dd, int b, int ppos, bf16_t val) {
    const int idx = ppos & 31, r16 = idx & 15;
    unsigned char* p = vf + (size_t)vhead * HEADB + ((size_t)b * 64 + (ppos >> 5)) * 4096 + (size_t)((dd >> 5) * 2 + (idx >> 4)) * 1024 + (size_t)((dd & 31) + 32 * ((r16 >> 2) & 1)) * 16 + (r16 >> 3) * 8 + (r16 & 3) * 2;
    *(bf16_t*)p = val;
}
struct EpiVT {
    const float* ss; unsigned char* vf;
    __device__ __forceinline__ void operator()(AccRef acc, const Unit& u, int wr, int wc, int, int) const { const int lane_ = vlane(); const int fr = lane_ & 15, fq = lane_ >> 4;
#pragma unroll
        for (int bj = 0; bj < 2; ++bj) {
            const int tok0 = u.pn * 256 + bj * 128 + wc * 32 + fq * 8;
            float rs[8];
#pragma unroll
            for (int e = 0; e < 8; ++e) rs[e] = rs16(ss, tok0 + e);
#pragma unroll
            for (int ai = 0; ai < 2; ++ai) {
                const int rbase = u.pm * 256 + ai * 128;
                if (rbase >= 640) continue;
                const bool dil = rbase >= 384;
#pragma unroll
                for (int m = 0; m < 4; ++m) {
                    const int row = rbase + wr * 64 + m * 16 + fr;
                    asm volatile("" ::: "memory");
                    const f32x4 a0 = acc[ai][bj][m][0], a1 = acc[ai][bj][m][1];
                    u32x4 w; w.x = cvt_pk_bf16(a0.x * rs[0], a0.y * rs[1]); w.y = cvt_pk_bf16(a0.z * rs[2], a0.w * rs[3]);
                    w.z = cvt_pk_bf16(a1.x * rs[4], a1.y * rs[5]); w.w = cvt_pk_bf16(a1.z * rs[6], a1.w * rs[7]);
                    const int vhead = row >> 6, dd = row & 63;
                    vstore8(vf, vhead, dd, tok0, w);
                    if (dil) {
                        const int b = tok0 >> 11, t0 = tok0 & (T - 1);
                        const unsigned ww[4] = {w.x, w.y, w.z, w.w};
#pragma unroll
                        for (int e = 0; e < 8; ++e) {
                            const int t = t0 + e; const bf16_t val = (bf16_t)((e & 1) ? (ww[e >> 1] >> 16) : (ww[e >> 1] & 0xffffu));
                            vstore1(vf, vhead + 4, dd, b, (t & 3) * 512 + (t >> 2), val);
                            vstore1(vf, vhead + 8, dd, b, (t & 15) * 128 + (t >> 4), val);
                        }
                    }
                }
            }
        }
    }
};
struct EpiQ {
    const float* mst; bf16_t* qm; const float* cs32;
    __device__ __forceinline__ void operator()(AccRef acc, const Unit& u, int wr, int wc, int, int) const { const int lane_ = vlane(); const int fr = lane_ & 15, fq = lane_ >> 4;
#pragma unroll
        for (int ai = 0; ai < 2; ++ai)
#pragma unroll
            for (int m = 0; m < 4; ++m) {
                const int row = u.pm * 256 + ai * 128 + wr * 64 + m * 16 + fr;
                asm volatile("" ::: "memory");
                const f32x4 st = *(const f32x4*)(mst + (size_t)row * 8);
                const float r = rsqrtf(sum4(st) * (1.0f / 256.0f) + EPS);
                const int pos = row & (T - 1);
#pragma unroll
                for (int bj = 0; bj < 2; ++bj) {
                    const int gcol = u.pn * 256 + bj * 128 + wc * 32;
                    if (gcol >= 384) continue;
                    f32x4 v0 = acc[ai][bj][m][0] * r, v1 = acc[ai][bj][m][1] * r;
                    if (((gcol >> 5) % 3) == 2) rope_rot(v0, v1, cs32 + ((size_t)pos * 4 + fq) * 8);
                    u32x4 w; w.x = cvt_pk_bf16(v0.x, v0.y); w.y = cvt_pk_bf16(v0.z, v0.w); w.z = cvt_pk_bf16(v1.x, v1.y); w.w = cvt_pk_bf16(v1.z, v1.w);
                    *(u32x4*)(qm + (size_t)row * QLD + gcol + fq * 8) = w;
                }
            }
    }
};
struct EpiK {
    const float* mst; unsigned char* ws;
    __device__ __forceinline__ void operator()(AccRef acc, const Unit& u, int wr, int wc, int, int) const { const int lane_ = vlane(); const int fr = lane_ & 15, fq = lane_ >> 4;
#pragma unroll
        for (int ai = 0; ai < 2; ++ai)
#pragma unroll
            for (int m = 0; m < 4; ++m) {
                const int row = u.pm * 256 + ai * 128 + wr * 64 + m * 16 + fr;
                asm volatile("" ::: "memory");
                const f32x4 st = *(const f32x4*)(mst + (size_t)row * 8 + 4);
                const float r = rsqrtf(sum4(st) * (1.0f / 128.0f) + EPS);
#pragma unroll
                for (int bj = 0; bj < 2; ++bj) {
                    const f32x4 v0 = acc[ai][bj][m][0] * r, v1 = acc[ai][bj][m][1] * r;
                    u32x4 w; w.x = cvt_pk_bf16(v0.x, v0.y); w.y = cvt_pk_bf16(v0.z, v0.w); w.z = cvt_pk_bf16(v1.x, v1.y); w.w = cvt_pk_bf16(v1.z, v1.w);
                    const int col0 = bj * 128 + wc * 32, c8 = ((col0 & 63) >> 3) + fq, pos = row & (T - 1);
                    *(u32x4*)(ws + OFF_KF + (size_t)(18 + (col0 >> 6)) * HEADB + ((size_t)(row >> 11) * 64 + (pos >> 5)) * 4096 + (size_t)(c8 >> 1) * 1024 + (size_t)((pos & 31) + 32 * (c8 & 1)) * 16) = w;
                }
            }
    }
};
struct EpiVTM {
    const float* mst; unsigned char* vf;
    __device__ __forceinline__ void operator()(AccRef acc, const Unit& u, int wr, int wc, int, int) const { const int lane_ = vlane(); const int fr = lane_ & 15, fq = lane_ >> 4;
#pragma unroll
        for (int bj = 0; bj < 2; ++bj) {
            const int tok0 = u.pn * 256 + bj * 128 + wc * 32 + fq * 8;
            float rs[8];
#pragma unroll
            for (int e = 0; e < 8; ++e) { const f32x4 st = *(const f32x4*)(mst + (size_t)(tok0 + e) * 8 + 4); rs[e] = rsqrtf(sum4(st) * (1.0f / 128.0f) + EPS); }
#pragma unroll
            for (int ai = 0; ai < 2; ++ai)
#pragma unroll
                for (int m = 0; m < 4; ++m) {
                    const int row = ai * 128 + wr * 64 + m * 16 + fr;
                    asm volatile("" ::: "memory");
                    const f32x4 a0 = acc[ai][bj][m][0], a1 = acc[ai][bj][m][1];
                    u32x4 w; w.x = cvt_pk_bf16(a0.x * rs[0], a0.y * rs[1]); w.y = cvt_pk_bf16(a0.z * rs[2], a0.w * rs[3]);
                    w.z = cvt_pk_bf16(a1.x * rs[4], a1.y * rs[5]); w.w = cvt_pk_bf16(a1.z * rs[6], a1.w * rs[7]);
                    vstore8(vf, 18 + (row >> 6), row & 63, tok0, w);
                }
        }
    }
};
struct EpiPP {
    bf16_t* O;
    __device__ __forceinline__ void operator()(AccRef acc, const Unit& u, int wr, int wc, int, int) const { const int lane_ = vlane(); const int fr = lane_ & 15, fq = lane_ >> 4;
#pragma unroll
        for (int ai = 0; ai < 2; ++ai)
#pragma unroll
            for (int m = 0; m < 4; ++m) {
                const int row = u.pm * 256 + ai * 128 + wr * 64 + m * 16 + fr;
                asm volatile("" ::: "memory");
#pragma unroll
                for (int bj = 0; bj < 2; ++bj) {
                    const f32x4 v0 = acc[ai][bj][m][0], v1 = acc[ai][bj][m][1];
                    u32x4 w; w.x = cvt_pk_bf16(v0.x, v0.y); w.y = cvt_pk_bf16(v0.z, v0.w); w.z = cvt_pk_bf16(v1.x, v1.y); w.w = cvt_pk_bf16(v1.z, v1.w);
                    *(u32x4*)(O + (size_t)row * D + u.pn * 256 + bj * 128 + wc * 32 + fq * 8) = w;
                }
            }
    }
};

template <class Epi>
__device__ __forceinline__ void run_gemm(int wv, LAS unsigned char* lds, const bf16_t* A, int lda, int rows, const bf16_t* Bt, int ldb, int cols, int K, int cshift, const Epi& E) {
    pg8::Gemm g{A, Bt, lda, ldb, K};
    pg8::StaticOrder S; const int G_ = lgrid(); S.init(rows, cols, G_, (lbid() + cshift) % G_);
    pg8::gemm_phase<Epi>(lds, g, S, E, wv);
}

__device__ __forceinline__ int p64(int d) { return d < 32 ? 8 * (d >> 2) + (d & 3) : 8 * ((d - 32) >> 2) + 4 + (d & 3); }
__device__ __forceinline__ int p32(int d) { return d < 16 ? 8 * (d >> 2) + (d & 3) : 8 * ((d - 16) >> 2) + 4 + (d & 3); }
__device__ __forceinline__ int maprow(int mapid, int c) {
    switch (mapid) {
        case 0: return c;
        case 1: return (c >> 2) * 8 + (c & 3);
        case 2: return (c >> 2) * 8 + 4 + (c & 3);
        case 3: {
            if (c < 768) return c < 512 ? c : 2048 + (c - 512);
            c -= 768;
            if (c < 512) return c < 384 ? 512 + (c >> 6) * 64 + p64(c & 63) : 2048 + 256 + (c - 384);
            c -= 512;
            if (c < 768) return c < 512 ? 1024 + (c >> 6) * 64 + p64(c & 63) : 2048 + 384 + (c - 512);
            c -= 768;
            if (c < 256) return 1536 + c;
            if (c < 384) return 1792 + (c - 256);
            return 1920 + p32(c - 384);
        }
        case 4: { const int h = c / 96, e = c % 96; return e < 64 ? 96 * h + e : 96 * h + 64 + p32(e - 64); }
        default: { const int h = c >> 7, e = c & 127; return e < 64 ? 64 * h + e : 256 + 64 * h + (e - 64); }
    }
}
__device__ __forceinline__ void tr_item(const float* W, int K, int N, const float* gain, bf16_t* dst, int mapid, int item, LAS float* s, int wv) {
    const int tid = ltid(wv);
    const int ncb = (N + 255) >> 8, kb = item / ncb, cb = item % ncb, k0 = kb * 64, c0 = cb * 256;
#pragma unroll
    for (int i = 0; i < 8; ++i) {
        const int kk = i * 8 + (tid >> 6), col = (tid & 63) * 4;
        f32x4 v = (f32x4){0.f, 0.f, 0.f, 0.f};
        if (c0 + col < N) v = *(const f32x4*)(W + (size_t)(k0 + kk) * N + c0 + col);
        if (gain) v *= gain[k0 + kk];
        *(LAS f32x4*)(s + kk * 260 + col) = v;
    }
    __syncthreads();
    const int cc = tid & 255, kh = tid >> 8, c = c0 + cc;
    if (c < N) {
        const int drow = maprow(mapid, c);
        bf16_t* o = dst + (size_t)drow * K + k0 + kh * 32;
#pragma unroll
        for (int q = 0; q < 4; ++q) {
            const LAS float* sp = s + (kh * 32 + q * 8) * 260 + cc;
            u32x4 w; w.x = cvt_pk_bf16(sp[0], sp[260]); w.y = cvt_pk_bf16(sp[2 * 260], sp[3 * 260]); w.z = cvt_pk_bf16(sp[4 * 260], sp[5 * 260]); w.w = cvt_pk_bf16(sp[6 * 260], sp[7 * 260]);
            *(u32x4*)(o + q * 8) = w;
        }
    }
    __syncthreads();
}

struct Args { const float* in[24]; float* out; unsigned char* ws; int ph_lo, ph_hi, coop, pad; };
typedef const __attribute__((address_space(4))) Args* KA;
__device__ __forceinline__ KA kargs() { KA p = (KA)__builtin_amdgcn_kernarg_segment_ptr(); asm volatile("" : "+s"(p)); return p; }

__device__ __forceinline__ void zero_rows(bf16_t* base, int row0, int nrows, int K, int gt, int ngt) {
    const size_t n16 = (size_t)nrows * K / 8; u32x4* p = (u32x4*)(base + (size_t)row0 * K);
    for (size_t i = gt; i < n16; i += ngt) p[i] = (u32x4){0u, 0u, 0u, 0u};
}

__device__ __forceinline__ void prologue(KA a, LAS unsigned char* lds, int wv) {
    LAS float* s = (LAS float*)lds;
    const int G = lgrid(), bid = lbid(), tid = ltid(wv);
    bf16_t* Wbase = (bf16_t*)(a->ws + OFF_W);
#if PRO_PARTS & 1
    constexpr int I_FFN = 16 * 11, I_DN = 44 * 4, I_IN = 16 * 10, I_UQ = 4 * 2, I_UKV = 2 * 2, I_O = 16 * 4, I_PP = 4 * 4;
    constexpr int I_LAYER = 4 * I_FFN + 2 * I_DN + I_IN + I_UQ + I_UKV + 2 * I_O + I_PP;
    for (int it = bid; it < I_LAYER * DEPTH; it += G) {
        const int l = it / I_LAYER; int r = it % I_LAYER;
        int sel = 0;
        if (r >= I_FFN) { r -= I_FFN; sel = 1;
        if (r >= I_FFN) { r -= I_FFN; sel = 2;
        if (r >= I_DN) { r -= I_DN; sel = 3;
        if (r >= I_IN) { r -= I_IN; sel = 4;
        if (r >= I_UQ) { r -= I_UQ; sel = 5;
        if (r >= I_UKV) { r -= I_UKV; sel = 6;
        if (r >= I_O) { r -= I_O; sel = 7;
        if (r >= I_FFN) { r -= I_FFN; sel = 8;
        if (r >= I_FFN) { r -= I_FFN; sel = 9;
        if (r >= I_DN) { r -= I_DN; sel = 10;
        if (r >= I_O) { r -= I_O; sel = 11; } } } } } } } } } } }
        const float* W0; const float* g0 = nullptr; int K, N, mapid; size_t doff;
        switch (sel) {
            case 0: W0 = a->in[3]; g0 = a->in[2]; K = D; N = FF; doff = WL_GU1; mapid = 1; break;
            case 1: W0 = a->in[4]; g0 = a->in[2]; K = D; N = FF; doff = WL_GU1; mapid = 2; break;
            case 2: W0 = a->in[5]; K = FF; N = D; doff = WL_D1; mapid = 0; break;
            case 3: W0 = a->in[7]; g0 = a->in[6]; K = D; N = 2464; doff = WL_IN; mapid = 3; break;
            case 4: W0 = a->in[11]; g0 = a->in[10]; K = 256; N = 384; doff = WL_UQ; mapid = 4; break;
            case 5: W0 = a->in[13]; g0 = a->in[12]; K = 128; N = 512; doff = WL_UKV; mapid = 5; break;
            case 6: W0 = a->in[15]; g0 = a->in[14]; K = D; N = D; doff = WL_O; mapid = 0; break;
            case 7: W0 = a->in[17]; g0 = a->in[16]; K = D; N = FF; doff = WL_GU2; mapid = 1; break;
            case 8: W0 = a->in[18]; g0 = a->in[16]; K = D; N = FF; doff = WL_GU2; mapid = 2; break;
            case 9: W0 = a->in[19]; K = FF; N = D; doff = WL_D2; mapid = 0; break;
            case 10: W0 = a->in[21]; g0 = a->in[20]; K = D; N = D; doff = WL_PG; mapid = 0; break;
            default: W0 = a->in[22]; K = PLE; N = D; doff = WL_PP; mapid = 0; break;
        }
        const float* W = W0 + (size_t)l * K * N;
        const float* gain = g0 ? g0 + (size_t)l * K : nullptr;
        tr_item(W, K, N, gain, Wbase + (size_t)l * WL_SIZE + doff, mapid, r, s, wv);
    }
#endif
    const int gt = bid * 512 + tid, ngt = G * 512;
    for (int l = 0; l < DEPTH; ++l) {
        bf16_t* WL = Wbase + (size_t)l * WL_SIZE;
        zero_rows(WL + WL_IN, 896, 128, D, gt, ngt); zero_rows(WL + WL_IN, 1952, 96, D, gt, ngt); zero_rows(WL + WL_IN, 2048 + 640, 128, D, gt, ngt);
        zero_rows(WL + WL_UQ, 384, 128, 256, gt, ngt);
    }
#if PRO_PARTS & 2
    float* cs64 = (float*)(a->ws + OFF_CS64); float* cs32 = (float*)(a->ws + OFF_CS32);
    for (int i = gt; i < T * 32; i += ngt) {
        const int pos = i >> 5, j = i & 31;
        const float inv = __builtin_amdgcn_exp2f(-(float)j * (13.287712379549449f / 32.0f)); const float ang = (float)pos * inv;
        const float rev = ang * 0.15915494309189535f, fr_ = rev - floorf(rev);
        float* p = cs64 + ((size_t)pos * 8 + (j >> 2)) * 8 + (j & 3);
        p[0] = __builtin_amdgcn_cosf(fr_); p[4] = __builtin_amdgcn_sinf(fr_);
    }
    for (int i = gt; i < T * 16; i += ngt) {
        const int pos = i >> 4, j = i & 15;
        const float inv = __builtin_amdgcn_exp2f(-(float)j * (13.287712379549449f / 16.0f)); const float ang = (float)pos * inv;
        const float rev = ang * 0.15915494309189535f, fr_ = rev - floorf(rev);
        float* p = cs32 + ((size_t)pos * 4 + (j >> 2)) * 8 + (j & 3);
        p[0] = __builtin_amdgcn_cosf(fr_); p[4] = __builtin_amdgcn_sinf(fr_);
    }
#endif
#if PRO_PARTS & 4
    const int lane = tid & 63, gw = bid * 8 + (tid >> 6), ngw = G * 8;
    bf16_t* xb = (bf16_t*)(a->ws + OFF_XBA); float* ss = (float*)(a->ws + OFF_SSA);
    for (int row = gw; row < M; row += ngw) {
        const f32x4* xr = (const f32x4*)(a->in[0] + (size_t)row * D) + lane; f32x4* orow = (f32x4*)(a->out + (size_t)row * D) + lane;
        float sq = 0.f;
#pragma unroll
        for (int j = 0; j < 4; ++j) {
            const f32x4 v = xr[64 * j]; orow[64 * j] = v; sq += dot4(v);
            u32x2 w; w.x = cvt_pk_bf16(v.x, v.y); w.y = cvt_pk_bf16(v.z, v.w);
            *(u32x2*)(xb + (size_t)row * D + 256 * j + lane * 4) = w;
        }
#pragma unroll
        for (int o = 1; o < 64; o <<= 1) sq += __shfl_xor(sq, o);
        if (lane < 16) ss[(size_t)row * 16 + lane] = lane == 0 ? sq : 0.f;
    }
#endif
}

__device__ __forceinline__ void convert_p(KA a, int layer, int wv) {
    const f32x4* src = (const f32x4*)(a->in[1] + (size_t)layer * M * PLE); u32x2* dst = (u32x2*)(a->ws + OFF_VT);
    const size_t n = (size_t)M * PLE / 4;
    const int tid_ = ltid(wv), bid_ = lbid(), G_ = lgrid();
    for (size_t i = (size_t)bid_ * 512 + tid_; i < n; i += (size_t)G_ * 512) {
        const f32x4 v = src[i]; u32x2 w; w.x = cvt_pk_bf16(v.x, v.y); w.y = cvt_pk_bf16(v.z, v.w); dst[i] = w;
    }
}

__device__ __forceinline__ void final_norm(KA a, int wv) {
    const int tid_ = ltid(wv); const int lane = tid_ & 63, gw = lbid() * 8 + (tid_ >> 6), ngw = lgrid() * 8;
    const float* ss = (const float*)(a->ws + OFF_SSA);
    f32x4 g[4];
#pragma unroll
    for (int j = 0; j < 4; ++j) g[j] = ((const f32x4*)a->in[23])[64 * j + lane];
    for (int row = gw; row < M; row += ngw) {
        const float r = rs16(ss, row);
        f32x4* orow = (f32x4*)(a->out + (size_t)row * D) + lane;
#pragma unroll
        for (int j = 0; j < 4; ++j) orow[64 * j] = orow[64 * j] * r * g[j];
    }
}

struct AttnP { const unsigned char* ws; const float* nab; const float* sink; };

template <int MODE>
__device__ __forceinline__ void attn_unit(const AttnP& P0, int unit, LAS float* xch, const LAS float* nabl, int wv) {
    const unsigned char* ws = P0.ws; asm volatile("" : "+s"(ws));
    constexpr int NS = MODE == 0 ? 6 : 4;
    const int lane = vlane(), w = wv, qs = w >> 2, h = w & 3, ql = lane & 31, hh = lane >> 5;
    const int lane16 = lane * 16;
    const int b = unit >> 5, rem = unit & 31;
    int qt, T0 = 0, rr = 0, qmin, qmax;
    if (MODE == 1) { T0 = 512 * (rem >> 3); rr = 2 * (rem & 7) + qs; qt = T0 + rr + 16 * ql; qmin = T0 + rr; qmax = qmin + 496; }
    else { qmin = 64 * rem + 32 * qs; qt = qmin + ql; qmax = qmin + 31; }
    const size_t tokbase = (size_t)b * T;
    const bf16_t* qrow; int khead, group;
    if (MODE == 0) { qrow = (const bf16_t*)(ws + OFF_QM) + (tokbase + qt) * QLD + 96 * h; khead = 18 + h; group = 3; }
    else if (MODE == 1) { qrow = (const bf16_t*)(ws + OFF_ZQ) + (tokbase + qt) * ZQLD + 512 + 64 * h; khead = 6 + h; group = 2; }
    else if (MODE == 2) { qrow = (const bf16_t*)(ws + OFF_ZQ) + (tokbase + qt) * ZQLD + 64 * h; khead = h; group = 0; }
    else { qrow = (const bf16_t*)(ws + OFF_ZQ) + (tokbase + qt) * ZQLD + 256 + 64 * h; khead = 4 + (h >> 1); group = 1; }
    const unsigned char* kfb = ws + OFF_KF + (size_t)b * 64 * 4096 + lane16;
    const unsigned char* vfb = ws + OFF_VT + (size_t)b * 64 * 4096 + lane16;
    const unsigned char* kpe = ws + OFF_KPE + (size_t)b * 64 * 2048 + lane16;
    bf16x8 qf[NS];
#pragma unroll
    for (int s = 0; s < NS; ++s) qf[s] = *(const bf16x8*)(qrow + 16 * s + 8 * hh);
    const float sc = (MODE == 0 ? 0.10206207261596577f : 0.125f) * LOG2E;
    f32x16 o0, o1;
#pragma unroll
    for (int e = 0; e < 16; ++e) { o0[e] = 0.f; o1[e] = 0.f; }
    float mrun = -1e20f, lrun = 0.f;
    if (MODE == 3) { mrun = P0.sink[h] * LOG2E; lrun = hh == 0 ? 1.f : 0.f; }
    const int qcol = qt & 63;
    const int nseg = MODE == 1 ? 3 : 1;
    for (int seg = 0; seg < nseg; ++seg) {
        int ntile, kb0, kstr, vb0, win, hd = khead;
        if (MODE == 0) { ntile = 64; kb0 = 0; kstr = 1; vb0 = 0; win = 1 << 20; }
        else if (MODE == 2) { ntile = 16; kb0 = 64 * min(max(rem - 4, 0), 24); kstr = 1; vb0 = kb0; win = 0; }
        else if (MODE == 3) { ntile = 9; kb0 = qmin - 128; kstr = 1; vb0 = kb0; win = 128; }
        else {
            if (seg == 0) { ntile = 20; kb0 = T0 - 64; kstr = 1; vb0 = kb0; win = 64; }
            else if (seg == 1) { ntile = 8; const int us = (T0 >> 2) - 64, r4 = rr & 3; kb0 = 4 * us + r4; kstr = 4; vb0 = r4 * 512 + us; win = 256; hd = khead + 4; }
            else { ntile = 5; const int nst = (T0 >> 4) - 64; kb0 = 16 * nst + rr; kstr = 16; vb0 = rr * 128 + nst; win = 1024; hd = khead + 8; }
        }
        const int kstep = 32 * kstr;
        int tlo = 0, thi = ntile;
        if (MODE == 1 || MODE == 3) { tlo = kb0 < 0 ? (-kb0 + kstep - 1) / kstep : 0; thi = min(ntile, (T - kb0 + kstep - 1) / kstep); }
        const unsigned char* kfh = kfb + (size_t)hd * HEADB; const unsigned char* vfh = vfb + (size_t)hd * HEADB;
        bf16x8 kf[NS], vf[4];
        {
            const int pt = (vb0 >> 5) + tlo;
#pragma unroll
            for (int s = 0; s < NS; ++s) kf[s] = (MODE == 0 && s >= 4) ? *(const bf16x8*)(kpe + (size_t)pt * 2048 + (s - 4) * 1024) : *(const bf16x8*)(kfh + (size_t)pt * 4096 + s * 1024);
#pragma unroll
            for (int j = 0; j < 4; ++j) vf[j] = *(const bf16x8*)(vfh + (size_t)pt * 4096 + j * 1024);
        }
        for (int tau = tlo; tau < thi; ++tau) {
            const int kb = kb0 + kstep * tau;
            bf16x8 kn[NS], vn[4];
            {
                const int pt = (vb0 >> 5) + min(tau + 1, thi - 1);
#pragma unroll
                for (int s = 0; s < NS; ++s) kn[s] = (MODE == 0 && s >= 4) ? *(const bf16x8*)(kpe + (size_t)pt * 2048 + (s - 4) * 1024) : *(const bf16x8*)(kfh + (size_t)pt * 4096 + s * 1024);
#pragma unroll
                for (int j = 0; j < 4; ++j) vn[j] = *(const bf16x8*)(vfh + (size_t)pt * 4096 + j * 1024);
            }
            f32x16 sacc;
#pragma unroll
            for (int e = 0; e < 16; ++e) sacc[e] = 0.f;
#pragma unroll
            for (int s = 0; s < NS; ++s) sacc = __builtin_amdgcn_mfma_f32_32x32x16_bf16(kf[s], qf[s], sacc, 0, 0, 0);
            if (MODE == 2) {
                const int c0 = 32 * (tau & 1), wsx = min(max(qcol - 8, 0), 48);
                const int mb = c0 - wsx + 4 * hh;
                const int drow = (kb >> 6) - rem + 7;
                const LAS float* bp = nabl + (h * 15 + drow) * 31 + c0 - qcol + 15 + 4 * hh;
#pragma unroll
                for (int e = 0; e < 16; ++e) {
                    const int o = 8 * (e >> 2) + (e & 3);
                    const float v = sacc[e] * sc + bp[o];
                    sacc[e] = (unsigned)(mb + o) < 16u ? v : -1e30f;
                }
            } else if (MODE != 0) {
                const bool full = (kb + 31 * kstr - qmin <= win) && (qmax - kb <= win);
                if (!full) {
                    const int mb = kb - qt + win + 4 * hh * kstr;
#pragma unroll
                    for (int e = 0; e < 16; ++e) {
                        const int o = (8 * (e >> 2) + (e & 3)) * kstr;
                        sacc[e] = (unsigned)(mb + o) <= (unsigned)(2 * win) ? sacc[e] : -1e30f;
                    }
                }
            }
            float tmax = fmaxf(fmaxf(sacc[0], sacc[1]), fmaxf(sacc[2], sacc[3]));
#pragma unroll
            for (int e = 4; e < 16; e += 4) tmax = fmaxf(tmax, fmaxf(fmaxf(sacc[e], sacc[e + 1]), fmaxf(sacc[e + 2], sacc[e + 3])));
            tmax = fmaxf(tmax, __shfl_xor(tmax, 32));
            if (MODE != 2) tmax *= sc;
            const float mnew = fmaxf(mrun, tmax);
            const bool grow = mnew > mrun;
            const float alpha = __builtin_amdgcn_exp2f(mrun - mnew);
            mrun = mnew;
            float psum = 0.f;
#pragma unroll
            for (int e = 0; e < 16; ++e) {
                const float p = MODE == 2 ? __builtin_amdgcn_exp2f(sacc[e] - mnew) : __builtin_amdgcn_exp2f(__builtin_fmaf(sacc[e], sc, -mnew));
                sacc[e] = p; psum += p;
            }
            lrun = lrun * alpha + psum;
            if (__builtin_amdgcn_ballot_w64(grow) != 0ull) {
#pragma unroll
                for (int e = 0; e < 16; ++e) { o0[e] *= alpha; o1[e] *= alpha; }
            }
            bf16x8 pb[2];
#pragma unroll
            for (int t = 0; t < 2; ++t) {
                u32x4 v; v.x = cvt_pk_bf16(sacc[8 * t + 0], sacc[8 * t + 1]); v.y = cvt_pk_bf16(sacc[8 * t + 2], sacc[8 * t + 3]);
                v.z = cvt_pk_bf16(sacc[8 * t + 4], sacc[8 * t + 5]); v.w = cvt_pk_bf16(sacc[8 * t + 6], sacc[8 * t + 7]);
                pb[t] = __builtin_bit_cast(bf16x8, v);
            }
            o0 = __builtin_amdgcn_mfma_f32_32x32x16_bf16(vf[0], pb[0], o0, 0, 0, 0);
            o0 = __builtin_amdgcn_mfma_f32_32x32x16_bf16(vf[1], pb[1], o0, 0, 0, 0);
            o1 = __builtin_amdgcn_mfma_f32_32x32x16_bf16(vf[2], pb[0], o1, 0, 0, 0);
            o1 = __builtin_amdgcn_mfma_f32_32x32x16_bf16(vf[3], pb[1], o1, 0, 0, 0);
#pragma unroll
            for (int s = 0; s < NS; ++s) kf[s] = kn[s];
#pragma unroll
            for (int j = 0; j < 4; ++j) vf[j] = vn[j];
        }
    }
    lrun += __shfl_xor(lrun, 32);
    const float inv = 1.0f / lrun;
    float sq = 0.f;
#pragma unroll
    for (int e = 0; e < 16; ++e) { o0[e] *= inv; o1[e] *= inv; sq += o0[e] * o0[e] + o1[e] * o1[e]; }
    sq += __shfl_xor(sq, 32);
    if (hh == 0) xch[w * 32 + ql] = sq;
    __syncthreads();
    const float tot = (xch[(qs * 4 + 0) * 32 + ql] + xch[(qs * 4 + 1) * 32 + ql]) + (xch[(qs * 4 + 2) * 32 + ql] + xch[(qs * 4 + 3) * 32 + ql]);
    const float rg = rsqrtf(tot * (1.0f / 256.0f) + EPS);
    bf16_t* yrow = (bf16_t*)(ws + OFF_XBA) + (tokbase + qt) * D + group * 256 + h * 64 + 4 * hh;
#pragma unroll
    for (int j = 0; j < 4; ++j) {
        u32x2 w0; w0.x = cvt_pk_bf16(o0[4 * j] * rg, o0[4 * j + 1] * rg); w0.y = cvt_pk_bf16(o0[4 * j + 2] * rg, o0[4 * j + 3] * rg);
        u32x2 w1; w1.x = cvt_pk_bf16(o1[4 * j] * rg, o1[4 * j + 1] * rg); w1.y = cvt_pk_bf16(o1[4 * j + 2] * rg, o1[4 * j + 3] * rg);
        *(u32x2*)(yrow + 8 * j) = w0; *(u32x2*)(yrow + 32 + 8 * j) = w1;
    }
}

__device__ __forceinline__ void sm_pv(f32x16& sacc, f32x16& o0, f32x16& o1, float& mrun, float& lrun, const bf16x8 (&vf)[4], float sc) {
    float tmax = fmaxf(fmaxf(sacc[0], sacc[1]), fmaxf(sacc[2], sacc[3]));
#pragma unroll
    for (int e = 4; e < 16; e += 4) tmax = fmaxf(tmax, fmaxf(fmaxf(sacc[e], sacc[e + 1]), fmaxf(sacc[e + 2], sacc[e + 3])));
    tmax = fmaxf(tmax, __shfl_xor(tmax, 32)) * sc;
    const float mnew = fmaxf(mrun, tmax);
    const bool grow = mnew > mrun;
    const float alpha = __builtin_amdgcn_exp2f(mrun - mnew);
    mrun = mnew;
    float psum = 0.f;
#pragma unroll
    for (int e = 0; e < 16; ++e) { const float p = __builtin_amdgcn_exp2f(__builtin_fmaf(sacc[e], sc, -mnew)); sacc[e] = p; psum += p; }
    lrun = lrun * alpha + psum;
    if (__builtin_amdgcn_ballot_w64(grow) != 0ull) {
#pragma unroll
        for (int e = 0; e < 16; ++e) { o0[e] *= alpha; o1[e] *= alpha; }
    }
    bf16x8 pb[2];
#pragma unroll
    for (int t = 0; t < 2; ++t) {
        u32x4 v; v.x = cvt_pk_bf16(sacc[8 * t + 0], sacc[8 * t + 1]); v.y = cvt_pk_bf16(sacc[8 * t + 2], sacc[8 * t + 3]);
        v.z = cvt_pk_bf16(sacc[8 * t + 4], sacc[8 * t + 5]); v.w = cvt_pk_bf16(sacc[8 * t + 6], sacc[8 * t + 7]);
        pb[t] = __builtin_bit_cast(bf16x8, v);
    }
    o0 = __builtin_amdgcn_mfma_f32_32x32x16_bf16(vf[0], pb[0], o0, 0, 0, 0);
    o0 = __builtin_amdgcn_mfma_f32_32x32x16_bf16(vf[1], pb[1], o0, 0, 0, 0);
    o1 = __builtin_amdgcn_mfma_f32_32x32x16_bf16(vf[2], pb[0], o1, 0, 0, 0);
    o1 = __builtin_amdgcn_mfma_f32_32x32x16_bf16(vf[3], pb[1], o1, 0, 0, 0);
}
__device__ __forceinline__ void attn_mla(const AttnP& P0, int unit, LAS float* xch, int wv) {
    const unsigned char* ws = P0.ws; asm volatile("" : "+s"(ws));
    const int lane = vlane(), w = wv, qs = w >> 2, h = w & 3, ql = lane & 31, hh = lane >> 5;
    const int lane16 = lane * 16;
    const int b = unit >> 4, q0 = 128 * (unit & 15) + 64 * qs;
    const size_t tokbase = (size_t)b * T;
    const bf16_t* qrA = (const bf16_t*)(ws + OFF_QM) + (tokbase + q0 + ql) * QLD + 96 * h;
    const bf16_t* qrB = qrA + 32 * QLD;
    const unsigned char* kfh = ws + OFF_KF + (size_t)(18 + h) * HEADB + (size_t)b * 64 * 4096 + lane16;
    const unsigned char* vfh = ws + OFF_VT + (size_t)(18 + h) * HEADB + (size_t)b * 64 * 4096 + lane16;
    const unsigned char* kpe = ws + OFF_KPE + (size_t)b * 64 * 2048 + lane16;
    bf16x8 qA[6], qB[6];
#pragma unroll
    for (int s = 0; s < 6; ++s) { qA[s] = *(const bf16x8*)(qrA + 16 * s + 8 * hh); qB[s] = *(const bf16x8*)(qrB + 16 * s + 8 * hh); }
    const float sc = 0.10206207261596577f * LOG2E;
    f32x16 oA0, oA1, oB0, oB1;
#pragma unroll
    for (int e = 0; e < 16; ++e) { oA0[e] = 0.f; oA1[e] = 0.f; oB0[e] = 0.f; oB1[e] = 0.f; }
    float mA = -1e20f, lA = 0.f, mB = -1e20f, lB = 0.f;
    bf16x8 kf[6], vf[4];
#pragma unroll
    for (int s = 0; s < 6; ++s) kf[s] = s >= 4 ? *(const bf16x8*)(kpe + (s - 4) * 1024) : *(const bf16x8*)(kfh + s * 1024);
#pragma unroll
    for (int j = 0; j < 4; ++j) vf[j] = *(const bf16x8*)(vfh + j * 1024);
    for (int tau = 0; tau < 64; ++tau) {
        bf16x8 kn[6], vn[4];
        const int pt = min(tau + 1, 63);
#pragma unroll
        for (int s = 0; s < 6; ++s) kn[s] = s >= 4 ? *(const bf16x8*)(kpe + (size_t)pt * 2048 + (s - 4) * 1024) : *(const bf16x8*)(kfh + (size_t)pt * 4096 + s * 1024);
#pragma unroll
        for (int j = 0; j < 4; ++j) vn[j] = *(const bf16x8*)(vfh + (size_t)pt * 4096 + j * 1024);
        f32x16 sa, sb;
#pragma unroll
        for (int e = 0; e < 16; ++e) { sa[e] = 0.f; sb[e] = 0.f; }
#pragma unroll
        for (int s = 0; s < 6; ++s) { sa = __builtin_amdgcn_mfma_f32_32x32x16_bf16(kf[s], qA[s], sa, 0, 0, 0); sb = __builtin_amdgcn_mfma_f32_32x32x16_bf16(kf[s], qB[s], sb, 0, 0, 0); }
        sm_pv(sa, oA0, oA1, mA, lA, vf, sc);
        sm_pv(sb, oB0, oB1, mB, lB, vf, sc);
#pragma unroll
        for (int s = 0; s < 6; ++s) kf[s] = kn[s];
#pragma unroll
        for (int j = 0; j < 4; ++j) vf[j] = vn[j];
    }
    lA += __shfl_xor(lA, 32); lB += __shfl_xor(lB, 32);
    const float iA = 1.0f / lA, iB = 1.0f / lB;
    float sqA = 0.f, sqB = 0.f;
#pragma unroll
    for (int e = 0; e < 16; ++e) { oA0[e] *= iA; oA1[e] *= iA; oB0[e] *= iB; oB1[e] *= iB; sqA += oA0[e] * oA0[e] + oA1[e] * oA1[e]; sqB += oB0[e] * oB0[e] + oB1[e] * oB1[e]; }
    sqA += __shfl_xor(sqA, 32); sqB += __shfl_xor(sqB, 32);
    if (hh == 0) { xch[w * 64 + ql] = sqA; xch[w * 64 + 32 + ql] = sqB; }
    __syncthreads();
    const LAS float* xq = xch + qs * 256 + ql;
    const float rA = rsqrtf(((xq[0] + xq[64]) + (xq[128] + xq[192])) * (1.0f / 256.0f) + EPS);
    const float rB = rsqrtf(((xq[32] + xq[96]) + (xq[160] + xq[224])) * (1.0f / 256.0f) + EPS);
    bf16_t* yA = (bf16_t*)(ws + OFF_XBA) + (tokbase + q0 + ql) * D + 3 * 256 + h * 64 + 4 * hh;
    bf16_t* yB = yA + 32 * D;
#pragma unroll
    for (int j = 0; j < 4; ++j) {
        u32x2 w0; w0.x = cvt_pk_bf16(oA0[4 * j] * rA, oA0[4 * j + 1] * rA); w0.y = cvt_pk_bf16(oA0[4 * j + 2] * rA, oA0[4 * j + 3] * rA);
        u32x2 w1; w1.x = cvt_pk_bf16(oA1[4 * j] * rA, oA1[4 * j + 1] * rA); w1.y = cvt_pk_bf16(oA1[4 * j + 2] * rA, oA1[4 * j + 3] * rA);
        *(u32x2*)(yA + 8 * j) = w0; *(u32x2*)(yA + 32 + 8 * j) = w1;
        u32x2 w2; w2.x = cvt_pk_bf16(oB0[4 * j] * rB, oB0[4 * j + 1] * rB); w2.y = cvt_pk_bf16(oB0[4 * j + 2] * rB, oB0[4 * j + 3] * rB);
        u32x2 w3; w3.x = cvt_pk_bf16(oB1[4 * j] * rB, oB1[4 * j + 1] * rB); w3.y = cvt_pk_bf16(oB1[4 * j + 2] * rB, oB1[4 * j + 3] * rB);
        *(u32x2*)(yB + 8 * j) = w2; *(u32x2*)(yB + 32 + 8 * j) = w3;
    }
}

__device__ __forceinline__ void attn_phase(KA a, int layer, LAS unsigned char* lds, int wv) {
    AttnP P; P.ws = a->ws; P.nab = a->in[8] + (size_t)layer * 4 * 15 * 31; P.sink = a->in[9] + layer * 4;
    LAS float* xch = (LAS float*)lds;
    for (int i = ltid(wv); i < 4 * 15 * 31; i += 512) xch[1024 + i] = P.nab[i] * LOG2E;
    __syncthreads();
    int it = 0;
    const int G_ = lgrid(), bid_ = lbid();
    const int vcu = (G_ & 7) == 0 ? (bid_ & 7) * (G_ >> 3) + (bid_ >> 3) : bid_;
    for (int u = vcu; u < 256 + 3 * 512; u += G_, ++it) {
        LAS float* x = xch + (it & 1) * 512;
        if (u < 256) attn_mla(P, u, x, wv);
        else {
            const int mode = 1 + ((u - 256) >> 9), unit = (u - 256) & 511;
            if (mode == 1) attn_unit<1>(P, unit, x, xch + 1024, wv);
            else if (mode == 2) attn_unit<2>(P, unit, x, xch + 1024, wv);
            else attn_unit<3>(P, unit, x, xch + 1024, wv);
        }
    }
    __syncthreads();
}

__device__ __forceinline__ void grid_bar(unsigned* ctr, unsigned target, int wv) {
    asm volatile("s_waitcnt vmcnt(0) lgkmcnt(0)" ::: "memory");
    __builtin_amdgcn_s_barrier();
    if (wv == 0) {
        if (vlane() == 0) {
            __builtin_amdgcn_fence(__ATOMIC_RELEASE, "agent");
            asm volatile("s_waitcnt vmcnt(0)" ::: "memory");
            __hip_atomic_fetch_add(ctr, 1u, __ATOMIC_RELAXED, __HIP_MEMORY_SCOPE_AGENT);
            unsigned spins = 0;
            while (__hip_atomic_load(ctr, __ATOMIC_RELAXED, __HIP_MEMORY_SCOPE_AGENT) < target) { __builtin_amdgcn_s_sleep(2); if (++spins > (1u << 26)) break; }
            __builtin_amdgcn_fence(__ATOMIC_ACQUIRE, "agent");
            asm volatile("s_waitcnt vmcnt(0)" ::: "memory");
        }
    }
    __builtin_amdgcn_s_barrier();
    asm volatile("" ::: "memory");
}

template <int PH>
__device__ __forceinline__ void run_phase(LAS unsigned char* lds, int wv) {
    KA a = kargs();
    unsigned char* ws = a->ws; asm volatile("" : "+s"(ws));
    bf16_t* Wbase = (bf16_t*)(ws + OFF_W);
    bf16_t* xbA = (bf16_t*)(ws + OFF_XBA); bf16_t* xbB = (bf16_t*)(ws + OFF_XBB);
    bf16_t* Hb = (bf16_t*)(ws + OFF_H); bf16_t* zl = (bf16_t*)(ws + OFF_ZL); bf16_t* qm = (bf16_t*)(ws + OFF_QM);
    unsigned char* vf = ws + OFF_VT;
    bf16_t* pb = (bf16_t*)(ws + OFF_VT);
    float* ssA = (float*)(ws + OFF_SSA); float* ssB = (float*)(ws + OFF_SSB); float* mst = (float*)(ws + OFF_MST);
    const float* cs64 = (const float*)(ws + OFF_CS64); const float* cs32 = (const float*)(ws + OFF_CS32);
    if constexpr (PH == 0) { if (PH_ON(0)) prologue(a, lds, wv); }
    else if constexpr (PH == NPH - 1) { if (PH_ON(1)) final_norm(a, wv); }
    else {
        constexpr int l = (PH - 1) / 9, k = (PH - 1) % 9;
        bf16_t* WL = Wbase + (size_t)l * WL_SIZE;
        if constexpr (k == 0) { if (PH_ON(2)) { EpiGU E{ssA, Hb}; run_gemm(wv, lds, xbA, D, M, WL + WL_GU1, D, 5632, D, 0, E); } }
        else if constexpr (k == 1) { if (PH_ON(3)) { EpiRes E{a->out, xbB, ssB, 0.5f}; run_gemm(wv, lds, Hb, FF, M, WL + WL_D1, FF, D, FF, 0, E); } }
        else if constexpr (k == 2) {
            if (PH_ON(4)) { EpiIn E{ssB, ws, mst, cs64, cs32}; run_gemm(wv, lds, xbB, D, M, WL + WL_IN, D, 2048, D, 0, E); }
            if (PH_ON(5)) { EpiVT E{ssB, vf}; run_gemm(wv, lds, WL + WL_IN + (size_t)2048 * D, D, 768, xbB, D, M, D, 0, E); }
        }
        else if constexpr (k == 3) {
            if (PH_ON(6)) { EpiQ E{mst, qm, cs32}; run_gemm(wv, lds, zl, ZLLD, M, WL + WL_UQ, 256, 512, 256, 0, E); }
            if (PH_ON(7)) { EpiK E{mst, ws}; run_gemm(wv, lds, zl + 256, ZLLD, M, WL + WL_UKV, 128, 256, 128, 0, E); }
            if (PH_ON(8)) { EpiVTM E{mst, vf}; run_gemm(wv, lds, WL + WL_UKV + (size_t)256 * 128, 128, 256, zl + 256, ZLLD, M, 128, 128, E); }
        }
        else if constexpr (k == 4) { if (PH_ON(9)) attn_phase(a, l, lds, wv); }
        else if constexpr (k == 5) { if (PH_ON(3)) { EpiRes E{a->out, xbB, ssB, 1.0f}; run_gemm(wv, lds, xbA, D, M, WL + WL_O, D, D, D, 0, E); } }
        else if constexpr (k == 6) { if (PH_ON(2)) { convert_p(a, l, wv); EpiGU E{ssB, Hb}; run_gemm(wv, lds, xbB, D, M, WL + WL_GU2, D, 5632, D, 0, E); } }
        else if constexpr (k == 7) {
            if (PH_ON(3)) { EpiRes E{a->out, xbB, ssB, 0.5f}; run_gemm(wv, lds, Hb, FF, M, WL + WL_D2, FF, D, FF, 0, E); }
            if (PH_ON(10)) { EpiPP E{xbA}; run_gemm(wv, lds, pb, PLE, M, WL + WL_PP, PLE, D, PLE, 0, E); }
        }
        else { if (PH_ON(11)) { EpiGate E{a->out, ssB, xbA, ssA}; run_gemm(wv, lds, xbB, D, M, WL + WL_PG, D, D, D, 0, E); } }
    }
}
template <int PH>
__device__ __forceinline__ void run_from(LAS unsigned char* lds, int ph_lo, int ph_hi, int wv) {
    if constexpr (PH < NPH) {
        if (PH >= ph_lo && PH < ph_hi) {
            run_phase<PH>(lds, wv);
            if constexpr (PH > 0 && PH < NPH - 1) { if constexpr ((DUPM >> ((PH - 1) % 9)) & 1) { __syncthreads(); run_phase<PH>(lds, wv); } }
            if constexpr (PH == 0 && ((DUPM >> 9) & 1)) { __syncthreads(); run_phase<PH>(lds, wv); }
            if (PH + 1 < ph_hi && kargs()->coop) {
                if constexpr (PH == 0) cg::this_grid().sync();
                else grid_bar((unsigned*)(kargs()->ws + OFF_BAR), (unsigned)PH * (unsigned)lgrid(), wv);
            }
        }
        run_from<PH + 1>(lds, ph_lo, ph_hi, wv);
    }
}
__global__ void __launch_bounds__(512, 2) mega(Args a_unused) {
    extern __shared__ __attribute__((aligned(16))) unsigned char lds_raw[];
    LAS unsigned char* lds = (LAS unsigned char*)lds_raw;
    const int ph_lo = kargs()->ph_lo, ph_hi = kargs()->ph_hi;
    const int wv = __builtin_amdgcn_readfirstlane((int)threadIdx.x >> 6);
    run_from<0>(lds, ph_lo, ph_hi, wv);
}

extern "C" void kernel_launch(void* const* d_in, const int* in_sizes, int n_in, void* d_out, int out_size, void* d_ws, size_t ws_size, hipStream_t stream) {
    static int grid = 0;
    if (grid == 0) {
        if (n_in != 24 || ws_size < WS_END) { fprintf(stderr, "kernel_launch: n_in %d ws %zu (need %zu)\n", n_in, ws_size, (size_t)WS_END); grid = -1; return; }
        int dev = 0, cus = 0, per_cu = 0;
        hipGetDevice(&dev); hipDeviceGetAttribute(&cus, hipDeviceAttributeMultiprocessorCount, dev);
        if (hipFuncSetAttribute((const void*)mega, hipFuncAttributeMaxDynamicSharedMemorySize, LDS_BYTES) != hipSuccess) { fprintf(stderr, "hipFuncSetAttribute failed\n"); grid = -1; return; }
        if (hipOccupancyMaxActiveBlocksPerMultiprocessor(&per_cu, (const void*)mega, 512, LDS_BYTES) != hipSuccess || per_cu < 1) per_cu = 1;
        (void)hipGetLastError();
        grid = cus * per_cu;
    }
    if (grid < 0) return;
    (void)hipMemsetAsync((char*)d_ws + OFF_BAR, 0, 256, stream);
    Args a{};
    for (int i = 0; i < 24; ++i) a.in[i] = (const float*)d_in[i];
    a.out = (float*)d_out; a.ws = (unsigned char*)d_ws;
#if MULTI_LAUNCH
    for (int ph = 0; ph < NPH; ++ph) {
        a.ph_lo = ph; a.ph_hi = ph + 1; a.coop = 0;
        hipLaunchKernelGGL(mega, dim3(grid), dim3(512), LDS_BYTES, stream, a);
    }
#else
    a.ph_lo = 0; a.ph_hi = NPH; a.coop = 1;
    void* args[] = {&a};
    hipError_t e = hipLaunchCooperativeKernel((void*)mega, dim3(grid), dim3(512), args, LDS_BYTES, stream);
    if (e != hipSuccess) fprintf(stderr, "cooperative launch failed: %s (grid %d)\n", hipGetErrorString(e), grid);
#endif
}
```

```cpp
#include <hip/hip_runtime.h>
#include <hip/hip_cooperative_groups.h>
#include <cstdio>
#include <cstdint>
namespace cg = cooperative_groups;

#ifndef MULTI_LAUNCH
#define MULTI_LAUNCH 0
#endif

#ifndef BARREP
#define BARREP 1
#endif
#ifndef DUPM
#define DUPM 0
#endif
#ifndef PRO_PARTS
#define PRO_PARTS 7
#endif
#ifndef PHM
#define PHM 0xffff
#endif
#define PH_ON(b) (((PHM) >> (b)) & 1)
#define LAS __attribute__((address_space(3)))
typedef unsigned short bf16_t;
typedef short bf16x8 __attribute__((ext_vector_type(8)));
typedef float f32x4 __attribute__((ext_vector_type(4)));
typedef float f32x16 __attribute__((ext_vector_type(16)));
typedef unsigned u32x4 __attribute__((ext_vector_type(4)));
typedef unsigned u32x2 __attribute__((ext_vector_type(2)));

constexpr int M = 32768, T = 2048, D = 1024, FF = 2816, DEPTH = 4, PLE = 256;
constexpr int ZQLD = 768, ZLLD = 384, QLD = 384;
constexpr size_t HEADB = (size_t)16 * 64 * 4096;
constexpr float EPS = 1e-6f;
constexpr float LOG2E = 1.4426950408889634f;

constexpr size_t WL_GU1 = 0, WL_D1 = WL_GU1 + (size_t)5632 * 1024, WL_IN = WL_D1 + (size_t)1024 * 2816, WL_UQ = WL_IN + (size_t)2816 * 1024,
                 WL_UKV = WL_UQ + (size_t)512 * 256, WL_O = WL_UKV + (size_t)512 * 128, WL_GU2 = WL_O + (size_t)1024 * 1024, WL_D2 = WL_GU2 + (size_t)5632 * 1024,
                 WL_PG = WL_D2 + (size_t)1024 * 2816, WL_PP = WL_PG + (size_t)1024 * 1024, WL_SIZE = WL_PP + (size_t)1024 * 256;
constexpr size_t OFF_W = 0;
constexpr size_t OFF_XBA = OFF_W + WL_SIZE * 2 * DEPTH;
constexpr size_t OFF_XBB = OFF_XBA + (size_t)M * D * 2;
constexpr size_t OFF_H = OFF_XBB + (size_t)M * D * 2;
constexpr size_t OFF_ZQ = OFF_H;
constexpr size_t OFF_ZL = OFF_ZQ + (size_t)M * ZQLD * 2;
constexpr size_t OFF_KF = OFF_ZL + (size_t)M * ZLLD * 2;
constexpr size_t OFF_KPE = OFF_KF + 22 * HEADB;
constexpr size_t OFF_VT = OFF_H + (size_t)M * FF * 2;
constexpr size_t OFF_SSA = OFF_VT + 22 * HEADB;
constexpr size_t OFF_SSB = OFF_SSA + (size_t)M * 16 * 4;
constexpr size_t OFF_MST = OFF_SSB + (size_t)M * 16 * 4;
constexpr size_t OFF_CS64 = OFF_MST + (size_t)M * 8 * 4;
constexpr size_t OFF_CS32 = OFF_CS64 + (size_t)T * 64 * 4;
constexpr size_t OFF_BAR = OFF_CS32 + (size_t)T * 32 * 4;
constexpr size_t OFF_QM = OFF_BAR + 512;
constexpr size_t WS_END = OFF_QM + (size_t)M * QLD * 2;
static_assert(OFF_KPE + (size_t)16 * 64 * 2048 <= OFF_VT, "zq|zl|KF|KPE inside the H region");
static_assert(WS_END <= 626121856, "workspace budget");

constexpr int LDS_BYTES = 147456;
constexpr int NPH = 2 + 9 * DEPTH;

__device__ __forceinline__ unsigned cvt_pk_bf16(float lo, float hi) { unsigned r; asm("v_cvt_pk_bf16_f32 %0, %1, %2" : "=v"(r) : "v"(lo), "v"(hi)); return r; }
__device__ __forceinline__ float bf_lo(unsigned u) { return __uint_as_float(u << 16); }
__device__ __forceinline__ float bf_hi(unsigned u) { return __uint_as_float(u & 0xffff0000u); }
__device__ __forceinline__ float sum4(f32x4 a) { return (a.x + a.y) + (a.z + a.w); }
__device__ __forceinline__ float dot4(f32x4 a) { return (a.x * a.x + a.y * a.y) + (a.z * a.z + a.w * a.w); }
__device__ __forceinline__ float rs16(const float* ss, int row) {
    const f32x4* p = (const f32x4*)(ss + (size_t)row * 16);
    const f32x4 a = p[0], b = p[1], c = p[2], d = p[3];
    return rsqrtf(((sum4(a) + sum4(b)) + (sum4(c) + sum4(d))) * (1.0f / 1024.0f) + EPS);
}
__device__ __forceinline__ int vlane() { int l; asm volatile("v_mbcnt_lo_u32_b32 %0, -1, 0\n\tv_mbcnt_hi_u32_b32 %0, -1, %0" : "=v"(l)); return l; }
__device__ __forceinline__ int ltid(int wv) { return (wv << 6) | vlane(); }
__device__ __forceinline__ int lbid() { int b = blockIdx.x; asm volatile("" : "+s"(b)); return b; }
__device__ __forceinline__ int lgrid() { int g = gridDim.x; asm volatile("" : "+s"(g)); return g; }
__device__ __forceinline__ float sigmoidf_(float v) { return __builtin_amdgcn_rcpf(1.0f + __expf(-v)); }

namespace pg8 {
constexpr int BM = 256, BK = 64, HALF = 128, HTB = HALF * BK * 2, STAGE_BYTES = 8 * HTB, NXCD = 8, WGM = 8;
__host__ __device__ __forceinline__ int lds_byte(int r, int c) { const int st = (r >> 4) * 2 + (c >> 5), rr = r & 15, cc = c & 31, ob = rr * 64 + cc * 2; return st * 1024 + (ob ^ (((ob >> 9) & 1) << 5)); }
__host__ __device__ __forceinline__ void stage_rc(int b, int& R, int& C) { const int st = b / 1024, sb = b % 1024, swz = sb ^ (((sb >> 9) & 1) << 5); R = (st >> 1) * 16 + swz / 64; C = (st & 1) * 32 + (swz % 64) / 2; }
__host__ __device__ __forceinline__ int perm32(int rho) { const int n = rho >> 4, i = rho & 15; return 8 * (i >> 2) + 4 * n + (i & 3); }

struct Unit { int pm, pn; };
struct Gemm { const bf16_t* A; const bf16_t* Bt; int lda, ldb, K; };

struct StaticOrder {
    int nM, nN, nwg, G, c;
    __device__ void init(int Mr, int Nc, int G_, int c_) { nM = Mr / BM; nN = Nc / BM; nwg = nM * nN; G = G_; c = c_; }
    __device__ bool next(int i, Unit& u) const {
        const long L = (long)i * G + c; if (L >= nwg) return false;
        int wgid = (int)L; { const int q = nwg / NXCD, r = nwg % NXCD, xcd = wgid % NXCD, off = wgid / NXCD; wgid = (xcd < r ? xcd * (q + 1) : r * (q + 1) + (xcd - r) * q) + off; }
        const int nig = WGM * nN, gid = wgid / nig, fm = gid * WGM, gsz = (nM - fm) < WGM ? (nM - fm) : WGM;
        u.pm = fm + ((wgid % nig) % gsz); u.pn = (wgid % nig) / gsz; return true;
    }
};

template <class Epi>
__device__ __forceinline__ void gemm_phase(LAS unsigned char* lds, const Gemm g, const StaticOrder& S, const Epi& E, int wv) {
    const int tid = ltid(wv);
    const int wid = wv, lane = tid & 63, wr = wid >> 2, wc = wid & 3, fr = lane & 15, fq = lane >> 4;
    const int K = g.K, nt = K / BK;
    unsigned voffA[2], voffB[2];
#pragma unroll
    for (int i = 0; i < 2; ++i) { int R, C; stage_rc(tid * 16 + i * 8192, R, C); const int Rb = (R & ~31) + perm32(R & 31);
        voffA[i] = (unsigned)(R * g.lda + C) * 2u; voffB[i] = (unsigned)(Rb * g.ldb + C) * 2u; }
    const size_t kstep = (size_t)(BK * 2);
    const size_t hstepA = (size_t)HALF * g.lda * 2, hstepB = (size_t)HALF * g.ldb * 2;
    const size_t tstepA = 2 * hstepA, tstepB = 2 * hstepB;
    const unsigned ldsw = (unsigned)wid * 1024u;
    const int aoff = lds_byte(wr * 64 + fr, fq * 8), boff = lds_byte(wc * 32 + fr, fq * 8);
#define PG8_SA(b, h) (((b) * 2 + (h)) * HTB)
#define PG8_SB(b, h) ((4 + (b) * 2 + (h)) * HTB)
#define PG8_STAGE(bufoff, gbase, voff) do { _Pragma("unroll") for (int _i = 0; _i < 2; ++_i) \
        __builtin_amdgcn_global_load_lds((const unsigned*)((const char*)(gbase) + (voff)[_i]), (LAS unsigned*)(lds + (bufoff) + ldsw + _i * 8192), 16, 0, 0); } while (0)
#define PG8_LDA(dst, b, h) do { _Pragma("unroll") for (int m = 0; m < 4; ++m) _Pragma("unroll") for (int k = 0; k < 2; ++k) dst[m][k] = *(const LAS bf16x8*)(lds + PG8_SA(b, h) + aoff + m * 2048 + k * 1024); } while (0)
#define PG8_LDB(dst, b, h) do { _Pragma("unroll") for (int n = 0; n < 2; ++n) _Pragma("unroll") for (int k = 0; k < 2; ++k) dst[n][k] = *(const LAS bf16x8*)(lds + PG8_SB(b, h) + boff + n * 2048 + k * 1024); } while (0)
#define PG8_MMA(ai, bj, At, Bt) do { __builtin_amdgcn_s_setprio(1); _Pragma("unroll") for (int m = 0; m < 4; ++m) _Pragma("unroll") for (int n = 0; n < 2; ++n) _Pragma("unroll") for (int k = 0; k < 2; ++k) \
        acc[ai][bj][m][n] = __builtin_amdgcn_mfma_f32_16x16x32_bf16(Bt[n][k], At[m][k], acc[ai][bj][m][n], 0, 0, 0); __builtin_amdgcn_s_setprio(0); } while (0)
#define PG8_WAIT_V(n) asm volatile("s_waitcnt vmcnt(" #n ")" ::: "memory")
#define PG8_WAIT_L(n) asm volatile("s_waitcnt lgkmcnt(" #n ")" ::: "memory")
#define PG8_BAR __builtin_amdgcn_s_barrier()
#define PG8_SCHED __builtin_amdgcn_sched_barrier(0)
    Unit cur, nxt; int ui = 0;
    if (!S.next(0, cur)) return;
    f32x4 acc[2][2][4][2];
#pragma unroll
    for (int a = 0; a < 2; ++a)
#pragma unroll
        for (int b = 0; b < 2; ++b)
#pragma unroll
            for (int m = 0; m < 4; ++m)
#pragma unroll
                for (int n = 0; n < 2; ++n) acc[a][b][m][n] = (f32x4){0.f, 0.f, 0.f, 0.f};
    bf16x8 At[4][2], B0[2][2], B1[2][2];
    const char* cA = (const char*)g.A + (size_t)cur.pm * tstepA; const char* cB = (const char*)g.Bt + (size_t)cur.pn * tstepB;
    PG8_STAGE(PG8_SB(0, 0), cB, voffB); PG8_STAGE(PG8_SB(0, 1), cB + hstepB, voffB); PG8_STAGE(PG8_SA(0, 0), cA, voffA); PG8_STAGE(PG8_SA(0, 1), cA + hstepA, voffA);
    if (wr == 1) PG8_BAR;
    PG8_WAIT_V(2); PG8_BAR;
    PG8_STAGE(PG8_SB(1, 0), cB + kstep, voffB); PG8_STAGE(PG8_SA(1, 0), cA + kstep, voffA); PG8_STAGE(PG8_SB(1, 1), cB + hstepB + kstep, voffB);
    PG8_WAIT_V(6); PG8_BAR;
    for (;;) {
        const bool has_next = S.next(ui + 1, nxt);
        const char* nA = has_next ? (const char*)g.A + (size_t)nxt.pm * tstepA : cA; const char* nB = has_next ? (const char*)g.Bt + (size_t)nxt.pn * tstepB : cB;
        for (int t = 0; t < nt; t += 2) {
            const bool last = (t == nt - 2);
            const char* a1 = cA + (size_t)(t + 1) * kstep;
            const char* a2 = last ? nA : cA + (size_t)(t + 2) * kstep; const char* b2 = last ? nB : cB + (size_t)(t + 2) * kstep;
            const char* a3 = a2 + kstep; const char* b3 = b2 + kstep;
            PG8_LDB(B0, 0, 0); PG8_LDB(B1, 0, 1); PG8_SCHED; PG8_LDA(At, 0, 0); PG8_STAGE(PG8_SA(1, 1), a1 + hstepA, voffA);
            PG8_WAIT_V(8); PG8_WAIT_L(0); PG8_BAR; PG8_MMA(0, 0, At, B0); PG8_MMA(0, 1, At, B1); PG8_BAR; PG8_SCHED;
            PG8_LDA(At, 0, 1); PG8_STAGE(PG8_SB(0, 0), b2, voffB); PG8_STAGE(PG8_SB(0, 1), b2 + hstepB, voffB); PG8_STAGE(PG8_SA(0, 0), a2, voffA);
            PG8_WAIT_V(8); PG8_WAIT_L(0); PG8_BAR; PG8_MMA(1, 0, At, B0); PG8_MMA(1, 1, At, B1); PG8_BAR; PG8_SCHED;
            PG8_LDB(B0, 1, 0); PG8_LDB(B1, 1, 1); PG8_SCHED; PG8_LDA(At, 1, 0); PG8_STAGE(PG8_SA(0, 1), a2 + hstepA, voffA);
            PG8_WAIT_V(8); PG8_WAIT_L(0); PG8_BAR; PG8_MMA(0, 0, At, B0); PG8_MMA(0, 1, At, B1); PG8_BAR; PG8_SCHED;
            PG8_LDA(At, 1, 1); PG8_STAGE(PG8_SB(1, 0), b3, voffB); PG8_STAGE(PG8_SB(1, 1), b3 + hstepB, voffB); PG8_STAGE(PG8_SA(1, 0), a3, voffA);
            PG8_WAIT_V(8); PG8_WAIT_L(0); PG8_BAR; PG8_MMA(1, 0, At, B0); PG8_MMA(1, 1, At, B1); PG8_BAR; PG8_SCHED;
        }
        if (wr == 0) PG8_BAR;
        E(acc, cur, wr, wc, fr, fq);
        if (!has_next) break;
#pragma unroll
        for (int a = 0; a < 2; ++a)
#pragma unroll
            for (int b = 0; b < 2; ++b)
#pragma unroll
                for (int m = 0; m < 4; ++m)
#pragma unroll
                    for (int n = 0; n < 2; ++n) acc[a][b][m][n] = (f32x4){0.f, 0.f, 0.f, 0.f};
        cur = nxt; cA = nA; cB = nB; ++ui;
        if (wr == 1) PG8_BAR;
    }
    PG8_WAIT_V(0);
    PG8_BAR;
#undef PG8_SA
#undef PG8_SB
#undef PG8_STAGE
#undef PG8_LDA
#undef PG8_LDB
#undef PG8_MMA
#undef PG8_WAIT_V
#undef PG8_WAIT_L
#undef PG8_BAR
#undef PG8_SCHED
}
}
using pg8::Unit;
typedef const f32x4 (&AccRef)[2][2][4][2];

struct EpiGU {
    const float* ss; bf16_t* H;
    __device__ __forceinline__ void operator()(AccRef acc, const Unit& u, int wr, int wc, int, int) const { const int lane_ = vlane(); const int fr = lane_ & 15, fq = lane_ >> 4;
#pragma unroll
        for (int ai = 0; ai < 2; ++ai)
#pragma unroll
            for (int m = 0; m < 4; ++m) {
                const int row = u.pm * 256 + ai * 128 + wr * 64 + m * 16 + fr;
                asm volatile("" ::: "memory");
                const float r = rs16(ss, row);
#pragma unroll
                for (int bj = 0; bj < 2; ++bj) {
                    const f32x4 g = acc[ai][bj][m][0] * r, v = acc[ai][bj][m][1] * r;
                    const float h0 = g.x * sigmoidf_(g.x) * v.x, h1 = g.y * sigmoidf_(g.y) * v.y, h2 = g.z * sigmoidf_(g.z) * v.z, h3 = g.w * sigmoidf_(g.w) * v.w;
                    u32x2 w; w.x = cvt_pk_bf16(h0, h1); w.y = cvt_pk_bf16(h2, h3);
                    *(u32x2*)(H + (size_t)row * FF + u.pn * 128 + bj * 64 + wc * 16 + fq * 4) = w;
                }
            }
    }
};
struct EpiRes {
    float* X; bf16_t* xb; float* ssOut; float alpha;
    __device__ __forceinline__ void operator()(AccRef acc, const Unit& u, int wr, int wc, int, int) const { const int lane_ = vlane(); const int fr = lane_ & 15, fq = lane_ >> 4;
#pragma unroll
        for (int ai = 0; ai < 2; ++ai)
#pragma unroll
            for (int m = 0; m < 4; ++m) {
                const int row = u.pm * 256 + ai * 128 + wr * 64 + m * 16 + fr;
                asm volatile("" ::: "memory");
                float sq = 0.f;
#pragma unroll
                for (int bj = 0; bj < 2; ++bj) {
                    const size_t off = (size_t)row * D + u.pn * 256 + bj * 128 + wc * 32 + fq * 8;
                    f32x4 x0 = *(const f32x4*)(X + off), x1 = *(const f32x4*)(X + off + 4);
                    x0 += acc[ai][bj][m][0] * alpha; x1 += acc[ai][bj][m][1] * alpha;
                    *(f32x4*)(X + off) = x0; *(f32x4*)(X + off + 4) = x1;
                    sq += dot4(x0) + dot4(x1);
                    u32x4 w; w.x = cvt_pk_bf16(x0.x, x0.y); w.y = cvt_pk_bf16(x0.z, x0.w); w.z = cvt_pk_bf16(x1.x, x1.y); w.w = cvt_pk_bf16(x1.z, x1.w);
                    *(u32x4*)(xb + off) = w;
                }
                sq += __shfl_xor(sq, 16); sq += __shfl_xor(sq, 32);
                if (fq == 0) ssOut[(size_t)row * 16 + u.pn * 4 + wc] = sq;
            }
    }
};
struct EpiGate {
    float* X; const float* ssIn; bf16_t* ppxb; float* ssOut; float gsc;
    __device__ __forceinline__ void operator()(AccRef acc, const Unit& u, int wr, int wc, int, int) const { const int lane_ = vlane(); const int fr = lane_ & 15, fq = lane_ >> 4;
#pragma unroll
        for (int ai = 0; ai < 2; ++ai)
#pragma unroll
            for (int m = 0; m < 4; ++m) {
                const int row = u.pm * 256 + ai * 128 + wr * 64 + m * 16 + fr;
                asm volatile("" ::: "memory");
                const float r = rs16(ssIn, row);
                float sq = 0.f;
#pragma unroll
                for (int bj = 0; bj < 2; ++bj) {
                    const size_t off = (size_t)row * D + u.pn * 256 + bj * 128 + wc * 32 + fq * 8;
                    f32x4 x0 = *(const f32x4*)(X + off), x1 = *(const f32x4*)(X + off + 4);
                    const u32x4 pp = *(const u32x4*)(ppxb + off); const float gs = gsc;
                    const f32x4 a0 = acc[ai][bj][m][0] * r, a1 = acc[ai][bj][m][1] * r;
                    x0.x += sigmoidf_(a0.x) * (bf_lo(pp.x) * gs); x0.y += sigmoidf_(a0.y) * (bf_hi(pp.x) * gs); x0.z += sigmoidf_(a0.z) * (bf_lo(pp.y) * gs); x0.w += sigmoidf_(a0.w) * (bf_hi(pp.y) * gs);
                    x1.x += sigmoidf_(a1.x) * (bf_lo(pp.z) * gs); x1.y += sigmoidf_(a1.y) * (bf_hi(pp.z) * gs); x1.z += sigmoidf_(a1.z) * (bf_lo(pp.w) * gs); x1.w += sigmoidf_(a1.w) * (bf_hi(pp.w) * gs);
                    *(f32x4*)(X + off) = x0; *(f32x4*)(X + off + 4) = x1;
                    sq += dot4(x0) + dot4(x1);
                    u32x4 w; w.x = cvt_pk_bf16(x0.x, x0.y); w.y = cvt_pk_bf16(x0.z, x0.w); w.z = cvt_pk_bf16(x1.x, x1.y); w.w = cvt_pk_bf16(x1.z, x1.w);
                    *(u32x4*)(ppxb + off) = w;
                }
                sq += __shfl_xor(sq, 16); sq += __shfl_xor(sq, 32);
                if (fq == 0) ssOut[(size_t)row * 16 + u.pn * 4 + wc] = sq;
            }
    }
};
__device__ __forceinline__ void rope_rot(f32x4& v0, f32x4& v1, const float* cs) {
    const f32x4 c = *(const f32x4*)cs, s = *(const f32x4*)(cs + 4);
    const f32x4 a = v0 * c - v1 * s, b = v1 * c + v0 * s; v0 = a; v1 = b;
}
struct EpiIn {
    const float* ss; unsigned char* ws; float* mst; const float* cs64; const float* cs32;
    __device__ __forceinline__ void operator()(AccRef acc, const Unit& u, int wr, int wc, int, int) const { const int lane_ = vlane(); const int fr = lane_ & 15, fq = lane_ >> 4;
#pragma unroll
        for (int ai = 0; ai < 2; ++ai)
#pragma unroll
            for (int m = 0; m < 4; ++m) {
                const int row = u.pm * 256 + ai * 128 + wr * 64 + m * 16 + fr;
                asm volatile("" ::: "memory");
                const float r = rs16(ss, row);
                const int pos = row & (T - 1), b = row >> 11;
                float sq = 0.f;
#pragma unroll
                for (int bj = 0; bj < 2; ++bj) {
                    const int gcol = u.pn * 256 + bj * 128 + wc * 32;
                    f32x4 v0 = acc[ai][bj][m][0] * r, v1 = acc[ai][bj][m][1] * r;
                    const bool r64 = (gcol >= 512 && gcol < 896) || (gcol >= 1024 && gcol < 1536);
                    if (r64) rope_rot(v0, v1, cs64 + ((size_t)pos * 8 + 4 * ((gcol >> 5) & 1) + fq) * 8);
                    if (gcol == 1920) rope_rot(v0, v1, cs32 + ((size_t)pos * 4 + fq) * 8);
                    if (u.pn == 6 || (u.pn == 7 && bj == 0)) sq += dot4(v0) + dot4(v1);
                    u32x4 w; w.x = cvt_pk_bf16(v0.x, v0.y); w.y = cvt_pk_bf16(v0.z, v0.w); w.z = cvt_pk_bf16(v1.x, v1.y); w.w = cvt_pk_bf16(v1.z, v1.w);
                    const int c8 = ((gcol & 63) >> 3) + fq;
                    const size_t frag = (size_t)(c8 >> 1) * 1024 + (size_t)((pos & 31) + 32 * (c8 & 1)) * 16;
                    const size_t rec = ((size_t)b * 64 + (pos >> 5)) * 4096;
                    if (gcol < 256) *(u32x4*)(ws + OFF_ZQ + ((size_t)row * ZQLD + gcol + fq * 8) * 2) = w;
                    else if (gcol < 512) *(u32x4*)(ws + OFF_KF + (size_t)((gcol - 256) >> 6) * HEADB + rec + frag) = w;
                    else if (gcol < 768) *(u32x4*)(ws + OFF_ZQ + ((size_t)row * ZQLD + (gcol - 256) + fq * 8) * 2) = w;
                    else if (gcol < 896) *(u32x4*)(ws + OFF_KF + (size_t)(4 + ((gcol - 768) >> 6)) * HEADB + rec + frag) = w;
                    else if (gcol < 1024) { }
                    else if (gcol < 1280) *(u32x4*)(ws + OFF_ZQ + ((size_t)row * ZQLD + (gcol - 512) + fq * 8) * 2) = w;
                    else if (gcol < 1536) {
                        const int hd = (gcol - 1280) >> 6;
                        *(u32x4*)(ws + OFF_KF + (size_t)(6 + hd) * HEADB + rec + frag) = w;
                        const int p4 = (pos & 3) * 512 + (pos >> 2), p16 = (pos & 15) * 128 + (pos >> 4);
                        *(u32x4*)(ws + OFF_KF + (size_t)(10 + hd) * HEADB + ((size_t)b * 64 + (p4 >> 5)) * 4096 + (size_t)(c8 >> 1) * 1024 + (size_t)((p4 & 31) + 32 * (c8 & 1)) * 16) = w;
                        *(u32x4*)(ws + OFF_KF + (size_t)(14 + hd) * HEADB + ((size_t)b * 64 + (p16 >> 5)) * 4096 + (size_t)(c8 >> 1) * 1024 + (size_t)((p16 & 31) + 32 * (c8 & 1)) * 16) = w;
                    }
                    else if (gcol < 1920) *(u32x4*)(ws + OFF_ZL + ((size_t)row * ZLLD + (gcol - 1536) + fq * 8) * 2) = w;
                    else if (gcol == 1920) *(u32x4*)(ws + OFF_KPE + ((size_t)b * 64 + (pos >> 5)) * 2048 + (size_t)(fq >> 1) * 1024 + (size_t)((pos & 31) + 32 * (fq & 1)) * 16) = w;
                }
                if (u.pn >= 6) {
                    sq += __shfl_xor(sq, 16); sq += __shfl_xor(sq, 32);
                    if (fq == 0) mst[(size_t)row * 8 + (u.pn - 6) * 4 + wc] = sq;
                }
            }
    }
};
__device__ __forceinline__ void vstore8(unsigned char* vf, int vhead, int dd, int tok0, u32x4 w) {
    const int b = tok0 >> 11, pos0 = tok0 & (T - 1), idx0 = pos0 & 31;
    unsigned char* p = vf + (size_t)vhead * HEADB + ((size_t)b * 64 + (pos0 >> 5)) * 4096 + (size_t)((dd >> 5) * 2 + (idx0 >> 4)) * 1024 + (size_t)(dd & 31) * 16 + ((idx0 >> 3) & 1) * 8;
    u32x2 lo; lo.x = w.x; lo.y = w.y; u32x2 hi; hi.x = w.z; hi.y = w.w;
    *(u32x2*)p = lo; *(u32x2*)(p + 512) = hi;
}
__device__ __forceinline__ void vstore1(unsigned char* vf, int vhead, int dd, int b, int ppos, bf16_t val) {
    const int idx = ppos & 31, r16 = idx & 15;
    unsigned char* p = vf + (size_t)vhead * HEADB + ((size_t)b * 64 + (ppos >> 5)) * 4096 + (size_t)((dd >> 5) * 2 + (idx >> 4)) * 1024 + (size_t)((dd & 31) + 32 * ((r16 >> 2) & 1)) * 16 + (r16 >> 3) * 8 + (r16 & 3) * 2;
    *(bf16_t*)p = val;
}
struct EpiVT {
    const float* ss; unsigned char* vf;
    __device__ __forceinline__ void operator()(AccRef acc, const Unit& u, int wr, int wc, int, int) const { const int lane_ = vlane(); const int fr = lane_ & 15, fq = lane_ >> 4;
#pragma unroll
        for (int bj = 0; bj < 2; ++bj) {
            const int tok0 = u.pn * 256 + bj * 128 + wc * 32 + fq * 8;
            float rs[8];
#pragma unroll
            for (int e = 0; e < 8; ++e) rs[e] = rs16(ss, tok0 + e);
#pragma unroll
            for (int ai = 0; ai < 2; ++ai) {
                const int rbase = u.pm * 256 + ai * 128;
                if (rbase >= 640) continue;
                const bool dil = rbase >= 384;
#pragma unroll
                for (int m = 0; m < 4; ++m) {
                    const int row = rbase + wr * 64 + m * 16 + fr;
                    asm volatile("" ::: "memory");
                    const f32x4 a0 = acc[ai][bj][m][0], a1 = acc[ai][bj][m][1];
                    u32x4 w; w.x = cvt_pk_bf16(a0.x * rs[0], a0.y * rs[1]); w.y = cvt_pk_bf16(a0.z * rs[2], a0.w * rs[3]);
                    w.z = cvt_pk_bf16(a1.x * rs[4], a1.y * rs[5]); w.w = cvt_pk_bf16(a1.z * rs[6], a1.w * rs[7]);
                    const int vhead = row >> 6, dd = row & 63;
                    vstore8(vf, vhead, dd, tok0, w);
                    if (dil) {
                        const int b = tok0 >> 11, t0 = tok0 & (T - 1);
                        const unsigned ww[4] = {w.x, w.y, w.z, w.w};
#pragma unroll
                        for (int e = 0; e < 8; ++e) {
                            const int t = t0 + e; const bf16_t val = (bf16_t)((e & 1) ? (ww[e >> 1] >> 16) : (ww[e >> 1] & 0xffffu));
                            vstore1(vf, vhead + 4, dd, b, (t & 3) * 512 + (t >> 2), val);
                            vstore1(vf, vhead + 8, dd, b, (t & 15) * 128 + (t >> 4), val);
                        }
                    }
                }
            }
        }
    }
};
struct EpiQ {
    const float* mst; bf16_t* qm; const float* cs32;
    __device__ __forceinline__ void operator()(AccRef acc, const Unit& u, int wr, int wc, int, int) const { const int lane_ = vlane(); const int fr = lane_ & 15, fq = lane_ >> 4;
#pragma unroll
        for (int ai = 0; ai < 2; ++ai)
#pragma unroll
            for (int m = 0; m < 4; ++m) {
                const int row = u.pm * 256 + ai * 128 + wr * 64 + m * 16 + fr;
                asm volatile("" ::: "memory");
                const f32x4 st = *(const f32x4*)(mst + (size_t)row * 8);
                const float r = rsqrtf(sum4(st) * (1.0f / 256.0f) + EPS);
                const int pos = row & (T - 1);
#pragma unroll
                for (int bj = 0; bj < 2; ++bj) {
                    const int gcol = u.pn * 256 + bj * 128 + wc * 32;
                    if (gcol >= 384) continue;
                    f32x4 v0 = acc[ai][bj][m][0] * r, v1 = acc[ai][bj][m][1] * r;
                    if (((gcol >> 5) % 3) == 2) rope_rot(v0, v1, cs32 + ((size_t)pos * 4 + fq) * 8);
                    u32x4 w; w.x = cvt_pk_bf16(v0.x, v0.y); w.y = cvt_pk_bf16(v0.z, v0.w); w.z = cvt_pk_bf16(v1.x, v1.y); w.w = cvt_pk_bf16(v1.z, v1.w);
                    *(u32x4*)(qm + (size_t)row * QLD + gcol + fq * 8) = w;
                }
            }
    }
};
struct EpiK {
    const float* mst; unsigned char* ws;
    __device__ __forceinline__ void operator()(AccRef acc, const Unit& u, int wr, int wc, int, int) const { const int lane_ = vlane(); const int fr = lane_ & 15, fq = lane_ >> 4;
#pragma unroll
        for (int ai = 0; ai < 2; ++ai)
#pragma unroll
            for (int m = 0; m < 4; ++m) {
                const int row = u.pm * 256 + ai * 128 + wr * 64 + m * 16 + fr;
                asm volatile("" ::: "memory");
                const f32x4 st = *(const f32x4*)(mst + (size_t)row * 8 + 4);
                const float r = rsqrtf(sum4(st) * (1.0f / 128.0f) + EPS);
#pragma unroll
                for (int bj = 0; bj < 2; ++bj) {
                    const f32x4 v0 = acc[ai][bj][m][0] * r, v1 = acc[ai][bj][m][1] * r;
                    u32x4 w; w.x = cvt_pk_bf16(v0.x, v0.y); w.y = cvt_pk_bf16(v0.z, v0.w); w.z = cvt_pk_bf16(v1.x, v1.y); w.w = cvt_pk_bf16(v1.z, v1.w);
                    const int col0 = bj * 128 + wc * 32, c8 = ((col0 & 63) >> 3) + fq, pos = row & (T - 1);
                    *(u32x4*)(ws + OFF_KF + (size_t)(18 + (col0 >> 6)) * HEADB + ((size_t)(row >> 11) * 64 + (pos >> 5)) * 4096 + (size_t)(c8 >> 1) * 1024 + (size_t)((pos & 31) + 32 * (c8 & 1)) * 16) = w;
                }
            }
    }
};
struct EpiVTM {
    const float* mst; unsigned char* vf;
    __device__ __forceinline__ void operator()(AccRef acc, const Unit& u, int wr, int wc, int, int) const { const int lane_ = vlane(); const int fr = lane_ & 15, fq = lane_ >> 4;
#pragma unroll
        for (int bj = 0; bj < 2; ++bj) {
            const int tok0 = u.pn * 256 + bj * 128 + wc * 32 + fq * 8;
            float rs[8];
#pragma unroll
            for (int e = 0; e < 8; ++e) { const f32x4 st = *(const f32x4*)(mst + (size_t)(tok0 + e) * 8 + 4); rs[e] = rsqrtf(sum4(st) * (1.0f / 128.0f) + EPS); }
#pragma unroll
            for (int ai = 0; ai < 2; ++ai)
#pragma unroll
                for (int m = 0; m < 4; ++m) {
                    const int row = ai * 128 + wr * 64 + m * 16 + fr;
                    asm volatile("" ::: "memory");
                    const f32x4 a0 = acc[ai][bj][m][0], a1 = acc[ai][bj][m][1];
                    u32x4 w; w.x = cvt_pk_bf16(a0.x * rs[0], a0.y * rs[1]); w.y = cvt_pk_bf16(a0.z * rs[2], a0.w * rs[3]);
                    w.z = cvt_pk_bf16(a1.x * rs[4], a1.y * rs[5]); w.w = cvt_pk_bf16(a1.z * rs[6], a1.w * rs[7]);
                    vstore8(vf, 18 + (row >> 6), row & 63, tok0, w);
                }
        }
    }
};
struct EpiPP {
    bf16_t* O;
    __device__ __forceinline__ void operator()(AccRef acc, const Unit& u, int wr, int wc, int, int) const { const int lane_ = vlane(); const int fr = lane_ & 15, fq = lane_ >> 4;
#pragma unroll
        for (int ai = 0; ai < 2; ++ai)
#pragma unroll
            for (int m = 0; m < 4; ++m) {
                const int row = u.pm * 256 + ai * 128 + wr * 64 + m * 16 + fr;
                asm volatile("" ::: "memory");
#pragma unroll
                for (int bj = 0; bj < 2; ++bj) {
                    const f32x4 v0 = acc[ai][bj][m][0], v1 = acc[ai][bj][m][1];
                    u32x4 w; w.x = cvt_pk_bf16(v0.x, v0.y); w.y = cvt_pk_bf16(v0.z, v0.w); w.z = cvt_pk_bf16(v1.x, v1.y); w.w = cvt_pk_bf16(v1.z, v1.w);
                    *(u32x4*)(O + (size_t)row * D + u.pn * 256 + bj * 128 + wc * 32 + fq * 8) = w;
                }
            }
    }
};

template <class Epi>
__device__ __forceinline__ void run_gemm(int wv, LAS unsigned char* lds, const bf16_t* A, int lda, int rows, const bf16_t* Bt, int ldb, int cols, int K, int cshift, const Epi& E) {
    pg8::Gemm g{A, Bt, lda, ldb, K};
    pg8::StaticOrder S; const int G_ = lgrid(); S.init(rows, cols, G_, (lbid() + cshift) % G_);
    pg8::gemm_phase<Epi>(lds, g, S, E, wv);
}

__device__ __forceinline__ int p64(int d) { return d < 32 ? 8 * (d >> 2) + (d & 3) : 8 * ((d - 32) >> 2) + 4 + (d & 3); }
__device__ __forceinline__ int p32(int d) { return d < 16 ? 8 * (d >> 2) + (d & 3) : 8 * ((d - 16) >> 2) + 4 + (d & 3); }
__device__ __forceinline__ int maprow(int mapid, int c) {
    switch (mapid) {
        case 0: return c;
        case 1: return (c >> 2) * 8 + (c & 3);
        case 2: return (c >> 2) * 8 + 4 + (c & 3);
        case 3: {
            if (c < 768) return c < 512 ? c : 2048 + (c - 512);
            c -= 768;
            if (c < 512) return c < 384 ? 512 + (c >> 6) * 64 + p64(c & 63) : 2048 + 256 + (c - 384);
            c -= 512;
            if (c < 768) return c < 512 ? 1024 + (c >> 6) * 64 + p64(c & 63) : 2048 + 384 + (c - 512);
            c -= 768;
            if (c < 256) return 1536 + c;
            if (c < 384) return 1792 + (c - 256);
            return 1920 + p32(c - 384);
        }
        case 4: { const int h = c / 96, e = c % 96; return e < 64 ? 96 * h + e : 96 * h + 64 + p32(e - 64); }
        default: { const int h = c >> 7, e = c & 127; return e < 64 ? 64 * h + e : 256 + 64 * h + (e - 64); }
    }
}
__device__ __forceinline__ void tr_item(const float* W, int K, int N, const float* gain, bf16_t* dst, int mapid, int item, LAS float* s, int wv) {
    const int tid = ltid(wv);
    const int ncb = (N + 255) >> 8, kb = item / ncb, cb = item % ncb, k0 = kb * 64, c0 = cb * 256;
#pragma unroll
    for (int i = 0; i < 8; ++i) {
        const int kk = i * 8 + (tid >> 6), col = (tid & 63) * 4;
        f32x4 v = (f32x4){0.f, 0.f, 0.f, 0.f};
        if (c0 + col < N) v = *(const f32x4*)(W + (size_t)(k0 + kk) * N + c0 + col);
        if (gain) v *= gain[k0 + kk];
        *(LAS f32x4*)(s + kk * 260 + col) = v;
    }
    __syncthreads();
    const int cc = tid & 255, kh = tid >> 8, c = c0 + cc;
    if (c < N) {
        const int drow = maprow(mapid, c);
        bf16_t* o = dst + (size_t)drow * K + k0 + kh * 32;
#pragma unroll
        for (int q = 0; q < 4; ++q) {
            const LAS float* sp = s + (kh * 32 + q * 8) * 260 + cc;
            u32x4 w; w.x = cvt_pk_bf16(sp[0], sp[260]); w.y = cvt_pk_bf16(sp[2 * 260], sp[3 * 260]); w.z = cvt_pk_bf16(sp[4 * 260], sp[5 * 260]); w.w = cvt_pk_bf16(sp[6 * 260], sp[7 * 260]);
            *(u32x4*)(o + q * 8) = w;
        }
    }
    __syncthreads();
}

struct Args { const float* in[24]; float* out; unsigned char* ws; int ph_lo, ph_hi, coop, pad; };
typedef const __attribute__((address_space(4))) Args* KA;
__device__ __forceinline__ KA kargs() { KA p = (KA)__builtin_amdgcn_kernarg_segment_ptr(); asm volatile("" : "+s"(p)); return p; }

__device__ __forceinline__ void zero_rows(bf16_t* base, int row0, int nrows, int K, int gt, int ngt) {
    const size_t n16 = (size_t)nrows * K / 8; u32x4* p = (u32x4*)(base + (size_t)row0 * K);
    for (size_t i = gt; i < n16; i += ngt) p[i] = (u32x4){0u, 0u, 0u, 0u};
}

__device__ __forceinline__ void prologue(KA a, LAS unsigned char* lds, int wv) {
    LAS float* s = (LAS float*)lds;
    const int G = lgrid(), bid = lbid(), tid = ltid(wv);
    bf16_t* Wbase = (bf16_t*)(a->ws + OFF_W);
#if PRO_PARTS & 1
    constexpr int I_FFN = 16 * 11, I_DN = 44 * 4, I_IN = 16 * 10, I_UQ = 4 * 2, I_UKV = 2 * 2, I_O = 16 * 4, I_PP = 4 * 4;
    constexpr int I_LAYER = 4 * I_FFN + 2 * I_DN + I_IN + I_UQ + I_UKV + 2 * I_O + I_PP;
    for (int it = bid; it < I_LAYER * DEPTH; it += G) {
        const int l = it / I_LAYER; int r = it % I_LAYER;
        int sel = 0;
        if (r >= I_FFN) { r -= I_FFN; sel = 1;
        if (r >= I_FFN) { r -= I_FFN; sel = 2;
        if (r >= I_DN) { r -= I_DN; sel = 3;
        if (r >= I_IN) { r -= I_IN; sel = 4;
        if (r >= I_UQ) { r -= I_UQ; sel = 5;
        if (r >= I_UKV) { r -= I_UKV; sel = 6;
        if (r >= I_O) { r -= I_O; sel = 7;
        if (r >= I_FFN) { r -= I_FFN; sel = 8;
        if (r >= I_FFN) { r -= I_FFN; sel = 9;
        if (r >= I_DN) { r -= I_DN; sel = 10;
        if (r >= I_O) { r -= I_O; sel = 11; } } } } } } } } } } }
        const float* W0; const float* g0 = nullptr; int K, N, mapid; size_t doff;
        switch (sel) {
            case 0: W0 = a->in[3]; g0 = a->in[2]; K = D; N = FF; doff = WL_GU1; mapid = 1; break;
            case 1: W0 = a->in[4]; g0 = a->in[2]; K = D; N = FF; doff = WL_GU1; mapid = 2; break;
            case 2: W0 = a->in[5]; K = FF; N = D; doff = WL_D1; mapid = 0; break;
            case 3: W0 = a->in[7]; g0 = a->in[6]; K = D; N = 2464; doff = WL_IN; mapid = 3; break;
            case 4: W0 = a->in[11]; g0 = a->in[10]; K = 256; N = 384; doff = WL_UQ; mapid = 4; break;
            case 5: W0 = a->in[13]; g0 = a->in[12]; K = 128; N = 512; doff = WL_UKV; mapid = 5; break;
            case 6: W0 = a->in[15]; g0 = a->in[14]; K = D; N = D; doff = WL_O; mapid = 0; break;
            case 7: W0 = a->in[17]; g0 = a->in[16]; K = D; N = FF; doff = WL_GU2; mapid = 1; break;
            case 8: W0 = a->in[18]; g0 = a->in[16]; K = D; N = FF; doff = WL_GU2; mapid = 2; break;
            case 9: W0 = a->in[19]; K = FF; N = D; doff = WL_D2; mapid = 0; break;
            case 10: W0 = a->in[21]; g0 = a->in[20]; K = D; N = D; doff = WL_PG; mapid = 0; break;
            default: W0 = a->in[22]; K = PLE; N = D; doff = WL_PP; mapid = 0; break;
        }
        const float* W = W0 + (size_t)l * K * N;
        const float* gain = g0 ? g0 + (size_t)l * K : nullptr;
        tr_item(W, K, N, gain, Wbase + (size_t)l * WL_SIZE + doff, mapid, r, s, wv);
    }
#endif
    const int gt = bid * 512 + tid, ngt = G * 512;
    for (int l = 0; l < DEPTH; ++l) {
        bf16_t* WL = Wbase + (size_t)l * WL_SIZE;
        zero_rows(WL + WL_IN, 896, 128, D, gt, ngt); zero_rows(WL + WL_IN, 1952, 96, D, gt, ngt); zero_rows(WL + WL_IN, 2048 + 640, 128, D, gt, ngt);
        zero_rows(WL + WL_UQ, 384, 128, 256, gt, ngt);
    }
#if PRO_PARTS & 2
    float* cs64 = (float*)(a->ws + OFF_CS64); float* cs32 = (float*)(a->ws + OFF_CS32);
    for (int i = gt; i < T * 32; i += ngt) {
        const int pos = i >> 5, j = i & 31;
        const float inv = __builtin_amdgcn_exp2f(-(float)j * (13.287712379549449f / 32.0f)); const float ang = (float)pos * inv;
        const float rev = ang * 0.15915494309189535f, fr_ = rev - floorf(rev);
        float* p = cs64 + ((size_t)pos * 8 + (j >> 2)) * 8 + (j & 3);
        p[0] = __builtin_amdgcn_cosf(fr_); p[4] = __builtin_amdgcn_sinf(fr_);
    }
    for (int i = gt; i < T * 16; i += ngt) {
        const int pos = i >> 4, j = i & 15;
        const float inv = __builtin_amdgcn_exp2f(-(float)j * (13.287712379549449f / 16.0f)); const float ang = (float)pos * inv;
        const float rev = ang * 0.15915494309189535f, fr_ = rev - floorf(rev);
        float* p = cs32 + ((size_t)pos * 4 + (j >> 2)) * 8 + (j & 3);
        p[0] = __builtin_amdgcn_cosf(fr_); p[4] = __builtin_amdgcn_sinf(fr_);
    }
#endif
#if PRO_PARTS & 4
    const int lane = tid & 63, gw = bid * 8 + (tid >> 6), ngw = G * 8;
    bf16_t* xb = (bf16_t*)(a->ws + OFF_XBA); float* ss = (float*)(a->ws + OFF_SSA);
    for (int row = gw; row < M; row += ngw) {
        const f32x4* xr = (const f32x4*)(a->in[0] + (size_t)row * D) + lane; f32x4* orow = (f32x4*)(a->out + (size_t)row * D) + lane;
        float sq = 0.f;
#pragma unroll
        for (int j = 0; j < 4; ++j) {
            const f32x4 v = xr[64 * j]; orow[64 * j] = v; sq += dot4(v);
            u32x2 w; w.x = cvt_pk_bf16(v.x, v.y); w.y = cvt_pk_bf16(v.z, v.w);
            *(u32x2*)(xb + (size_t)row * D + 256 * j + lane * 4) = w;
        }
#pragma unroll
        for (int o = 1; o < 64; o <<= 1) sq += __shfl_xor(sq, o);
        if (lane < 16) ss[(size_t)row * 16 + lane] = lane == 0 ? sq : 0.f;
    }
#endif
}

__device__ __forceinline__ void convert_p(KA a, int layer, int wv) {
    const f32x4* src = (const f32x4*)(a->in[1] + (size_t)layer * M * PLE); u32x2* dst = (u32x2*)(a->ws + OFF_VT);
    const size_t n = (size_t)M * PLE / 4;
    const int tid_ = ltid(wv), bid_ = lbid(), G_ = lgrid();
    for (size_t i = (size_t)bid_ * 512 + tid_; i < n; i += (size_t)G_ * 512) {
        const f32x4 v = src[i]; u32x2 w; w.x = cvt_pk_bf16(v.x, v.y); w.y = cvt_pk_bf16(v.z, v.w); dst[i] = w;
    }
}

__device__ __forceinline__ void final_norm(KA a, int wv) {
    const int tid_ = ltid(wv); const int lane = tid_ & 63, gw = lbid() * 8 + (tid_ >> 6), ngw = lgrid() * 8;
    const float* ss = (const float*)(a->ws + OFF_SSA);
    f32x4 g[4];
#pragma unroll
    for (int j = 0; j < 4; ++j) g[j] = ((const f32x4*)a->in[23])[64 * j + lane];
    for (int row = gw; row < M; row += ngw) {
        const float r = rs16(ss, row);
        f32x4* orow = (f32x4*)(a->out + (size_t)row * D) + lane;
#pragma unroll
        for (int j = 0; j < 4; ++j) orow[64 * j] = orow[64 * j] * r * g[j];
    }
}

struct AttnP { const unsigned char* ws; const float* nab; const float* sink; };

template <int MODE>
__device__ __forceinline__ void attn_unit(const AttnP& P0, int unit, LAS float* xch, const LAS float* nabl, int wv) {
    const unsigned char* ws = P0.ws; asm volatile("" : "+s"(ws));
    constexpr int NS = MODE == 0 ? 6 : 4;
    const int lane = vlane(), w = wv, qs = w >> 2, h = w & 3, ql = lane & 31, hh = lane >> 5;
    const int lane16 = lane * 16;
    const int b = unit >> 5, rem = unit & 31;
    int qt, T0 = 0, rr = 0, qmin, qmax;
    if (MODE == 1) { T0 = 512 * (rem >> 3); rr = 2 * (rem & 7) + qs; qt = T0 + rr + 16 * ql; qmin = T0 + rr; qmax = qmin + 496; }
    else { qmin = 64 * rem + 32 * qs; qt = qmin + ql; qmax = qmin + 31; }
    const size_t tokbase = (size_t)b * T;
    const bf16_t* qrow; int khead, group;
    if (MODE == 0) { qrow = (const bf16_t*)(ws + OFF_QM) + (tokbase + qt) * QLD + 96 * h; khead = 18 + h; group = 3; }
    else if (MODE == 1) { qrow = (const bf16_t*)(ws + OFF_ZQ) + (tokbase + qt) * ZQLD + 512 + 64 * h; khead = 6 + h; group = 2; }
    else if (MODE == 2) { qrow = (const bf16_t*)(ws + OFF_ZQ) + (tokbase + qt) * ZQLD + 64 * h; khead = h; group = 0; }
    else { qrow = (const bf16_t*)(ws + OFF_ZQ) + (tokbase + qt) * ZQLD + 256 + 64 * h; khead = 4 + (h >> 1); group = 1; }
    const unsigned char* kfb = ws + OFF_KF + (size_t)b * 64 * 4096 + lane16;
    const unsigned char* vfb = ws + OFF_VT + (size_t)b * 64 * 4096 + lane16;
    const unsigned char* kpe = ws + OFF_KPE + (size_t)b * 64 * 2048 + lane16;
    bf16x8 qf[NS];
#pragma unroll
    for (int s = 0; s < NS; ++s) qf[s] = *(const bf16x8*)(qrow + 16 * s + 8 * hh);
    const float sc = (MODE == 0 ? 0.10206207261596577f : 0.125f) * LOG2E;
    f32x16 o0, o1;
#pragma unroll
    for (int e = 0; e < 16; ++e) { o0[e] = 0.f; o1[e] = 0.f; }
    float mrun = -1e20f, lrun = 0.f;
    if (MODE == 3) { mrun = P0.sink[h] * LOG2E; lrun = hh == 0 ? 1.f : 0.f; }
    const int qcol = qt & 63;
    const int nseg = MODE == 1 ? 3 : 1;
    for (int seg = 0; seg < nseg; ++seg) {
        int ntile, kb0, kstr, vb0, win, hd = khead;
        if (MODE == 0) { ntile = 64; kb0 = 0; kstr = 1; vb0 = 0; win = 1 << 20; }
        else if (MODE == 2) { ntile = 16; kb0 = 64 * min(max(rem - 4, 0), 24); kstr = 1; vb0 = kb0; win = 0; }
        else if (MODE == 3) { ntile = 9; kb0 = qmin - 128; kstr = 1; vb0 = kb0; win = 128; }
        else {
            if (seg == 0) { ntile = 20; kb0 = T0 - 64; kstr = 1; vb0 = kb0; win = 64; }
            else if (seg == 1) { ntile = 8; const int us = (T0 >> 2) - 64, r4 = rr & 3; kb0 = 4 * us + r4; kstr = 4; vb0 = r4 * 512 + us; win = 256; hd = khead + 4; }
            else { ntile = 5; const int nst = (T0 >> 4) - 64; kb0 = 16 * nst + rr; kstr = 16; vb0 = rr * 128 + nst; win = 1024; hd = khead + 8; }
        }
        const int kstep = 32 * kstr;
        int tlo = 0, thi = ntile;
        if (MODE == 1 || MODE == 3) { tlo = kb0 < 0 ? (-kb0 + kstep - 1) / kstep : 0; thi = min(ntile, (T - kb0 + kstep - 1) / kstep); }
        const unsigned char* kfh = kfb + (size_t)hd * HEADB; const unsigned char* vfh = vfb + (size_t)hd * HEADB;
        bf16x8 kf[NS], vf[4];
        {
            const int pt = (vb0 >> 5) + tlo;
#pragma unroll
            for (int s = 0; s < NS; ++s) kf[s] = (MODE == 0 && s >= 4) ? *(const bf16x8*)(kpe + (size_t)pt * 2048 + (s - 4) * 1024) : *(const bf16x8*)(kfh + (size_t)pt * 4096 + s * 1024);
#pragma unroll
            for (int j = 0; j < 4; ++j) vf[j] = *(const bf16x8*)(vfh + (size_t)pt * 4096 + j * 1024);
        }
        for (int tau = tlo; tau < thi; ++tau) {
            const int kb = kb0 + kstep * tau;
            bf16x8 kn[NS], vn[4];
            {
                const int pt = (vb0 >> 5) + min(tau + 1, thi - 1);
#pragma unroll
                for (int s = 0; s < NS; ++s) kn[s] = (MODE == 0 && s >= 4) ? *(const bf16x8*)(kpe + (size_t)pt * 2048 + (s - 4) * 1024) : *(const bf16x8*)(kfh + (size_t)pt * 4096 + s * 1024);
#pragma unroll
                for (int j = 0; j < 4; ++j) vn[j] = *(const bf16x8*)(vfh + (size_t)pt * 4096 + j * 1024);
            }
            f32x16 sacc;
#pragma unroll
            for (int e = 0; e < 16; ++e) sacc[e] = 0.f;
#pragma unroll
            for (int s = 0; s < NS; ++s) sacc = __builtin_amdgcn_mfma_f32_32x32x16_bf16(kf[s], qf[s], sacc, 0, 0, 0);
            if (MODE == 2) {
                const int c0 = 32 * (tau & 1), wsx = min(max(qcol - 8, 0), 48);
                const int mb = c0 - wsx + 4 * hh;
                const int drow = (kb >> 6) - rem + 7;
                const LAS float* bp = nabl + (h * 15 + drow) * 31 + c0 - qcol + 15 + 4 * hh;
#pragma unroll
                for (int e = 0; e < 16; ++e) {
                    const int o = 8 * (e >> 2) + (e & 3);
                    const float v = sacc[e] * sc + bp[o];
                    sacc[e] = (unsigned)(mb + o) < 16u ? v : -1e30f;
                }
            } else if (MODE != 0) {
                const bool full = (kb + 31 * kstr - qmin <= win) && (qmax - kb <= win);
                if (!full) {
                    const int mb = kb - qt + win + 4 * hh * kstr;
#pragma unroll
                    for (int e = 0; e < 16; ++e) {
                        const int o = (8 * (e >> 2) + (e & 3)) * kstr;
                        sacc[e] = (unsigned)(mb + o) <= (unsigned)(2 * win) ? sacc[e] : -1e30f;
                    }
                }
            }
            float tmax = fmaxf(fmaxf(sacc[0], sacc[1]), fmaxf(sacc[2], sacc[3]));
#pragma unroll
            for (int e = 4; e < 16; e += 4) tmax = fmaxf(tmax, fmaxf(fmaxf(sacc[e], sacc[e + 1]), fmaxf(sacc[e + 2], sacc[e + 3])));
            tmax = fmaxf(tmax, __shfl_xor(tmax, 32));
            if (MODE != 2) tmax *= sc;
            const float mnew = fmaxf(mrun, tmax);
            const bool grow = mnew > mrun;
            const float alpha = __builtin_amdgcn_exp2f(mrun - mnew);
            mrun = mnew;
            float psum = 0.f;
#pragma unroll
            for (int e = 0; e < 16; ++e) {
                const float p = MODE == 2 ? __builtin_amdgcn_exp2f(sacc[e] - mnew) : __builtin_amdgcn_exp2f(__builtin_fmaf(sacc[e], sc, -mnew));
                sacc[e] = p; psum += p;
            }
            lrun = lrun * alpha + psum;
            if (__builtin_amdgcn_ballot_w64(grow) != 0ull) {
#pragma unroll
                for (int e = 0; e < 16; ++e) { o0[e] *= alpha; o1[e] *= alpha; }
            }
            bf16x8 pb[2];
#pragma unroll
            for (int t = 0; t < 2; ++t) {
                u32x4 v; v.x = cvt_pk_bf16(sacc[8 * t + 0], sacc[8 * t + 1]); v.y = cvt_pk_bf16(sacc[8 * t + 2], sacc[8 * t + 3]);
                v.z = cvt_pk_bf16(sacc[8 * t + 4], sacc[8 * t + 5]); v.w = cvt_pk_bf16(sacc[8 * t + 6], sacc[8 * t + 7]);
                pb[t] = __builtin_bit_cast(bf16x8, v);
            }
            o0 = __builtin_amdgcn_mfma_f32_32x32x16_bf16(vf[0], pb[0], o0, 0, 0, 0);
            o0 = __builtin_amdgcn_mfma_f32_32x32x16_bf16(vf[1], pb[1], o0, 0, 0, 0);
            o1 = __builtin_amdgcn_mfma_f32_32x32x16_bf16(vf[2], pb[0], o1, 0, 0, 0);
            o1 = __builtin_amdgcn_mfma_f32_32x32x16_bf16(vf[3], pb[1], o1, 0, 0, 0);
#pragma unroll
            for (int s = 0; s < NS; ++s) kf[s] = kn[s];
#pragma unroll
            for (int j = 0; j < 4; ++j) vf[j] = vn[j];
        }
    }
    lrun += __shfl_xor(lrun, 32);
    const float inv = 1.0f / lrun;
    float sq = 0.f;
#pragma unroll
    for (int e = 0; e < 16; ++e) { o0[e] *= inv; o1[e] *= inv; sq += o0[e] * o0[e] + o1[e] * o1[e]; }
    sq += __shfl_xor(sq, 32);
    if (hh == 0) xch[w * 32 + ql] = sq;
    __syncthreads();
    const float tot = (xch[(qs * 4 + 0) * 32 + ql] + xch[(qs * 4 + 1) * 32 + ql]) + (xch[(qs * 4 + 2) * 32 + ql] + xch[(qs * 4 + 3) * 32 + ql]);
    const float rg = rsqrtf(tot * (1.0f / 256.0f) + EPS);
    bf16_t* yrow = (bf16_t*)(ws + OFF_XBA) + (tokbase + qt) * D + group * 256 + h * 64 + 4 * hh;
#pragma unroll
    for (int j = 0; j < 4; ++j) {
        u32x2 w0; w0.x = cvt_pk_bf16(o0[4 * j] * rg, o0[4 * j + 1] * rg); w0.y = cvt_pk_bf16(o0[4 * j + 2] * rg, o0[4 * j + 3] * rg);
        u32x2 w1; w1.x = cvt_pk_bf16(o1[4 * j] * rg, o1[4 * j + 1] * rg); w1.y = cvt_pk_bf16(o1[4 * j + 2] * rg, o1[4 * j + 3] * rg);
        *(u32x2*)(yrow + 8 * j) = w0; *(u32x2*)(yrow + 32 + 8 * j) = w1;
    }
}

__device__ __forceinline__ void sm_pv(f32x16& sacc, f32x16& o0, f32x16& o1, float& mrun, float& lrun, const bf16x8 (&vf)[4], float sc) {
    float tmax = fmaxf(fmaxf(sacc[0], sacc[1]), fmaxf(sacc[2], sacc[3]));
#pragma unroll
    for (int e = 4; e < 16; e += 4) tmax = fmaxf(tmax, fmaxf(fmaxf(sacc[e], sacc[e + 1]), fmaxf(sacc[e + 2], sacc[e + 3])));
    tmax = fmaxf(tmax, __shfl_xor(tmax, 32)) * sc;
    const float mnew = fmaxf(mrun, tmax);
    const bool grow = mnew > mrun;
    const float alpha = __builtin_amdgcn_exp2f(mrun - mnew);
    mrun = mnew;
    float psum = 0.f;
#pragma unroll
    for (int e = 0; e < 16; ++e) { const float p = __builtin_amdgcn_exp2f(__builtin_fmaf(sacc[e], sc, -mnew)); sacc[e] = p; psum += p; }
    lrun = lrun * alpha + psum;
    if (__builtin_amdgcn_ballot_w64(grow) != 0ull) {
#pragma unroll
        for (int e = 0; e < 16; ++e) { o0[e] *= alpha; o1[e] *= alpha; }
    }
    bf16x8 pb[2];
#pragma unroll
    for (int t = 0; t < 2; ++t) {
        u32x4 v; v.x = cvt_pk_bf16(sacc[8 * t + 0], sacc[8 * t + 1]); v.y = cvt_pk_bf16(sacc[8 * t + 2], sacc[8 * t + 3]);
        v.z = cvt_pk_bf16(sacc[8 * t + 4], sacc[8 * t + 5]); v.w = cvt_pk_bf16(sacc[8 * t + 6], sacc[8 * t + 7]);
        pb[t] = __builtin_bit_cast(bf16x8, v);
    }
    o0 = __builtin_amdgcn_mfma_f32_32x32x16_bf16(vf[0], pb[0], o0, 0, 0, 0);
    o0 = __builtin_amdgcn_mfma_f32_32x32x16_bf16(vf[1], pb[1], o0, 0, 0, 0);
    o1 = __builtin_amdgcn_mfma_f32_32x32x16_bf16(vf[2], pb[0], o1, 0, 0, 0);
    o1 = __builtin_amdgcn_mfma_f32_32x32x16_bf16(vf[3], pb[1], o1, 0, 0, 0);
}
__device__ __forceinline__ void attn_mla(const AttnP& P0, int unit, LAS float* xch, int wv) {
    const unsigned char* ws = P0.ws; asm volatile("" : "+s"(ws));
    const int lane = vlane(), w = wv, qs = w >> 2, h = w & 3, ql = lane & 31, hh = lane >> 5;
    const int lane16 = lane * 16;
    const int b = unit >> 4, q0 = 128 * (unit & 15) + 64 * qs;
    const size_t tokbase = (size_t)b * T;
    const bf16_t* qrA = (const bf16_t*)(ws + OFF_QM) + (tokbase + q0 + ql) * QLD + 96 * h;
    const bf16_t* qrB = qrA + 32 * QLD;
    const unsigned char* kfh = ws + OFF_KF + (size_t)(18 + h) * HEADB + (size_t)b * 64 * 4096 + lane16;
    const unsigned char* vfh = ws + OFF_VT + (size_t)(18 + h) * HEADB + (size_t)b * 64 * 4096 + lane16;
    const unsigned char* kpe = ws + OFF_KPE + (size_t)b * 64 * 2048 + lane16;
    bf16x8 qA[6], qB[6];
#pragma unroll
    for (int s = 0; s < 6; ++s) { qA[s] = *(const bf16x8*)(qrA + 16 * s + 8 * hh); qB[s] = *(const bf16x8*)(qrB + 16 * s + 8 * hh); }
    const float sc = 0.10206207261596577f * LOG2E;
    f32x16 oA0, oA1, oB0, oB1;
#pragma unroll
    for (int e = 0; e < 16; ++e) { oA0[e] = 0.f; oA1[e] = 0.f; oB0[e] = 0.f; oB1[e] = 0.f; }
    float mA = -1e20f, lA = 0.f, mB = -1e20f, lB = 0.f;
    bf16x8 kf[6], vf[4];
#pragma unroll
    for (int s = 0; s < 6; ++s) kf[s] = s >= 4 ? *(const bf16x8*)(kpe + (s - 4) * 1024) : *(const bf16x8*)(kfh + s * 1024);
#pragma unroll
    for (int j = 0; j < 4; ++j) vf[j] = *(const bf16x8*)(vfh + j * 1024);
    for (int tau = 0; tau < 64; ++tau) {
        bf16x8 kn[6], vn[4];
        const int pt = min(tau + 1, 63);
#pragma unroll
        for (int s = 0; s < 6; ++s) kn[s] = s >= 4 ? *(const bf16x8*)(kpe + (size_t)pt * 2048 + (s - 4) * 1024) : *(const bf16x8*)(kfh + (size_t)pt * 4096 + s * 1024);
#pragma unroll
        for (int j = 0; j < 4; ++j) vn[j] = *(const bf16x8*)(vfh + (size_t)pt * 4096 + j * 1024);
        f32x16 sa, sb;
#pragma unroll
        for (int e = 0; e < 16; ++e) { sa[e] = 0.f; sb[e] = 0.f; }
#pragma unroll
        for (int s = 0; s < 6; ++s) { sa = __builtin_amdgcn_mfma_f32_32x32x16_bf16(kf[s], qA[s], sa, 0, 0, 0); sb = __builtin_amdgcn_mfma_f32_32x32x16_bf16(kf[s], qB[s], sb, 0, 0, 0); }
        sm_pv(sa, oA0, oA1, mA, lA, vf, sc);
        sm_pv(sb, oB0, oB1, mB, lB, vf, sc);
#pragma unroll
        for (int s = 0; s < 6; ++s) kf[s] = kn[s];
#pragma unroll
        for (int j = 0; j < 4; ++j) vf[j] = vn[j];
    }
    lA += __shfl_xor(lA, 32); lB += __shfl_xor(lB, 32);
    const float iA = 1.0f / lA, iB = 1.0f / lB;
    float sqA = 0.f, sqB = 0.f;
#pragma unroll
    for (int e = 0; e < 16; ++e) { oA0[e] *= iA; oA1[e] *= iA; oB0[e] *= iB; oB1[e] *= iB; sqA += oA0[e] * oA0[e] + oA1[e] * oA1[e]; sqB += oB0[e] * oB0[e] + oB1[e] * oB1[e]; }
    sqA += __shfl_xor(sqA, 32); sqB += __shfl_xor(sqB, 32);
    if (hh == 0) { xch[w * 64 + ql] = sqA; xch[w * 64 + 32 + ql] = sqB; }
    __syncthreads();
    const LAS float* xq = xch + qs * 256 + ql;
    const float rA = rsqrtf(((xq[0] + xq[64]) + (xq[128] + xq[192])) * (1.0f / 256.0f) + EPS);
    const float rB = rsqrtf(((xq[32] + xq[96]) + (xq[160] + xq[224])) * (1.0f / 256.0f) + EPS);
    bf16_t* yA = (bf16_t*)(ws + OFF_XBA) + (tokbase + q0 + ql) * D + 3 * 256 + h * 64 + 4 * hh;
    bf16_t* yB = yA + 32 * D;
#pragma unroll
    for (int j = 0; j < 4; ++j) {
        u32x2 w0; w0.x = cvt_pk_bf16(oA0[4 * j] * rA, oA0[4 * j + 1] * rA); w0.y = cvt_pk_bf16(oA0[4 * j + 2] * rA, oA0[4 * j + 3] * rA);
        u32x2 w1; w1.x = cvt_pk_bf16(oA1[4 * j] * rA, oA1[4 * j + 1] * rA); w1.y = cvt_pk_bf16(oA1[4 * j + 2] * rA, oA1[4 * j + 3] * rA);
        *(u32x2*)(yA + 8 * j) = w0; *(u32x2*)(yA + 32 + 8 * j) = w1;
        u32x2 w2; w2.x = cvt_pk_bf16(oB0[4 * j] * rB, oB0[4 * j + 1] * rB); w2.y = cvt_pk_bf16(oB0[4 * j + 2] * rB, oB0[4 * j + 3] * rB);
        u32x2 w3; w3.x = cvt_pk_bf16(oB1[4 * j] * rB, oB1[4 * j + 1] * rB); w3.y = cvt_pk_bf16(oB1[4 * j + 2] * rB, oB1[4 * j + 3] * rB);
        *(u32x2*)(yB + 8 * j) = w2; *(u32x2*)(yB + 32 + 8 * j) = w3;
    }
}

__device__ __forceinline__ void attn_phase(KA a, int layer, LAS unsigned char* lds, int wv) {
    AttnP P; P.ws = a->ws; P.nab = a->in[8] + (size_t)layer * 4 * 15 * 31; P.sink = a->in[9] + layer * 4;
    LAS float* xch = (LAS float*)lds;
    for (int i = ltid(wv); i < 4 * 15 * 31; i += 512) xch[1024 + i] = P.nab[i] * LOG2E;
    __syncthreads();
    int it = 0;
    const int G_ = lgrid(), bid_ = lbid();
    const int vcu = (G_ & 7) == 0 ? (bid_ & 7) * (G_ >> 3) + (bid_ >> 3) : bid_;
    for (int u = vcu; u < 256 + 3 * 512; u += G_, ++it) {
        LAS float* x = xch + (it & 1) * 512;
        if (u < 256) attn_mla(P, u, x, wv);
        else {
            const int mode = 1 + ((u - 256) >> 9), unit = (u - 256) & 511;
            if (mode == 1) attn_unit<1>(P, unit, x, xch + 1024, wv);
            else if (mode == 2) attn_unit<2>(P, unit, x, xch + 1024, wv);
            else attn_unit<3>(P, unit, x, xch + 1024, wv);
        }
    }
    __syncthreads();
}

__device__ __forceinline__ void grid_bar(unsigned* ctr, unsigned target, int wv) {
    asm volatile("s_waitcnt vmcnt(0) lgkmcnt(0)" ::: "memory");
    __builtin_amdgcn_s_barrier();
    if (wv == 0) {
        if (vlane() == 0) {
            __builtin_amdgcn_fence(__ATOMIC_RELEASE, "agent");
            asm volatile("s_waitcnt vmcnt(0)" ::: "memory");
            const unsigned old = __hip_atomic_fetch_add(ctr, 1u, __ATOMIC_RELAXED, __HIP_MEMORY_SCOPE_AGENT);
            unsigned* flag = ctr + 64;
            if (old + 1u == target) __hip_atomic_store(flag, target, __ATOMIC_RELAXED, __HIP_MEMORY_SCOPE_AGENT);
            else { unsigned spins = 0; while (__hip_atomic_load(flag, __ATOMIC_RELAXED, __HIP_MEMORY_SCOPE_AGENT) < target) { __builtin_amdgcn_s_sleep(1); if (++spins > (1u << 26)) break; } }
            __builtin_amdgcn_fence(__ATOMIC_ACQUIRE, "agent");
            asm volatile("s_waitcnt vmcnt(0)" ::: "memory");
        }
    }
    __builtin_amdgcn_s_barrier();
    asm volatile("" ::: "memory");
}

template <int PH, bool ZERO = false>
__device__ __forceinline__ void run_phase(LAS unsigned char* lds, int wv) {
    KA a = kargs();
    unsigned char* ws = a->ws; asm volatile("" : "+s"(ws));
    bf16_t* Wbase = (bf16_t*)(ws + OFF_W);
    bf16_t* xbA = (bf16_t*)(ws + OFF_XBA); bf16_t* xbB = (bf16_t*)(ws + OFF_XBB);
    bf16_t* Hb = (bf16_t*)(ws + OFF_H); bf16_t* zl = (bf16_t*)(ws + OFF_ZL); bf16_t* qm = (bf16_t*)(ws + OFF_QM);
    unsigned char* vf = ws + OFF_VT;
    bf16_t* pb = (bf16_t*)(ws + OFF_VT);
    float* ssA = (float*)(ws + OFF_SSA); float* ssB = (float*)(ws + OFF_SSB); float* mst = (float*)(ws + OFF_MST);
    const float* cs64 = (const float*)(ws + OFF_CS64); const float* cs32 = (const float*)(ws + OFF_CS32);
    if constexpr (PH == 0) { if (PH_ON(0)) prologue(a, lds, wv); }
    else if constexpr (PH == NPH - 1) { if (PH_ON(1)) final_norm(a, wv); }
    else {
        constexpr int l = (PH - 1) / 9, k = (PH - 1) % 9;
        bf16_t* WL = Wbase + (size_t)l * WL_SIZE;
        if constexpr (k == 0) { if (PH_ON(2)) { EpiGU E{ssA, Hb}; run_gemm(wv, lds, xbA, D, M, WL + WL_GU1, D, 5632, D, 0, E); } }
        else if constexpr (k == 1) { if (PH_ON(3)) { EpiRes E{a->out, xbB, ssB, ZERO ? 0.f : 0.5f}; run_gemm(wv, lds, Hb, FF, M, WL + WL_D1, FF, D, FF, 0, E); } }
        else if constexpr (k == 2) {
            if (PH_ON(4)) { EpiIn E{ssB, ws, mst, cs64, cs32}; run_gemm(wv, lds, xbB, D, M, WL + WL_IN, D, 2048, D, 0, E); }
            if (PH_ON(5)) { EpiVT E{ssB, vf}; run_gemm(wv, lds, WL + WL_IN + (size_t)2048 * D, D, 768, xbB, D, M, D, 0, E); }
        }
        else if constexpr (k == 3) {
            if (PH_ON(6)) { EpiQ E{mst, qm, cs32}; run_gemm(wv, lds, zl, ZLLD, M, WL + WL_UQ, 256, 512, 256, 0, E); }
            if (PH_ON(7)) { EpiK E{mst, ws}; run_gemm(wv, lds, zl + 256, ZLLD, M, WL + WL_UKV, 128, 256, 128, 0, E); }
            if (PH_ON(8)) { EpiVTM E{mst, vf}; run_gemm(wv, lds, WL + WL_UKV + (size_t)256 * 128, 128, 256, zl + 256, ZLLD, M, 128, 128, E); }
        }
        else if constexpr (k == 4) { if (PH_ON(9)) attn_phase(a, l, lds, wv); }
        else if constexpr (k == 5) { if (PH_ON(3)) { EpiRes E{a->out, xbB, ssB, ZERO ? 0.f : 1.0f}; run_gemm(wv, lds, xbA, D, M, WL + WL_O, D, D, D, 0, E); } }
        else if constexpr (k == 6) { if (PH_ON(2)) { convert_p(a, l, wv); EpiGU E{ssB, Hb}; run_gemm(wv, lds, xbB, D, M, WL + WL_GU2, D, 5632, D, 0, E); } }
        else if constexpr (k == 7) {
            if (PH_ON(3)) { EpiRes E{a->out, xbB, ssB, ZERO ? 0.f : 0.5f}; run_gemm(wv, lds, Hb, FF, M, WL + WL_D2, FF, D, FF, 0, E); }
            if (PH_ON(10)) { EpiPP E{xbA}; run_gemm(wv, lds, pb, PLE, M, WL + WL_PP, PLE, D, PLE, 0, E); }
        }
        else { if (PH_ON(11)) { EpiGate E{a->out, ssB, xbA, ssA, ZERO ? 0.f : 1.0f}; run_gemm(wv, lds, xbB, D, M, WL + WL_PG, D, D, D, 0, E); } }
    }
}
template <int PH>
__device__ __forceinline__ void run_from(LAS unsigned char* lds, int ph_lo, int ph_hi, int wv) {
    if constexpr (PH < NPH) {
        if (PH >= ph_lo && PH < ph_hi) {
            run_phase<PH>(lds, wv);
            if constexpr (PH > 0 && PH < NPH - 1) { if constexpr ((DUPM >> ((PH - 1) % 9)) & 1) { __syncthreads(); run_phase<PH, true>(lds, wv); } }
            if constexpr (PH == 0 && ((DUPM >> 9) & 1)) { __syncthreads(); run_phase<PH>(lds, wv); }
            if (PH + 1 < ph_hi && kargs()->coop) {
                if constexpr (PH == 0) cg::this_grid().sync();
                else { for (int r_ = 0; r_ < BARREP; ++r_) grid_bar((unsigned*)(kargs()->ws + OFF_BAR), (unsigned)((PH - 1) * BARREP + r_ + 1) * (unsigned)lgrid(), wv); }
            }
        }
        run_from<PH + 1>(lds, ph_lo, ph_hi, wv);
    }
}
__global__ void __launch_bounds__(512, 2) mega(Args a_unused) {
    extern __shared__ __attribute__((aligned(16))) unsigned char lds_raw[];
    LAS unsigned char* lds = (LAS unsigned char*)lds_raw;
    const int ph_lo = kargs()->ph_lo, ph_hi = kargs()->ph_hi;
    const int wv = __builtin_amdgcn_readfirstlane((int)threadIdx.x >> 6);
    run_from<0>(lds, ph_lo, ph_hi, wv);
}

extern "C" void kernel_launch(void* const* d_in, const int* in_sizes, int n_in, void* d_out, int out_size, void* d_ws, size_t ws_size, hipStream_t stream) {
    static int grid = 0;
    if (grid == 0) {
        if (n_in != 24 || ws_size < WS_END) { fprintf(stderr, "kernel_launch: n_in %d ws %zu (need %zu)\n", n_in, ws_size, (size_t)WS_END); grid = -1; return; }
        int dev = 0, cus = 0, per_cu = 0;
        hipGetDevice(&dev); hipDeviceGetAttribute(&cus, hipDeviceAttributeMultiprocessorCount, dev);
        if (hipFuncSetAttribute((const void*)mega, hipFuncAttributeMaxDynamicSharedMemorySize, LDS_BYTES) != hipSuccess) { fprintf(stderr, "hipFuncSetAttribute failed\n"); grid = -1; return; }
        if (hipOccupancyMaxActiveBlocksPerMultiprocessor(&per_cu, (const void*)mega, 512, LDS_BYTES) != hipSuccess || per_cu < 1) per_cu = 1;
        (void)hipGetLastError();
        grid = cus * per_cu;
    }
    if (grid < 0) return;
    (void)hipMemsetAsync((char*)d_ws + OFF_BAR, 0, 512, stream);
    Args a{};
    for (int i = 0; i < 24; ++i) a.in[i] = (const float*)d_in[i];
    a.out = (float*)d_out; a.ws = (unsigned char*)d_ws;
#if MULTI_LAUNCH
    for (int ph = 0; ph < NPH; ++ph) {
        a.ph_lo = ph; a.ph_hi = ph + 1; a.coop = 0;
        hipLaunchKernelGGL(mega, dim3(grid), dim3(512), LDS_BYTES, stream, a);
    }
#else
    a.ph_lo = 0; a.ph_hi = NPH; a.coop = 1;
    void* args[] = {&a};
    hipError_t e = hipLaunchCooperativeKernel((void*)mega, dim3(grid), dim3(512), args, LDS_BYTES, stream);
    if (e != hipSuccess) fprintf(stderr, "cooperative launch failed: %s (grid %d)\n", hipGetErrorString(e), grid);
#endif
}
```

```cpp
#include <hip/hip_runtime.h>
#include <hip/hip_cooperative_groups.h>
#include <cstdio>
#include <cstdint>
namespace cg = cooperative_groups;

#ifndef MULTI_LAUNCH
#define MULTI_LAUNCH 0
#endif

#ifndef BARREP
#define BARREP 1
#endif
#ifndef DUPM
#define DUPM 0
#endif
#ifndef PRO_PARTS
#define PRO_PARTS 7
#endif
#ifndef PHM
#define PHM 0xffff
#endif
#define PH_ON(b) (((PHM) >> (b)) & 1)
#define LAS __attribute__((address_space(3)))
typedef unsigned short bf16_t;
typedef short bf16x8 __attribute__((ext_vector_type(8)));
typedef float f32x4 __attribute__((ext_vector_type(4)));
typedef float f32x16 __attribute__((ext_vector_type(16)));
typedef unsigned u32x4 __attribute__((ext_vector_type(4)));
typedef unsigned u32x2 __attribute__((ext_vector_type(2)));

constexpr int M = 32768, T = 2048, D = 1024, FF = 2816, DEPTH = 4, PLE = 256;
constexpr int ZQLD = 768, ZLLD = 384, QLD = 384;
constexpr size_t HEADB = (size_t)16 * 64 * 4096;
constexpr float EPS = 1e-6f;
constexpr float LOG2E = 1.4426950408889634f;

constexpr size_t WL_GU1 = 0, WL_D1 = WL_GU1 + (size_t)5632 * 1024, WL_IN = WL_D1 + (size_t)1024 * 2816, WL_UQ = WL_IN + (size_t)2816 * 1024,
                 WL_UKV = WL_UQ + (size_t)512 * 256, WL_O = WL_UKV + (size_t)512 * 128, WL_GU2 = WL_O + (size_t)1024 * 1024, WL_D2 = WL_GU2 + (size_t)5632 * 1024,
                 WL_PG = WL_D2 + (size_t)1024 * 2816, WL_PP = WL_PG + (size_t)1024 * 1024, WL_SIZE = WL_PP + (size_t)1024 * 256;
constexpr size_t OFF_W = 0;
constexpr size_t OFF_XBA = OFF_W + WL_SIZE * 2 * DEPTH;
constexpr size_t OFF_XBB = OFF_XBA + (size_t)M * D * 2;
constexpr size_t OFF_H = OFF_XBB + (size_t)M * D * 2;
constexpr size_t OFF_ZQ = OFF_H;
constexpr size_t OFF_ZL = OFF_ZQ + (size_t)M * ZQLD * 2;
constexpr size_t OFF_KF = OFF_ZL + (size_t)M * ZLLD * 2;
constexpr size_t OFF_KPE = OFF_KF + 22 * HEADB;
constexpr size_t OFF_VT = OFF_H + (size_t)M * FF * 2;
constexpr size_t OFF_SSA = OFF_VT + 22 * HEADB;
constexpr size_t OFF_SSB = OFF_SSA + (size_t)M * 16 * 4;
constexpr size_t OFF_MST = OFF_SSB + (size_t)M * 16 * 4;
constexpr size_t OFF_CS64 = OFF_MST + (size_t)M * 8 * 4;
constexpr size_t OFF_CS32 = OFF_CS64 + (size_t)T * 64 * 4;
constexpr size_t OFF_BAR = OFF_CS32 + (size_t)T * 32 * 4;
constexpr size_t OFF_QM = OFF_BAR + 4096;
constexpr size_t WS_END = OFF_QM + (size_t)M * QLD * 2;
static_assert(OFF_KPE + (size_t)16 * 64 * 2048 <= OFF_VT, "zq|zl|KF|KPE inside the H region");
static_assert(WS_END <= 626121856, "workspace budget");

constexpr int LDS_BYTES = 147456;
constexpr int NPH = 2 + 9 * DEPTH;

__device__ __forceinline__ unsigned cvt_pk_bf16(float lo, float hi) { unsigned r; asm("v_cvt_pk_bf16_f32 %0, %1, %2" : "=v"(r) : "v"(lo), "v"(hi)); return r; }
__device__ __forceinline__ float bf_lo(unsigned u) { return __uint_as_float(u << 16); }
__device__ __forceinline__ float bf_hi(unsigned u) { return __uint_as_float(u & 0xffff0000u); }
__device__ __forceinline__ float sum4(f32x4 a) { return (a.x + a.y) + (a.z + a.w); }
__device__ __forceinline__ float dot4(f32x4 a) { return (a.x * a.x + a.y * a.y) + (a.z * a.z + a.w * a.w); }
__device__ __forceinline__ float rs16(const float* ss, int row) {
    const f32x4* p = (const f32x4*)(ss + (size_t)row * 16);
    const f32x4 a = p[0], b = p[1], c = p[2], d = p[3];
    return rsqrtf(((sum4(a) + sum4(b)) + (sum4(c) + sum4(d))) * (1.0f / 1024.0f) + EPS);
}
__device__ __forceinline__ int vlane() { int l; asm volatile("v_mbcnt_lo_u32_b32 %0, -1, 0\n\tv_mbcnt_hi_u32_b32 %0, -1, %0" : "=v"(l)); return l; }
__device__ __forceinline__ int ltid(int wv) { return (wv << 6) | vlane(); }
__device__ __forceinline__ int lbid() { int b = blockIdx.x; asm volatile("" : "+s"(b)); return b; }
__device__ __forceinline__ int lgrid() { int g = gridDim.x; asm volatile("" : "+s"(g)); return g; }
__device__ __forceinline__ float sigmoidf_(float v) { return __builtin_amdgcn_rcpf(1.0f + __expf(-v)); }

namespace pg8 {
constexpr int BM = 256, BK = 64, HALF = 128, HTB = HALF * BK * 2, STAGE_BYTES = 8 * HTB, NXCD = 8, WGM = 8;
__host__ __device__ __forceinline__ int lds_byte(int r, int c) { const int st = (r >> 4) * 2 + (c >> 5), rr = r & 15, cc = c & 31, ob = rr * 64 + cc * 2; return st * 1024 + (ob ^ (((ob >> 9) & 1) << 5)); }
__host__ __device__ __forceinline__ void stage_rc(int b, int& R, int& C) { const int st = b / 1024, sb = b % 1024, swz = sb ^ (((sb >> 9) & 1) << 5); R = (st >> 1) * 16 + swz / 64; C = (st & 1) * 32 + (swz % 64) / 2; }
__host__ __device__ __forceinline__ int perm32(int rho) { const int n = rho >> 4, i = rho & 15; return 8 * (i >> 2) + 4 * n + (i & 3); }

struct Unit { int pm, pn; };
struct Gemm { const bf16_t* A; const bf16_t* Bt; int lda, ldb, K; };

struct StaticOrder {
    int nM, nN, nwg, G, c;
    __device__ void init(int Mr, int Nc, int G_, int c_) { nM = Mr / BM; nN = Nc / BM; nwg = nM * nN; G = G_; c = c_; }
    __device__ bool next(int i, Unit& u) const {
        const long L = (long)i * G + c; if (L >= nwg) return false;
        int wgid = (int)L; { const int q = nwg / NXCD, r = nwg % NXCD, xcd = wgid % NXCD, off = wgid / NXCD; wgid = (xcd < r ? xcd * (q + 1) : r * (q + 1) + (xcd - r) * q) + off; }
        const int nig = WGM * nN, gid = wgid / nig, fm = gid * WGM, gsz = (nM - fm) < WGM ? (nM - fm) : WGM;
        u.pm = fm + ((wgid % nig) % gsz); u.pn = (wgid % nig) / gsz; return true;
    }
};

template <class Epi>
__device__ __forceinline__ void gemm_phase(LAS unsigned char* lds, const Gemm g, const StaticOrder& S, const Epi& E, int wv) {
    const int tid = ltid(wv);
    const int wid = wv, lane = tid & 63, wr = wid >> 2, wc = wid & 3, fr = lane & 15, fq = lane >> 4;
    const int K = g.K, nt = K / BK;
    unsigned voffA[2], voffB[2];
#pragma unroll
    for (int i = 0; i < 2; ++i) { int R, C; stage_rc(tid * 16 + i * 8192, R, C); const int Rb = (R & ~31) + perm32(R & 31);
        voffA[i] = (unsigned)(R * g.lda + C) * 2u; voffB[i] = (unsigned)(Rb * g.ldb + C) * 2u; }
    const size_t kstep = (size_t)(BK * 2);
    const size_t hstepA = (size_t)HALF * g.lda * 2, hstepB = (size_t)HALF * g.ldb * 2;
    const size_t tstepA = 2 * hstepA, tstepB = 2 * hstepB;
    const unsigned ldsw = (unsigned)wid * 1024u;
    const int aoff = lds_byte(wr * 64 + fr, fq * 8), boff = lds_byte(wc * 32 + fr, fq * 8);
#define PG8_SA(b, h) (((b) * 2 + (h)) * HTB)
#define PG8_SB(b, h) ((4 + (b) * 2 + (h)) * HTB)
#define PG8_STAGE(bufoff, gbase, voff) do { _Pragma("unroll") for (int _i = 0; _i < 2; ++_i) \
        __builtin_amdgcn_global_load_lds((const unsigned*)((const char*)(gbase) + (voff)[_i]), (LAS unsigned*)(lds + (bufoff) + ldsw + _i * 8192), 16, 0, 0); } while (0)
#define PG8_LDA(dst, b, h) do { _Pragma("unroll") for (int m = 0; m < 4; ++m) _Pragma("unroll") for (int k = 0; k < 2; ++k) dst[m][k] = *(const LAS bf16x8*)(lds + PG8_SA(b, h) + aoff + m * 2048 + k * 1024); } while (0)
#define PG8_LDB(dst, b, h) do { _Pragma("unroll") for (int n = 0; n < 2; ++n) _Pragma("unroll") for (int k = 0; k < 2; ++k) dst[n][k] = *(const LAS bf16x8*)(lds + PG8_SB(b, h) + boff + n * 2048 + k * 1024); } while (0)
#define PG8_MMA(ai, bj, At, Bt) do { __builtin_amdgcn_s_setprio(1); _Pragma("unroll") for (int m = 0; m < 4; ++m) _Pragma("unroll") for (int n = 0; n < 2; ++n) _Pragma("unroll") for (int k = 0; k < 2; ++k) \
        acc[ai][bj][m][n] = __builtin_amdgcn_mfma_f32_16x16x32_bf16(Bt[n][k], At[m][k], acc[ai][bj][m][n], 0, 0, 0); __builtin_amdgcn_s_setprio(0); } while (0)
#define PG8_WAIT_V(n) asm volatile("s_waitcnt vmcnt(" #n ")" ::: "memory")
#define PG8_WAIT_L(n) asm volatile("s_waitcnt lgkmcnt(" #n ")" ::: "memory")
#define PG8_BAR __builtin_amdgcn_s_barrier()
#define PG8_SCHED __builtin_amdgcn_sched_barrier(0)
    Unit cur, nxt; int ui = 0;
    if (!S.next(0, cur)) return;
    f32x4 acc[2][2][4][2];
#pragma unroll
    for (int a = 0; a < 2; ++a)
#pragma unroll
        for (int b = 0; b < 2; ++b)
#pragma unroll
            for (int m = 0; m < 4; ++m)
#pragma unroll
                for (int n = 0; n < 2; ++n) acc[a][b][m][n] = (f32x4){0.f, 0.f, 0.f, 0.f};
    bf16x8 At[4][2], B0[2][2], B1[2][2];
    const char* cA = (const char*)g.A + (size_t)cur.pm * tstepA; const char* cB = (const char*)g.Bt + (size_t)cur.pn * tstepB;
    PG8_STAGE(PG8_SB(0, 0), cB, voffB); PG8_STAGE(PG8_SB(0, 1), cB + hstepB, voffB); PG8_STAGE(PG8_SA(0, 0), cA, voffA); PG8_STAGE(PG8_SA(0, 1), cA + hstepA, voffA);
    if (wr == 1) PG8_BAR;
    PG8_WAIT_V(2); PG8_BAR;
    PG8_STAGE(PG8_SB(1, 0), cB + kstep, voffB); PG8_STAGE(PG8_SA(1, 0), cA + kstep, voffA); PG8_STAGE(PG8_SB(1, 1), cB + hstepB + kstep, voffB);
    PG8_WAIT_V(6); PG8_BAR;
    for (;;) {
        const bool has_next = S.next(ui + 1, nxt);
        const char* nA = has_next ? (const char*)g.A + (size_t)nxt.pm * tstepA : cA; const char* nB = has_next ? (const char*)g.Bt + (size_t)nxt.pn * tstepB : cB;
        for (int t = 0; t < nt; t += 2) {
            const bool last = (t == nt - 2);
            const char* a1 = cA + (size_t)(t + 1) * kstep;
            const char* a2 = last ? nA : cA + (size_t)(t + 2) * kstep; const char* b2 = last ? nB : cB + (size_t)(t + 2) * kstep;
            const char* a3 = a2 + kstep; const char* b3 = b2 + kstep;
            PG8_LDB(B0, 0, 0); PG8_LDB(B1, 0, 1); PG8_SCHED; PG8_LDA(At, 0, 0); PG8_STAGE(PG8_SA(1, 1), a1 + hstepA, voffA);
            PG8_WAIT_V(8); PG8_WAIT_L(0); PG8_BAR; PG8_MMA(0, 0, At, B0); PG8_MMA(0, 1, At, B1); PG8_BAR; PG8_SCHED;
            PG8_LDA(At, 0, 1); PG8_STAGE(PG8_SB(0, 0), b2, voffB); PG8_STAGE(PG8_SB(0, 1), b2 + hstepB, voffB); PG8_STAGE(PG8_SA(0, 0), a2, voffA);
            PG8_WAIT_V(8); PG8_WAIT_L(0); PG8_BAR; PG8_MMA(1, 0, At, B0); PG8_MMA(1, 1, At, B1); PG8_BAR; PG8_SCHED;
            PG8_LDB(B0, 1, 0); PG8_LDB(B1, 1, 1); PG8_SCHED; PG8_LDA(At, 1, 0); PG8_STAGE(PG8_SA(0, 1), a2 + hstepA, voffA);
            PG8_WAIT_V(8); PG8_WAIT_L(0); PG8_BAR; PG8_MMA(0, 0, At, B0); PG8_MMA(0, 1, At, B1); PG8_BAR; PG8_SCHED;
            PG8_LDA(At, 1, 1); PG8_STAGE(PG8_SB(1, 0), b3, voffB); PG8_STAGE(PG8_SB(1, 1), b3 + hstepB, voffB); PG8_STAGE(PG8_SA(1, 0), a3, voffA);
            PG8_WAIT_V(8); PG8_WAIT_L(0); PG8_BAR; PG8_MMA(1, 0, At, B0); PG8_MMA(1, 1, At, B1); PG8_BAR; PG8_SCHED;
        }
        if (wr == 0) PG8_BAR;
        E(acc, cur, wr, wc, fr, fq);
        if (!has_next) break;
#pragma unroll
        for (int a = 0; a < 2; ++a)
#pragma unroll
            for (int b = 0; b < 2; ++b)
#pragma unroll
                for (int m = 0; m < 4; ++m)
#pragma unroll
                    for (int n = 0; n < 2; ++n) acc[a][b][m][n] = (f32x4){0.f, 0.f, 0.f, 0.f};
        cur = nxt; cA = nA; cB = nB; ++ui;
        if (wr == 1) PG8_BAR;
    }
    PG8_WAIT_V(0);
    PG8_BAR;
#undef PG8_SA
#undef PG8_SB
#undef PG8_STAGE
#undef PG8_LDA
#undef PG8_LDB
#undef PG8_MMA
#undef PG8_WAIT_V
#undef PG8_WAIT_L
#undef PG8_BAR
#undef PG8_SCHED
}
}
using pg8::Unit;
typedef const f32x4 (&AccRef)[2][2][4][2];

struct EpiGU {
    const float* ss; bf16_t* H;
    __device__ __forceinline__ void operator()(AccRef acc, const Unit& u, int wr, int wc, int, int) const { const int lane_ = vlane(); const int fr = lane_ & 15, fq = lane_ >> 4;
#pragma unroll
        for (int ai = 0; ai < 2; ++ai)
#pragma unroll
            for (int m = 0; m < 4; ++m) {
                const int row = u.pm * 256 + ai * 128 + wr * 64 + m * 16 + fr;
                asm volatile("" ::: "memory");
                const float r = rs16(ss, row);
#pragma unroll
                for (int bj = 0; bj < 2; ++bj) {
                    const f32x4 g = acc[ai][bj][m][0] * r, v = acc[ai][bj][m][1] * r;
                    const float h0 = g.x * sigmoidf_(g.x) * v.x, h1 = g.y * sigmoidf_(g.y) * v.y, h2 = g.z * sigmoidf_(g.z) * v.z, h3 = g.w * sigmoidf_(g.w) * v.w;
                    u32x2 w; w.x = cvt_pk_bf16(h0, h1); w.y = cvt_pk_bf16(h2, h3);
                    *(u32x2*)(H + (size_t)row * FF + u.pn * 128 + bj * 64 + wc * 16 + fq * 4) = w;
                }
            }
    }
};
struct EpiRes {
    float* X; bf16_t* xb; float* ssOut; float alpha;
    __device__ __forceinline__ void operator()(AccRef acc, const Unit& u, int wr, int wc, int, int) const { const int lane_ = vlane(); const int fr = lane_ & 15, fq = lane_ >> 4;
#pragma unroll
        for (int ai = 0; ai < 2; ++ai)
#pragma unroll
            for (int m = 0; m < 4; ++m) {
                const int row = u.pm * 256 + ai * 128 + wr * 64 + m * 16 + fr;
                asm volatile("" ::: "memory");
                float sq = 0.f;
#pragma unroll
                for (int bj = 0; bj < 2; ++bj) {
                    const size_t off = (size_t)row * D + u.pn * 256 + bj * 128 + wc * 32 + fq * 8;
                    f32x4 x0 = *(const f32x4*)(X + off), x1 = *(const f32x4*)(X + off + 4);
                    x0 += acc[ai][bj][m][0] * alpha; x1 += acc[ai][bj][m][1] * alpha;
                    *(f32x4*)(X + off) = x0; *(f32x4*)(X + off + 4) = x1;
                    sq += dot4(x0) + dot4(x1);
                    u32x4 w; w.x = cvt_pk_bf16(x0.x, x0.y); w.y = cvt_pk_bf16(x0.z, x0.w); w.z = cvt_pk_bf16(x1.x, x1.y); w.w = cvt_pk_bf16(x1.z, x1.w);
                    *(u32x4*)(xb + off) = w;
                }
                sq += __shfl_xor(sq, 16); sq += __shfl_xor(sq, 32);
                if (fq == 0) ssOut[(size_t)row * 16 + u.pn * 4 + wc] = sq;
            }
    }
};
struct EpiGate {
    float* X; const float* ssIn; bf16_t* ppxb; float* ssOut; float gsc;
    __device__ __forceinline__ void operator()(AccRef acc, const Unit& u, int wr, int wc, int, int) const { const int lane_ = vlane(); const int fr = lane_ & 15, fq = lane_ >> 4;
#pragma unroll
        for (int ai = 0; ai < 2; ++ai)
#pragma unroll
            for (int m = 0; m < 4; ++m) {
                const int row = u.pm * 256 + ai * 128 + wr * 64 + m * 16 + fr;
                asm volatile("" ::: "memory");
                const float r = rs16(ssIn, row);
                float sq = 0.f;
#pragma unroll
                for (int bj = 0; bj < 2; ++bj) {
                    const size_t off = (size_t)row * D + u.pn * 256 + bj * 128 + wc * 32 + fq * 8;
                    f32x4 x0 = *(const f32x4*)(X + off), x1 = *(const f32x4*)(X + off + 4);
                    const u32x4 pp = *(const u32x4*)(ppxb + off); const float gs = gsc;
                    const f32x4 a0 = acc[ai][bj][m][0] * r, a1 = acc[ai][bj][m][1] * r;
                    x0.x += sigmoidf_(a0.x) * (bf_lo(pp.x) * gs); x0.y += sigmoidf_(a0.y) * (bf_hi(pp.x) * gs); x0.z += sigmoidf_(a0.z) * (bf_lo(pp.y) * gs); x0.w += sigmoidf_(a0.w) * (bf_hi(pp.y) * gs);
                    x1.x += sigmoidf_(a1.x) * (bf_lo(pp.z) * gs); x1.y += sigmoidf_(a1.y) * (bf_hi(pp.z) * gs); x1.z += sigmoidf_(a1.z) * (bf_lo(pp.w) * gs); x1.w += sigmoidf_(a1.w) * (bf_hi(pp.w) * gs);
                    *(f32x4*)(X + off) = x0; *(f32x4*)(X + off + 4) = x1;
                    sq += dot4(x0) + dot4(x1);
                    u32x4 w; w.x = cvt_pk_bf16(x0.x, x0.y); w.y = cvt_pk_bf16(x0.z, x0.w); w.z = cvt_pk_bf16(x1.x, x1.y); w.w = cvt_pk_bf16(x1.z, x1.w);
                    *(u32x4*)(ppxb + off) = w;
                }
                sq += __shfl_xor(sq, 16); sq += __shfl_xor(sq, 32);
                if (fq == 0) ssOut[(size_t)row * 16 + u.pn * 4 + wc] = sq;
            }
    }
};
__device__ __forceinline__ void rope_rot(f32x4& v0, f32x4& v1, const float* cs) {
    const f32x4 c = *(const f32x4*)cs, s = *(const f32x4*)(cs + 4);
    const f32x4 a = v0 * c - v1 * s, b = v1 * c + v0 * s; v0 = a; v1 = b;
}
struct EpiIn {
    const float* ss; unsigned char* ws; float* mst; const float* cs64; const float* cs32;
    __device__ __forceinline__ void operator()(AccRef acc, const Unit& u, int wr, int wc, int, int) const { const int lane_ = vlane(); const int fr = lane_ & 15, fq = lane_ >> 4;
#pragma unroll
        for (int ai = 0; ai < 2; ++ai)
#pragma unroll
            for (int m = 0; m < 4; ++m) {
                const int row = u.pm * 256 + ai * 128 + wr * 64 + m * 16 + fr;
                asm volatile("" ::: "memory");
                const float r = rs16(ss, row);
                const int pos = row & (T - 1), b = row >> 11;
                float sq = 0.f;
#pragma unroll
                for (int bj = 0; bj < 2; ++bj) {
                    const int gcol = u.pn * 256 + bj * 128 + wc * 32;
                    f32x4 v0 = acc[ai][bj][m][0] * r, v1 = acc[ai][bj][m][1] * r;
                    const bool r64 = (gcol >= 512 && gcol < 896) || (gcol >= 1024 && gcol < 1536);
                    if (r64) rope_rot(v0, v1, cs64 + ((size_t)pos * 8 + 4 * ((gcol >> 5) & 1) + fq) * 8);
                    if (gcol == 1920) rope_rot(v0, v1, cs32 + ((size_t)pos * 4 + fq) * 8);
                    if (u.pn == 6 || (u.pn == 7 && bj == 0)) sq += dot4(v0) + dot4(v1);
                    u32x4 w; w.x = cvt_pk_bf16(v0.x, v0.y); w.y = cvt_pk_bf16(v0.z, v0.w); w.z = cvt_pk_bf16(v1.x, v1.y); w.w = cvt_pk_bf16(v1.z, v1.w);
                    const int c8 = ((gcol & 63) >> 3) + fq;
                    const size_t frag = (size_t)(c8 >> 1) * 1024 + (size_t)((pos & 31) + 32 * (c8 & 1)) * 16;
                    const size_t rec = ((size_t)b * 64 + (pos >> 5)) * 4096;
                    if (gcol < 256) *(u32x4*)(ws + OFF_ZQ + ((size_t)row * ZQLD + gcol + fq * 8) * 2) = w;
                    else if (gcol < 512) *(u32x4*)(ws + OFF_KF + (size_t)((gcol - 256) >> 6) * HEADB + rec + frag) = w;
                    else if (gcol < 768) *(u32x4*)(ws + OFF_ZQ + ((size_t)row * ZQLD + (gcol - 256) + fq * 8) * 2) = w;
                    else if (gcol < 896) *(u32x4*)(ws + OFF_KF + (size_t)(4 + ((gcol - 768) >> 6)) * HEADB + rec + frag) = w;
                    else if (gcol < 1024) { }
                    else if (gcol < 1280) *(u32x4*)(ws + OFF_ZQ + ((size_t)row * ZQLD + (gcol - 512) + fq * 8) * 2) = w;
                    else if (gcol < 1536) {
                        const int hd = (gcol - 1280) >> 6;
                        *(u32x4*)(ws + OFF_KF + (size_t)(6 + hd) * HEADB + rec + frag) = w;
                        const int p4 = (pos & 3) * 512 + (pos >> 2), p16 = (pos & 15) * 128 + (pos >> 4);
                        *(u32x4*)(ws + OFF_KF + (size_t)(10 + hd) * HEADB + ((size_t)b * 64 + (p4 >> 5)) * 4096 + (size_t)(c8 >> 1) * 1024 + (size_t)((p4 & 31) + 32 * (c8 & 1)) * 16) = w;
                        *(u32x4*)(ws + OFF_KF + (size_t)(14 + hd) * HEADB + ((size_t)b * 64 + (p16 >> 5)) * 4096 + (size_t)(c8 >> 1) * 1024 + (size_t)((p16 & 31) + 32 * (c8 & 1)) * 16) = w;
                    }
                    else if (gcol < 1920) *(u32x4*)(ws + OFF_ZL + ((size_t)row * ZLLD + (gcol - 1536) + fq * 8) * 2) = w;
                    else if (gcol == 1920) *(u32x4*)(ws + OFF_KPE + ((size_t)b * 64 + (pos >> 5)) * 2048 + (size_t)(fq >> 1) * 1024 + (size_t)((pos & 31) + 32 * (fq & 1)) * 16) = w;
                }
                if (u.pn >= 6) {
                    sq += __shfl_xor(sq, 16); sq += __shfl_xor(sq, 32);
                    if (fq == 0) mst[(size_t)row * 8 + (u.pn - 6) * 4 + wc] = sq;
                }
            }
    }
};
__device__ __forceinline__ void vstore8(unsigned char* vf, int vhead, int dd, int tok0, u32x4 w) {
    const int b = tok0 >> 11, pos0 = tok0 & (T - 1), idx0 = pos0 & 31;
    unsigned char* p = vf + (size_t)vhead * HEADB + ((size_t)b * 64 + (pos0 >> 5)) * 4096 + (size_t)((dd >> 5) * 2 + (idx0 >> 4)) * 1024 + (size_t)(dd & 31) * 16 + ((idx0 >> 3) & 1) * 8;
    u32x2 lo; lo.x = w.x; lo.y = w.y; u32x2 hi; hi.x = w.z; hi.y = w.w;
    *(u32x2*)p = lo; *(u32x2*)(p + 512) = hi;
}
__device__ __forceinline__ void vstore1(unsigned char* vf, int vhead, int dd, int b, int ppos, bf16_t val) {
    const int idx = ppos & 31, r16 = idx & 15;
    unsigned char* p = vf + (size_t)vhead * HEADB + ((size_t)b * 64 + (ppos >> 5)) * 4096 + (size_t)((dd >> 5) * 2 + (idx >> 4)) * 1024 + (size_t)((dd & 31) + 32 * ((r16 >> 2) & 1)) * 16 + (r16 >> 3) * 8 + (r16 & 3) * 2;
    *(bf16_t*)p = val;
}
struct EpiVT {
    const float* ss; unsigned char* vf;
    __device__ __forceinline__ void operator()(AccRef acc, const Unit& u, int wr, int wc, int, int) const { const int lane_ = vlane(); const int fr = lane_ & 15, fq = lane_ >> 4;
#pragma unroll
        for (int bj = 0; bj < 2; ++bj) {
            const int tok0 = u.pn * 256 + bj * 128 + wc * 32 + fq * 8;
            float rs[8];
#pragma unroll
            for (int e = 0; e < 8; ++e) rs[e] = rs16(ss, tok0 + e);
#pragma unroll
            for (int ai = 0; ai < 2; ++ai) {
                const int rbase = u.pm * 256 + ai * 128;
                if (rbase >= 640) continue;
                const bool dil = rbase >= 384;
#pragma unroll
                for (int m = 0; m < 4; ++m) {
                    const int row = rbase + wr * 64 + m * 16 + fr;
                    asm volatile("" ::: "memory");
                    const f32x4 a0 = acc[ai][bj][m][0], a1 = acc[ai][bj][m][1];
                    u32x4 w; w.x = cvt_pk_bf16(a0.x * rs[0], a0.y * rs[1]); w.y = cvt_pk_bf16(a0.z * rs[2], a0.w * rs[3]);
                    w.z = cvt_pk_bf16(a1.x * rs[4], a1.y * rs[5]); w.w = cvt_pk_bf16(a1.z * rs[6], a1.w * rs[7]);
                    const int vhead = row >> 6, dd = row & 63;
                    vstore8(vf, vhead, dd, tok0, w);
                    if (dil) {
                        const int b = tok0 >> 11, t0 = tok0 & (T - 1);
                        const unsigned ww[4] = {w.x, w.y, w.z, w.w};
#pragma unroll
                        for (int e = 0; e < 8; ++e) {
                            const int t = t0 + e; const bf16_t val = (bf16_t)((e & 1) ? (ww[e >> 1] >> 16) : (ww[e >> 1] & 0xffffu));
                            vstore1(vf, vhead + 4, dd, b, (t & 3) * 512 + (t >> 2), val);
                            vstore1(vf, vhead + 8, dd, b, (t & 15) * 128 + (t >> 4), val);
                        }
                    }
                }
            }
        }
    }
};
struct EpiQ {
    const float* mst; bf16_t* qm; const float* cs32;
    __device__ __forceinline__ void operator()(AccRef acc, const Unit& u, int wr, int wc, int, int) const { const int lane_ = vlane(); const int fr = lane_ & 15, fq = lane_ >> 4;
#pragma unroll
        for (int ai = 0; ai < 2; ++ai)
#pragma unroll
            for (int m = 0; m < 4; ++m) {
                const int row = u.pm * 256 + ai * 128 + wr * 64 + m * 16 + fr;
                asm volatile("" ::: "memory");
                const f32x4 st = *(const f32x4*)(mst + (size_t)row * 8);
                const float r = rsqrtf(sum4(st) * (1.0f / 256.0f) + EPS);
                const int pos = row & (T - 1);
#pragma unroll
                for (int bj = 0; bj < 2; ++bj) {
                    const int gcol = u.pn * 256 + bj * 128 + wc * 32;
                    if (gcol >= 384) continue;
                    f32x4 v0 = acc[ai][bj][m][0] * r, v1 = acc[ai][bj][m][1] * r;
                    if (((gcol >> 5) % 3) == 2) rope_rot(v0, v1, cs32 + ((size_t)pos * 4 + fq) * 8);
                    u32x4 w; w.x = cvt_pk_bf16(v0.x, v0.y); w.y = cvt_pk_bf16(v0.z, v0.w); w.z = cvt_pk_bf16(v1.x, v1.y); w.w = cvt_pk_bf16(v1.z, v1.w);
                    *(u32x4*)(qm + (size_t)row * QLD + gcol + fq * 8) = w;
                }
            }
    }
};
struct EpiK {
    const float* mst; unsigned char* ws;
    __device__ __forceinline__ void operator()(AccRef acc, const Unit& u, int wr, int wc, int, int) const { const int lane_ = vlane(); const int fr = lane_ & 15, fq = lane_ >> 4;
#pragma unroll
        for (int ai = 0; ai < 2; ++ai)
#pragma unroll
            for (int m = 0; m < 4; ++m) {
                const int row = u.pm * 256 + ai * 128 + wr * 64 + m * 16 + fr;
                asm volatile("" ::: "memory");
                const f32x4 st = *(const f32x4*)(mst + (size_t)row * 8 + 4);
                const float r = rsqrtf(sum4(st) * (1.0f / 128.0f) + EPS);
#pragma unroll
                for (int bj = 0; bj < 2; ++bj) {
                    const f32x4 v0 = acc[ai][bj][m][0] * r, v1 = acc[ai][bj][m][1] * r;
                    u32x4 w; w.x = cvt_pk_bf16(v0.x, v0.y); w.y = cvt_pk_bf16(v0.z, v0.w); w.z = cvt_pk_bf16(v1.x, v1.y); w.w = cvt_pk_bf16(v1.z, v1.w);
                    const int col0 = bj * 128 + wc * 32, c8 = ((col0 & 63) >> 3) + fq, pos = row & (T - 1);
                    *(u32x4*)(ws + OFF_KF + (size_t)(18 + (col0 >> 6)) * HEADB + ((size_t)(row >> 11) * 64 + (pos >> 5)) * 4096 + (size_t)(c8 >> 1) * 1024 + (size_t)((pos & 31) + 32 * (c8 & 1)) * 16) = w;
                }
            }
    }
};
struct EpiVTM {
    const float* mst; unsigned char* vf;
    __device__ __forceinline__ void operator()(AccRef acc, const Unit& u, int wr, int wc, int, int) const { const int lane_ = vlane(); const int fr = lane_ & 15, fq = lane_ >> 4;
#pragma unroll
        for (int bj = 0; bj < 2; ++bj) {
            const int tok0 = u.pn * 256 + bj * 128 + wc * 32 + fq * 8;
            float rs[8];
#pragma unroll
            for (int e = 0; e < 8; ++e) { const f32x4 st = *(const f32x4*)(mst + (size_t)(tok0 + e) * 8 + 4); rs[e] = rsqrtf(sum4(st) * (1.0f / 128.0f) + EPS); }
#pragma unroll
            for (int ai = 0; ai < 2; ++ai)
#pragma unroll
                for (int m = 0; m < 4; ++m) {
                    const int row = ai * 128 + wr * 64 + m * 16 + fr;
                    asm volatile("" ::: "memory");
                    const f32x4 a0 = acc[ai][bj][m][0], a1 = acc[ai][bj][m][1];
                    u32x4 w; w.x = cvt_pk_bf16(a0.x * rs[0], a0.y * rs[1]); w.y = cvt_pk_bf16(a0.z * rs[2], a0.w * rs[3]);
                    w.z = cvt_pk_bf16(a1.x * rs[4], a1.y * rs[5]); w.w = cvt_pk_bf16(a1.z * rs[6], a1.w * rs[7]);
                    vstore8(vf, 18 + (row >> 6), row & 63, tok0, w);
                }
        }
    }
};
struct EpiPP {
    bf16_t* O;
    __device__ __forceinline__ void operator()(AccRef acc, const Unit& u, int wr, int wc, int, int) const { const int lane_ = vlane(); const int fr = lane_ & 15, fq = lane_ >> 4;
#pragma unroll
        for (int ai = 0; ai < 2; ++ai)
#pragma unroll
            for (int m = 0; m < 4; ++m) {
                const int row = u.pm * 256 + ai * 128 + wr * 64 + m * 16 + fr;
                asm volatile("" ::: "memory");
#pragma unroll
                for (int bj = 0; bj < 2; ++bj) {
                    const f32x4 v0 = acc[ai][bj][m][0], v1 = acc[ai][bj][m][1];
                    u32x4 w; w.x = cvt_pk_bf16(v0.x, v0.y); w.y = cvt_pk_bf16(v0.z, v0.w); w.z = cvt_pk_bf16(v1.x, v1.y); w.w = cvt_pk_bf16(v1.z, v1.w);
                    *(u32x4*)(O + (size_t)row * D + u.pn * 256 + bj * 128 + wc * 32 + fq * 8) = w;
                }
            }
    }
};

template <class Epi>
__device__ __forceinline__ void run_gemm(int wv, LAS unsigned char* lds, const bf16_t* A, int lda, int rows, const bf16_t* Bt, int ldb, int cols, int K, int cshift, const Epi& E) {
    pg8::Gemm g{A, Bt, lda, ldb, K};
    pg8::StaticOrder S; const int G_ = lgrid(); S.init(rows, cols, G_, (lbid() + cshift) % G_);
    pg8::gemm_phase<Epi>(lds, g, S, E, wv);
}

__device__ __forceinline__ int p64(int d) { return d < 32 ? 8 * (d >> 2) + (d & 3) : 8 * ((d - 32) >> 2) + 4 + (d & 3); }
__device__ __forceinline__ int p32(int d) { return d < 16 ? 8 * (d >> 2) + (d & 3) : 8 * ((d - 16) >> 2) + 4 + (d & 3); }
__device__ __forceinline__ int maprow(int mapid, int c) {
    switch (mapid) {
        case 0: return c;
        case 1: return (c >> 2) * 8 + (c & 3);
        case 2: return (c >> 2) * 8 + 4 + (c & 3);
        case 3: {
            if (c < 768) return c < 512 ? c : 2048 + (c - 512);
            c -= 768;
            if (c < 512) return c < 384 ? 512 + (c >> 6) * 64 + p64(c & 63) : 2048 + 256 + (c - 384);
            c -= 512;
            if (c < 768) return c < 512 ? 1024 + (c >> 6) * 64 + p64(c & 63) : 2048 + 384 + (c - 512);
            c -= 768;
            if (c < 256) return 1536 + c;
            if (c < 384) return 1792 + (c - 256);
            return 1920 + p32(c - 384);
        }
        case 4: { const int h = c / 96, e = c % 96; return e < 64 ? 96 * h + e : 96 * h + 64 + p32(e - 64); }
        default: { const int h = c >> 7, e = c & 127; return e < 64 ? 64 * h + e : 256 + 64 * h + (e - 64); }
    }
}
__device__ __forceinline__ void tr_item(const float* W, int K, int N, const float* gain, bf16_t* dst, int mapid, int item, LAS float* s, int wv) {
    const int tid = ltid(wv);
    const int ncb = (N + 255) >> 8, kb = item / ncb, cb = item % ncb, k0 = kb * 64, c0 = cb * 256;
#pragma unroll
    for (int i = 0; i < 8; ++i) {
        const int kk = i * 8 + (tid >> 6), col = (tid & 63) * 4;
        f32x4 v = (f32x4){0.f, 0.f, 0.f, 0.f};
        if (c0 + col < N) v = *(const f32x4*)(W + (size_t)(k0 + kk) * N + c0 + col);
        if (gain) v *= gain[k0 + kk];
        *(LAS f32x4*)(s + kk * 260 + col) = v;
    }
    __syncthreads();
    const int cc = tid & 255, kh = tid >> 8, c = c0 + cc;
    if (c < N) {
        const int drow = maprow(mapid, c);
        bf16_t* o = dst + (size_t)drow * K + k0 + kh * 32;
#pragma unroll
        for (int q = 0; q < 4; ++q) {
            const LAS float* sp = s + (kh * 32 + q * 8) * 260 + cc;
            u32x4 w; w.x = cvt_pk_bf16(sp[0], sp[260]); w.y = cvt_pk_bf16(sp[2 * 260], sp[3 * 260]); w.z = cvt_pk_bf16(sp[4 * 260], sp[5 * 260]); w.w = cvt_pk_bf16(sp[6 * 260], sp[7 * 260]);
            *(u32x4*)(o + q * 8) = w;
        }
    }
    __syncthreads();
}

struct Args { const float* in[24]; float* out; unsigned char* ws; int ph_lo, ph_hi, coop, pad; };
typedef const __attribute__((address_space(4))) Args* KA;
__device__ __forceinline__ KA kargs() { KA p = (KA)__builtin_amdgcn_kernarg_segment_ptr(); asm volatile("" : "+s"(p)); return p; }

__device__ __forceinline__ void zero_rows(bf16_t* base, int row0, int nrows, int K, int gt, int ngt) {
    const size_t n16 = (size_t)nrows * K / 8; u32x4* p = (u32x4*)(base + (size_t)row0 * K);
    for (size_t i = gt; i < n16; i += ngt) p[i] = (u32x4){0u, 0u, 0u, 0u};
}

__device__ __forceinline__ void prologue(KA a, LAS unsigned char* lds, int wv) {
    LAS float* s = (LAS float*)lds;
    const int G = lgrid(), bid = lbid(), tid = ltid(wv);
    bf16_t* Wbase = (bf16_t*)(a->ws + OFF_W);
#if PRO_PARTS & 1
    constexpr int I_FFN = 16 * 11, I_DN = 44 * 4, I_IN = 16 * 10, I_UQ = 4 * 2, I_UKV = 2 * 2, I_O = 16 * 4, I_PP = 4 * 4;
    constexpr int I_LAYER = 4 * I_FFN + 2 * I_DN + I_IN + I_UQ + I_UKV + 2 * I_O + I_PP;
    for (int it = bid; it < I_LAYER * DEPTH; it += G) {
        const int l = it / I_LAYER; int r = it % I_LAYER;
        int sel = 0;
        if (r >= I_FFN) { r -= I_FFN; sel = 1;
        if (r >= I_FFN) { r -= I_FFN; sel = 2;
        if (r >= I_DN) { r -= I_DN; sel = 3;
        if (r >= I_IN) { r -= I_IN; sel = 4;
        if (r >= I_UQ) { r -= I_UQ; sel = 5;
        if (r >= I_UKV) { r -= I_UKV; sel = 6;
        if (r >= I_O) { r -= I_O; sel = 7;
        if (r >= I_FFN) { r -= I_FFN; sel = 8;
        if (r >= I_FFN) { r -= I_FFN; sel = 9;
        if (r >= I_DN) { r -= I_DN; sel = 10;
        if (r >= I_O) { r -= I_O; sel = 11; } } } } } } } } } } }
        const float* W0; const float* g0 = nullptr; int K, N, mapid; size_t doff;
        switch (sel) {
            case 0: W0 = a->in[3]; g0 = a->in[2]; K = D; N = FF; doff = WL_GU1; mapid = 1; break;
            case 1: W0 = a->in[4]; g0 = a->in[2]; K = D; N = FF; doff = WL_GU1; mapid = 2; break;
            case 2: W0 = a->in[5]; K = FF; N = D; doff = WL_D1; mapid = 0; break;
            case 3: W0 = a->in[7]; g0 = a->in[6]; K = D; N = 2464; doff = WL_IN; mapid = 3; break;
            case 4: W0 = a->in[11]; g0 = a->in[10]; K = 256; N = 384; doff = WL_UQ; mapid = 4; break;
            case 5: W0 = a->in[13]; g0 = a->in[12]; K = 128; N = 512; doff = WL_UKV; mapid = 5; break;
            case 6: W0 = a->in[15]; g0 = a->in[14]; K = D; N = D; doff = WL_O; mapid = 0; break;
            case 7: W0 = a->in[17]; g0 = a->in[16]; K = D; N = FF; doff = WL_GU2; mapid = 1; break;
            case 8: W0 = a->in[18]; g0 = a->in[16]; K = D; N = FF; doff = WL_GU2; mapid = 2; break;
            case 9: W0 = a->in[19]; K = FF; N = D; doff = WL_D2; mapid = 0; break;
            case 10: W0 = a->in[21]; g0 = a->in[20]; K = D; N = D; doff = WL_PG; mapid = 0; break;
            default: W0 = a->in[22]; K = PLE; N = D; doff = WL_PP; mapid = 0; break;
        }
        const float* W = W0 + (size_t)l * K * N;
        const float* gain = g0 ? g0 + (size_t)l * K : nullptr;
        tr_item(W, K, N, gain, Wbase + (size_t)l * WL_SIZE + doff, mapid, r, s, wv);
    }
#endif
    const int gt = bid * 512 + tid, ngt = G * 512;
    for (int l = 0; l < DEPTH; ++l) {
        bf16_t* WL = Wbase + (size_t)l * WL_SIZE;
        zero_rows(WL + WL_IN, 896, 128, D, gt, ngt); zero_rows(WL + WL_IN, 1952, 96, D, gt, ngt); zero_rows(WL + WL_IN, 2048 + 640, 128, D, gt, ngt);
        zero_rows(WL + WL_UQ, 384, 128, 256, gt, ngt);
    }
#if PRO_PARTS & 2
    float* cs64 = (float*)(a->ws + OFF_CS64); float* cs32 = (float*)(a->ws + OFF_CS32);
    for (int i = gt; i < T * 32; i += ngt) {
        const int pos = i >> 5, j = i & 31;
        const float inv = __builtin_amdgcn_exp2f(-(float)j * (13.287712379549449f / 32.0f)); const float ang = (float)pos * inv;
        const float rev = ang * 0.15915494309189535f, fr_ = rev - floorf(rev);
        float* p = cs64 + ((size_t)pos * 8 + (j >> 2)) * 8 + (j & 3);
        p[0] = __builtin_amdgcn_cosf(fr_); p[4] = __builtin_amdgcn_sinf(fr_);
    }
    for (int i = gt; i < T * 16; i += ngt) {
        const int pos = i >> 4, j = i & 15;
        const float inv = __builtin_amdgcn_exp2f(-(float)j * (13.287712379549449f / 16.0f)); const float ang = (float)pos * inv;
        const float rev = ang * 0.15915494309189535f, fr_ = rev - floorf(rev);
        float* p = cs32 + ((size_t)pos * 4 + (j >> 2)) * 8 + (j & 3);
        p[0] = __builtin_amdgcn_cosf(fr_); p[4] = __builtin_amdgcn_sinf(fr_);
    }
#endif
#if PRO_PARTS & 4
    const int lane = tid & 63, gw = bid * 8 + (tid >> 6), ngw = G * 8;
    bf16_t* xb = (bf16_t*)(a->ws + OFF_XBA); float* ss = (float*)(a->ws + OFF_SSA);
    for (int row = gw; row < M; row += ngw) {
        const f32x4* xr = (const f32x4*)(a->in[0] + (size_t)row * D) + lane; f32x4* orow = (f32x4*)(a->out + (size_t)row * D) + lane;
        float sq = 0.f;
#pragma unroll
        for (int j = 0; j < 4; ++j) {
            const f32x4 v = xr[64 * j]; orow[64 * j] = v; sq += dot4(v);
            u32x2 w; w.x = cvt_pk_bf16(v.x, v.y); w.y = cvt_pk_bf16(v.z, v.w);
            *(u32x2*)(xb + (size_t)row * D + 256 * j + lane * 4) = w;
        }
#pragma unroll
        for (int o = 1; o < 64; o <<= 1) sq += __shfl_xor(sq, o);
        if (lane < 16) ss[(size_t)row * 16 + lane] = lane == 0 ? sq : 0.f;
    }
#endif
}

__device__ __forceinline__ void convert_p(KA a, int layer, int wv) {
    const f32x4* src = (const f32x4*)(a->in[1] + (size_t)layer * M * PLE); u32x2* dst = (u32x2*)(a->ws + OFF_VT);
    const size_t n = (size_t)M * PLE / 4;
    const int tid_ = ltid(wv), bid_ = lbid(), G_ = lgrid();
    for (size_t i = (size_t)bid_ * 512 + tid_; i < n; i += (size_t)G_ * 512) {
        const f32x4 v = src[i]; u32x2 w; w.x = cvt_pk_bf16(v.x, v.y); w.y = cvt_pk_bf16(v.z, v.w); dst[i] = w;
    }
}

__device__ __forceinline__ void final_norm(KA a, int wv) {
    const int tid_ = ltid(wv); const int lane = tid_ & 63, gw = lbid() * 8 + (tid_ >> 6), ngw = lgrid() * 8;
    const float* ss = (const float*)(a->ws + OFF_SSA);
    f32x4 g[4];
#pragma unroll
    for (int j = 0; j < 4; ++j) g[j] = ((const f32x4*)a->in[23])[64 * j + lane];
    for (int row = gw; row < M; row += ngw) {
        const float r = rs16(ss, row);
        f32x4* orow = (f32x4*)(a->out + (size_t)row * D) + lane;
#pragma unroll
        for (int j = 0; j < 4; ++j) orow[64 * j] = orow[64 * j] * r * g[j];
    }
}

struct AttnP { const unsigned char* ws; const float* nab; const float* sink; };

template <int MODE>
__device__ __forceinline__ void attn_unit(const AttnP& P0, int unit, LAS float* xch, const LAS float* nabl, int wv) {
    const unsigned char* ws = P0.ws; asm volatile("" : "+s"(ws));
    constexpr int NS = MODE == 0 ? 6 : 4;
    const int lane = vlane(), w = wv, qs = w >> 2, h = w & 3, ql = lane & 31, hh = lane >> 5;
    const int lane16 = lane * 16;
    const int b = unit >> 5, rem = unit & 31;
    int qt, T0 = 0, rr = 0, qmin, qmax;
    if (MODE == 1) { T0 = 512 * (rem >> 3); rr = 2 * (rem & 7) + qs; qt = T0 + rr + 16 * ql; qmin = T0 + rr; qmax = qmin + 496; }
    else { qmin = 64 * rem + 32 * qs; qt = qmin + ql; qmax = qmin + 31; }
    const size_t tokbase = (size_t)b * T;
    const bf16_t* qrow; int khead, group;
    if (MODE == 0) { qrow = (const bf16_t*)(ws + OFF_QM) + (tokbase + qt) * QLD + 96 * h; khead = 18 + h; group = 3; }
    else if (MODE == 1) { qrow = (const bf16_t*)(ws + OFF_ZQ) + (tokbase + qt) * ZQLD + 512 + 64 * h; khead = 6 + h; group = 2; }
    else if (MODE == 2) { qrow = (const bf16_t*)(ws + OFF_ZQ) + (tokbase + qt) * ZQLD + 64 * h; khead = h; group = 0; }
    else { qrow = (const bf16_t*)(ws + OFF_ZQ) + (tokbase + qt) * ZQLD + 256 + 64 * h; khead = 4 + (h >> 1); group = 1; }
    const unsigned char* kfb = ws + OFF_KF + (size_t)b * 64 * 4096 + lane16;
    const unsigned char* vfb = ws + OFF_VT + (size_t)b * 64 * 4096 + lane16;
    const unsigned char* kpe = ws + OFF_KPE + (size_t)b * 64 * 2048 + lane16;
    bf16x8 qf[NS];
#pragma unroll
    for (int s = 0; s < NS; ++s) qf[s] = *(const bf16x8*)(qrow + 16 * s + 8 * hh);
    const float sc = (MODE == 0 ? 0.10206207261596577f : 0.125f) * LOG2E;
    f32x16 o0, o1;
#pragma unroll
    for (int e = 0; e < 16; ++e) { o0[e] = 0.f; o1[e] = 0.f; }
    float mrun = -1e20f, lrun = 0.f;
    if (MODE == 3) { mrun = P0.sink[h] * LOG2E; lrun = hh == 0 ? 1.f : 0.f; }
    const int qcol = qt & 63;
    const int nseg = MODE == 1 ? 3 : 1;
    for (int seg = 0; seg < nseg; ++seg) {
        int ntile, kb0, kstr, vb0, win, hd = khead;
        if (MODE == 0) { ntile = 64; kb0 = 0; kstr = 1; vb0 = 0; win = 1 << 20; }
        else if (MODE == 2) { ntile = 16; kb0 = 64 * min(max(rem - 4, 0), 24); kstr = 1; vb0 = kb0; win = 0; }
        else if (MODE == 3) { ntile = 9; kb0 = qmin - 128; kstr = 1; vb0 = kb0; win = 128; }
        else {
            if (seg == 0) { ntile = 20; kb0 = T0 - 64; kstr = 1; vb0 = kb0; win = 64; }
            else if (seg == 1) { ntile = 8; const int us = (T0 >> 2) - 64, r4 = rr & 3; kb0 = 4 * us + r4; kstr = 4; vb0 = r4 * 512 + us; win = 256; hd = khead + 4; }
            else { ntile = 5; const int nst = (T0 >> 4) - 64; kb0 = 16 * nst + rr; kstr = 16; vb0 = rr * 128 + nst; win = 1024; hd = khead + 8; }
        }
        const int kstep = 32 * kstr;
        int tlo = 0, thi = ntile;
        if (MODE == 1 || MODE == 3) { tlo = kb0 < 0 ? (-kb0 + kstep - 1) / kstep : 0; thi = min(ntile, (T - kb0 + kstep - 1) / kstep); }
        const unsigned char* kfh = kfb + (size_t)hd * HEADB; const unsigned char* vfh = vfb + (size_t)hd * HEADB;
        bf16x8 kf[NS], vf[4];
        {
            const int pt = (vb0 >> 5) + tlo;
#pragma unroll
            for (int s = 0; s < NS; ++s) kf[s] = (MODE == 0 && s >= 4) ? *(const bf16x8*)(kpe + (size_t)pt * 2048 + (s - 4) * 1024) : *(const bf16x8*)(kfh + (size_t)pt * 4096 + s * 1024);
#pragma unroll
            for (int j = 0; j < 4; ++j) vf[j] = *(const bf16x8*)(vfh + (size_t)pt * 4096 + j * 1024);
        }
        for (int tau = tlo; tau < thi; ++tau) {
            const int kb = kb0 + kstep * tau;
            bf16x8 kn[NS], vn[4];
            {
                const int pt = (vb0 >> 5) + min(tau + 1, thi - 1);
#pragma unroll
                for (int s = 0; s < NS; ++s) kn[s] = (MODE == 0 && s >= 4) ? *(const bf16x8*)(kpe + (size_t)pt * 2048 + (s - 4) * 1024) : *(const bf16x8*)(kfh + (size_t)pt * 4096 + s * 1024);
#pragma unroll
                for (int j = 0; j < 4; ++j) vn[j] = *(const bf16x8*)(vfh + (size_t)pt * 4096 + j * 1024);
            }
            f32x16 sacc;
#pragma unroll
            for (int e = 0; e < 16; ++e) sacc[e] = 0.f;
#pragma unroll
            for (int s = 0; s < NS; ++s) sacc = __builtin_amdgcn_mfma_f32_32x32x16_bf16(kf[s], qf[s], sacc, 0, 0, 0);
            if (MODE == 2) {
                const int c0 = 32 * (tau & 1), wsx = min(max(qcol - 8, 0), 48);
                const int mb = c0 - wsx + 4 * hh;
                const int drow = (kb >> 6) - rem + 7;
                const LAS float* bp = nabl + (h * 15 + drow) * 31 + c0 - qcol + 15 + 4 * hh;
#pragma unroll
                for (int e = 0; e < 16; ++e) {
                    const int o = 8 * (e >> 2) + (e & 3);
                    const float v = sacc[e] * sc + bp[o];
                    sacc[e] = (unsigned)(mb + o) < 16u ? v : -1e30f;
                }
            } else if (MODE != 0) {
                const bool full = (kb + 31 * kstr - qmin <= win) && (qmax - kb <= win);
                if (!full) {
                    const int mb = kb - qt + win + 4 * hh * kstr;
#pragma unroll
                    for (int e = 0; e < 16; ++e) {
                        const int o = (8 * (e >> 2) + (e & 3)) * kstr;
                        sacc[e] = (unsigned)(mb + o) <= (unsigned)(2 * win) ? sacc[e] : -1e30f;
                    }
                }
            }
            float tmax = fmaxf(fmaxf(sacc[0], sacc[1]), fmaxf(sacc[2], sacc[3]));
#pragma unroll
            for (int e = 4; e < 16; e += 4) tmax = fmaxf(tmax, fmaxf(fmaxf(sacc[e], sacc[e + 1]), fmaxf(sacc[e + 2], sacc[e + 3])));
            tmax = fmaxf(tmax, __shfl_xor(tmax, 32));
            if (MODE != 2) tmax *= sc;
            const float mnew = fmaxf(mrun, tmax);
            const bool grow = mnew > mrun;
            const float alpha = __builtin_amdgcn_exp2f(mrun - mnew);
            mrun = mnew;
            float psum = 0.f;
#pragma unroll
            for (int e = 0; e < 16; ++e) {
                const float p = MODE == 2 ? __builtin_amdgcn_exp2f(sacc[e] - mnew) : __builtin_amdgcn_exp2f(__builtin_fmaf(sacc[e], sc, -mnew));
                sacc[e] = p; psum += p;
            }
            lrun = lrun * alpha + psum;
            if (__builtin_amdgcn_ballot_w64(grow) != 0ull) {
#pragma unroll
                for (int e = 0; e < 16; ++e) { o0[e] *= alpha; o1[e] *= alpha; }
            }
            bf16x8 pb[2];
#pragma unroll
            for (int t = 0; t < 2; ++t) {
                u32x4 v; v.x = cvt_pk_bf16(sacc[8 * t + 0], sacc[8 * t + 1]); v.y = cvt_pk_bf16(sacc[8 * t + 2], sacc[8 * t + 3]);
                v.z = cvt_pk_bf16(sacc[8 * t + 4], sacc[8 * t + 5]); v.w = cvt_pk_bf16(sacc[8 * t + 6], sacc[8 * t + 7]);
                pb[t] = __builtin_bit_cast(bf16x8, v);
            }
            o0 = __builtin_amdgcn_mfma_f32_32x32x16_bf16(vf[0], pb[0], o0, 0, 0, 0);
            o0 = __builtin_amdgcn_mfma_f32_32x32x16_bf16(vf[1], pb[1], o0, 0, 0, 0);
            o1 = __builtin_amdgcn_mfma_f32_32x32x16_bf16(vf[2], pb[0], o1, 0, 0, 0);
            o1 = __builtin_amdgcn_mfma_f32_32x32x16_bf16(vf[3], pb[1], o1, 0, 0, 0);
#pragma unroll
            for (int s = 0; s < NS; ++s) kf[s] = kn[s];
#pragma unroll
            for (int j = 0; j < 4; ++j) vf[j] = vn[j];
        }
    }
    lrun += __shfl_xor(lrun, 32);
    const float inv = 1.0f / lrun;
    float sq = 0.f;
#pragma unroll
    for (int e = 0; e < 16; ++e) { o0[e] *= inv; o1[e] *= inv; sq += o0[e] * o0[e] + o1[e] * o1[e]; }
    sq += __shfl_xor(sq, 32);
    if (hh == 0) xch[w * 32 + ql] = sq;
    __syncthreads();
    const float tot = (xch[(qs * 4 + 0) * 32 + ql] + xch[(qs * 4 + 1) * 32 + ql]) + (xch[(qs * 4 + 2) * 32 + ql] + xch[(qs * 4 + 3) * 32 + ql]);
    const float rg = rsqrtf(tot * (1.0f / 256.0f) + EPS);
    bf16_t* yrow = (bf16_t*)(ws + OFF_XBA) + (tokbase + qt) * D + group * 256 + h * 64 + 4 * hh;
#pragma unroll
    for (int j = 0; j < 4; ++j) {
        u32x2 w0; w0.x = cvt_pk_bf16(o0[4 * j] * rg, o0[4 * j + 1] * rg); w0.y = cvt_pk_bf16(o0[4 * j + 2] * rg, o0[4 * j + 3] * rg);
        u32x2 w1; w1.x = cvt_pk_bf16(o1[4 * j] * rg, o1[4 * j + 1] * rg); w1.y = cvt_pk_bf16(o1[4 * j + 2] * rg, o1[4 * j + 3] * rg);
        *(u32x2*)(yrow + 8 * j) = w0; *(u32x2*)(yrow + 32 + 8 * j) = w1;
    }
}

__device__ __forceinline__ void sm_pv(f32x16& sacc, f32x16& o0, f32x16& o1, float& mrun, float& lrun, const bf16x8 (&vf)[4], float sc) {
    float tmax = fmaxf(fmaxf(sacc[0], sacc[1]), fmaxf(sacc[2], sacc[3]));
#pragma unroll
    for (int e = 4; e < 16; e += 4) tmax = fmaxf(tmax, fmaxf(fmaxf(sacc[e], sacc[e + 1]), fmaxf(sacc[e + 2], sacc[e + 3])));
    tmax = fmaxf(tmax, __shfl_xor(tmax, 32)) * sc;
    const float mnew = fmaxf(mrun, tmax);
    const bool grow = mnew > mrun;
    const float alpha = __builtin_amdgcn_exp2f(mrun - mnew);
    mrun = mnew;
    float psum = 0.f;
#pragma unroll
    for (int e = 0; e < 16; ++e) { const float p = __builtin_amdgcn_exp2f(__builtin_fmaf(sacc[e], sc, -mnew)); sacc[e] = p; psum += p; }
    lrun = lrun * alpha + psum;
    if (__builtin_amdgcn_ballot_w64(grow) != 0ull) {
#pragma unroll
        for (int e = 0; e < 16; ++e) { o0[e] *= alpha; o1[e] *= alpha; }
    }
    bf16x8 pb[2];
#pragma unroll
    for (int t = 0; t < 2; ++t) {
        u32x4 v; v.x = cvt_pk_bf16(sacc[8 * t + 0], sacc[8 * t + 1]); v.y = cvt_pk_bf16(sacc[8 * t + 2], sacc[8 * t + 3]);
        v.z = cvt_pk_bf16(sacc[8 * t + 4], sacc[8 * t + 5]); v.w = cvt_pk_bf16(sacc[8 * t + 6], sacc[8 * t + 7]);
        pb[t] = __builtin_bit_cast(bf16x8, v);
    }
    o0 = __builtin_amdgcn_mfma_f32_32x32x16_bf16(vf[0], pb[0], o0, 0, 0, 0);
    o0 = __builtin_amdgcn_mfma_f32_32x32x16_bf16(vf[1], pb[1], o0, 0, 0, 0);
    o1 = __builtin_amdgcn_mfma_f32_32x32x16_bf16(vf[2], pb[0], o1, 0, 0, 0);
    o1 = __builtin_amdgcn_mfma_f32_32x32x16_bf16(vf[3], pb[1], o1, 0, 0, 0);
}
__device__ __forceinline__ void attn_mla(const AttnP& P0, int unit, LAS float* xch, int wv) {
    const unsigned char* ws = P0.ws; asm volatile("" : "+s"(ws));
    const int lane = vlane(), w = wv, qs = w >> 2, h = w & 3, ql = lane & 31, hh = lane >> 5;
    const int lane16 = lane * 16;
    const int b = unit >> 4, q0 = 128 * (unit & 15) + 64 * qs;
    const size_t tokbase = (size_t)b * T;
    const bf16_t* qrA = (const bf16_t*)(ws + OFF_QM) + (tokbase + q0 + ql) * QLD + 96 * h;
    const bf16_t* qrB = qrA + 32 * QLD;
    const unsigned char* kfh = ws + OFF_KF + (size_t)(18 + h) * HEADB + (size_t)b * 64 * 4096 + lane16;
    const unsigned char* vfh = ws + OFF_VT + (size_t)(18 + h) * HEADB + (size_t)b * 64 * 4096 + lane16;
    const unsigned char* kpe = ws + OFF_KPE + (size_t)b * 64 * 2048 + lane16;
    bf16x8 qA[6], qB[6];
#pragma unroll
    for (int s = 0; s < 6; ++s) { qA[s] = *(const bf16x8*)(qrA + 16 * s + 8 * hh); qB[s] = *(const bf16x8*)(qrB + 16 * s + 8 * hh); }
    const float sc = 0.10206207261596577f * LOG2E;
    f32x16 oA0, oA1, oB0, oB1;
#pragma unroll
    for (int e = 0; e < 16; ++e) { oA0[e] = 0.f; oA1[e] = 0.f; oB0[e] = 0.f; oB1[e] = 0.f; }
    float mA = -1e20f, lA = 0.f, mB = -1e20f, lB = 0.f;
    bf16x8 kf[6], vf[4];
#pragma unroll
    for (int s = 0; s < 6; ++s) kf[s] = s >= 4 ? *(const bf16x8*)(kpe + (s - 4) * 1024) : *(const bf16x8*)(kfh + s * 1024);
#pragma unroll
    for (int j = 0; j < 4; ++j) vf[j] = *(const bf16x8*)(vfh + j * 1024);
    for (int tau = 0; tau < 64; ++tau) {
        bf16x8 kn[6], vn[4];
        const int pt = min(tau + 1, 63);
#pragma unroll
        for (int s = 0; s < 6; ++s) kn[s] = s >= 4 ? *(const bf16x8*)(kpe + (size_t)pt * 2048 + (s - 4) * 1024) : *(const bf16x8*)(kfh + (size_t)pt * 4096 + s * 1024);
#pragma unroll
        for (int j = 0; j < 4; ++j) vn[j] = *(const bf16x8*)(vfh + (size_t)pt * 4096 + j * 1024);
        f32x16 sa, sb;
#pragma unroll
        for (int e = 0; e < 16; ++e) { sa[e] = 0.f; sb[e] = 0.f; }
#pragma unroll
        for (int s = 0; s < 6; ++s) { sa = __builtin_amdgcn_mfma_f32_32x32x16_bf16(kf[s], qA[s], sa, 0, 0, 0); sb = __builtin_amdgcn_mfma_f32_32x32x16_bf16(kf[s], qB[s], sb, 0, 0, 0); }
        sm_pv(sa, oA0, oA1, mA, lA, vf, sc);
        sm_pv(sb, oB0, oB1, mB, lB, vf, sc);
#pragma unroll
        for (int s = 0; s < 6; ++s) kf[s] = kn[s];
#pragma unroll
        for (int j = 0; j < 4; ++j) vf[j] = vn[j];
    }
    lA += __shfl_xor(lA, 32); lB += __shfl_xor(lB, 32);
    const float iA = 1.0f / lA, iB = 1.0f / lB;
    float sqA = 0.f, sqB = 0.f;
#pragma unroll
    for (int e = 0; e < 16; ++e) { oA0[e] *= iA; oA1[e] *= iA; oB0[e] *= iB; oB1[e] *= iB; sqA += oA0[e] * oA0[e] + oA1[e] * oA1[e]; sqB += oB0[e] * oB0[e] + oB1[e] * oB1[e]; }
    sqA += __shfl_xor(sqA, 32); sqB += __shfl_xor(sqB, 32);
    if (hh == 0) { xch[w * 64 + ql] = sqA; xch[w * 64 + 32 + ql] = sqB; }
    __syncthreads();
    const LAS float* xq = xch + qs * 256 + ql;
    const float rA = rsqrtf(((xq[0] + xq[64]) + (xq[128] + xq[192])) * (1.0f / 256.0f) + EPS);
    const float rB = rsqrtf(((xq[32] + xq[96]) + (xq[160] + xq[224])) * (1.0f / 256.0f) + EPS);
    bf16_t* yA = (bf16_t*)(ws + OFF_XBA) + (tokbase + q0 + ql) * D + 3 * 256 + h * 64 + 4 * hh;
    bf16_t* yB = yA + 32 * D;
#pragma unroll
    for (int j = 0; j < 4; ++j) {
        u32x2 w0; w0.x = cvt_pk_bf16(oA0[4 * j] * rA, oA0[4 * j + 1] * rA); w0.y = cvt_pk_bf16(oA0[4 * j + 2] * rA, oA0[4 * j + 3] * rA);
        u32x2 w1; w1.x = cvt_pk_bf16(oA1[4 * j] * rA, oA1[4 * j + 1] * rA); w1.y = cvt_pk_bf16(oA1[4 * j + 2] * rA, oA1[4 * j + 3] * rA);
        *(u32x2*)(yA + 8 * j) = w0; *(u32x2*)(yA + 32 + 8 * j) = w1;
        u32x2 w2; w2.x = cvt_pk_bf16(oB0[4 * j] * rB, oB0[4 * j + 1] * rB); w2.y = cvt_pk_bf16(oB0[4 * j + 2] * rB, oB0[4 * j + 3] * rB);
        u32x2 w3; w3.x = cvt_pk_bf16(oB1[4 * j] * rB, oB1[4 * j + 1] * rB); w3.y = cvt_pk_bf16(oB1[4 * j + 2] * rB, oB1[4 * j + 3] * rB);
        *(u32x2*)(yB + 8 * j) = w2; *(u32x2*)(yB + 32 + 8 * j) = w3;
    }
}

__device__ __forceinline__ void attn_phase(KA a, int layer, LAS unsigned char* lds, int wv) {
    AttnP P; P.ws = a->ws; P.nab = a->in[8] + (size_t)layer * 4 * 15 * 31; P.sink = a->in[9] + layer * 4;
    LAS float* xch = (LAS float*)lds;
    for (int i = ltid(wv); i < 4 * 15 * 31; i += 512) xch[1024 + i] = P.nab[i] * LOG2E;
    __syncthreads();
    int it = 0;
    const int G_ = lgrid(), bid_ = lbid();
    const int vcu = (G_ & 7) == 0 ? (bid_ & 7) * (G_ >> 3) + (bid_ >> 3) : bid_;
    for (int u = vcu; u < 256 + 3 * 512; u += G_, ++it) {
        LAS float* x = xch + (it & 1) * 512;
        if (u < 256) attn_mla(P, u, x, wv);
        else {
            const int mode = 1 + ((u - 256) >> 9), unit = (u - 256) & 511;
            if (mode == 1) attn_unit<1>(P, unit, x, xch + 1024, wv);
            else if (mode == 2) attn_unit<2>(P, unit, x, xch + 1024, wv);
            else attn_unit<3>(P, unit, x, xch + 1024, wv);
        }
    }
    __syncthreads();
}

__device__ __forceinline__ void grid_bar(unsigned* bar, unsigned seq, int wv) {
    asm volatile("s_waitcnt vmcnt(0) lgkmcnt(0)" ::: "memory");
    __builtin_amdgcn_s_barrier();
    if (wv == 0) {
        if (vlane() == 0) {
            const unsigned G = (unsigned)lgrid(), b = (unsigned)lbid(), g = b & 7u;
            const unsigned ng = (G - g + 7u) >> 3, ngroups = G < 8u ? G : 8u;
            unsigned* flag = bar + 64 * 9;
            __builtin_amdgcn_fence(__ATOMIC_RELEASE, "agent");
            asm volatile("s_waitcnt vmcnt(0)" ::: "memory");
            const unsigned old = __hip_atomic_fetch_add(bar + 64 * g, 1u, __ATOMIC_RELAXED, __HIP_MEMORY_SCOPE_AGENT);
            bool waitf = true;
            if (old + 1u == seq * ng) {
                __builtin_amdgcn_fence(__ATOMIC_SEQ_CST, "agent");
                const unsigned old2 = __hip_atomic_fetch_add(bar + 64 * 8, 1u, __ATOMIC_RELAXED, __HIP_MEMORY_SCOPE_AGENT);
                if (old2 + 1u == seq * ngroups) { __builtin_amdgcn_fence(__ATOMIC_SEQ_CST, "agent"); __hip_atomic_store(flag, seq, __ATOMIC_RELAXED, __HIP_MEMORY_SCOPE_AGENT); waitf = false; }
            }
            if (waitf) { unsigned spins = 0; while (__hip_atomic_load(flag, __ATOMIC_RELAXED, __HIP_MEMORY_SCOPE_AGENT) < seq) { __builtin_amdgcn_s_sleep(1); if (++spins > (1u << 26)) break; } }
            __builtin_amdgcn_fence(__ATOMIC_ACQUIRE, "agent");
            asm volatile("s_waitcnt vmcnt(0)" ::: "memory");
        }
    }
    __builtin_amdgcn_s_barrier();
    asm volatile("" ::: "memory");
}

template <int PH, bool ZERO = false>
__device__ __forceinline__ void run_phase(LAS unsigned char* lds, int wv) {
    KA a = kargs();
    unsigned char* ws = a->ws; asm volatile("" : "+s"(ws));
    bf16_t* Wbase = (bf16_t*)(ws + OFF_W);
    bf16_t* xbA = (bf16_t*)(ws + OFF_XBA); bf16_t* xbB = (bf16_t*)(ws + OFF_XBB);
    bf16_t* Hb = (bf16_t*)(ws + OFF_H); bf16_t* zl = (bf16_t*)(ws + OFF_ZL); bf16_t* qm = (bf16_t*)(ws + OFF_QM);
    unsigned char* vf = ws + OFF_VT;
    bf16_t* pb = (bf16_t*)(ws + OFF_VT);
    float* ssA = (float*)(ws + OFF_SSA); float* ssB = (float*)(ws + OFF_SSB); float* mst = (float*)(ws + OFF_MST);
    const float* cs64 = (const float*)(ws + OFF_CS64); const float* cs32 = (const float*)(ws + OFF_CS32);
    if constexpr (PH == 0) { if (PH_ON(0)) prologue(a, lds, wv); }
    else if constexpr (PH == NPH - 1) { if (PH_ON(1)) final_norm(a, wv); }
    else {
        constexpr int l = (PH - 1) / 9, k = (PH - 1) % 9;
        bf16_t* WL = Wbase + (size_t)l * WL_SIZE;
        if constexpr (k == 0) { if (PH_ON(2)) { EpiGU E{ssA, Hb}; run_gemm(wv, lds, xbA, D, M, WL + WL_GU1, D, 5632, D, 0, E); } }
        else if constexpr (k == 1) { if (PH_ON(3)) { EpiRes E{a->out, xbB, ssB, ZERO ? 0.f : 0.5f}; run_gemm(wv, lds, Hb, FF, M, WL + WL_D1, FF, D, FF, 0, E); } }
        else if constexpr (k == 2) {
            if (PH_ON(4)) { EpiIn E{ssB, ws, mst, cs64, cs32}; run_gemm(wv, lds, xbB, D, M, WL + WL_IN, D, 2048, D, 0, E); }
            if (PH_ON(5)) { EpiVT E{ssB, vf}; run_gemm(wv, lds, WL + WL_IN + (size_t)2048 * D, D, 768, xbB, D, M, D, 0, E); }
        }
        else if constexpr (k == 3) {
            if (PH_ON(6)) { EpiQ E{mst, qm, cs32}; run_gemm(wv, lds, zl, ZLLD, M, WL + WL_UQ, 256, 512, 256, 0, E); }
            if (PH_ON(7)) { EpiK E{mst, ws}; run_gemm(wv, lds, zl + 256, ZLLD, M, WL + WL_UKV, 128, 256, 128, 0, E); }
            if (PH_ON(8)) { EpiVTM E{mst, vf}; run_gemm(wv, lds, WL + WL_UKV + (size_t)256 * 128, 128, 256, zl + 256, ZLLD, M, 128, 128, E); }
        }
        else if constexpr (k == 4) { if (PH_ON(9)) attn_phase(a, l, lds, wv); }
        else if constexpr (k == 5) { if (PH_ON(3)) { EpiRes E{a->out, xbB, ssB, ZERO ? 0.f : 1.0f}; run_gemm(wv, lds, xbA, D, M, WL + WL_O, D, D, D, 0, E); } }
        else if constexpr (k == 6) { if (PH_ON(2)) { convert_p(a, l, wv); EpiGU E{ssB, Hb}; run_gemm(wv, lds, xbB, D, M, WL + WL_GU2, D, 5632, D, 0, E); } }
        else if constexpr (k == 7) {
            if (PH_ON(3)) { EpiRes E{a->out, xbB, ssB, ZERO ? 0.f : 0.5f}; run_gemm(wv, lds, Hb, FF, M, WL + WL_D2, FF, D, FF, 0, E); }
            if (PH_ON(10)) { EpiPP E{xbA}; run_gemm(wv, lds, pb, PLE, M, WL + WL_PP, PLE, D, PLE, 0, E); }
        }
        else { if (PH_ON(11)) { EpiGate E{a->out, ssB, xbA, ssA, ZERO ? 0.f : 1.0f}; run_gemm(wv, lds, xbB, D, M, WL + WL_PG, D, D, D, 0, E); } }
    }
}
template <int PH>
__device__ __forceinline__ void run_from(LAS unsigned char* lds, int ph_lo, int ph_hi, int wv) {
    if constexpr (PH < NPH) {
        if (PH >= ph_lo && PH < ph_hi) {
            run_phase<PH>(lds, wv);
            if constexpr (PH > 0 && PH < NPH - 1) { if constexpr ((DUPM >> ((PH - 1) % 9)) & 1) { __syncthreads(); run_phase<PH, true>(lds, wv); } }
            if constexpr (PH == 0 && ((DUPM >> 9) & 1)) { __syncthreads(); run_phase<PH>(lds, wv); }
            if (PH + 1 < ph_hi && kargs()->coop) {
                if constexpr (PH == 0) cg::this_grid().sync();
                else { for (int r_ = 0; r_ < BARREP; ++r_) grid_bar((unsigned*)(kargs()->ws + OFF_BAR), (unsigned)((PH - 1) * BARREP + r_ + 1), wv); }
            }
        }
        run_from<PH + 1>(lds, ph_lo, ph_hi, wv);
    }
}
__global__ void __launch_bounds__(512, 2) mega(Args a_unused) {
    extern __shared__ __attribute__((aligned(16))) unsigned char lds_raw[];
    LAS unsigned char* lds = (LAS unsigned char*)lds_raw;
    const int ph_lo = kargs()->ph_lo, ph_hi = kargs()->ph_hi;
    const int wv = __builtin_amdgcn_readfirstlane((int)threadIdx.x >> 6);
    run_from<0>(lds, ph_lo, ph_hi, wv);
}

extern "C" void kernel_launch(void* const* d_in, const int* in_sizes, int n_in, void* d_out, int out_size, void* d_ws, size_t ws_size, hipStream_t stream) {
    static int grid = 0;
    if (grid == 0) {
        if (n_in != 24 || ws_size < WS_END) { fprintf(stderr, "kernel_launch: n_in %d ws %zu (need %zu)\n", n_in, ws_size, (size_t)WS_END); grid = -1; return; }
        int dev = 0, cus = 0, per_cu = 0;
        hipGetDevice(&dev); hipDeviceGetAttribute(&cus, hipDeviceAttributeMultiprocessorCount, dev);
        if (hipFuncSetAttribute((const void*)mega, hipFuncAttributeMaxDynamicSharedMemorySize, LDS_BYTES) != hipSuccess) { fprintf(stderr, "hipFuncSetAttribute failed\n"); grid = -1; return; }
        if (hipOccupancyMaxActiveBlocksPerMultiprocessor(&per_cu, (const void*)mega, 512, LDS_BYTES) != hipSuccess || per_cu < 1) per_cu = 1;
        (void)hipGetLastError();
        grid = cus * per_cu;
    }
    if (grid < 0) return;
    (void)hipMemsetAsync((char*)d_ws + OFF_BAR, 0, 4096, stream);
    Args a{};
    for (int i = 0; i < 24; ++i) a.in[i] = (const float*)d_in[i];
    a.out = (float*)d_out; a.ws = (unsigned char*)d_ws;
#if MULTI_LAUNCH
    for (int ph = 0; ph < NPH; ++ph) {
        a.ph_lo = ph; a.ph_hi = ph + 1; a.coop = 0;
        hipLaunchKernelGGL(mega, dim3(grid), dim3(512), LDS_BYTES, stream, a);
    }
#else
    a.ph_lo = 0; a.ph_hi = NPH; a.coop = 1;
    void* args[] = {&a};
    hipError_t e = hipLaunchCooperativeKernel((void*)mega, dim3(grid), dim3(512), args, LDS_BYTES, stream);
    if (e != hipSuccess) fprintf(stderr, "cooperative launch failed: %s (grid %d)\n", hipGetErrorString(e), grid);
#endif
}
```

```cpp
#include <hip/hip_runtime.h>
#include <hip/hip_cooperative_groups.h>
#include <cstdio>
#include <cstdint>
namespace cg = cooperative_groups;

#ifndef MULTI_LAUNCH
#define MULTI_LAUNCH 0
#endif

#ifndef BARREP
#define BARREP 1
#endif
#ifndef DUPM
#define DUPM 0
#endif
#ifndef PRO_PARTS
#define PRO_PARTS 7
#endif
#ifndef PHM
#define PHM 0xffff
#endif
#define PH_ON(b) (((PHM) >> (b)) & 1)
#define LAS __attribute__((address_space(3)))
typedef unsigned short bf16_t;
typedef short bf16x8 __attribute__((ext_vector_type(8)));
typedef float f32x4 __attribute__((ext_vector_type(4)));
typedef float f32x16 __attribute__((ext_vector_type(16)));
typedef unsigned u32x4 __attribute__((ext_vector_type(4)));
typedef unsigned u32x2 __attribute__((ext_vector_type(2)));

constexpr int M = 32768, T = 2048, D = 1024, FF = 2816, DEPTH = 4, PLE = 256;
constexpr int ZQLD = 768, ZLLD = 384, QLD = 384;
constexpr size_t HEADB = (size_t)16 * 64 * 4096;
constexpr float EPS = 1e-6f;
constexpr float LOG2E = 1.4426950408889634f;

constexpr size_t WL_GU1 = 0, WL_D1 = WL_GU1 + (size_t)5632 * 1024, WL_IN = WL_D1 + (size_t)1024 * 2816, WL_UQ = WL_IN + (size_t)2816 * 1024,
                 WL_UKV = WL_UQ + (size_t)512 * 256, WL_O = WL_UKV + (size_t)512 * 128, WL_GU2 = WL_O + (size_t)1024 * 1024, WL_D2 = WL_GU2 + (size_t)5632 * 1024,
                 WL_PG = WL_D2 + (size_t)1024 * 2816, WL_PP = WL_PG + (size_t)1024 * 1024, WL_SIZE = WL_PP + (size_t)1024 * 256;
constexpr size_t OFF_W = 0;
constexpr size_t OFF_XBA = OFF_W + WL_SIZE * 2 * DEPTH;
constexpr size_t OFF_XBB = OFF_XBA + (size_t)M * D * 2;
constexpr size_t OFF_H = OFF_XBB + (size_t)M * D * 2;
constexpr size_t OFF_ZQ = OFF_H;
constexpr size_t OFF_ZL = OFF_ZQ + (size_t)M * ZQLD * 2;
constexpr size_t OFF_KF = OFF_ZL + (size_t)M * ZLLD * 2;
constexpr size_t OFF_KPE = OFF_KF + 22 * HEADB;
constexpr size_t OFF_VT = OFF_H + (size_t)M * FF * 2;
constexpr size_t OFF_SSA = OFF_VT + 22 * HEADB;
constexpr size_t OFF_SSB = OFF_SSA + (size_t)M * 16 * 4;
constexpr size_t OFF_MST = OFF_SSB + (size_t)M * 16 * 4;
constexpr size_t OFF_CS64 = OFF_MST + (size_t)M * 8 * 4;
constexpr size_t OFF_CS32 = OFF_CS64 + (size_t)T * 64 * 4;
constexpr size_t OFF_BAR = OFF_CS32 + (size_t)T * 32 * 4;
constexpr size_t OFF_QM = OFF_BAR + 4096;
constexpr size_t WS_END = OFF_QM + (size_t)M * QLD * 2;
static_assert(OFF_KPE + (size_t)16 * 64 * 2048 <= OFF_VT, "zq|zl|KF|KPE inside the H region");
static_assert(WS_END <= 626121856, "workspace budget");

constexpr int LDS_BYTES = 147456;
constexpr int NPH = 2 + 9 * DEPTH;

__device__ __forceinline__ unsigned cvt_pk_bf16(float lo, float hi) { unsigned r; asm("v_cvt_pk_bf16_f32 %0, %1, %2" : "=v"(r) : "v"(lo), "v"(hi)); return r; }
__device__ __forceinline__ float bf_lo(unsigned u) { return __uint_as_float(u << 16); }
__device__ __forceinline__ float bf_hi(unsigned u) { return __uint_as_float(u & 0xffff0000u); }
__device__ __forceinline__ float sum4(f32x4 a) { return (a.x + a.y) + (a.z + a.w); }
__device__ __forceinline__ float dot4(f32x4 a) { return (a.x * a.x + a.y * a.y) + (a.z * a.z + a.w * a.w); }
__device__ __forceinline__ float rs16(const float* ss, int row) {
    const f32x4* p = (const f32x4*)(ss + (size_t)row * 16);
    const f32x4 a = p[0], b = p[1], c = p[2], d = p[3];
    return rsqrtf(((sum4(a) + sum4(b)) + (sum4(c) + sum4(d))) * (1.0f / 1024.0f) + EPS);
}
__device__ __forceinline__ int vlane() { int l; asm volatile("v_mbcnt_lo_u32_b32 %0, -1, 0\n\tv_mbcnt_hi_u32_b32 %0, -1, %0" : "=v"(l)); return l; }
__device__ __forceinline__ int ltid(int wv) { return (wv << 6) | vlane(); }
__device__ __forceinline__ int lbid() { int b = blockIdx.x; asm volatile("" : "+s"(b)); return b; }
__device__ __forceinline__ int lgrid() { int g = gridDim.x; asm volatile("" : "+s"(g)); return g; }
__device__ __forceinline__ float sigmoidf_(float v) { return __builtin_amdgcn_rcpf(1.0f + __expf(-v)); }

namespace pg8 {
constexpr int BM = 256, BK = 64, HALF = 128, HTB = HALF * BK * 2, STAGE_BYTES = 8 * HTB, NXCD = 8, WGM = 8;
__host__ __device__ __forceinline__ int lds_byte(int r, int c) { const int st = (r >> 4) * 2 + (c >> 5), rr = r & 15, cc = c & 31, ob = rr * 64 + cc * 2; return st * 1024 + (ob ^ (((ob >> 9) & 1) << 5)); }
__host__ __device__ __forceinline__ void stage_rc(int b, int& R, int& C) { const int st = b / 1024, sb = b % 1024, swz = sb ^ (((sb >> 9) & 1) << 5); R = (st >> 1) * 16 + swz / 64; C = (st & 1) * 32 + (swz % 64) / 2; }
__host__ __device__ __forceinline__ int perm32(int rho) { const int n = rho >> 4, i = rho & 15; return 8 * (i >> 2) + 4 * n + (i & 3); }

struct Unit { int pm, pn; };
struct Gemm { const bf16_t* A; const bf16_t* Bt; int lda, ldb, K; };

struct StaticOrder {
    int nM, nN, nwg, G, c;
    __device__ void init(int Mr, int Nc, int G_, int c_) { nM = Mr / BM; nN = Nc / BM; nwg = nM * nN; G = G_; c = c_; }
    __device__ bool next(int i, Unit& u) const {
        const long L = (long)i * G + c; if (L >= nwg) return false;
        int wgid = (int)L; { const int q = nwg / NXCD, r = nwg % NXCD, xcd = wgid % NXCD, off = wgid / NXCD; wgid = (xcd < r ? xcd * (q + 1) : r * (q + 1) + (xcd - r) * q) + off; }
        const int nig = WGM * nN, gid = wgid / nig, fm = gid * WGM, gsz = (nM - fm) < WGM ? (nM - fm) : WGM;
        u.pm = fm + ((wgid % nig) % gsz); u.pn = (wgid % nig) / gsz; return true;
    }
};

template <class Epi>
__device__ __forceinline__ void gemm_phase(LAS unsigned char* lds, const Gemm g, const StaticOrder& S, const Epi& E, int wv) {
    const int tid = ltid(wv);
    const int wid = wv, lane = tid & 63, wr = wid >> 2, wc = wid & 3, fr = lane & 15, fq = lane >> 4;
    const int K = g.K, nt = K / BK;
    unsigned voffA[2], voffB[2];
#pragma unroll
    for (int i = 0; i < 2; ++i) { int R, C; stage_rc(tid * 16 + i * 8192, R, C); const int Rb = (R & ~31) + perm32(R & 31);
        voffA[i] = (unsigned)(R * g.lda + C) * 2u; voffB[i] = (unsigned)(Rb * g.ldb + C) * 2u; }
    const size_t kstep = (size_t)(BK * 2);
    const size_t hstepA = (size_t)HALF * g.lda * 2, hstepB = (size_t)HALF * g.ldb * 2;
    const size_t tstepA = 2 * hstepA, tstepB = 2 * hstepB;
    const unsigned ldsw = (unsigned)wid * 1024u;
    const int aoff = lds_byte(wr * 64 + fr, fq * 8), boff = lds_byte(wc * 32 + fr, fq * 8);
#define PG8_SA(b, h) (((b) * 2 + (h)) * HTB)
#define PG8_SB(b, h) ((4 + (b) * 2 + (h)) * HTB)
#define PG8_STAGE(bufoff, gbase, voff) do { _Pragma("unroll") for (int _i = 0; _i < 2; ++_i) \
        __builtin_amdgcn_global_load_lds((const unsigned*)((const char*)(gbase) + (voff)[_i]), (LAS unsigned*)(lds + (bufoff) + ldsw + _i * 8192), 16, 0, 0); } while (0)
#define PG8_LDA(dst, b, h) do { _Pragma("unroll") for (int m = 0; m < 4; ++m) _Pragma("unroll") for (int k = 0; k < 2; ++k) dst[m][k] = *(const LAS bf16x8*)(lds + PG8_SA(b, h) + aoff + m * 2048 + k * 1024); } while (0)
#define PG8_LDB(dst, b, h) do { _Pragma("unroll") for (int n = 0; n < 2; ++n) _Pragma("unroll") for (int k = 0; k < 2; ++k) dst[n][k] = *(const LAS bf16x8*)(lds + PG8_SB(b, h) + boff + n * 2048 + k * 1024); } while (0)
#define PG8_MMA(ai, bj, At, Bt) do { __builtin_amdgcn_s_setprio(1); _Pragma("unroll") for (int m = 0; m < 4; ++m) _Pragma("unroll") for (int n = 0; n < 2; ++n) _Pragma("unroll") for (int k = 0; k < 2; ++k) \
        acc[ai][bj][m][n] = __builtin_amdgcn_mfma_f32_16x16x32_bf16(Bt[n][k], At[m][k], acc[ai][bj][m][n], 0, 0, 0); __builtin_amdgcn_s_setprio(0); } while (0)
#define PG8_WAIT_V(n) asm volatile("s_waitcnt vmcnt(" #n ")" ::: "memory")
#define PG8_WAIT_L(n) asm volatile("s_waitcnt lgkmcnt(" #n ")" ::: "memory")
#define PG8_BAR __builtin_amdgcn_s_barrier()
#define PG8_SCHED __builtin_amdgcn_sched_barrier(0)
    Unit cur, nxt; int ui = 0;
    if (!S.next(0, cur)) return;
    f32x4 acc[2][2][4][2];
#pragma unroll
    for (int a = 0; a < 2; ++a)
#pragma unroll
        for (int b = 0; b < 2; ++b)
#pragma unroll
            for (int m = 0; m < 4; ++m)
#pragma unroll
                for (int n = 0; n < 2; ++n) acc[a][b][m][n] = (f32x4){0.f, 0.f, 0.f, 0.f};
    bf16x8 At[4][2], B0[2][2], B1[2][2];
    const char* cA = (const char*)g.A + (size_t)cur.pm * tstepA; const char* cB = (const char*)g.Bt + (size_t)cur.pn * tstepB;
    PG8_STAGE(PG8_SB(0, 0), cB, voffB); PG8_STAGE(PG8_SB(0, 1), cB + hstepB, voffB); PG8_STAGE(PG8_SA(0, 0), cA, voffA); PG8_STAGE(PG8_SA(0, 1), cA + hstepA, voffA);
    if (wr == 1) PG8_BAR;
    PG8_WAIT_V(2); PG8_BAR;
    PG8_STAGE(PG8_SB(1, 0), cB + kstep, voffB); PG8_STAGE(PG8_SA(1, 0), cA + kstep, voffA); PG8_STAGE(PG8_SB(1, 1), cB + hstepB + kstep, voffB);
    PG8_WAIT_V(6); PG8_BAR;
    for (;;) {
        const bool has_next = S.next(ui + 1, nxt);
        const char* nA = has_next ? (const char*)g.A + (size_t)nxt.pm * tstepA : cA; const char* nB = has_next ? (const char*)g.Bt + (size_t)nxt.pn * tstepB : cB;
        for (int t = 0; t < nt; t += 2) {
            const bool last = (t == nt - 2);
            const char* a1 = cA + (size_t)(t + 1) * kstep;
            const char* a2 = last ? nA : cA + (size_t)(t + 2) * kstep; const char* b2 = last ? nB : cB + (size_t)(t + 2) * kstep;
            const char* a3 = a2 + kstep; const char* b3 = b2 + kstep;
            PG8_LDB(B0, 0, 0); PG8_LDB(B1, 0, 1); PG8_SCHED; PG8_LDA(At, 0, 0); PG8_STAGE(PG8_SA(1, 1), a1 + hstepA, voffA);
            PG8_WAIT_V(8); PG8_WAIT_L(0); PG8_BAR; PG8_MMA(0, 0, At, B0); PG8_MMA(0, 1, At, B1); PG8_BAR; PG8_SCHED;
            PG8_LDA(At, 0, 1); PG8_STAGE(PG8_SB(0, 0), b2, voffB); PG8_STAGE(PG8_SB(0, 1), b2 + hstepB, voffB); PG8_STAGE(PG8_SA(0, 0), a2, voffA);
            PG8_WAIT_V(8); PG8_WAIT_L(0); PG8_BAR; PG8_MMA(1, 0, At, B0); PG8_MMA(1, 1, At, B1); PG8_BAR; PG8_SCHED;
            PG8_LDB(B0, 1, 0); PG8_LDB(B1, 1, 1); PG8_SCHED; PG8_LDA(At, 1, 0); PG8_STAGE(PG8_SA(0, 1), a2 + hstepA, voffA);
            PG8_WAIT_V(8); PG8_WAIT_L(0); PG8_BAR; PG8_MMA(0, 0, At, B0); PG8_MMA(0, 1, At, B1); PG8_BAR; PG8_SCHED;
            PG8_LDA(At, 1, 1); PG8_STAGE(PG8_SB(1, 0), b3, voffB); PG8_STAGE(PG8_SB(1, 1), b3 + hstepB, voffB); PG8_STAGE(PG8_SA(1, 0), a3, voffA);
            PG8_WAIT_V(8); PG8_WAIT_L(0); PG8_BAR; PG8_MMA(1, 0, At, B0); PG8_MMA(1, 1, At, B1); PG8_BAR; PG8_SCHED;
        }
        if (wr == 0) PG8_BAR;
        E(acc, cur, wr, wc, fr, fq);
        if (!has_next) break;
#pragma unroll
        for (int a = 0; a < 2; ++a)
#pragma unroll
            for (int b = 0; b < 2; ++b)
#pragma unroll
                for (int m = 0; m < 4; ++m)
#pragma unroll
                    for (int n = 0; n < 2; ++n) acc[a][b][m][n] = (f32x4){0.f, 0.f, 0.f, 0.f};
        cur = nxt; cA = nA; cB = nB; ++ui;
        if (wr == 1) PG8_BAR;
    }
    PG8_WAIT_V(0);
    PG8_BAR;
#undef PG8_SA
#undef PG8_SB
#undef PG8_STAGE
#undef PG8_LDA
#undef PG8_LDB
#undef PG8_MMA
#undef PG8_WAIT_V
#undef PG8_WAIT_L
#undef PG8_BAR
#undef PG8_SCHED
}
}
using pg8::Unit;
typedef const f32x4 (&AccRef)[2][2][4][2];

struct EpiGU {
    const float* ss; bf16_t* H;
    __device__ __forceinline__ void operator()(AccRef acc, const Unit& u, int wr, int wc, int, int) const { const int lane_ = vlane(); const int fr = lane_ & 15, fq = lane_ >> 4;
#pragma unroll
        for (int ai = 0; ai < 2; ++ai)
#pragma unroll
            for (int m = 0; m < 4; ++m) {
                const int row = u.pm * 256 + ai * 128 + wr * 64 + m * 16 + fr;
                asm volatile("" ::: "memory");
                const float r = rs16(ss, row);
#pragma unroll
                for (int bj = 0; bj < 2; ++bj) {
                    const f32x4 g = acc[ai][bj][m][0] * r, v = acc[ai][bj][m][1] * r;
                    const float h0 = g.x * sigmoidf_(g.x) * v.x, h1 = g.y * sigmoidf_(g.y) * v.y, h2 = g.z * sigmoidf_(g.z) * v.z, h3 = g.w * sigmoidf_(g.w) * v.w;
                    u32x2 w; w.x = cvt_pk_bf16(h0, h1); w.y = cvt_pk_bf16(h2, h3);
                    *(u32x2*)(H + (size_t)row * FF + u.pn * 128 + bj * 64 + wc * 16 + fq * 4) = w;
                }
            }
    }
};
struct EpiRes {
    float* X; bf16_t* xb; float* ssOut; float alpha;
    __device__ __forceinline__ void operator()(AccRef acc, const Unit& u, int wr, int wc, int, int) const { const int lane_ = vlane(); const int fr = lane_ & 15, fq = lane_ >> 4;
#pragma unroll
        for (int ai = 0; ai < 2; ++ai)
#pragma unroll
            for (int m = 0; m < 4; ++m) {
                const int row = u.pm * 256 + ai * 128 + wr * 64 + m * 16 + fr;
                asm volatile("" ::: "memory");
                float sq = 0.f;
#pragma unroll
                for (int bj = 0; bj < 2; ++bj) {
                    const size_t off = (size_t)row * D + u.pn * 256 + bj * 128 + wc * 32 + fq * 8;
                    f32x4 x0 = *(const f32x4*)(X + off), x1 = *(const f32x4*)(X + off + 4);
                    x0 += acc[ai][bj][m][0] * alpha; x1 += acc[ai][bj][m][1] * alpha;
                    *(f32x4*)(X + off) = x0; *(f32x4*)(X + off + 4) = x1;
                    sq += dot4(x0) + dot4(x1);
                    u32x4 w; w.x = cvt_pk_bf16(x0.x, x0.y); w.y = cvt_pk_bf16(x0.z, x0.w); w.z = cvt_pk_bf16(x1.x, x1.y); w.w = cvt_pk_bf16(x1.z, x1.w);
                    *(u32x4*)(xb + off) = w;
                }
                sq += __shfl_xor(sq, 16); sq += __shfl_xor(sq, 32);
                if (fq == 0) ssOut[(size_t)row * 16 + u.pn * 4 + wc] = sq;
            }
    }
};
struct EpiGate {
    float* X; const float* ssIn; bf16_t* ppxb; float* ssOut; float gsc;
    __device__ __forceinline__ void operator()(AccRef acc, const Unit& u, int wr, int wc, int, int) const { const int lane_ = vlane(); const int fr = lane_ & 15, fq = lane_ >> 4;
#pragma unroll
        for (int ai = 0; ai < 2; ++ai)
#pragma unroll
            for (int m = 0; m < 4; ++m) {
                const int row = u.pm * 256 + ai * 128 + wr * 64 + m * 16 + fr;
                asm volatile("" ::: "memory");
                const float r = rs16(ssIn, row);
                float sq = 0.f;
#pragma unroll
                for (int bj = 0; bj < 2; ++bj) {
                    const size_t off = (size_t)row * D + u.pn * 256 + bj * 128 + wc * 32 + fq * 8;
                    f32x4 x0 = *(const f32x4*)(X + off), x1 = *(const f32x4*)(X + off + 4);
                    const u32x4 pp = *(const u32x4*)(ppxb + off); const float gs = gsc;
                    const f32x4 a0 = acc[ai][bj][m][0] * r, a1 = acc[ai][bj][m][1] * r;
                    x0.x += sigmoidf_(a0.x) * (bf_lo(pp.x) * gs); x0.y += sigmoidf_(a0.y) * (bf_hi(pp.x) * gs); x0.z += sigmoidf_(a0.z) * (bf_lo(pp.y) * gs); x0.w += sigmoidf_(a0.w) * (bf_hi(pp.y) * gs);
                    x1.x += sigmoidf_(a1.x) * (bf_lo(pp.z) * gs); x1.y += sigmoidf_(a1.y) * (bf_hi(pp.z) * gs); x1.z += sigmoidf_(a1.z) * (bf_lo(pp.w) * gs); x1.w += sigmoidf_(a1.w) * (bf_hi(pp.w) * gs);
                    *(f32x4*)(X + off) = x0; *(f32x4*)(X + off + 4) = x1;
                    sq += dot4(x0) + dot4(x1);
                    u32x4 w; w.x = cvt_pk_bf16(x0.x, x0.y); w.y = cvt_pk_bf16(x0.z, x0.w); w.z = cvt_pk_bf16(x1.x, x1.y); w.w = cvt_pk_bf16(x1.z, x1.w);
                    *(u32x4*)(ppxb + off) = w;
                }
                sq += __shfl_xor(sq, 16); sq += __shfl_xor(sq, 32);
                if (fq == 0) ssOut[(size_t)row * 16 + u.pn * 4 + wc] = sq;
            }
    }
};
__device__ __forceinline__ void rope_rot(f32x4& v0, f32x4& v1, const float* cs) {
    const f32x4 c = *(const f32x4*)cs, s = *(const f32x4*)(cs + 4);
    const f32x4 a = v0 * c - v1 * s, b = v1 * c + v0 * s; v0 = a; v1 = b;
}
__device__ __forceinline__ void vstore1(unsigned char* vf, int vhead, int dd, int b, int ppos, bf16_t val);
struct EpiIn {
    const float* ss; unsigned char* ws; float* mst; const float* cs64; const float* cs32;
    __device__ __forceinline__ void operator()(AccRef acc, const Unit& u, int wr, int wc, int, int) const { const int lane_ = vlane(); const int fr = lane_ & 15, fq = lane_ >> 4;
#pragma unroll
        for (int ai = 0; ai < 2; ++ai)
#pragma unroll
            for (int m = 0; m < 4; ++m) {
                const int row = u.pm * 256 + ai * 128 + wr * 64 + m * 16 + fr;
                asm volatile("" ::: "memory");
                const float r = rs16(ss, row);
                const int pos = row & (T - 1), b = row >> 11;
                float sq = 0.f;
#pragma unroll
                for (int bj = 0; bj < 2; ++bj) {
                    const int gcol = u.pn * 256 + bj * 128 + wc * 32;
                    f32x4 v0 = acc[ai][bj][m][0] * r, v1 = acc[ai][bj][m][1] * r;
                    const bool r64 = (gcol >= 512 && gcol < 896) || (gcol >= 1024 && gcol < 1536);
                    if (r64) rope_rot(v0, v1, cs64 + ((size_t)pos * 8 + 4 * ((gcol >> 5) & 1) + fq) * 8);
                    if (gcol == 1920) rope_rot(v0, v1, cs32 + ((size_t)pos * 4 + fq) * 8);
                    if (u.pn == 6 || (u.pn == 7 && bj == 0)) sq += dot4(v0) + dot4(v1);
                    u32x4 w; w.x = cvt_pk_bf16(v0.x, v0.y); w.y = cvt_pk_bf16(v0.z, v0.w); w.z = cvt_pk_bf16(v1.x, v1.y); w.w = cvt_pk_bf16(v1.z, v1.w);
                    const int c8 = ((gcol & 63) >> 3) + fq;
                    const size_t frag = (size_t)(c8 >> 1) * 1024 + (size_t)((pos & 31) + 32 * (c8 & 1)) * 16;
                    const size_t rec = ((size_t)b * 64 + (pos >> 5)) * 4096;
                    if (gcol < 256) *(u32x4*)(ws + OFF_ZQ + ((size_t)row * ZQLD + gcol + fq * 8) * 2) = w;
                    else if (gcol < 512) *(u32x4*)(ws + OFF_KF + (size_t)((gcol - 256) >> 6) * HEADB + rec + frag) = w;
                    else if (gcol < 768) *(u32x4*)(ws + OFF_ZQ + ((size_t)row * ZQLD + (gcol - 256) + fq * 8) * 2) = w;
                    else if (gcol < 896) *(u32x4*)(ws + OFF_KF + (size_t)(4 + ((gcol - 768) >> 6)) * HEADB + rec + frag) = w;
                    else if (gcol < 1024) {
                        const int dd0 = (gcol - 896) + fq * 8; const unsigned ww[4] = {w.x, w.y, w.z, w.w};
#pragma unroll
                        for (int e = 0; e < 8; ++e) vstore1(ws + OFF_VT, 4 + (dd0 >> 6), (dd0 & 63) + e, b, pos, (bf16_t)((e & 1) ? (ww[e >> 1] >> 16) : (ww[e >> 1] & 0xffffu)));
                    }
                    else if (gcol < 1280) *(u32x4*)(ws + OFF_ZQ + ((size_t)row * ZQLD + (gcol - 512) + fq * 8) * 2) = w;
                    else if (gcol < 1536) {
                        const int hd = (gcol - 1280) >> 6;
                        *(u32x4*)(ws + OFF_KF + (size_t)(6 + hd) * HEADB + rec + frag) = w;
                        const int p4 = (pos & 3) * 512 + (pos >> 2), p16 = (pos & 15) * 128 + (pos >> 4);
                        *(u32x4*)(ws + OFF_KF + (size_t)(10 + hd) * HEADB + ((size_t)b * 64 + (p4 >> 5)) * 4096 + (size_t)(c8 >> 1) * 1024 + (size_t)((p4 & 31) + 32 * (c8 & 1)) * 16) = w;
                        *(u32x4*)(ws + OFF_KF + (size_t)(14 + hd) * HEADB + ((size_t)b * 64 + (p16 >> 5)) * 4096 + (size_t)(c8 >> 1) * 1024 + (size_t)((p16 & 31) + 32 * (c8 & 1)) * 16) = w;
                    }
                    else if (gcol < 1920) *(u32x4*)(ws + OFF_ZL + ((size_t)row * ZLLD + (gcol - 1536) + fq * 8) * 2) = w;
                    else if (gcol == 1920) *(u32x4*)(ws + OFF_KPE + ((size_t)b * 64 + (pos >> 5)) * 2048 + (size_t)(fq >> 1) * 1024 + (size_t)((pos & 31) + 32 * (fq & 1)) * 16) = w;
                }
                if (u.pn >= 6) {
                    sq += __shfl_xor(sq, 16); sq += __shfl_xor(sq, 32);
                    if (fq == 0) mst[(size_t)row * 8 + (u.pn - 6) * 4 + wc] = sq;
                }
            }
    }
};
__device__ __forceinline__ void vstore8(unsigned char* vf, int vhead, int dd, int tok0, u32x4 w) {
    const int b = tok0 >> 11, pos0 = tok0 & (T - 1), idx0 = pos0 & 31;
    unsigned char* p = vf + (size_t)vhead * HEADB + ((size_t)b * 64 + (pos0 >> 5)) * 4096 + (size_t)((dd >> 5) * 2 + (idx0 >> 4)) * 1024 + (size_t)(dd & 31) * 16 + ((idx0 >> 3) & 1) * 8;
    u32x2 lo; lo.x = w.x; lo.y = w.y; u32x2 hi; hi.x = w.z; hi.y = w.w;
    *(u32x2*)p = lo; *(u32x2*)(p + 512) = hi;
}
__device__ __forceinline__ void vstore1(unsigned char* vf, int vhead, int dd, int b, int ppos, bf16_t val) {
    const int idx = ppos & 31, r16 = idx & 15;
    unsigned char* p = vf + (size_t)vhead * HEADB + ((size_t)b * 64 + (ppos >> 5)) * 4096 + (size_t)((dd >> 5) * 2 + (idx >> 4)) * 1024 + (size_t)((dd & 31) + 32 * ((r16 >> 2) & 1)) * 16 + (r16 >> 3) * 8 + (r16 & 3) * 2;
    *(bf16_t*)p = val;
}
struct EpiVT {
    const float* ss; unsigned char* vf;
    __device__ __forceinline__ void operator()(AccRef acc, const Unit& u, int wr, int wc, int, int) const { const int lane_ = vlane(); const int fr = lane_ & 15, fq = lane_ >> 4;
#pragma unroll
        for (int bj = 0; bj < 2; ++bj) {
            const int tok0 = u.pn * 256 + bj * 128 + wc * 32 + fq * 8;
            float rs[8];
#pragma unroll
            for (int e = 0; e < 8; ++e) rs[e] = rs16(ss, tok0 + e);
#pragma unroll
            for (int ai = 0; ai < 2; ++ai) {
                const int rbase = u.pm * 256 + ai * 128;
                const bool dil = rbase >= 256;
#pragma unroll
                for (int m = 0; m < 4; ++m) {
                    const int row = rbase + wr * 64 + m * 16 + fr;
                    asm volatile("" ::: "memory");
                    const f32x4 a0 = acc[ai][bj][m][0], a1 = acc[ai][bj][m][1];
                    u32x4 w; w.x = cvt_pk_bf16(a0.x * rs[0], a0.y * rs[1]); w.y = cvt_pk_bf16(a0.z * rs[2], a0.w * rs[3]);
                    w.z = cvt_pk_bf16(a1.x * rs[4], a1.y * rs[5]); w.w = cvt_pk_bf16(a1.z * rs[6], a1.w * rs[7]);
                    const int vhead = (row >> 6) + (dil ? 2 : 0), dd = row & 63;
                    vstore8(vf, vhead, dd, tok0, w);
                    if (dil) {
                        const int b = tok0 >> 11, t0 = tok0 & (T - 1);
                        const unsigned ww[4] = {w.x, w.y, w.z, w.w};
#pragma unroll
                        for (int e = 0; e < 8; ++e) {
                            const int t = t0 + e; const bf16_t val = (bf16_t)((e & 1) ? (ww[e >> 1] >> 16) : (ww[e >> 1] & 0xffffu));
                            vstore1(vf, vhead + 4, dd, b, (t & 3) * 512 + (t >> 2), val);
                            vstore1(vf, vhead + 8, dd, b, (t & 15) * 128 + (t >> 4), val);
                        }
                    }
                }
            }
        }
    }
};
struct EpiQ {
    const float* mst; bf16_t* qm; const float* cs32;
    __device__ __forceinline__ void operator()(AccRef acc, const Unit& u, int wr, int wc, int, int) const { const int lane_ = vlane(); const int fr = lane_ & 15, fq = lane_ >> 4;
#pragma unroll
        for (int ai = 0; ai < 2; ++ai)
#pragma unroll
            for (int m = 0; m < 4; ++m) {
                const int row = u.pm * 256 + ai * 128 + wr * 64 + m * 16 + fr;
                asm volatile("" ::: "memory");
                const f32x4 st = *(const f32x4*)(mst + (size_t)row * 8);
                const float r = rsqrtf(sum4(st) * (1.0f / 256.0f) + EPS);
                const int pos = row & (T - 1);
#pragma unroll
                for (int bj = 0; bj < 2; ++bj) {
                    const int gcol = u.pn * 256 + bj * 128 + wc * 32;
                    if (gcol >= 384) continue;
                    f32x4 v0 = acc[ai][bj][m][0] * r, v1 = acc[ai][bj][m][1] * r;
                    if (((gcol >> 5) % 3) == 2) rope_rot(v0, v1, cs32 + ((size_t)pos * 4 + fq) * 8);
                    u32x4 w; w.x = cvt_pk_bf16(v0.x, v0.y); w.y = cvt_pk_bf16(v0.z, v0.w); w.z = cvt_pk_bf16(v1.x, v1.y); w.w = cvt_pk_bf16(v1.z, v1.w);
                    *(u32x4*)(qm + (size_t)row * QLD + gcol + fq * 8) = w;
                }
            }
    }
};
struct EpiK {
    const float* mst; unsigned char* ws;
    __device__ __forceinline__ void operator()(AccRef acc, const Unit& u, int wr, int wc, int, int) const { const int lane_ = vlane(); const int fr = lane_ & 15, fq = lane_ >> 4;
#pragma unroll
        for (int ai = 0; ai < 2; ++ai)
#pragma unroll
            for (int m = 0; m < 4; ++m) {
                const int row = u.pm * 256 + ai * 128 + wr * 64 + m * 16 + fr;
                asm volatile("" ::: "memory");
                const f32x4 st = *(const f32x4*)(mst + (size_t)row * 8 + 4);
                const float r = rsqrtf(sum4(st) * (1.0f / 128.0f) + EPS);
#pragma unroll
                for (int bj = 0; bj < 2; ++bj) {
                    const f32x4 v0 = acc[ai][bj][m][0] * r, v1 = acc[ai][bj][m][1] * r;
                    u32x4 w; w.x = cvt_pk_bf16(v0.x, v0.y); w.y = cvt_pk_bf16(v0.z, v0.w); w.z = cvt_pk_bf16(v1.x, v1.y); w.w = cvt_pk_bf16(v1.z, v1.w);
                    const int col0 = bj * 128 + wc * 32, c8 = ((col0 & 63) >> 3) + fq, pos = row & (T - 1);
                    *(u32x4*)(ws + OFF_KF + (size_t)(18 + (col0 >> 6)) * HEADB + ((size_t)(row >> 11) * 64 + (pos >> 5)) * 4096 + (size_t)(c8 >> 1) * 1024 + (size_t)((pos & 31) + 32 * (c8 & 1)) * 16) = w;
                }
            }
    }
};
struct EpiVTM {
    const float* mst; unsigned char* vf;
    __device__ __forceinline__ void operator()(AccRef acc, const Unit& u, int wr, int wc, int, int) const { const int lane_ = vlane(); const int fr = lane_ & 15, fq = lane_ >> 4;
#pragma unroll
        for (int bj = 0; bj < 2; ++bj) {
            const int tok0 = u.pn * 256 + bj * 128 + wc * 32 + fq * 8;
            float rs[8];
#pragma unroll
            for (int e = 0; e < 8; ++e) { const f32x4 st = *(const f32x4*)(mst + (size_t)(tok0 + e) * 8 + 4); rs[e] = rsqrtf(sum4(st) * (1.0f / 128.0f) + EPS); }
#pragma unroll
            for (int ai = 0; ai < 2; ++ai)
#pragma unroll
                for (int m = 0; m < 4; ++m) {
                    const int row = ai * 128 + wr * 64 + m * 16 + fr;
                    asm volatile("" ::: "memory");
                    const f32x4 a0 = acc[ai][bj][m][0], a1 = acc[ai][bj][m][1];
                    u32x4 w; w.x = cvt_pk_bf16(a0.x * rs[0], a0.y * rs[1]); w.y = cvt_pk_bf16(a0.z * rs[2], a0.w * rs[3]);
                    w.z = cvt_pk_bf16(a1.x * rs[4], a1.y * rs[5]); w.w = cvt_pk_bf16(a1.z * rs[6], a1.w * rs[7]);
                    vstore8(vf, 18 + (row >> 6), row & 63, tok0, w);
                }
        }
    }
};
struct EpiPP {
    bf16_t* O;
    __device__ __forceinline__ void operator()(AccRef acc, const Unit& u, int wr, int wc, int, int) const { const int lane_ = vlane(); const int fr = lane_ & 15, fq = lane_ >> 4;
#pragma unroll
        for (int ai = 0; ai < 2; ++ai)
#pragma unroll
            for (int m = 0; m < 4; ++m) {
                const int row = u.pm * 256 + ai * 128 + wr * 64 + m * 16 + fr;
                asm volatile("" ::: "memory");
#pragma unroll
                for (int bj = 0; bj < 2; ++bj) {
                    const f32x4 v0 = acc[ai][bj][m][0], v1 = acc[ai][bj][m][1];
                    u32x4 w; w.x = cvt_pk_bf16(v0.x, v0.y); w.y = cvt_pk_bf16(v0.z, v0.w); w.z = cvt_pk_bf16(v1.x, v1.y); w.w = cvt_pk_bf16(v1.z, v1.w);
                    *(u32x4*)(O + (size_t)row * D + u.pn * 256 + bj * 128 + wc * 32 + fq * 8) = w;
                }
            }
    }
};

template <class Epi>
__device__ __forceinline__ void run_gemm(int wv, LAS unsigned char* lds, const bf16_t* A, int lda, int rows, const bf16_t* Bt, int ldb, int cols, int K, int cshift, const Epi& E) {
    pg8::Gemm g{A, Bt, lda, ldb, K};
    pg8::StaticOrder S; const int G_ = lgrid(); S.init(rows, cols, G_, (lbid() + cshift) % G_);
    pg8::gemm_phase<Epi>(lds, g, S, E, wv);
}

__device__ __forceinline__ int p64(int d) { return d < 32 ? 8 * (d >> 2) + (d & 3) : 8 * ((d - 32) >> 2) + 4 + (d & 3); }
__device__ __forceinline__ int p32(int d) { return d < 16 ? 8 * (d >> 2) + (d & 3) : 8 * ((d - 16) >> 2) + 4 + (d & 3); }
__device__ __forceinline__ int maprow(int mapid, int c) {
    switch (mapid) {
        case 0: return c;
        case 1: return (c >> 2) * 8 + (c & 3);
        case 2: return (c >> 2) * 8 + 4 + (c & 3);
        case 3: {
            if (c < 768) return c < 512 ? c : 2048 + (c - 512);
            c -= 768;
            if (c < 512) return c < 384 ? 512 + (c >> 6) * 64 + p64(c & 63) : 896 + (c - 384);
            c -= 512;
            if (c < 768) return c < 512 ? 1024 + (c >> 6) * 64 + p64(c & 63) : 2048 + 256 + (c - 512);
            c -= 768;
            if (c < 256) return 1536 + c;
            if (c < 384) return 1792 + (c - 256);
            return 1920 + p32(c - 384);
        }
        case 4: { const int h = c / 96, e = c % 96; return e < 64 ? 96 * h + e : 96 * h + 64 + p32(e - 64); }
        default: { const int h = c >> 7, e = c & 127; return e < 64 ? 64 * h + e : 256 + 64 * h + (e - 64); }
    }
}
__device__ __forceinline__ void tr_item(const float* W, int K, int N, const float* gain, bf16_t* dst, int mapid, int item, LAS float* s, int wv) {
    const int tid = ltid(wv);
    const int ncb = (N + 255) >> 8, kb = item / ncb, cb = item % ncb, k0 = kb * 64, c0 = cb * 256;
#pragma unroll
    for (int i = 0; i < 8; ++i) {
        const int kk = i * 8 + (tid >> 6), col = (tid & 63) * 4;
        f32x4 v = (f32x4){0.f, 0.f, 0.f, 0.f};
        if (c0 + col < N) v = *(const f32x4*)(W + (size_t)(k0 + kk) * N + c0 + col);
        if (gain) v *= gain[k0 + kk];
        *(LAS f32x4*)(s + kk * 260 + col) = v;
    }
    __syncthreads();
    const int cc = tid & 255, kh = tid >> 8, c = c0 + cc;
    if (c < N) {
        const int drow = maprow(mapid, c);
        bf16_t* o = dst + (size_t)drow * K + k0 + kh * 32;
#pragma unroll
        for (int q = 0; q < 4; ++q) {
            const LAS float* sp = s + (kh * 32 + q * 8) * 260 + cc;
            u32x4 w; w.x = cvt_pk_bf16(sp[0], sp[260]); w.y = cvt_pk_bf16(sp[2 * 260], sp[3 * 260]); w.z = cvt_pk_bf16(sp[4 * 260], sp[5 * 260]); w.w = cvt_pk_bf16(sp[6 * 260], sp[7 * 260]);
            *(u32x4*)(o + q * 8) = w;
        }
    }
    __syncthreads();
}

struct Args { const float* in[24]; float* out; unsigned char* ws; int ph_lo, ph_hi, coop, pad; };
typedef const __attribute__((address_space(4))) Args* KA;
__device__ __forceinline__ KA kargs() { KA p = (KA)__builtin_amdgcn_kernarg_segment_ptr(); asm volatile("" : "+s"(p)); return p; }

__device__ __forceinline__ void zero_rows(bf16_t* base, int row0, int nrows, int K, int gt, int ngt) {
    const size_t n16 = (size_t)nrows * K / 8; u32x4* p = (u32x4*)(base + (size_t)row0 * K);
    for (size_t i = gt; i < n16; i += ngt) p[i] = (u32x4){0u, 0u, 0u, 0u};
}

__device__ __forceinline__ void prologue(KA a, LAS unsigned char* lds, int wv) {
    LAS float* s = (LAS float*)lds;
    const int G = lgrid(), bid = lbid(), tid = ltid(wv);
    bf16_t* Wbase = (bf16_t*)(a->ws + OFF_W);
#if PRO_PARTS & 1
    constexpr int I_FFN = 16 * 11, I_DN = 44 * 4, I_IN = 16 * 10, I_UQ = 4 * 2, I_UKV = 2 * 2, I_O = 16 * 4, I_PP = 4 * 4;
    constexpr int I_LAYER = 4 * I_FFN + 2 * I_DN + I_IN + I_UQ + I_UKV + 2 * I_O + I_PP;
    for (int it = bid; it < I_LAYER * DEPTH; it += G) {
        const int l = it / I_LAYER; int r = it % I_LAYER;
        int sel = 0;
        if (r >= I_FFN) { r -= I_FFN; sel = 1;
        if (r >= I_FFN) { r -= I_FFN; sel = 2;
        if (r >= I_DN) { r -= I_DN; sel = 3;
        if (r >= I_IN) { r -= I_IN; sel = 4;
        if (r >= I_UQ) { r -= I_UQ; sel = 5;
        if (r >= I_UKV) { r -= I_UKV; sel = 6;
        if (r >= I_O) { r -= I_O; sel = 7;
        if (r >= I_FFN) { r -= I_FFN; sel = 8;
        if (r >= I_FFN) { r -= I_FFN; sel = 9;
        if (r >= I_DN) { r -= I_DN; sel = 10;
        if (r >= I_O) { r -= I_O; sel = 11; } } } } } } } } } } }
        const float* W0; const float* g0 = nullptr; int K, N, mapid; size_t doff;
        switch (sel) {
            case 0: W0 = a->in[3]; g0 = a->in[2]; K = D; N = FF; doff = WL_GU1; mapid = 1; break;
            case 1: W0 = a->in[4]; g0 = a->in[2]; K = D; N = FF; doff = WL_GU1; mapid = 2; break;
            case 2: W0 = a->in[5]; K = FF; N = D; doff = WL_D1; mapid = 0; break;
            case 3: W0 = a->in[7]; g0 = a->in[6]; K = D; N = 2464; doff = WL_IN; mapid = 3; break;
            case 4: W0 = a->in[11]; g0 = a->in[10]; K = 256; N = 384; doff = WL_UQ; mapid = 4; break;
            case 5: W0 = a->in[13]; g0 = a->in[12]; K = 128; N = 512; doff = WL_UKV; mapid = 5; break;
            case 6: W0 = a->in[15]; g0 = a->in[14]; K = D; N = D; doff = WL_O; mapid = 0; break;
            case 7: W0 = a->in[17]; g0 = a->in[16]; K = D; N = FF; doff = WL_GU2; mapid = 1; break;
            case 8: W0 = a->in[18]; g0 = a->in[16]; K = D; N = FF; doff = WL_GU2; mapid = 2; break;
            case 9: W0 = a->in[19]; K = FF; N = D; doff = WL_D2; mapid = 0; break;
            case 10: W0 = a->in[21]; g0 = a->in[20]; K = D; N = D; doff = WL_PG; mapid = 0; break;
            default: W0 = a->in[22]; K = PLE; N = D; doff = WL_PP; mapid = 0; break;
        }
        const float* W = W0 + (size_t)l * K * N;
        const float* gain = g0 ? g0 + (size_t)l * K : nullptr;
        tr_item(W, K, N, gain, Wbase + (size_t)l * WL_SIZE + doff, mapid, r, s, wv);
    }
#endif
    const int gt = bid * 512 + tid, ngt = G * 512;
    for (int l = 0; l < DEPTH; ++l) {
        bf16_t* WL = Wbase + (size_t)l * WL_SIZE;
        zero_rows(WL + WL_IN, 1952, 96, D, gt, ngt);
        zero_rows(WL + WL_UQ, 384, 128, 256, gt, ngt);
    }
#if PRO_PARTS & 2
    float* cs64 = (float*)(a->ws + OFF_CS64); float* cs32 = (float*)(a->ws + OFF_CS32);
    for (int i = gt; i < T * 32; i += ngt) {
        const int pos = i >> 5, j = i & 31;
        const float inv = __builtin_amdgcn_exp2f(-(float)j * (13.287712379549449f / 32.0f)); const float ang = (float)pos * inv;
        const float rev = ang * 0.15915494309189535f, fr_ = rev - floorf(rev);
        float* p = cs64 + ((size_t)pos * 8 + (j >> 2)) * 8 + (j & 3);
        p[0] = __builtin_amdgcn_cosf(fr_); p[4] = __builtin_amdgcn_sinf(fr_);
    }
    for (int i = gt; i < T * 16; i += ngt) {
        const int pos = i >> 4, j = i & 15;
        const float inv = __builtin_amdgcn_exp2f(-(float)j * (13.287712379549449f / 16.0f)); const float ang = (float)pos * inv;
        const float rev = ang * 0.15915494309189535f, fr_ = rev - floorf(rev);
        float* p = cs32 + ((size_t)pos * 4 + (j >> 2)) * 8 + (j & 3);
        p[0] = __builtin_amdgcn_cosf(fr_); p[4] = __builtin_amdgcn_sinf(fr_);
    }
#endif
#if PRO_PARTS & 4
    const int lane = tid & 63, gw = bid * 8 + (tid >> 6), ngw = G * 8;
    bf16_t* xb = (bf16_t*)(a->ws + OFF_XBA); float* ss = (float*)(a->ws + OFF_SSA);
    for (int row = gw; row < M; row += ngw) {
        const f32x4* xr = (const f32x4*)(a->in[0] + (size_t)row * D) + lane; f32x4* orow = (f32x4*)(a->out + (size_t)row * D) + lane;
        float sq = 0.f;
#pragma unroll
        for (int j = 0; j < 4; ++j) {
            const f32x4 v = xr[64 * j]; orow[64 * j] = v; sq += dot4(v);
            u32x2 w; w.x = cvt_pk_bf16(v.x, v.y); w.y = cvt_pk_bf16(v.z, v.w);
            *(u32x2*)(xb + (size_t)row * D + 256 * j + lane * 4) = w;
        }
#pragma unroll
        for (int o = 1; o < 64; o <<= 1) sq += __shfl_xor(sq, o);
        if (lane < 16) ss[(size_t)row * 16 + lane] = lane == 0 ? sq : 0.f;
    }
#endif
}

__device__ __forceinline__ void convert_p(KA a, int layer, int wv) {
    const f32x4* src = (const f32x4*)(a->in[1] + (size_t)layer * M * PLE); u32x2* dst = (u32x2*)(a->ws + OFF_VT);
    const size_t n = (size_t)M * PLE / 4;
    const int tid_ = ltid(wv), bid_ = lbid(), G_ = lgrid();
    for (size_t i = (size_t)bid_ * 512 + tid_; i < n; i += (size_t)G_ * 512) {
        const f32x4 v = src[i]; u32x2 w; w.x = cvt_pk_bf16(v.x, v.y); w.y = cvt_pk_bf16(v.z, v.w); dst[i] = w;
    }
}

__device__ __forceinline__ void final_norm(KA a, int wv) {
    const int tid_ = ltid(wv); const int lane = tid_ & 63, gw = lbid() * 8 + (tid_ >> 6), ngw = lgrid() * 8;
    const float* ss = (const float*)(a->ws + OFF_SSA);
    f32x4 g[4];
#pragma unroll
    for (int j = 0; j < 4; ++j) g[j] = ((const f32x4*)a->in[23])[64 * j + lane];
    for (int row = gw; row < M; row += ngw) {
        const float r = rs16(ss, row);
        f32x4* orow = (f32x4*)(a->out + (size_t)row * D) + lane;
#pragma unroll
        for (int j = 0; j < 4; ++j) orow[64 * j] = orow[64 * j] * r * g[j];
    }
}

struct AttnP { const unsigned char* ws; const float* nab; const float* sink; };

template <int MODE>
__device__ __forceinline__ void attn_unit(const AttnP& P0, int unit, LAS float* xch, const LAS float* nabl, int wv) {
    const unsigned char* ws = P0.ws; asm volatile("" : "+s"(ws));
    constexpr int NS = MODE == 0 ? 6 : 4;
    const int lane = vlane(), w = wv, qs = w >> 2, h = w & 3, ql = lane & 31, hh = lane >> 5;
    const int lane16 = lane * 16;
    const int b = unit >> 5, rem = unit & 31;
    int qt, T0 = 0, rr = 0, qmin, qmax;
    if (MODE == 1) { T0 = 512 * (rem >> 3); rr = 2 * (rem & 7) + qs; qt = T0 + rr + 16 * ql; qmin = T0 + rr; qmax = qmin + 496; }
    else { qmin = 64 * rem + 32 * qs; qt = qmin + ql; qmax = qmin + 31; }
    const size_t tokbase = (size_t)b * T;
    const bf16_t* qrow; int khead, group;
    if (MODE == 0) { qrow = (const bf16_t*)(ws + OFF_QM) + (tokbase + qt) * QLD + 96 * h; khead = 18 + h; group = 3; }
    else if (MODE == 1) { qrow = (const bf16_t*)(ws + OFF_ZQ) + (tokbase + qt) * ZQLD + 512 + 64 * h; khead = 6 + h; group = 2; }
    else if (MODE == 2) { qrow = (const bf16_t*)(ws + OFF_ZQ) + (tokbase + qt) * ZQLD + 64 * h; khead = h; group = 0; }
    else { qrow = (const bf16_t*)(ws + OFF_ZQ) + (tokbase + qt) * ZQLD + 256 + 64 * h; khead = 4 + (h >> 1); group = 1; }
    const unsigned char* kfb = ws + OFF_KF + (size_t)b * 64 * 4096 + lane16;
    const unsigned char* vfb = ws + OFF_VT + (size_t)b * 64 * 4096 + lane16;
    const unsigned char* kpe = ws + OFF_KPE + (size_t)b * 64 * 2048 + lane16;
    bf16x8 qf[NS];
#pragma unroll
    for (int s = 0; s < NS; ++s) qf[s] = *(const bf16x8*)(qrow + 16 * s + 8 * hh);
    const float sc = (MODE == 0 ? 0.10206207261596577f : 0.125f) * LOG2E;
    f32x16 o0, o1;
#pragma unroll
    for (int e = 0; e < 16; ++e) { o0[e] = 0.f; o1[e] = 0.f; }
    float mrun = -1e20f, lrun = 0.f;
    if (MODE == 3) { mrun = P0.sink[h] * LOG2E; lrun = hh == 0 ? 1.f : 0.f; }
    const int qcol = qt & 63;
    const int nseg = MODE == 1 ? 3 : 1;
    for (int seg = 0; seg < nseg; ++seg) {
        int ntile, kb0, kstr, vb0, win, hd = khead;
        if (MODE == 0) { ntile = 64; kb0 = 0; kstr = 1; vb0 = 0; win = 1 << 20; }
        else if (MODE == 2) { ntile = 16; kb0 = 64 * min(max(rem - 4, 0), 24); kstr = 1; vb0 = kb0; win = 0; }
        else if (MODE == 3) { ntile = 9; kb0 = qmin - 128; kstr = 1; vb0 = kb0; win = 128; }
        else {
            if (seg == 0) { ntile = 20; kb0 = T0 - 64; kstr = 1; vb0 = kb0; win = 64; }
            else if (seg == 1) { ntile = 8; const int us = (T0 >> 2) - 64, r4 = rr & 3; kb0 = 4 * us + r4; kstr = 4; vb0 = r4 * 512 + us; win = 256; hd = khead + 4; }
            else { ntile = 5; const int nst = (T0 >> 4) - 64; kb0 = 16 * nst + rr; kstr = 16; vb0 = rr * 128 + nst; win = 1024; hd = khead + 8; }
        }
        const int kstep = 32 * kstr;
        int tlo = 0, thi = ntile;
        if (MODE == 1 || MODE == 3) { tlo = kb0 < 0 ? (-kb0 + kstep - 1) / kstep : 0; thi = min(ntile, (T - kb0 + kstep - 1) / kstep); }
        const unsigned char* kfh = kfb + (size_t)hd * HEADB; const unsigned char* vfh = vfb + (size_t)hd * HEADB;
        bf16x8 kf[NS], vf[4];
        {
            const int pt = (vb0 >> 5) + tlo;
#pragma unroll
            for (int s = 0; s < NS; ++s) kf[s] = (MODE == 0 && s >= 4) ? *(const bf16x8*)(kpe + (size_t)pt * 2048 + (s - 4) * 1024) : *(const bf16x8*)(kfh + (size_t)pt * 4096 + s * 1024);
#pragma unroll
            for (int j = 0; j < 4; ++j) vf[j] = *(const bf16x8*)(vfh + (size_t)pt * 4096 + j * 1024);
        }
        for (int tau = tlo; tau < thi; ++tau) {
            const int kb = kb0 + kstep * tau;
            bf16x8 kn[NS], vn[4];
            {
                const int pt = (vb0 >> 5) + min(tau + 1, thi - 1);
#pragma unroll
                for (int s = 0; s < NS; ++s) kn[s] = (MODE == 0 && s >= 4) ? *(const bf16x8*)(kpe + (size_t)pt * 2048 + (s - 4) * 1024) : *(const bf16x8*)(kfh + (size_t)pt * 4096 + s * 1024);
#pragma unroll
                for (int j = 0; j < 4; ++j) vn[j] = *(const bf16x8*)(vfh + (size_t)pt * 4096 + j * 1024);
            }
            f32x16 sacc;
#pragma unroll
            for (int e = 0; e < 16; ++e) sacc[e] = 0.f;
#pragma unroll
            for (int s = 0; s < NS; ++s) sacc = __builtin_amdgcn_mfma_f32_32x32x16_bf16(kf[s], qf[s], sacc, 0, 0, 0);
            if (MODE == 2) {
                const int c0 = 32 * (tau & 1), wsx = min(max(qcol - 8, 0), 48);
                const int mb = c0 - wsx + 4 * hh;
                const int drow = (kb >> 6) - rem + 7;
                const LAS float* bp = nabl + (h * 15 + drow) * 31 + c0 - qcol + 15 + 4 * hh;
#pragma unroll
                for (int e = 0; e < 16; ++e) {
                    const int o = 8 * (e >> 2) + (e & 3);
                    const float v = sacc[e] * sc + bp[o];
                    sacc[e] = (unsigned)(mb + o) < 16u ? v : -1e30f;
                }
            } else if (MODE != 0) {
                const bool full = (kb + 31 * kstr - qmin <= win) && (qmax - kb <= win);
                if (!full) {
                    const int mb = kb - qt + win + 4 * hh * kstr;
#pragma unroll
                    for (int e = 0; e < 16; ++e) {
                        const int o = (8 * (e >> 2) + (e & 3)) * kstr;
                        sacc[e] = (unsigned)(mb + o) <= (unsigned)(2 * win) ? sacc[e] : -1e30f;
                    }
                }
            }
            float tmax = fmaxf(fmaxf(sacc[0], sacc[1]), fmaxf(sacc[2], sacc[3]));
#pragma unroll
            for (int e = 4; e < 16; e += 4) tmax = fmaxf(tmax, fmaxf(fmaxf(sacc[e], sacc[e + 1]), fmaxf(sacc[e + 2], sacc[e + 3])));
            tmax = fmaxf(tmax, __shfl_xor(tmax, 32));
            if (MODE != 2) tmax *= sc;
            const float mnew = fmaxf(mrun, tmax);
            const bool grow = mnew > mrun;
            const float alpha = __builtin_amdgcn_exp2f(mrun - mnew);
            mrun = mnew;
            float psum = 0.f;
#pragma unroll
            for (int e = 0; e < 16; ++e) {
                const float p = MODE == 2 ? __builtin_amdgcn_exp2f(sacc[e] - mnew) : __builtin_amdgcn_exp2f(__builtin_fmaf(sacc[e], sc, -mnew));
                sacc[e] = p; psum += p;
            }
            lrun = lrun * alpha + psum;
            if (__builtin_amdgcn_ballot_w64(grow) != 0ull) {
#pragma unroll
                for (int e = 0; e < 16; ++e) { o0[e] *= alpha; o1[e] *= alpha; }
            }
            bf16x8 pb[2];
#pragma unroll
            for (int t = 0; t < 2; ++t) {
                u32x4 v; v.x = cvt_pk_bf16(sacc[8 * t + 0], sacc[8 * t + 1]); v.y = cvt_pk_bf16(sacc[8 * t + 2], sacc[8 * t + 3]);
                v.z = cvt_pk_bf16(sacc[8 * t + 4], sacc[8 * t + 5]); v.w = cvt_pk_bf16(sacc[8 * t + 6], sacc[8 * t + 7]);
                pb[t] = __builtin_bit_cast(bf16x8, v);
            }
            o0 = __builtin_amdgcn_mfma_f32_32x32x16_bf16(vf[0], pb[0], o0, 0, 0, 0);
            o0 = __builtin_amdgcn_mfma_f32_32x32x16_bf16(vf[1], pb[1], o0, 0, 0, 0);
            o1 = __builtin_amdgcn_mfma_f32_32x32x16_bf16(vf[2], pb[0], o1, 0, 0, 0);
            o1 = __builtin_amdgcn_mfma_f32_32x32x16_bf16(vf[3], pb[1], o1, 0, 0, 0);
#pragma unroll
            for (int s = 0; s < NS; ++s) kf[s] = kn[s];
#pragma unroll
            for (int j = 0; j < 4; ++j) vf[j] = vn[j];
        }
    }
    lrun += __shfl_xor(lrun, 32);
    const float inv = 1.0f / lrun;
    float sq = 0.f;
#pragma unroll
    for (int e = 0; e < 16; ++e) { o0[e] *= inv; o1[e] *= inv; sq += o0[e] * o0[e] + o1[e] * o1[e]; }
    sq += __shfl_xor(sq, 32);
    if (hh == 0) xch[w * 32 + ql] = sq;
    __syncthreads();
    const float tot = (xch[(qs * 4 + 0) * 32 + ql] + xch[(qs * 4 + 1) * 32 + ql]) + (xch[(qs * 4 + 2) * 32 + ql] + xch[(qs * 4 + 3) * 32 + ql]);
    const float rg = rsqrtf(tot * (1.0f / 256.0f) + EPS);
    bf16_t* yrow = (bf16_t*)(ws + OFF_XBA) + (tokbase + qt) * D + group * 256 + h * 64 + 4 * hh;
#pragma unroll
    for (int j = 0; j < 4; ++j) {
        u32x2 w0; w0.x = cvt_pk_bf16(o0[4 * j] * rg, o0[4 * j + 1] * rg); w0.y = cvt_pk_bf16(o0[4 * j + 2] * rg, o0[4 * j + 3] * rg);
        u32x2 w1; w1.x = cvt_pk_bf16(o1[4 * j] * rg, o1[4 * j + 1] * rg); w1.y = cvt_pk_bf16(o1[4 * j + 2] * rg, o1[4 * j + 3] * rg);
        *(u32x2*)(yrow + 8 * j) = w0; *(u32x2*)(yrow + 32 + 8 * j) = w1;
    }
}

__device__ __forceinline__ void sm_pv(f32x16& sacc, f32x16& o0, f32x16& o1, float& mrun, float& lrun, const bf16x8 (&vf)[4], float sc) {
    float tmax = fmaxf(fmaxf(sacc[0], sacc[1]), fmaxf(sacc[2], sacc[3]));
#pragma unroll
    for (int e = 4; e < 16; e += 4) tmax = fmaxf(tmax, fmaxf(fmaxf(sacc[e], sacc[e + 1]), fmaxf(sacc[e + 2], sacc[e + 3])));
    tmax = fmaxf(tmax, __shfl_xor(tmax, 32)) * sc;
    const float mnew = fmaxf(mrun, tmax);
    const bool grow = mnew > mrun;
    const float alpha = __builtin_amdgcn_exp2f(mrun - mnew);
    mrun = mnew;
    float psum = 0.f;
#pragma unroll
    for (int e = 0; e < 16; ++e) { const float p = __builtin_amdgcn_exp2f(__builtin_fmaf(sacc[e], sc, -mnew)); sacc[e] = p; psum += p; }
    lrun = lrun * alpha + psum;
    if (__builtin_amdgcn_ballot_w64(grow) != 0ull) {
#pragma unroll
        for (int e = 0; e < 16; ++e) { o0[e] *= alpha; o1[e] *= alpha; }
    }
    bf16x8 pb[2];
#pragma unroll
    for (int t = 0; t < 2; ++t) {
        u32x4 v; v.x = cvt_pk_bf16(sacc[8 * t + 0], sacc[8 * t + 1]); v.y = cvt_pk_bf16(sacc[8 * t + 2], sacc[8 * t + 3]);
        v.z = cvt_pk_bf16(sacc[8 * t + 4], sacc[8 * t + 5]); v.w = cvt_pk_bf16(sacc[8 * t + 6], sacc[8 * t + 7]);
        pb[t] = __builtin_bit_cast(bf16x8, v);
    }
    o0 = __builtin_amdgcn_mfma_f32_32x32x16_bf16(vf[0], pb[0], o0, 0, 0, 0);
    o0 = __builtin_amdgcn_mfma_f32_32x32x16_bf16(vf[1], pb[1], o0, 0, 0, 0);
    o1 = __builtin_amdgcn_mfma_f32_32x32x16_bf16(vf[2], pb[0], o1, 0, 0, 0);
    o1 = __builtin_amdgcn_mfma_f32_32x32x16_bf16(vf[3], pb[1], o1, 0, 0, 0);
}
__device__ __forceinline__ void attn_mla(const AttnP& P0, int unit, LAS float* xch, int wv) {
    const unsigned char* ws = P0.ws; asm volatile("" : "+s"(ws));
    const int lane = vlane(), w = wv, qs = w >> 2, h = w & 3, ql = lane & 31, hh = lane >> 5;
    const int lane16 = lane * 16;
    const int b = unit >> 4, q0 = 128 * (unit & 15) + 64 * qs;
    const size_t tokbase = (size_t)b * T;
    const bf16_t* qrA = (const bf16_t*)(ws + OFF_QM) + (tokbase + q0 + ql) * QLD + 96 * h;
    const bf16_t* qrB = qrA + 32 * QLD;
    const unsigned char* kfh = ws + OFF_KF + (size_t)(18 + h) * HEADB + (size_t)b * 64 * 4096 + lane16;
    const unsigned char* vfh = ws + OFF_VT + (size_t)(18 + h) * HEADB + (size_t)b * 64 * 4096 + lane16;
    const unsigned char* kpe = ws + OFF_KPE + (size_t)b * 64 * 2048 + lane16;
    bf16x8 qA[6], qB[6];
#pragma unroll
    for (int s = 0; s < 6; ++s) { qA[s] = *(const bf16x8*)(qrA + 16 * s + 8 * hh); qB[s] = *(const bf16x8*)(qrB + 16 * s + 8 * hh); }
    const float sc = 0.10206207261596577f * LOG2E;
    f32x16 oA0, oA1, oB0, oB1;
#pragma unroll
    for (int e = 0; e < 16; ++e) { oA0[e] = 0.f; oA1[e] = 0.f; oB0[e] = 0.f; oB1[e] = 0.f; }
    float mA = -1e20f, lA = 0.f, mB = -1e20f, lB = 0.f;
    bf16x8 kf[6], vf[4];
#pragma unroll
    for (int s = 0; s < 6; ++s) kf[s] = s >= 4 ? *(const bf16x8*)(kpe + (s - 4) * 1024) : *(const bf16x8*)(kfh + s * 1024);
#pragma unroll
    for (int j = 0; j < 4; ++j) vf[j] = *(const bf16x8*)(vfh + j * 1024);
    for (int tau = 0; tau < 64; ++tau) {
        bf16x8 kn[6], vn[4];
        const int pt = min(tau + 1, 63);
#pragma unroll
        for (int s = 0; s < 6; ++s) kn[s] = s >= 4 ? *(const bf16x8*)(kpe + (size_t)pt * 2048 + (s - 4) * 1024) : *(const bf16x8*)(kfh + (size_t)pt * 4096 + s * 1024);
#pragma unroll
        for (int j = 0; j < 4; ++j) vn[j] = *(const bf16x8*)(vfh + (size_t)pt * 4096 + j * 1024);
        f32x16 sa, sb;
#pragma unroll
        for (int e = 0; e < 16; ++e) { sa[e] = 0.f; sb[e] = 0.f; }
#pragma unroll
        for (int s = 0; s < 6; ++s) { sa = __builtin_amdgcn_mfma_f32_32x32x16_bf16(kf[s], qA[s], sa, 0, 0, 0); sb = __builtin_amdgcn_mfma_f32_32x32x16_bf16(kf[s], qB[s], sb, 0, 0, 0); }
        sm_pv(sa, oA0, oA1, mA, lA, vf, sc);
        sm_pv(sb, oB0, oB1, mB, lB, vf, sc);
#pragma unroll
        for (int s = 0; s < 6; ++s) kf[s] = kn[s];
#pragma unroll
        for (int j = 0; j < 4; ++j) vf[j] = vn[j];
    }
    lA += __shfl_xor(lA, 32); lB += __shfl_xor(lB, 32);
    const float iA = 1.0f / lA, iB = 1.0f / lB;
    float sqA = 0.f, sqB = 0.f;
#pragma unroll
    for (int e = 0; e < 16; ++e) { oA0[e] *= iA; oA1[e] *= iA; oB0[e] *= iB; oB1[e] *= iB; sqA += oA0[e] * oA0[e] + oA1[e] * oA1[e]; sqB += oB0[e] * oB0[e] + oB1[e] * oB1[e]; }
    sqA += __shfl_xor(sqA, 32); sqB += __shfl_xor(sqB, 32);
    if (hh == 0) { xch[w * 64 + ql] = sqA; xch[w * 64 + 32 + ql] = sqB; }
    __syncthreads();
    const LAS float* xq = xch + qs * 256 + ql;
    const float rA = rsqrtf(((xq[0] + xq[64]) + (xq[128] + xq[192])) * (1.0f / 256.0f) + EPS);
    const float rB = rsqrtf(((xq[32] + xq[96]) + (xq[160] + xq[224])) * (1.0f / 256.0f) + EPS);
    bf16_t* yA = (bf16_t*)(ws + OFF_XBA) + (tokbase + q0 + ql) * D + 3 * 256 + h * 64 + 4 * hh;
    bf16_t* yB = yA + 32 * D;
#pragma unroll
    for (int j = 0; j < 4; ++j) {
        u32x2 w0; w0.x = cvt_pk_bf16(oA0[4 * j] * rA, oA0[4 * j + 1] * rA); w0.y = cvt_pk_bf16(oA0[4 * j + 2] * rA, oA0[4 * j + 3] * rA);
        u32x2 w1; w1.x = cvt_pk_bf16(oA1[4 * j] * rA, oA1[4 * j + 1] * rA); w1.y = cvt_pk_bf16(oA1[4 * j + 2] * rA, oA1[4 * j + 3] * rA);
        *(u32x2*)(yA + 8 * j) = w0; *(u32x2*)(yA + 32 + 8 * j) = w1;
        u32x2 w2; w2.x = cvt_pk_bf16(oB0[4 * j] * rB, oB0[4 * j + 1] * rB); w2.y = cvt_pk_bf16(oB0[4 * j + 2] * rB, oB0[4 * j + 3] * rB);
        u32x2 w3; w3.x = cvt_pk_bf16(oB1[4 * j] * rB, oB1[4 * j + 1] * rB); w3.y = cvt_pk_bf16(oB1[4 * j + 2] * rB, oB1[4 * j + 3] * rB);
        *(u32x2*)(yB + 8 * j) = w2; *(u32x2*)(yB + 32 + 8 * j) = w3;
    }
}

__device__ __forceinline__ void attn_phase(KA a, int layer, LAS unsigned char* lds, int wv) {
    AttnP P; P.ws = a->ws; P.nab = a->in[8] + (size_t)layer * 4 * 15 * 31; P.sink = a->in[9] + layer * 4;
    LAS float* xch = (LAS float*)lds;
    for (int i = ltid(wv); i < 4 * 15 * 31; i += 512) xch[1024 + i] = P.nab[i] * LOG2E;
    __syncthreads();
    int it = 0;
    const int G_ = lgrid(), bid_ = lbid();
    const int vcu = (G_ & 7) == 0 ? (bid_ & 7) * (G_ >> 3) + (bid_ >> 3) : bid_;
    for (int u = vcu; u < 256 + 3 * 512; u += G_, ++it) {
        LAS float* x = xch + (it & 1) * 512;
        if (u < 256) attn_mla(P, u, x, wv);
        else {
            const int mode = 1 + ((u - 256) >> 9), unit = (u - 256) & 511;
            if (mode == 1) attn_unit<1>(P, unit, x, xch + 1024, wv);
            else if (mode == 2) attn_unit<2>(P, unit, x, xch + 1024, wv);
            else attn_unit<3>(P, unit, x, xch + 1024, wv);
        }
    }
    __syncthreads();
}

__device__ __forceinline__ void grid_bar(unsigned* bar, unsigned seq, int wv) {
    asm volatile("s_waitcnt vmcnt(0) lgkmcnt(0)" ::: "memory");
    __builtin_amdgcn_s_barrier();
    if (wv == 0) {
        if (vlane() == 0) {
            const unsigned G = (unsigned)lgrid(), b = (unsigned)lbid(), g = b & 7u;
            const unsigned ng = (G - g + 7u) >> 3, ngroups = G < 8u ? G : 8u;
            unsigned* flag = bar + 64 * 9;
            __builtin_amdgcn_fence(__ATOMIC_RELEASE, "agent");
            asm volatile("s_waitcnt vmcnt(0)" ::: "memory");
            const unsigned old = __hip_atomic_fetch_add(bar + 64 * g, 1u, __ATOMIC_RELAXED, __HIP_MEMORY_SCOPE_AGENT);
            bool waitf = true;
            if (old + 1u == seq * ng) {
                __builtin_amdgcn_fence(__ATOMIC_SEQ_CST, "agent");
                const unsigned old2 = __hip_atomic_fetch_add(bar + 64 * 8, 1u, __ATOMIC_RELAXED, __HIP_MEMORY_SCOPE_AGENT);
                if (old2 + 1u == seq * ngroups) { __builtin_amdgcn_fence(__ATOMIC_SEQ_CST, "agent"); __hip_atomic_store(flag, seq, __ATOMIC_RELAXED, __HIP_MEMORY_SCOPE_AGENT); waitf = false; }
            }
            if (waitf) { unsigned spins = 0; while (__hip_atomic_load(flag, __ATOMIC_RELAXED, __HIP_MEMORY_SCOPE_AGENT) < seq) { __builtin_amdgcn_s_sleep(1); if (++spins > (1u << 26)) break; } }
            __builtin_amdgcn_fence(__ATOMIC_ACQUIRE, "agent");
            asm volatile("s_waitcnt vmcnt(0)" ::: "memory");
        }
    }
    __builtin_amdgcn_s_barrier();
    asm volatile("" ::: "memory");
}

template <int PH, bool ZERO = false>
__device__ __forceinline__ void run_phase(LAS unsigned char* lds, int wv) {
    KA a = kargs();
    unsigned char* ws = a->ws; asm volatile("" : "+s"(ws));
    bf16_t* Wbase = (bf16_t*)(ws + OFF_W);
    bf16_t* xbA = (bf16_t*)(ws + OFF_XBA); bf16_t* xbB = (bf16_t*)(ws + OFF_XBB);
    bf16_t* Hb = (bf16_t*)(ws + OFF_H); bf16_t* zl = (bf16_t*)(ws + OFF_ZL); bf16_t* qm = (bf16_t*)(ws + OFF_QM);
    unsigned char* vf = ws + OFF_VT;
    bf16_t* pb = (bf16_t*)(ws + OFF_VT);
    float* ssA = (float*)(ws + OFF_SSA); float* ssB = (float*)(ws + OFF_SSB); float* mst = (float*)(ws + OFF_MST);
    const float* cs64 = (const float*)(ws + OFF_CS64); const float* cs32 = (const float*)(ws + OFF_CS32);
    if constexpr (PH == 0) { if (PH_ON(0)) prologue(a, lds, wv); }
    else if constexpr (PH == NPH - 1) { if (PH_ON(1)) final_norm(a, wv); }
    else {
        constexpr int l = (PH - 1) / 9, k = (PH - 1) % 9;
        bf16_t* WL = Wbase + (size_t)l * WL_SIZE;
        if constexpr (k == 0) { if (PH_ON(2)) { EpiGU E{ssA, Hb}; run_gemm(wv, lds, xbA, D, M, WL + WL_GU1, D, 5632, D, 0, E); } }
        else if constexpr (k == 1) { if (PH_ON(3)) { EpiRes E{a->out, xbB, ssB, ZERO ? 0.f : 0.5f}; run_gemm(wv, lds, Hb, FF, M, WL + WL_D1, FF, D, FF, 0, E); } }
        else if constexpr (k == 2) {
            if (PH_ON(4)) { EpiIn E{ssB, ws, mst, cs64, cs32}; run_gemm(wv, lds, xbB, D, M, WL + WL_IN, D, 2048, D, 0, E); }
            if (PH_ON(5)) { EpiVT E{ssB, vf}; run_gemm(wv, lds, WL + WL_IN + (size_t)2048 * D, D, 512, xbB, D, M, D, 0, E); }
        }
        else if constexpr (k == 3) {
            if (PH_ON(6)) { EpiQ E{mst, qm, cs32}; run_gemm(wv, lds, zl, ZLLD, M, WL + WL_UQ, 256, 512, 256, 0, E); }
            if (PH_ON(7)) { EpiK E{mst, ws}; run_gemm(wv, lds, zl + 256, ZLLD, M, WL + WL_UKV, 128, 256, 128, 0, E); }
            if (PH_ON(8)) { EpiVTM E{mst, vf}; run_gemm(wv, lds, WL + WL_UKV + (size_t)256 * 128, 128, 256, zl + 256, ZLLD, M, 128, 128, E); }
        }
        else if constexpr (k == 4) { if (PH_ON(9)) attn_phase(a, l, lds, wv); }
        else if constexpr (k == 5) { if (PH_ON(3)) { EpiRes E{a->out, xbB, ssB, ZERO ? 0.f : 1.0f}; run_gemm(wv, lds, xbA, D, M, WL + WL_O, D, D, D, 0, E); } }
        else if constexpr (k == 6) { if (PH_ON(2)) { convert_p(a, l, wv); EpiGU E{ssB, Hb}; run_gemm(wv, lds, xbB, D, M, WL + WL_GU2, D, 5632, D, 0, E); } }
        else if constexpr (k == 7) {
            if (PH_ON(3)) { EpiRes E{a->out, xbB, ssB, ZERO ? 0.f : 0.5f}; run_gemm(wv, lds, Hb, FF, M, WL + WL_D2, FF, D, FF, 0, E); }
            if (PH_ON(10)) { EpiPP E{xbA}; run_gemm(wv, lds, pb, PLE, M, WL + WL_PP, PLE, D, PLE, 0, E); }
        }
        else { if (PH_ON(11)) { EpiGate E{a->out, ssB, xbA, ssA, ZERO ? 0.f : 1.0f}; run_gemm(wv, lds, xbB, D, M, WL + WL_PG, D, D, D, 0, E); } }
    }
}
template <int PH>
__device__ __forceinline__ void run_from(LAS unsigned char* lds, int ph_lo, int ph_hi, int wv) {
    if constexpr (PH < NPH) {
        if (PH >= ph_lo && PH < ph_hi) {
            run_phase<PH>(lds, wv);
            if constexpr (PH > 0 && PH < NPH - 1) { if constexpr ((DUPM >> ((PH - 1) % 9)) & 1) { __syncthreads(); run_phase<PH, true>(lds, wv); } }
            if constexpr (PH == 0 && ((DUPM >> 9) & 1)) { __syncthreads(); run_phase<PH>(lds, wv); }
            if (PH + 1 < ph_hi && kargs()->coop) {
                if constexpr (PH == 0) cg::this_grid().sync();
                else { for (int r_ = 0; r_ < BARREP; ++r_) grid_bar((unsigned*)(kargs()->ws + OFF_BAR), (unsigned)((PH - 1) * BARREP + r_ + 1), wv); }
            }
        }
        run_from<PH + 1>(lds, ph_lo, ph_hi, wv);
    }
}
__global__ void __launch_bounds__(512, 2) mega(Args a_unused) {
    extern __shared__ __attribute__((aligned(16))) unsigned char lds_raw[];
    LAS unsigned char* lds = (LAS unsigned char*)lds_raw;
    const int ph_lo = kargs()->ph_lo, ph_hi = kargs()->ph_hi;
    const int wv = __builtin_amdgcn_readfirstlane((int)threadIdx.x >> 6);
    run_from<0>(lds, ph_lo, ph_hi, wv);
}

extern "C" void kernel_launch(void* const* d_in, const int* in_sizes, int n_in, void* d_out, int out_size, void* d_ws, size_t ws_size, hipStream_t stream) {
    static int grid = 0;
    if (grid == 0) {
        if (n_in != 24 || ws_size < WS_END) { fprintf(stderr, "kernel_launch: n_in %d ws %zu (need %zu)\n", n_in, ws_size, (size_t)WS_END); grid = -1; return; }
        int dev = 0, cus = 0, per_cu = 0;
        hipGetDevice(&dev); hipDeviceGetAttribute(&cus, hipDeviceAttributeMultiprocessorCount, dev);
        if (hipFuncSetAttribute((const void*)mega, hipFuncAttributeMaxDynamicSharedMemorySize, LDS_BYTES) != hipSuccess) { fprintf(stderr, "hipFuncSetAttribute failed\n"); grid = -1; return; }
        if (hipOccupancyMaxActiveBlocksPerMultiprocessor(&per_cu, (const void*)mega, 512, LDS_BYTES) != hipSuccess || per_cu < 1) per_cu = 1;
        (void)hipGetLastError();
        grid = cus * per_cu;
    }
    if (grid < 0) return;
    (void)hipMemsetAsync((char*)d_ws + OFF_BAR, 0, 4096, stream);
    Args a{};
    for (int i = 0; i < 24; ++i) a.in[i] = (const float*)d_in[i];
    a.out = (float*)d_out; a.ws = (unsigned char*)d_ws;
#if MULTI_LAUNCH
    for (int ph = 0; ph < NPH; ++ph) {
        a.ph_lo = ph; a.ph_hi = ph + 1; a.coop = 0;
        hipLaunchKernelGGL(mega, dim3(grid), dim3(512), LDS_BYTES, stream, a);
    }
#else
    a.ph_lo = 0; a.ph_hi = NPH; a.coop = 1;
    void* args[] = {&a};
    hipError_t e = hipLaunchCooperativeKernel((void*)mega, dim3(grid), dim3(512), args, LDS_BYTES, stream);
    if (e != hipSuccess) fprintf(stderr, "cooperative launch failed: %s (grid %d)\n", hipGetErrorString(e), grid);
#endif
}
```

```cpp
#include <hip/hip_runtime.h>
#include <hip/hip_cooperative_groups.h>
#include <cstdio>
#include <cstdint>
namespace cg = cooperative_groups;

#ifndef MULTI_LAUNCH
#define MULTI_LAUNCH 0
#endif

#ifndef BARREP
#define BARREP 1
#endif
#ifndef DUPM
#define DUPM 0
#endif
#ifndef PRO_PARTS
#define PRO_PARTS 7
#endif
#ifndef PHM
#define PHM 0xffff
#endif
#define PH_ON(b) (((PHM) >> (b)) & 1)
#define LAS __attribute__((address_space(3)))
typedef unsigned short bf16_t;
typedef short bf16x8 __attribute__((ext_vector_type(8)));
typedef float f32x4 __attribute__((ext_vector_type(4)));
typedef float f32x16 __attribute__((ext_vector_type(16)));
typedef unsigned u32x4 __attribute__((ext_vector_type(4)));
typedef unsigned u32x2 __attribute__((ext_vector_type(2)));

constexpr int M = 32768, T = 2048, D = 1024, FF = 2816, DEPTH = 4, PLE = 256;
constexpr int ZQLD = 768, ZLLD = 384, QLD = 384;
constexpr size_t HEADB = (size_t)16 * 64 * 4096;
constexpr float EPS = 1e-6f;
constexpr float LOG2E = 1.4426950408889634f;

constexpr size_t WL_GU1 = 0, WL_D1 = WL_GU1 + (size_t)5632 * 1024, WL_IN = WL_D1 + (size_t)1024 * 2816, WL_UQ = WL_IN + (size_t)2816 * 1024,
                 WL_UKV = WL_UQ + (size_t)512 * 256, WL_O = WL_UKV + (size_t)512 * 128, WL_GU2 = WL_O + (size_t)1024 * 1024, WL_D2 = WL_GU2 + (size_t)5632 * 1024,
                 WL_PG = WL_D2 + (size_t)1024 * 2816, WL_PP = WL_PG + (size_t)1024 * 1024, WL_SIZE = WL_PP + (size_t)1024 * 256;
constexpr size_t OFF_W = 0;
constexpr size_t OFF_XBA = OFF_W + WL_SIZE * 2 * DEPTH;
constexpr size_t OFF_XBB = OFF_XBA + (size_t)M * D * 2;
constexpr size_t OFF_H = OFF_XBB + (size_t)M * D * 2;
constexpr size_t OFF_ZQ = OFF_H;
constexpr size_t OFF_ZL = OFF_ZQ + (size_t)M * ZQLD * 2;
constexpr size_t OFF_KF = OFF_ZL + (size_t)M * ZLLD * 2;
constexpr size_t OFF_KPE = OFF_KF + 22 * HEADB;
constexpr size_t OFF_VT = OFF_H + (size_t)M * FF * 2;
constexpr size_t OFF_SSA = OFF_VT + 22 * HEADB;
constexpr size_t OFF_SSB = OFF_SSA + (size_t)M * 16 * 4;
constexpr size_t OFF_MST = OFF_SSB + (size_t)M * 16 * 4;
constexpr size_t OFF_CS64 = OFF_MST + (size_t)M * 8 * 4;
constexpr size_t OFF_CS32 = OFF_CS64 + (size_t)T * 64 * 4;
constexpr size_t OFF_BAR = OFF_CS32 + (size_t)T * 32 * 4;
constexpr size_t OFF_QM = OFF_BAR + 4096;
constexpr size_t WS_END = OFF_QM + (size_t)M * QLD * 2;
static_assert(OFF_KPE + (size_t)16 * 64 * 2048 <= OFF_VT, "zq|zl|KF|KPE inside the H region");
static_assert(WS_END <= 626121856, "workspace budget");

constexpr int LDS_BYTES = 147456;
constexpr int NPH = 2 + 9 * DEPTH;

__device__ __forceinline__ unsigned cvt_pk_bf16(float lo, float hi) { unsigned r; asm("v_cvt_pk_bf16_f32 %0, %1, %2" : "=v"(r) : "v"(lo), "v"(hi)); return r; }
__device__ __forceinline__ float bf_lo(unsigned u) { return __uint_as_float(u << 16); }
__device__ __forceinline__ float bf_hi(unsigned u) { return __uint_as_float(u & 0xffff0000u); }
__device__ __forceinline__ float sum4(f32x4 a) { return (a.x + a.y) + (a.z + a.w); }
__device__ __forceinline__ float dot4(f32x4 a) { return (a.x * a.x + a.y * a.y) + (a.z * a.z + a.w * a.w); }
__device__ __forceinline__ float rs16(const float* ss, int row) {
    const f32x4* p = (const f32x4*)(ss + (size_t)row * 16);
    const f32x4 a = p[0], b = p[1], c = p[2], d = p[3];
    return rsqrtf(((sum4(a) + sum4(b)) + (sum4(c) + sum4(d))) * (1.0f / 1024.0f) + EPS);
}
__device__ __forceinline__ int vlane() { int l; asm volatile("v_mbcnt_lo_u32_b32 %0, -1, 0\n\tv_mbcnt_hi_u32_b32 %0, -1, %0" : "=v"(l)); return l; }
__device__ __forceinline__ int ltid(int wv) { return (wv << 6) | vlane(); }
__device__ __forceinline__ int lbid() { int b = blockIdx.x; asm volatile("" : "+s"(b)); return b; }
__device__ __forceinline__ int lgrid() { int g = gridDim.x; asm volatile("" : "+s"(g)); return g; }
__device__ __forceinline__ float sigmoidf_(float v) { return __builtin_amdgcn_rcpf(1.0f + __expf(-v)); }

namespace pg8 {
constexpr int BM = 256, BK = 64, HALF = 128, HTB = HALF * BK * 2, STAGE_BYTES = 8 * HTB, NXCD = 8, WGM = 8;
__host__ __device__ __forceinline__ int lds_byte(int r, int c) { const int st = (r >> 4) * 2 + (c >> 5), rr = r & 15, cc = c & 31, ob = rr * 64 + cc * 2; return st * 1024 + (ob ^ (((ob >> 9) & 1) << 5)); }
__host__ __device__ __forceinline__ void stage_rc(int b, int& R, int& C) { const int st = b / 1024, sb = b % 1024, swz = sb ^ (((sb >> 9) & 1) << 5); R = (st >> 1) * 16 + swz / 64; C = (st & 1) * 32 + (swz % 64) / 2; }
__host__ __device__ __forceinline__ int perm32(int rho) { const int n = rho >> 4, i = rho & 15; return 8 * (i >> 2) + 4 * n + (i & 3); }

struct Unit { int pm, pn; };
struct Gemm { const bf16_t* A; const bf16_t* Bt; int lda, ldb, K; };

struct StaticOrder {
    int nM, nN, nwg, G, c;
    __device__ void init(int Mr, int Nc, int G_, int c_) { nM = Mr / BM; nN = Nc / BM; nwg = nM * nN; G = G_; c = c_; }
    __device__ bool next(int i, Unit& u) const {
        const long L = (long)i * G + c; if (L >= nwg) return false;
        int wgid = (int)L; { const int q = nwg / NXCD, r = nwg % NXCD, xcd = wgid % NXCD, off = wgid / NXCD; wgid = (xcd < r ? xcd * (q + 1) : r * (q + 1) + (xcd - r) * q) + off; }
        const int nig = WGM * nN, gid = wgid / nig, fm = gid * WGM, gsz = (nM - fm) < WGM ? (nM - fm) : WGM;
        u.pm = fm + ((wgid % nig) % gsz); u.pn = (wgid % nig) / gsz; return true;
    }
};

template <class Epi>
__device__ __forceinline__ void gemm_phase(LAS unsigned char* lds, const Gemm g, const StaticOrder& S, const Epi& E, int wv) {
    const int tid = ltid(wv);
    const int wid = wv, lane = tid & 63, wr = wid >> 2, wc = wid & 3, fr = lane & 15, fq = lane >> 4;
    const int K = g.K, nt = K / BK;
    unsigned voffA[2], voffB[2];
#pragma unroll
    for (int i = 0; i < 2; ++i) { int R, C; stage_rc(tid * 16 + i * 8192, R, C); const int Rb = (R & ~31) + perm32(R & 31);
        voffA[i] = (unsigned)(R * g.lda + C) * 2u; voffB[i] = (unsigned)(Rb * g.ldb + C) * 2u; }
    const size_t kstep = (size_t)(BK * 2);
    const size_t hstepA = (size_t)HALF * g.lda * 2, hstepB = (size_t)HALF * g.ldb * 2;
    const size_t tstepA = 2 * hstepA, tstepB = 2 * hstepB;
    const unsigned ldsw = (unsigned)wid * 1024u;
    const int aoff = lds_byte(wr * 64 + fr, fq * 8), boff = lds_byte(wc * 32 + fr, fq * 8);
#define PG8_SA(b, h) (((b) * 2 + (h)) * HTB)
#define PG8_SB(b, h) ((4 + (b) * 2 + (h)) * HTB)
#define PG8_STAGE(bufoff, gbase, voff) do { _Pragma("unroll") for (int _i = 0; _i < 2; ++_i) \
        __builtin_amdgcn_global_load_lds((const unsigned*)((const char*)(gbase) + (voff)[_i]), (LAS unsigned*)(lds + (bufoff) + ldsw + _i * 8192), 16, 0, 0); } while (0)
#define PG8_LDA(dst, b, h) do { _Pragma("unroll") for (int m = 0; m < 4; ++m) _Pragma("unroll") for (int k = 0; k < 2; ++k) dst[m][k] = *(const LAS bf16x8*)(lds + PG8_SA(b, h) + aoff + m * 2048 + k * 1024); } while (0)
#define PG8_LDB(dst, b, h) do { _Pragma("unroll") for (int n = 0; n < 2; ++n) _Pragma("unroll") for (int k = 0; k < 2; ++k) dst[n][k] = *(const LAS bf16x8*)(lds + PG8_SB(b, h) + boff + n * 2048 + k * 1024); } while (0)
#define PG8_MMA(ai, bj, At, Bt) do { __builtin_amdgcn_s_setprio(1); _Pragma("unroll") for (int m = 0; m < 4; ++m) _Pragma("unroll") for (int n = 0; n < 2; ++n) _Pragma("unroll") for (int k = 0; k < 2; ++k) \
        acc[ai][bj][m][n] = __builtin_amdgcn_mfma_f32_16x16x32_bf16(Bt[n][k], At[m][k], acc[ai][bj][m][n], 0, 0, 0); __builtin_amdgcn_s_setprio(0); } while (0)
#define PG8_WAIT_V(n) asm volatile("s_waitcnt vmcnt(" #n ")" ::: "memory")
#define PG8_WAIT_L(n) asm volatile("s_waitcnt lgkmcnt(" #n ")" ::: "memory")
#define PG8_BAR __builtin_amdgcn_s_barrier()
#define PG8_SCHED __builtin_amdgcn_sched_barrier(0)
    Unit cur, nxt; int ui = 0;
    if (!S.next(0, cur)) return;
    f32x4 acc[2][2][4][2];
#pragma unroll
    for (int a = 0; a < 2; ++a)
#pragma unroll
        for (int b = 0; b < 2; ++b)
#pragma unroll
            for (int m = 0; m < 4; ++m)
#pragma unroll
                for (int n = 0; n < 2; ++n) acc[a][b][m][n] = (f32x4){0.f, 0.f, 0.f, 0.f};
    bf16x8 At[4][2], B0[2][2], B1[2][2];
    const char* cA = (const char*)g.A + (size_t)cur.pm * tstepA; const char* cB = (const char*)g.Bt + (size_t)cur.pn * tstepB;
    PG8_STAGE(PG8_SB(0, 0), cB, voffB); PG8_STAGE(PG8_SB(0, 1), cB + hstepB, voffB); PG8_STAGE(PG8_SA(0, 0), cA, voffA); PG8_STAGE(PG8_SA(0, 1), cA + hstepA, voffA);
    if (wr == 1) PG8_BAR;
    PG8_WAIT_V(2); PG8_BAR;
    PG8_STAGE(PG8_SB(1, 0), cB + kstep, voffB); PG8_STAGE(PG8_SA(1, 0), cA + kstep, voffA); PG8_STAGE(PG8_SB(1, 1), cB + hstepB + kstep, voffB);
    PG8_WAIT_V(6); PG8_BAR;
    for (;;) {
        const bool has_next = S.next(ui + 1, nxt);
        const char* nA = has_next ? (const char*)g.A + (size_t)nxt.pm * tstepA : cA; const char* nB = has_next ? (const char*)g.Bt + (size_t)nxt.pn * tstepB : cB;
        for (int t = 0; t < nt; t += 2) {
            const bool last = (t == nt - 2);
            const char* a1 = cA + (size_t)(t + 1) * kstep;
            const char* a2 = last ? nA : cA + (size_t)(t + 2) * kstep; const char* b2 = last ? nB : cB + (size_t)(t + 2) * kstep;
            const char* a3 = a2 + kstep; const char* b3 = b2 + kstep;
            PG8_LDB(B0, 0, 0); PG8_LDB(B1, 0, 1); PG8_SCHED; PG8_LDA(At, 0, 0); PG8_STAGE(PG8_SA(1, 1), a1 + hstepA, voffA);
            PG8_WAIT_V(8); PG8_WAIT_L(0); PG8_BAR; PG8_MMA(0, 0, At, B0); PG8_MMA(0, 1, At, B1); PG8_BAR; PG8_SCHED;
            PG8_LDA(At, 0, 1); PG8_STAGE(PG8_SB(0, 0), b2, voffB); PG8_STAGE(PG8_SB(0, 1), b2 + hstepB, voffB); PG8_STAGE(PG8_SA(0, 0), a2, voffA);
            PG8_WAIT_V(8); PG8_WAIT_L(0); PG8_BAR; PG8_MMA(1, 0, At, B0); PG8_MMA(1, 1, At, B1); PG8_BAR; PG8_SCHED;
            PG8_LDB(B0, 1, 0); PG8_LDB(B1, 1, 1); PG8_SCHED; PG8_LDA(At, 1, 0); PG8_STAGE(PG8_SA(0, 1), a2 + hstepA, voffA);
            PG8_WAIT_V(8); PG8_WAIT_L(0); PG8_BAR; PG8_MMA(0, 0, At, B0); PG8_MMA(0, 1, At, B1); PG8_BAR; PG8_SCHED;
            PG8_LDA(At, 1, 1); PG8_STAGE(PG8_SB(1, 0), b3, voffB); PG8_STAGE(PG8_SB(1, 1), b3 + hstepB, voffB); PG8_STAGE(PG8_SA(1, 0), a3, voffA);
            PG8_WAIT_V(8); PG8_WAIT_L(0); PG8_BAR; PG8_MMA(1, 0, At, B0); PG8_MMA(1, 1, At, B1); PG8_BAR; PG8_SCHED;
        }
        if (wr == 0) PG8_BAR;
        E(acc, cur, wr, wc, fr, fq);
        if (!has_next) break;
#pragma unroll
        for (int a = 0; a < 2; ++a)
#pragma unroll
            for (int b = 0; b < 2; ++b)
#pragma unroll
                for (int m = 0; m < 4; ++m)
#pragma unroll
                    for (int n = 0; n < 2; ++n) acc[a][b][m][n] = (f32x4){0.f, 0.f, 0.f, 0.f};
        cur = nxt; cA = nA; cB = nB; ++ui;
        if (wr == 1) PG8_BAR;
    }
    PG8_WAIT_V(0);
    PG8_BAR;
#undef PG8_SA
#undef PG8_SB
#undef PG8_STAGE
#undef PG8_LDA
#undef PG8_LDB
#undef PG8_MMA
#undef PG8_WAIT_V
#undef PG8_WAIT_L
#undef PG8_BAR
#undef PG8_SCHED
}
}
using pg8::Unit;
typedef const f32x4 (&AccRef)[2][2][4][2];

struct EpiGU {
    const float* ss; bf16_t* H;
    __device__ __forceinline__ void operator()(AccRef acc, const Unit& u, int wr, int wc, int, int) const { const int lane_ = vlane(); const int fr = lane_ & 15, fq = lane_ >> 4;
#pragma unroll
        for (int ai = 0; ai < 2; ++ai)
#pragma unroll
            for (int m = 0; m < 4; ++m) {
                const int row = u.pm * 256 + ai * 128 + wr * 64 + m * 16 + fr;
                asm volatile("" ::: "memory");
                const float r = rs16(ss, row);
                const f32x4 g0 = acc[ai][0][m][0] * r, g1 = acc[ai][0][m][1] * r, v0 = acc[ai][1][m][0] * r, v1 = acc[ai][1][m][1] * r;
                u32x4 w;
                w.x = cvt_pk_bf16(g0.x * sigmoidf_(g0.x) * v0.x, g0.y * sigmoidf_(g0.y) * v0.y); w.y = cvt_pk_bf16(g0.z * sigmoidf_(g0.z) * v0.z, g0.w * sigmoidf_(g0.w) * v0.w);
                w.z = cvt_pk_bf16(g1.x * sigmoidf_(g1.x) * v1.x, g1.y * sigmoidf_(g1.y) * v1.y); w.w = cvt_pk_bf16(g1.z * sigmoidf_(g1.z) * v1.z, g1.w * sigmoidf_(g1.w) * v1.w);
                *(u32x4*)(H + (size_t)row * FF + u.pn * 128 + wc * 32 + fq * 8) = w;
            }
    }
};
struct EpiRes {
    float* X; bf16_t* xb; float* ssOut; float alpha;
    __device__ __forceinline__ void operator()(AccRef acc, const Unit& u, int wr, int wc, int, int) const { const int lane_ = vlane(); const int fr = lane_ & 15, fq = lane_ >> 4;
#pragma unroll
        for (int ai = 0; ai < 2; ++ai)
#pragma unroll
            for (int m = 0; m < 4; ++m) {
                const int row = u.pm * 256 + ai * 128 + wr * 64 + m * 16 + fr;
                asm volatile("" ::: "memory");
                float sq = 0.f;
#pragma unroll
                for (int bj = 0; bj < 2; ++bj) {
                    const size_t off = (size_t)row * D + u.pn * 256 + bj * 128 + wc * 32 + fq * 8;
                    f32x4 x0 = *(const f32x4*)(X + off), x1 = *(const f32x4*)(X + off + 4);
                    x0 += acc[ai][bj][m][0] * alpha; x1 += acc[ai][bj][m][1] * alpha;
                    *(f32x4*)(X + off) = x0; *(f32x4*)(X + off + 4) = x1;
                    sq += dot4(x0) + dot4(x1);
                    u32x4 w; w.x = cvt_pk_bf16(x0.x, x0.y); w.y = cvt_pk_bf16(x0.z, x0.w); w.z = cvt_pk_bf16(x1.x, x1.y); w.w = cvt_pk_bf16(x1.z, x1.w);
                    *(u32x4*)(xb + off) = w;
                }
                sq += __shfl_xor(sq, 16); sq += __shfl_xor(sq, 32);
                if (fq == 0) ssOut[(size_t)row * 16 + u.pn * 4 + wc] = sq;
            }
    }
};
struct EpiGate {
    float* X; const float* ssIn; bf16_t* ppxb; float* ssOut; float gsc;
    __device__ __forceinline__ void operator()(AccRef acc, const Unit& u, int wr, int wc, int, int) const { const int lane_ = vlane(); const int fr = lane_ & 15, fq = lane_ >> 4;
#pragma unroll
        for (int ai = 0; ai < 2; ++ai)
#pragma unroll
            for (int m = 0; m < 4; ++m) {
                const int row = u.pm * 256 + ai * 128 + wr * 64 + m * 16 + fr;
                asm volatile("" ::: "memory");
                const float r = rs16(ssIn, row);
                float sq = 0.f;
#pragma unroll
                for (int bj = 0; bj < 2; ++bj) {
                    const size_t off = (size_t)row * D + u.pn * 256 + bj * 128 + wc * 32 + fq * 8;
                    f32x4 x0 = *(const f32x4*)(X + off), x1 = *(const f32x4*)(X + off + 4);
                    const u32x4 pp = *(const u32x4*)(ppxb + off); const float gs = gsc;
                    const f32x4 a0 = acc[ai][bj][m][0] * r, a1 = acc[ai][bj][m][1] * r;
                    x0.x += sigmoidf_(a0.x) * (bf_lo(pp.x) * gs); x0.y += sigmoidf_(a0.y) * (bf_hi(pp.x) * gs); x0.z += sigmoidf_(a0.z) * (bf_lo(pp.y) * gs); x0.w += sigmoidf_(a0.w) * (bf_hi(pp.y) * gs);
                    x1.x += sigmoidf_(a1.x) * (bf_lo(pp.z) * gs); x1.y += sigmoidf_(a1.y) * (bf_hi(pp.z) * gs); x1.z += sigmoidf_(a1.z) * (bf_lo(pp.w) * gs); x1.w += sigmoidf_(a1.w) * (bf_hi(pp.w) * gs);
                    *(f32x4*)(X + off) = x0; *(f32x4*)(X + off + 4) = x1;
                    sq += dot4(x0) + dot4(x1);
                    u32x4 w; w.x = cvt_pk_bf16(x0.x, x0.y); w.y = cvt_pk_bf16(x0.z, x0.w); w.z = cvt_pk_bf16(x1.x, x1.y); w.w = cvt_pk_bf16(x1.z, x1.w);
                    *(u32x4*)(ppxb + off) = w;
                }
                sq += __shfl_xor(sq, 16); sq += __shfl_xor(sq, 32);
                if (fq == 0) ssOut[(size_t)row * 16 + u.pn * 4 + wc] = sq;
            }
    }
};
__device__ __forceinline__ void rope_rot(f32x4& v0, f32x4& v1, const float* cs) {
    const f32x4 c = *(const f32x4*)cs, s = *(const f32x4*)(cs + 4);
    const f32x4 a = v0 * c - v1 * s, b = v1 * c + v0 * s; v0 = a; v1 = b;
}
__device__ __forceinline__ void vstore1(unsigned char* vf, int vhead, int dd, int b, int ppos, bf16_t val);
struct EpiIn {
    const float* ss; unsigned char* ws; float* mst; const float* cs64; const float* cs32;
    __device__ __forceinline__ void operator()(AccRef acc, const Unit& u, int wr, int wc, int, int) const { const int lane_ = vlane(); const int fr = lane_ & 15, fq = lane_ >> 4;
#pragma unroll
        for (int ai = 0; ai < 2; ++ai)
#pragma unroll
            for (int m = 0; m < 4; ++m) {
                const int row = u.pm * 256 + ai * 128 + wr * 64 + m * 16 + fr;
                asm volatile("" ::: "memory");
                const float r = rs16(ss, row);
                const int pos = row & (T - 1), b = row >> 11;
                float sq = 0.f;
#pragma unroll
                for (int bj = 0; bj < 2; ++bj) {
                    const int gcol = u.pn * 256 + bj * 128 + wc * 32;
                    f32x4 v0 = acc[ai][bj][m][0] * r, v1 = acc[ai][bj][m][1] * r;
                    const bool r64 = (gcol >= 512 && gcol < 896) || (gcol >= 1024 && gcol < 1536);
                    if (r64) rope_rot(v0, v1, cs64 + ((size_t)pos * 8 + 4 * ((gcol >> 5) & 1) + fq) * 8);
                    if (gcol == 1920) rope_rot(v0, v1, cs32 + ((size_t)pos * 4 + fq) * 8);
                    if (u.pn == 6 || (u.pn == 7 && bj == 0)) sq += dot4(v0) + dot4(v1);
                    u32x4 w; w.x = cvt_pk_bf16(v0.x, v0.y); w.y = cvt_pk_bf16(v0.z, v0.w); w.z = cvt_pk_bf16(v1.x, v1.y); w.w = cvt_pk_bf16(v1.z, v1.w);
                    const int c8 = ((gcol & 63) >> 3) + fq;
                    const size_t frag = (size_t)(c8 >> 1) * 1024 + (size_t)((pos & 31) + 32 * (c8 & 1)) * 16;
                    const size_t rec = ((size_t)b * 64 + (pos >> 5)) * 4096;
                    if (gcol < 256) *(u32x4*)(ws + OFF_ZQ + ((size_t)row * ZQLD + gcol + fq * 8) * 2) = w;
                    else if (gcol < 512) *(u32x4*)(ws + OFF_KF + (size_t)((gcol - 256) >> 6) * HEADB + rec + frag) = w;
                    else if (gcol < 768) *(u32x4*)(ws + OFF_ZQ + ((size_t)row * ZQLD + (gcol - 256) + fq * 8) * 2) = w;
                    else if (gcol < 896) *(u32x4*)(ws + OFF_KF + (size_t)(4 + ((gcol - 768) >> 6)) * HEADB + rec + frag) = w;
                    else if (gcol < 1024) {
                        const int dd0 = (gcol - 896) + fq * 8; const unsigned ww[4] = {w.x, w.y, w.z, w.w};
#pragma unroll
                        for (int e = 0; e < 8; ++e) vstore1(ws + OFF_VT, 4 + (dd0 >> 6), (dd0 & 63) + e, b, pos, (bf16_t)((e & 1) ? (ww[e >> 1] >> 16) : (ww[e >> 1] & 0xffffu)));
                    }
                    else if (gcol < 1280) *(u32x4*)(ws + OFF_ZQ + ((size_t)row * ZQLD + (gcol - 512) + fq * 8) * 2) = w;
                    else if (gcol < 1536) {
                        const int hd = (gcol - 1280) >> 6;
                        *(u32x4*)(ws + OFF_KF + (size_t)(6 + hd) * HEADB + rec + frag) = w;
                        const int p4 = (pos & 3) * 512 + (pos >> 2), p16 = (pos & 15) * 128 + (pos >> 4);
                        *(u32x4*)(ws + OFF_KF + (size_t)(10 + hd) * HEADB + ((size_t)b * 64 + (p4 >> 5)) * 4096 + (size_t)(c8 >> 1) * 1024 + (size_t)((p4 & 31) + 32 * (c8 & 1)) * 16) = w;
                        *(u32x4*)(ws + OFF_KF + (size_t)(14 + hd) * HEADB + ((size_t)b * 64 + (p16 >> 5)) * 4096 + (size_t)(c8 >> 1) * 1024 + (size_t)((p16 & 31) + 32 * (c8 & 1)) * 16) = w;
                    }
                    else if (gcol < 1920) *(u32x4*)(ws + OFF_ZL + ((size_t)row * ZLLD + (gcol - 1536) + fq * 8) * 2) = w;
                    else if (gcol == 1920) *(u32x4*)(ws + OFF_KPE + ((size_t)b * 64 + (pos >> 5)) * 2048 + (size_t)(fq >> 1) * 1024 + (size_t)((pos & 31) + 32 * (fq & 1)) * 16) = w;
                }
                if (u.pn >= 6) {
                    sq += __shfl_xor(sq, 16); sq += __shfl_xor(sq, 32);
                    if (fq == 0) mst[(size_t)row * 8 + (u.pn - 6) * 4 + wc] = sq;
                }
            }
    }
};
__device__ __forceinline__ void vstore8(unsigned char* vf, int vhead, int dd, int tok0, u32x4 w) {
    const int b = tok0 >> 11, pos0 = tok0 & (T - 1), idx0 = pos0 & 31;
    unsigned char* p = vf + (size_t)vhead * HEADB + ((size_t)b * 64 + (pos0 >> 5)) * 4096 + (size_t)((dd >> 5) * 2 + (idx0 >> 4)) * 1024 + (size_t)(dd & 31) * 16 + ((idx0 >> 3) & 1) * 8;
    u32x2 lo; lo.x = w.x; lo.y = w.y; u32x2 hi; hi.x = w.z; hi.y = w.w;
    *(u32x2*)p = lo; *(u32x2*)(p + 512) = hi;
}
__device__ __forceinline__ void vstore1(unsigned char* vf, int vhead, int dd, int b, int ppos, bf16_t val) {
    const int idx = ppos & 31, r16 = idx & 15;
    unsigned char* p = vf + (size_t)vhead * HEADB + ((size_t)b * 64 + (ppos >> 5)) * 4096 + (size_t)((dd >> 5) * 2 + (idx >> 4)) * 1024 + (size_t)((dd & 31) + 32 * ((r16 >> 2) & 1)) * 16 + (r16 >> 3) * 8 + (r16 & 3) * 2;
    *(bf16_t*)p = val;
}
struct EpiVT {
    const float* ss; unsigned char* vf;
    __device__ __forceinline__ void operator()(AccRef acc, const Unit& u, int wr, int wc, int, int) const { const int lane_ = vlane(); const int fr = lane_ & 15, fq = lane_ >> 4;
#pragma unroll
        for (int bj = 0; bj < 2; ++bj) {
            const int tok0 = u.pn * 256 + bj * 128 + wc * 32 + fq * 8;
            float rs[8];
#pragma unroll
            for (int e = 0; e < 8; ++e) rs[e] = rs16(ss, tok0 + e);
#pragma unroll
            for (int ai = 0; ai < 2; ++ai) {
                const int rbase = u.pm * 256 + ai * 128;
                const bool dil = rbase >= 256;
#pragma unroll
                for (int m = 0; m < 4; ++m) {
                    const int row = rbase + wr * 64 + m * 16 + fr;
                    asm volatile("" ::: "memory");
                    const f32x4 a0 = acc[ai][bj][m][0], a1 = acc[ai][bj][m][1];
                    u32x4 w; w.x = cvt_pk_bf16(a0.x * rs[0], a0.y * rs[1]); w.y = cvt_pk_bf16(a0.z * rs[2], a0.w * rs[3]);
                    w.z = cvt_pk_bf16(a1.x * rs[4], a1.y * rs[5]); w.w = cvt_pk_bf16(a1.z * rs[6], a1.w * rs[7]);
                    const int vhead = (row >> 6) + (dil ? 2 : 0), dd = row & 63;
                    vstore8(vf, vhead, dd, tok0, w);
                    if (dil) {
                        const int b = tok0 >> 11, t0 = tok0 & (T - 1);
                        const unsigned ww[4] = {w.x, w.y, w.z, w.w};
#pragma unroll
                        for (int e = 0; e < 8; ++e) {
                            const int t = t0 + e; const bf16_t val = (bf16_t)((e & 1) ? (ww[e >> 1] >> 16) : (ww[e >> 1] & 0xffffu));
                            vstore1(vf, vhead + 4, dd, b, (t & 3) * 512 + (t >> 2), val);
                            vstore1(vf, vhead + 8, dd, b, (t & 15) * 128 + (t >> 4), val);
                        }
                    }
                }
            }
        }
    }
};
struct EpiQ {
    const float* mst; bf16_t* qm; const float* cs32;
    __device__ __forceinline__ void operator()(AccRef acc, const Unit& u, int wr, int wc, int, int) const { const int lane_ = vlane(); const int fr = lane_ & 15, fq = lane_ >> 4;
#pragma unroll
        for (int ai = 0; ai < 2; ++ai)
#pragma unroll
            for (int m = 0; m < 4; ++m) {
                const int row = u.pm * 256 + ai * 128 + wr * 64 + m * 16 + fr;
                asm volatile("" ::: "memory");
                const f32x4 st = *(const f32x4*)(mst + (size_t)row * 8);
                const float r = rsqrtf(sum4(st) * (1.0f / 256.0f) + EPS);
                const int pos = row & (T - 1);
#pragma unroll
                for (int bj = 0; bj < 2; ++bj) {
                    const int gcol = u.pn * 256 + bj * 128 + wc * 32;
                    if (gcol >= 384) continue;
                    f32x4 v0 = acc[ai][bj][m][0] * r, v1 = acc[ai][bj][m][1] * r;
                    if (((gcol >> 5) % 3) == 2) rope_rot(v0, v1, cs32 + ((size_t)pos * 4 + fq) * 8);
                    u32x4 w; w.x = cvt_pk_bf16(v0.x, v0.y); w.y = cvt_pk_bf16(v0.z, v0.w); w.z = cvt_pk_bf16(v1.x, v1.y); w.w = cvt_pk_bf16(v1.z, v1.w);
                    *(u32x4*)(qm + (size_t)row * QLD + gcol + fq * 8) = w;
                }
            }
    }
};
struct EpiK {
    const float* mst; unsigned char* ws;
    __device__ __forceinline__ void operator()(AccRef acc, const Unit& u, int wr, int wc, int, int) const { const int lane_ = vlane(); const int fr = lane_ & 15, fq = lane_ >> 4;
#pragma unroll
        for (int ai = 0; ai < 2; ++ai)
#pragma unroll
            for (int m = 0; m < 4; ++m) {
                const int row = u.pm * 256 + ai * 128 + wr * 64 + m * 16 + fr;
                asm volatile("" ::: "memory");
                const f32x4 st = *(const f32x4*)(mst + (size_t)row * 8 + 4);
                const float r = rsqrtf(sum4(st) * (1.0f / 128.0f) + EPS);
#pragma unroll
                for (int bj = 0; bj < 2; ++bj) {
                    const f32x4 v0 = acc[ai][bj][m][0] * r, v1 = acc[ai][bj][m][1] * r;
                    u32x4 w; w.x = cvt_pk_bf16(v0.x, v0.y); w.y = cvt_pk_bf16(v0.z, v0.w); w.z = cvt_pk_bf16(v1.x, v1.y); w.w = cvt_pk_bf16(v1.z, v1.w);
                    const int col0 = bj * 128 + wc * 32, c8 = ((col0 & 63) >> 3) + fq, pos = row & (T - 1);
                    *(u32x4*)(ws + OFF_KF + (size_t)(18 + (col0 >> 6)) * HEADB + ((size_t)(row >> 11) * 64 + (pos >> 5)) * 4096 + (size_t)(c8 >> 1) * 1024 + (size_t)((pos & 31) + 32 * (c8 & 1)) * 16) = w;
                }
            }
    }
};
struct EpiVTM {
    const float* mst; unsigned char* vf;
    __device__ __forceinline__ void operator()(AccRef acc, const Unit& u, int wr, int wc, int, int) const { const int lane_ = vlane(); const int fr = lane_ & 15, fq = lane_ >> 4;
#pragma unroll
        for (int bj = 0; bj < 2; ++bj) {
            const int tok0 = u.pn * 256 + bj * 128 + wc * 32 + fq * 8;
            float rs[8];
#pragma unroll
            for (int e = 0; e < 8; ++e) { const f32x4 st = *(const f32x4*)(mst + (size_t)(tok0 + e) * 8 + 4); rs[e] = rsqrtf(sum4(st) * (1.0f / 128.0f) + EPS); }
#pragma unroll
            for (int ai = 0; ai < 2; ++ai)
#pragma unroll
                for (int m = 0; m < 4; ++m) {
                    const int row = ai * 128 + wr * 64 + m * 16 + fr;
                    asm volatile("" ::: "memory");
                    const f32x4 a0 = acc[ai][bj][m][0], a1 = acc[ai][bj][m][1];
                    u32x4 w; w.x = cvt_pk_bf16(a0.x * rs[0], a0.y * rs[1]); w.y = cvt_pk_bf16(a0.z * rs[2], a0.w * rs[3]);
                    w.z = cvt_pk_bf16(a1.x * rs[4], a1.y * rs[5]); w.w = cvt_pk_bf16(a1.z * rs[6], a1.w * rs[7]);
                    vstore8(vf, 18 + (row >> 6), row & 63, tok0, w);
                }
        }
    }
};
struct EpiPP {
    bf16_t* O;
    __device__ __forceinline__ void operator()(AccRef acc, const Unit& u, int wr, int wc, int, int) const { const int lane_ = vlane(); const int fr = lane_ & 15, fq = lane_ >> 4;
#pragma unroll
        for (int ai = 0; ai < 2; ++ai)
#pragma unroll
            for (int m = 0; m < 4; ++m) {
                const int row = u.pm * 256 + ai * 128 + wr * 64 + m * 16 + fr;
                asm volatile("" ::: "memory");
#pragma unroll
                for (int bj = 0; bj < 2; ++bj) {
                    const f32x4 v0 = acc[ai][bj][m][0], v1 = acc[ai][bj][m][1];
                    u32x4 w; w.x = cvt_pk_bf16(v0.x, v0.y); w.y = cvt_pk_bf16(v0.z, v0.w); w.z = cvt_pk_bf16(v1.x, v1.y); w.w = cvt_pk_bf16(v1.z, v1.w);
                    *(u32x4*)(O + (size_t)row * D + u.pn * 256 + bj * 128 + wc * 32 + fq * 8) = w;
                }
            }
    }
};

template <class Epi>
__device__ __forceinline__ void run_gemm(int wv, LAS unsigned char* lds, const bf16_t* A, int lda, int rows, const bf16_t* Bt, int ldb, int cols, int K, int cshift, const Epi& E) {
    pg8::Gemm g{A, Bt, lda, ldb, K};
    pg8::StaticOrder S; const int G_ = lgrid(); S.init(rows, cols, G_, (lbid() + cshift) % G_);
    pg8::gemm_phase<Epi>(lds, g, S, E, wv);
}

__device__ __forceinline__ int p64(int d) { return d < 32 ? 8 * (d >> 2) + (d & 3) : 8 * ((d - 32) >> 2) + 4 + (d & 3); }
__device__ __forceinline__ int p32(int d) { return d < 16 ? 8 * (d >> 2) + (d & 3) : 8 * ((d - 16) >> 2) + 4 + (d & 3); }
__device__ __forceinline__ int maprow(int mapid, int c) {
    switch (mapid) {
        case 0: return c;
        case 1: return (c >> 7) * 256 + (c & 127);
        case 2: return (c >> 7) * 256 + 128 + (c & 127);
        case 3: {
            if (c < 768) return c < 512 ? c : 2048 + (c - 512);
            c -= 768;
            if (c < 512) return c < 384 ? 512 + (c >> 6) * 64 + p64(c & 63) : 896 + (c - 384);
            c -= 512;
            if (c < 768) return c < 512 ? 1024 + (c >> 6) * 64 + p64(c & 63) : 2048 + 256 + (c - 512);
            c -= 768;
            if (c < 256) return 1536 + c;
            if (c < 384) return 1792 + (c - 256);
            return 1920 + p32(c - 384);
        }
        case 4: { const int h = c / 96, e = c % 96; return e < 64 ? 96 * h + e : 96 * h + 64 + p32(e - 64); }
        default: { const int h = c >> 7, e = c & 127; return e < 64 ? 64 * h + e : 256 + 64 * h + (e - 64); }
    }
}
__device__ __forceinline__ void tr_item(const float* W, int K, int N, const float* gain, bf16_t* dst, int mapid, int item, LAS float* s, int wv) {
    const int tid = ltid(wv);
    const int ncb = (N + 255) >> 8, kb = item / ncb, cb = item % ncb, k0 = kb * 64, c0 = cb * 256;
#pragma unroll
    for (int i = 0; i < 8; ++i) {
        const int kk = i * 8 + (tid >> 6), col = (tid & 63) * 4;
        f32x4 v = (f32x4){0.f, 0.f, 0.f, 0.f};
        if (c0 + col < N) v = *(const f32x4*)(W + (size_t)(k0 + kk) * N + c0 + col);
        if (gain) v *= gain[k0 + kk];
        *(LAS f32x4*)(s + kk * 260 + col) = v;
    }
    __syncthreads();
    const int cc = tid & 255, kh = tid >> 8, c = c0 + cc;
    if (c < N) {
        const int drow = maprow(mapid, c);
        bf16_t* o = dst + (size_t)drow * K + k0 + kh * 32;
#pragma unroll
        for (int q = 0; q < 4; ++q) {
            const LAS float* sp = s + (kh * 32 + q * 8) * 260 + cc;
            u32x4 w; w.x = cvt_pk_bf16(sp[0], sp[260]); w.y = cvt_pk_bf16(sp[2 * 260], sp[3 * 260]); w.z = cvt_pk_bf16(sp[4 * 260], sp[5 * 260]); w.w = cvt_pk_bf16(sp[6 * 260], sp[7 * 260]);
            *(u32x4*)(o + q * 8) = w;
        }
    }
    __syncthreads();
}

struct Args { const float* in[24]; float* out; unsigned char* ws; int ph_lo, ph_hi, coop, pad; };
typedef const __attribute__((address_space(4))) Args* KA;
__device__ __forceinline__ KA kargs() { KA p = (KA)__builtin_amdgcn_kernarg_segment_ptr(); asm volatile("" : "+s"(p)); return p; }

__device__ __forceinline__ void zero_rows(bf16_t* base, int row0, int nrows, int K, int gt, int ngt) {
    const size_t n16 = (size_t)nrows * K / 8; u32x4* p = (u32x4*)(base + (size_t)row0 * K);
    for (size_t i = gt; i < n16; i += ngt) p[i] = (u32x4){0u, 0u, 0u, 0u};
}

__device__ __forceinline__ void prologue(KA a, LAS unsigned char* lds, int wv) {
    LAS float* s = (LAS float*)lds;
    const int G = lgrid(), bid = lbid(), tid = ltid(wv);
    bf16_t* Wbase = (bf16_t*)(a->ws + OFF_W);
#if PRO_PARTS & 1
    constexpr int I_FFN = 16 * 11, I_DN = 44 * 4, I_IN = 16 * 10, I_UQ = 4 * 2, I_UKV = 2 * 2, I_O = 16 * 4, I_PP = 4 * 4;
    constexpr int I_LAYER = 4 * I_FFN + 2 * I_DN + I_IN + I_UQ + I_UKV + 2 * I_O + I_PP;
    for (int it = bid; it < I_LAYER * DEPTH; it += G) {
        const int l = it / I_LAYER; int r = it % I_LAYER;
        int sel = 0;
        if (r >= I_FFN) { r -= I_FFN; sel = 1;
        if (r >= I_FFN) { r -= I_FFN; sel = 2;
        if (r >= I_DN) { r -= I_DN; sel = 3;
        if (r >= I_IN) { r -= I_IN; sel = 4;
        if (r >= I_UQ) { r -= I_UQ; sel = 5;
        if (r >= I_UKV) { r -= I_UKV; sel = 6;
        if (r >= I_O) { r -= I_O; sel = 7;
        if (r >= I_FFN) { r -= I_FFN; sel = 8;
        if (r >= I_FFN) { r -= I_FFN; sel = 9;
        if (r >= I_DN) { r -= I_DN; sel = 10;
        if (r >= I_O) { r -= I_O; sel = 11; } } } } } } } } } } }
        const float* W0; const float* g0 = nullptr; int K, N, mapid; size_t doff;
        switch (sel) {
            case 0: W0 = a->in[3]; g0 = a->in[2]; K = D; N = FF; doff = WL_GU1; mapid = 1; break;
            case 1: W0 = a->in[4]; g0 = a->in[2]; K = D; N = FF; doff = WL_GU1; mapid = 2; break;
            case 2: W0 = a->in[5]; K = FF; N = D; doff = WL_D1; mapid = 0; break;
            case 3: W0 = a->in[7]; g0 = a->in[6]; K = D; N = 2464; doff = WL_IN; mapid = 3; break;
            case 4: W0 = a->in[11]; g0 = a->in[10]; K = 256; N = 384; doff = WL_UQ; mapid = 4; break;
            case 5: W0 = a->in[13]; g0 = a->in[12]; K = 128; N = 512; doff = WL_UKV; mapid = 5; break;
            case 6: W0 = a->in[15]; g0 = a->in[14]; K = D; N = D; doff = WL_O; mapid = 0; break;
            case 7: W0 = a->in[17]; g0 = a->in[16]; K = D; N = FF; doff = WL_GU2; mapid = 1; break;
            case 8: W0 = a->in[18]; g0 = a->in[16]; K = D; N = FF; doff = WL_GU2; mapid = 2; break;
            case 9: W0 = a->in[19]; K = FF; N = D; doff = WL_D2; mapid = 0; break;
            case 10: W0 = a->in[21]; g0 = a->in[20]; K = D; N = D; doff = WL_PG; mapid = 0; break;
            default: W0 = a->in[22]; K = PLE; N = D; doff = WL_PP; mapid = 0; break;
        }
        const float* W = W0 + (size_t)l * K * N;
        const float* gain = g0 ? g0 + (size_t)l * K : nullptr;
        tr_item(W, K, N, gain, Wbase + (size_t)l * WL_SIZE + doff, mapid, r, s, wv);
    }
#endif
    const int gt = bid * 512 + tid, ngt = G * 512;
    for (int l = 0; l < DEPTH; ++l) {
        bf16_t* WL = Wbase + (size_t)l * WL_SIZE;
        zero_rows(WL + WL_IN, 1952, 96, D, gt, ngt);
        zero_rows(WL + WL_UQ, 384, 128, 256, gt, ngt);
    }
#if PRO_PARTS & 2
    float* cs64 = (float*)(a->ws + OFF_CS64); float* cs32 = (float*)(a->ws + OFF_CS32);
    for (int i = gt; i < T * 32; i += ngt) {
        const int pos = i >> 5, j = i & 31;
        const float inv = __builtin_amdgcn_exp2f(-(float)j * (13.287712379549449f / 32.0f)); const float ang = (float)pos * inv;
        const float rev = ang * 0.15915494309189535f, fr_ = rev - floorf(rev);
        float* p = cs64 + ((size_t)pos * 8 + (j >> 2)) * 8 + (j & 3);
        p[0] = __builtin_amdgcn_cosf(fr_); p[4] = __builtin_amdgcn_sinf(fr_);
    }
    for (int i = gt; i < T * 16; i += ngt) {
        const int pos = i >> 4, j = i & 15;
        const float inv = __builtin_amdgcn_exp2f(-(float)j * (13.287712379549449f / 16.0f)); const float ang = (float)pos * inv;
        const float rev = ang * 0.15915494309189535f, fr_ = rev - floorf(rev);
        float* p = cs32 + ((size_t)pos * 4 + (j >> 2)) * 8 + (j & 3);
        p[0] = __builtin_amdgcn_cosf(fr_); p[4] = __builtin_amdgcn_sinf(fr_);
    }
#endif
#if PRO_PARTS & 4
    const int lane = tid & 63, gw = bid * 8 + (tid >> 6), ngw = G * 8;
    bf16_t* xb = (bf16_t*)(a->ws + OFF_XBA); float* ss = (float*)(a->ws + OFF_SSA);
    for (int row = gw; row < M; row += ngw) {
        const f32x4* xr = (const f32x4*)(a->in[0] + (size_t)row * D) + lane; f32x4* orow = (f32x4*)(a->out + (size_t)row * D) + lane;
        float sq = 0.f;
#pragma unroll
        for (int j = 0; j < 4; ++j) {
            const f32x4 v = xr[64 * j]; orow[64 * j] = v; sq += dot4(v);
            u32x2 w; w.x = cvt_pk_bf16(v.x, v.y); w.y = cvt_pk_bf16(v.z, v.w);
            *(u32x2*)(xb + (size_t)row * D + 256 * j + lane * 4) = w;
        }
#pragma unroll
        for (int o = 1; o < 64; o <<= 1) sq += __shfl_xor(sq, o);
        if (lane < 16) ss[(size_t)row * 16 + lane] = lane == 0 ? sq : 0.f;
    }
#endif
}

__device__ __forceinline__ void convert_p(KA a, int layer, int wv) {
    const f32x4* src = (const f32x4*)(a->in[1] + (size_t)layer * M * PLE); u32x2* dst = (u32x2*)(a->ws + OFF_VT);
    const size_t n = (size_t)M * PLE / 4;
    const int tid_ = ltid(wv), bid_ = lbid(), G_ = lgrid();
    for (size_t i = (size_t)bid_ * 512 + tid_; i < n; i += (size_t)G_ * 512) {
        const f32x4 v = src[i]; u32x2 w; w.x = cvt_pk_bf16(v.x, v.y); w.y = cvt_pk_bf16(v.z, v.w); dst[i] = w;
    }
}

__device__ __forceinline__ void final_norm(KA a, int wv) {
    const int tid_ = ltid(wv); const int lane = tid_ & 63, gw = lbid() * 8 + (tid_ >> 6), ngw = lgrid() * 8;
    const float* ss = (const float*)(a->ws + OFF_SSA);
    f32x4 g[4];
#pragma unroll
    for (int j = 0; j < 4; ++j) g[j] = ((const f32x4*)a->in[23])[64 * j + lane];
    for (int row = gw; row < M; row += ngw) {
        const float r = rs16(ss, row);
        f32x4* orow = (f32x4*)(a->out + (size_t)row * D) + lane;
#pragma unroll
        for (int j = 0; j < 4; ++j) orow[64 * j] = orow[64 * j] * r * g[j];
    }
}

struct AttnP { const unsigned char* ws; const float* nab; const float* sink; };

template <int MODE>
__device__ __forceinline__ void attn_unit(const AttnP& P0, int unit, LAS float* xch, const LAS float* nabl, int wv) {
    const unsigned char* ws = P0.ws; asm volatile("" : "+s"(ws));
    constexpr int NS = MODE == 0 ? 6 : 4;
    const int lane = vlane(), w = wv, qs = w >> 2, h = w & 3, ql = lane & 31, hh = lane >> 5;
    const int lane16 = lane * 16;
    const int b = unit >> 5, rem = unit & 31;
    int qt, T0 = 0, rr = 0, qmin, qmax;
    if (MODE == 1) { T0 = 512 * (rem >> 3); rr = 2 * (rem & 7) + qs; qt = T0 + rr + 16 * ql; qmin = T0 + rr; qmax = qmin + 496; }
    else { qmin = 64 * rem + 32 * qs; qt = qmin + ql; qmax = qmin + 31; }
    const size_t tokbase = (size_t)b * T;
    const bf16_t* qrow; int khead, group;
    if (MODE == 0) { qrow = (const bf16_t*)(ws + OFF_QM) + (tokbase + qt) * QLD + 96 * h; khead = 18 + h; group = 3; }
    else if (MODE == 1) { qrow = (const bf16_t*)(ws + OFF_ZQ) + (tokbase + qt) * ZQLD + 512 + 64 * h; khead = 6 + h; group = 2; }
    else if (MODE == 2) { qrow = (const bf16_t*)(ws + OFF_ZQ) + (tokbase + qt) * ZQLD + 64 * h; khead = h; group = 0; }
    else { qrow = (const bf16_t*)(ws + OFF_ZQ) + (tokbase + qt) * ZQLD + 256 + 64 * h; khead = 4 + (h >> 1); group = 1; }
    const unsigned char* kfb = ws + OFF_KF + (size_t)b * 64 * 4096 + lane16;
    const unsigned char* vfb = ws + OFF_VT + (size_t)b * 64 * 4096 + lane16;
    const unsigned char* kpe = ws + OFF_KPE + (size_t)b * 64 * 2048 + lane16;
    bf16x8 qf[NS];
#pragma unroll
    for (int s = 0; s < NS; ++s) qf[s] = *(const bf16x8*)(qrow + 16 * s + 8 * hh);
    const float sc = (MODE == 0 ? 0.10206207261596577f : 0.125f) * LOG2E;
    f32x16 o0, o1;
#pragma unroll
    for (int e = 0; e < 16; ++e) { o0[e] = 0.f; o1[e] = 0.f; }
    float mrun = -1e20f, lrun = 0.f;
    if (MODE == 3) { mrun = P0.sink[h] * LOG2E; lrun = hh == 0 ? 1.f : 0.f; }
    const int qcol = qt & 63;
    const int nseg = MODE == 1 ? 3 : 1;
    for (int seg = 0; seg < nseg; ++seg) {
        int ntile, kb0, kstr, vb0, win, hd = khead;
        if (MODE == 0) { ntile = 64; kb0 = 0; kstr = 1; vb0 = 0; win = 1 << 20; }
        else if (MODE == 2) { ntile = 16; kb0 = 64 * min(max(rem - 4, 0), 24); kstr = 1; vb0 = kb0; win = 0; }
        else if (MODE == 3) { ntile = 9; kb0 = qmin - 128; kstr = 1; vb0 = kb0; win = 128; }
        else {
            if (seg == 0) { ntile = 20; kb0 = T0 - 64; kstr = 1; vb0 = kb0; win = 64; }
            else if (seg == 1) { ntile = 8; const int us = (T0 >> 2) - 64, r4 = rr & 3; kb0 = 4 * us + r4; kstr = 4; vb0 = r4 * 512 + us; win = 256; hd = khead + 4; }
            else { ntile = 5; const int nst = (T0 >> 4) - 64; kb0 = 16 * nst + rr; kstr = 16; vb0 = rr * 128 + nst; win = 1024; hd = khead + 8; }
        }
        const int kstep = 32 * kstr;
        int tlo = 0, thi = ntile;
        if (MODE == 1 || MODE == 3) { tlo = kb0 < 0 ? (-kb0 + kstep - 1) / kstep : 0; thi = min(ntile, (T - kb0 + kstep - 1) / kstep); }
        const unsigned char* kfh = kfb + (size_t)hd * HEADB; const unsigned char* vfh = vfb + (size_t)hd * HEADB;
        bf16x8 kf[NS], vf[4];
        {
            const int pt = (vb0 >> 5) + tlo;
#pragma unroll
            for (int s = 0; s < NS; ++s) kf[s] = (MODE == 0 && s >= 4) ? *(const bf16x8*)(kpe + (size_t)pt * 2048 + (s - 4) * 1024) : *(const bf16x8*)(kfh + (size_t)pt * 4096 + s * 1024);
#pragma unroll
            for (int j = 0; j < 4; ++j) vf[j] = *(const bf16x8*)(vfh + (size_t)pt * 4096 + j * 1024);
        }
        for (int tau = tlo; tau < thi; ++tau) {
            const int kb = kb0 + kstep * tau;
            bf16x8 kn[NS], vn[4];
            {
                const int pt = (vb0 >> 5) + min(tau + 1, thi - 1);
#pragma unroll
                for (int s = 0; s < NS; ++s) kn[s] = (MODE == 0 && s >= 4) ? *(const bf16x8*)(kpe + (size_t)pt * 2048 + (s - 4) * 1024) : *(const bf16x8*)(kfh + (size_t)pt * 4096 + s * 1024);
#pragma unroll
                for (int j = 0; j < 4; ++j) vn[j] = *(const bf16x8*)(vfh + (size_t)pt * 4096 + j * 1024);
            }
            f32x16 sacc;
#pragma unroll
            for (int e = 0; e < 16; ++e) sacc[e] = 0.f;
#pragma unroll
            for (int s = 0; s < NS; ++s) sacc = __builtin_amdgcn_mfma_f32_32x32x16_bf16(kf[s], qf[s], sacc, 0, 0, 0);
            if (MODE == 2) {
                const int c0 = 32 * (tau & 1), wsx = min(max(qcol - 8, 0), 48);
                const int mb = c0 - wsx + 4 * hh;
                const int drow = (kb >> 6) - rem + 7;
                const LAS float* bp = nabl + (h * 15 + drow) * 31 + c0 - qcol + 15 + 4 * hh;
#pragma unroll
                for (int e = 0; e < 16; ++e) {
                    const int o = 8 * (e >> 2) + (e & 3);
                    const float v = sacc[e] * sc + bp[o];
                    sacc[e] = (unsigned)(mb + o) < 16u ? v : -1e30f;
                }
            } else if (MODE != 0) {
                const bool full = (kb + 31 * kstr - qmin <= win) && (qmax - kb <= win);
                if (!full) {
                    const int mb = kb - qt + win + 4 * hh * kstr;
#pragma unroll
                    for (int e = 0; e < 16; ++e) {
                        const int o = (8 * (e >> 2) + (e & 3)) * kstr;
                        sacc[e] = (unsigned)(mb + o) <= (unsigned)(2 * win) ? sacc[e] : -1e30f;
                    }
                }
            }
            float tmax = fmaxf(fmaxf(sacc[0], sacc[1]), fmaxf(sacc[2], sacc[3]));
#pragma unroll
            for (int e = 4; e < 16; e += 4) tmax = fmaxf(tmax, fmaxf(fmaxf(sacc[e], sacc[e + 1]), fmaxf(sacc[e + 2], sacc[e + 3])));
            tmax = fmaxf(tmax, __shfl_xor(tmax, 32));
            if (MODE != 2) tmax *= sc;
            const float mnew = fmaxf(mrun, tmax);
            const bool grow = mnew > mrun;
            const float alpha = __builtin_amdgcn_exp2f(mrun - mnew);
            mrun = mnew;
            float psum = 0.f;
#pragma unroll
            for (int e = 0; e < 16; ++e) {
                const float p = MODE == 2 ? __builtin_amdgcn_exp2f(sacc[e] - mnew) : __builtin_amdgcn_exp2f(__builtin_fmaf(sacc[e], sc, -mnew));
                sacc[e] = p; psum += p;
            }
            lrun = lrun * alpha + psum;
            if (__builtin_amdgcn_ballot_w64(grow) != 0ull) {
#pragma unroll
                for (int e = 0; e < 16; ++e) { o0[e] *= alpha; o1[e] *= alpha; }
            }
            bf16x8 pb[2];
#pragma unroll
            for (int t = 0; t < 2; ++t) {
                u32x4 v; v.x = cvt_pk_bf16(sacc[8 * t + 0], sacc[8 * t + 1]); v.y = cvt_pk_bf16(sacc[8 * t + 2], sacc[8 * t + 3]);
                v.z = cvt_pk_bf16(sacc[8 * t + 4], sacc[8 * t + 5]); v.w = cvt_pk_bf16(sacc[8 * t + 6], sacc[8 * t + 7]);
                pb[t] = __builtin_bit_cast(bf16x8, v);
            }
            o0 = __builtin_amdgcn_mfma_f32_32x32x16_bf16(vf[0], pb[0], o0, 0, 0, 0);
            o0 = __builtin_amdgcn_mfma_f32_32x32x16_bf16(vf[1], pb[1], o0, 0, 0, 0);
            o1 = __builtin_amdgcn_mfma_f32_32x32x16_bf16(vf[2], pb[0], o1, 0, 0, 0);
            o1 = __builtin_amdgcn_mfma_f32_32x32x16_bf16(vf[3], pb[1], o1, 0, 0, 0);
#pragma unroll
            for (int s = 0; s < NS; ++s) kf[s] = kn[s];
#pragma unroll
            for (int j = 0; j < 4; ++j) vf[j] = vn[j];
        }
    }
    lrun += __shfl_xor(lrun, 32);
    const float inv = 1.0f / lrun;
    float sq = 0.f;
#pragma unroll
    for (int e = 0; e < 16; ++e) { o0[e] *= inv; o1[e] *= inv; sq += o0[e] * o0[e] + o1[e] * o1[e]; }
    sq += __shfl_xor(sq, 32);
    if (hh == 0) xch[w * 32 + ql] = sq;
    __syncthreads();
    const float tot = (xch[(qs * 4 + 0) * 32 + ql] + xch[(qs * 4 + 1) * 32 + ql]) + (xch[(qs * 4 + 2) * 32 + ql] + xch[(qs * 4 + 3) * 32 + ql]);
    const float rg = rsqrtf(tot * (1.0f / 256.0f) + EPS);
    bf16_t* yrow = (bf16_t*)(ws + OFF_XBA) + (tokbase + qt) * D + group * 256 + h * 64 + 4 * hh;
#pragma unroll
    for (int j = 0; j < 4; ++j) {
        u32x2 w0; w0.x = cvt_pk_bf16(o0[4 * j] * rg, o0[4 * j + 1] * rg); w0.y = cvt_pk_bf16(o0[4 * j + 2] * rg, o0[4 * j + 3] * rg);
        u32x2 w1; w1.x = cvt_pk_bf16(o1[4 * j] * rg, o1[4 * j + 1] * rg); w1.y = cvt_pk_bf16(o1[4 * j + 2] * rg, o1[4 * j + 3] * rg);
        *(u32x2*)(yrow + 8 * j) = w0; *(u32x2*)(yrow + 32 + 8 * j) = w1;
    }
}

__device__ __forceinline__ void sm_pv(f32x16& sacc, f32x16& o0, f32x16& o1, float& mrun, float& lrun, const bf16x8 (&vf)[4], float sc) {
    float tmax = fmaxf(fmaxf(sacc[0], sacc[1]), fmaxf(sacc[2], sacc[3]));
#pragma unroll
    for (int e = 4; e < 16; e += 4) tmax = fmaxf(tmax, fmaxf(fmaxf(sacc[e], sacc[e + 1]), fmaxf(sacc[e + 2], sacc[e + 3])));
    tmax = fmaxf(tmax, __shfl_xor(tmax, 32)) * sc;
    const float mnew = fmaxf(mrun, tmax);
    const bool grow = mnew > mrun;
    const float alpha = __builtin_amdgcn_exp2f(mrun - mnew);
    mrun = mnew;
    float psum = 0.f;
#pragma unroll
    for (int e = 0; e < 16; ++e) { const float p = __builtin_amdgcn_exp2f(__builtin_fmaf(sacc[e], sc, -mnew)); sacc[e] = p; psum += p; }
    lrun = lrun * alpha + psum;
    if (__builtin_amdgcn_ballot_w64(grow) != 0ull) {
#pragma unroll
        for (int e = 0; e < 16; ++e) { o0[e] *= alpha; o1[e] *= alpha; }
    }
    bf16x8 pb[2];
#pragma unroll
    for (int t = 0; t < 2; ++t) {
        u32x4 v; v.x = cvt_pk_bf16(sacc[8 * t + 0], sacc[8 * t + 1]); v.y = cvt_pk_bf16(sacc[8 * t + 2], sacc[8 * t + 3]);
        v.z = cvt_pk_bf16(sacc[8 * t + 4], sacc[8 * t + 5]); v.w = cvt_pk_bf16(sacc[8 * t + 6], sacc[8 * t + 7]);
        pb[t] = __builtin_bit_cast(bf16x8, v);
    }
    o0 = __builtin_amdgcn_mfma_f32_32x32x16_bf16(vf[0], pb[0], o0, 0, 0, 0);
    o0 = __builtin_amdgcn_mfma_f32_32x32x16_bf16(vf[1], pb[1], o0, 0, 0, 0);
    o1 = __builtin_amdgcn_mfma_f32_32x32x16_bf16(vf[2], pb[0], o1, 0, 0, 0);
    o1 = __builtin_amdgcn_mfma_f32_32x32x16_bf16(vf[3], pb[1], o1, 0, 0, 0);
}
__device__ __forceinline__ void attn_mla(const AttnP& P0, int unit, LAS float* xch, int wv) {
    const unsigned char* ws = P0.ws; asm volatile("" : "+s"(ws));
    const int lane = vlane(), w = wv, qs = w >> 2, h = w & 3, ql = lane & 31, hh = lane >> 5;
    const int lane16 = lane * 16;
    const int b = unit >> 4, q0 = 128 * (unit & 15) + 64 * qs;
    const size_t tokbase = (size_t)b * T;
    const bf16_t* qrA = (const bf16_t*)(ws + OFF_QM) + (tokbase + q0 + ql) * QLD + 96 * h;
    const bf16_t* qrB = qrA + 32 * QLD;
    const unsigned char* kfh = ws + OFF_KF + (size_t)(18 + h) * HEADB + (size_t)b * 64 * 4096 + lane16;
    const unsigned char* vfh = ws + OFF_VT + (size_t)(18 + h) * HEADB + (size_t)b * 64 * 4096 + lane16;
    const unsigned char* kpe = ws + OFF_KPE + (size_t)b * 64 * 2048 + lane16;
    bf16x8 qA[6], qB[6];
#pragma unroll
    for (int s = 0; s < 6; ++s) { qA[s] = *(const bf16x8*)(qrA + 16 * s + 8 * hh); qB[s] = *(const bf16x8*)(qrB + 16 * s + 8 * hh); }
    const float sc = 0.10206207261596577f * LOG2E;
    f32x16 oA0, oA1, oB0, oB1;
#pragma unroll
    for (int e = 0; e < 16; ++e) { oA0[e] = 0.f; oA1[e] = 0.f; oB0[e] = 0.f; oB1[e] = 0.f; }
    float mA = -1e20f, lA = 0.f, mB = -1e20f, lB = 0.f;
    bf16x8 kf[6], vf[4];
#pragma unroll
    for (int s = 0; s < 6; ++s) kf[s] = s >= 4 ? *(const bf16x8*)(kpe + (s - 4) * 1024) : *(const bf16x8*)(kfh + s * 1024);
#pragma unroll
    for (int j = 0; j < 4; ++j) vf[j] = *(const bf16x8*)(vfh + j * 1024);
    for (int tau = 0; tau < 64; ++tau) {
        bf16x8 kn[6], vn[4];
        const int pt = min(tau + 1, 63);
#pragma unroll
        for (int s = 0; s < 6; ++s) kn[s] = s >= 4 ? *(const bf16x8*)(kpe + (size_t)pt * 2048 + (s - 4) * 1024) : *(const bf16x8*)(kfh + (size_t)pt * 4096 + s * 1024);
#pragma unroll
        for (int j = 0; j < 4; ++j) vn[j] = *(const bf16x8*)(vfh + (size_t)pt * 4096 + j * 1024);
        f32x16 sa, sb;
#pragma unroll
        for (int e = 0; e < 16; ++e) { sa[e] = 0.f; sb[e] = 0.f; }
#pragma unroll
        for (int s = 0; s < 6; ++s) { sa = __builtin_amdgcn_mfma_f32_32x32x16_bf16(kf[s], qA[s], sa, 0, 0, 0); sb = __builtin_amdgcn_mfma_f32_32x32x16_bf16(kf[s], qB[s], sb, 0, 0, 0); }
        sm_pv(sa, oA0, oA1, mA, lA, vf, sc);
        sm_pv(sb, oB0, oB1, mB, lB, vf, sc);
#pragma unroll
        for (int s = 0; s < 6; ++s) kf[s] = kn[s];
#pragma unroll
        for (int j = 0; j < 4; ++j) vf[j] = vn[j];
    }
    lA += __shfl_xor(lA, 32); lB += __shfl_xor(lB, 32);
    const float iA = 1.0f / lA, iB = 1.0f / lB;
    float sqA = 0.f, sqB = 0.f;
#pragma unroll
    for (int e = 0; e < 16; ++e) { oA0[e] *= iA; oA1[e] *= iA; oB0[e] *= iB; oB1[e] *= iB; sqA += oA0[e] * oA0[e] + oA1[e] * oA1[e]; sqB += oB0[e] * oB0[e] + oB1[e] * oB1[e]; }
    sqA += __shfl_xor(sqA, 32); sqB += __shfl_xor(sqB, 32);
    if (hh == 0) { xch[w * 64 + ql] = sqA; xch[w * 64 + 32 + ql] = sqB; }
    __syncthreads();
    const LAS float* xq = xch + qs * 256 + ql;
    const float rA = rsqrtf(((xq[0] + xq[64]) + (xq[128] + xq[192])) * (1.0f / 256.0f) + EPS);
    const float rB = rsqrtf(((xq[32] + xq[96]) + (xq[160] + xq[224])) * (1.0f / 256.0f) + EPS);
    bf16_t* yA = (bf16_t*)(ws + OFF_XBA) + (tokbase + q0 + ql) * D + 3 * 256 + h * 64 + 4 * hh;
    bf16_t* yB = yA + 32 * D;
#pragma unroll
    for (int j = 0; j < 4; ++j) {
        u32x2 w0; w0.x = cvt_pk_bf16(oA0[4 * j] * rA, oA0[4 * j + 1] * rA); w0.y = cvt_pk_bf16(oA0[4 * j + 2] * rA, oA0[4 * j + 3] * rA);
        u32x2 w1; w1.x = cvt_pk_bf16(oA1[4 * j] * rA, oA1[4 * j + 1] * rA); w1.y = cvt_pk_bf16(oA1[4 * j + 2] * rA, oA1[4 * j + 3] * rA);
        *(u32x2*)(yA + 8 * j) = w0; *(u32x2*)(yA + 32 + 8 * j) = w1;
        u32x2 w2; w2.x = cvt_pk_bf16(oB0[4 * j] * rB, oB0[4 * j + 1] * rB); w2.y = cvt_pk_bf16(oB0[4 * j + 2] * rB, oB0[4 * j + 3] * rB);
        u32x2 w3; w3.x = cvt_pk_bf16(oB1[4 * j] * rB, oB1[4 * j + 1] * rB); w3.y = cvt_pk_bf16(oB1[4 * j + 2] * rB, oB1[4 * j + 3] * rB);
        *(u32x2*)(yB + 8 * j) = w2; *(u32x2*)(yB + 32 + 8 * j) = w3;
    }
}

__device__ __forceinline__ void attn_phase(KA a, int layer, LAS unsigned char* lds, int wv) {
    AttnP P; P.ws = a->ws; P.nab = a->in[8] + (size_t)layer * 4 * 15 * 31; P.sink = a->in[9] + layer * 4;
    LAS float* xch = (LAS float*)lds;
    for (int i = ltid(wv); i < 4 * 15 * 31; i += 512) xch[1024 + i] = P.nab[i] * LOG2E;
    __syncthreads();
    int it = 0;
    const int G_ = lgrid(), bid_ = lbid();
    const int vcu = (G_ & 7) == 0 ? (bid_ & 7) * (G_ >> 3) + (bid_ >> 3) : bid_;
    for (int u = vcu; u < 256 + 3 * 512; u += G_, ++it) {
        LAS float* x = xch + (it & 1) * 512;
        if (u < 256) attn_mla(P, u, x, wv);
        else {
            const int mode = 1 + ((u - 256) >> 9), unit = (u - 256) & 511;
            if (mode == 1) attn_unit<1>(P, unit, x, xch + 1024, wv);
            else if (mode == 2) attn_unit<2>(P, unit, x, xch + 1024, wv);
            else attn_unit<3>(P, unit, x, xch + 1024, wv);
        }
    }
    __syncthreads();
}

__device__ __forceinline__ void grid_bar(unsigned* bar, unsigned seq, int wv) {
    asm volatile("s_waitcnt vmcnt(0) lgkmcnt(0)" ::: "memory");
    __builtin_amdgcn_s_barrier();
    if (wv == 0) {
        if (vlane() == 0) {
            const unsigned G = (unsigned)lgrid(), b = (unsigned)lbid(), g = b & 7u;
            const unsigned ng = (G - g + 7u) >> 3, ngroups = G < 8u ? G : 8u;
            unsigned* flag = bar + 64 * 9;
            __builtin_amdgcn_fence(__ATOMIC_RELEASE, "agent");
            asm volatile("s_waitcnt vmcnt(0)" ::: "memory");
            const unsigned old = __hip_atomic_fetch_add(bar + 64 * g, 1u, __ATOMIC_RELAXED, __HIP_MEMORY_SCOPE_AGENT);
            bool waitf = true;
            if (old + 1u == seq * ng) {
                __builtin_amdgcn_fence(__ATOMIC_SEQ_CST, "agent");
                const unsigned old2 = __hip_atomic_fetch_add(bar + 64 * 8, 1u, __ATOMIC_RELAXED, __HIP_MEMORY_SCOPE_AGENT);
                if (old2 + 1u == seq * ngroups) { __builtin_amdgcn_fence(__ATOMIC_SEQ_CST, "agent"); __hip_atomic_store(flag, seq, __ATOMIC_RELAXED, __HIP_MEMORY_SCOPE_AGENT); waitf = false; }
            }
            if (waitf) { unsigned spins = 0; while (__hip_atomic_load(flag, __ATOMIC_RELAXED, __HIP_MEMORY_SCOPE_AGENT) < seq) { __builtin_amdgcn_s_sleep(1); if (++spins > (1u << 26)) break; } }
            __builtin_amdgcn_fence(__ATOMIC_ACQUIRE, "agent");
            asm volatile("s_waitcnt vmcnt(0)" ::: "memory");
        }
    }
    __builtin_amdgcn_s_barrier();
    asm volatile("" ::: "memory");
}

template <int PH, bool ZERO = false>
__device__ __forceinline__ void run_phase(LAS unsigned char* lds, int wv) {
    KA a = kargs();
    unsigned char* ws = a->ws; asm volatile("" : "+s"(ws));
    bf16_t* Wbase = (bf16_t*)(ws + OFF_W);
    bf16_t* xbA = (bf16_t*)(ws + OFF_XBA); bf16_t* xbB = (bf16_t*)(ws + OFF_XBB);
    bf16_t* Hb = (bf16_t*)(ws + OFF_H); bf16_t* zl = (bf16_t*)(ws + OFF_ZL); bf16_t* qm = (bf16_t*)(ws + OFF_QM);
    unsigned char* vf = ws + OFF_VT;
    bf16_t* pb = (bf16_t*)(ws + OFF_VT);
    float* ssA = (float*)(ws + OFF_SSA); float* ssB = (float*)(ws + OFF_SSB); float* mst = (float*)(ws + OFF_MST);
    const float* cs64 = (const float*)(ws + OFF_CS64); const float* cs32 = (const float*)(ws + OFF_CS32);
    if constexpr (PH == 0) { if (PH_ON(0)) prologue(a, lds, wv); }
    else if constexpr (PH == NPH - 1) { if (PH_ON(1)) final_norm(a, wv); }
    else {
        constexpr int l = (PH - 1) / 9, k = (PH - 1) % 9;
        bf16_t* WL = Wbase + (size_t)l * WL_SIZE;
        if constexpr (k == 0) { if (PH_ON(2)) { EpiGU E{ssA, Hb}; run_gemm(wv, lds, xbA, D, M, WL + WL_GU1, D, 5632, D, 0, E); } }
        else if constexpr (k == 1) { if (PH_ON(3)) { EpiRes E{a->out, xbB, ssB, ZERO ? 0.f : 0.5f}; run_gemm(wv, lds, Hb, FF, M, WL + WL_D1, FF, D, FF, 0, E); } }
        else if constexpr (k == 2) {
            if (PH_ON(4)) { EpiIn E{ssB, ws, mst, cs64, cs32}; run_gemm(wv, lds, xbB, D, M, WL + WL_IN, D, 2048, D, 0, E); }
            if (PH_ON(5)) { EpiVT E{ssB, vf}; run_gemm(wv, lds, WL + WL_IN + (size_t)2048 * D, D, 512, xbB, D, M, D, 0, E); }
        }
        else if constexpr (k == 3) {
            if (PH_ON(6)) { EpiQ E{mst, qm, cs32}; run_gemm(wv, lds, zl, ZLLD, M, WL + WL_UQ, 256, 512, 256, 0, E); }
            if (PH_ON(7)) { EpiK E{mst, ws}; run_gemm(wv, lds, zl + 256, ZLLD, M, WL + WL_UKV, 128, 256, 128, 0, E); }
            if (PH_ON(8)) { EpiVTM E{mst, vf}; run_gemm(wv, lds, WL + WL_UKV + (size_t)256 * 128, 128, 256, zl + 256, ZLLD, M, 128, 128, E); }
        }
        else if constexpr (k == 4) { if (PH_ON(9)) attn_phase(a, l, lds, wv); }
        else if constexpr (k == 5) { if (PH_ON(3)) { EpiRes E{a->out, xbB, ssB, ZERO ? 0.f : 1.0f}; run_gemm(wv, lds, xbA, D, M, WL + WL_O, D, D, D, 0, E); } }
        else if constexpr (k == 6) { if (PH_ON(2)) { convert_p(a, l, wv); EpiGU E{ssB, Hb}; run_gemm(wv, lds, xbB, D, M, WL + WL_GU2, D, 5632, D, 0, E); } }
        else if constexpr (k == 7) {
            if (PH_ON(3)) { EpiRes E{a->out, xbB, ssB, ZERO ? 0.f : 0.5f}; run_gemm(wv, lds, Hb, FF, M, WL + WL_D2, FF, D, FF, 0, E); }
            if (PH_ON(10)) { EpiPP E{xbA}; run_gemm(wv, lds, pb, PLE, M, WL + WL_PP, PLE, D, PLE, 0, E); }
        }
        else { if (PH_ON(11)) { EpiGate E{a->out, ssB, xbA, ssA, ZERO ? 0.f : 1.0f}; run_gemm(wv, lds, xbB, D, M, WL + WL_PG, D, D, D, 0, E); } }
    }
}
template <int PH>
__device__ __forceinline__ void run_from(LAS unsigned char* lds, int ph_lo, int ph_hi, int wv) {
    if constexpr (PH < NPH) {
        if (PH >= ph_lo && PH < ph_hi) {
            run_phase<PH>(lds, wv);
            if constexpr (PH > 0 && PH < NPH - 1) { if constexpr ((DUPM >> ((PH - 1) % 9)) & 1) { __syncthreads(); run_phase<PH, true>(lds, wv); } }
            if constexpr (PH == 0 && ((DUPM >> 9) & 1)) { __syncthreads(); run_phase<PH>(lds, wv); }
            if (PH + 1 < ph_hi && kargs()->coop) {
                if constexpr (PH == 0) cg::this_grid().sync();
                else { for (int r_ = 0; r_ < BARREP; ++r_) grid_bar((unsigned*)(kargs()->ws + OFF_BAR), (unsigned)((PH - 1) * BARREP + r_ + 1), wv); }
            }
        }
        run_from<PH + 1>(lds, ph_lo, ph_hi, wv);
    }
}
__global__ void __launch_bounds__(512, 2) mega(Args a_unused) {
    extern __shared__ __attribute__((aligned(16))) unsigned char lds_raw[];
    LAS unsigned char* lds = (LAS unsigned char*)lds_raw;
    const int ph_lo = kargs()->ph_lo, ph_hi = kargs()->ph_hi;
    const int wv = __builtin_amdgcn_readfirstlane((int)threadIdx.x >> 6);
    run_from<0>(lds, ph_lo, ph_hi, wv);
}

extern "C" void kernel_launch(void* const* d_in, const int* in_sizes, int n_in, void* d_out, int out_size, void* d_ws, size_t ws_size, hipStream_t stream) {
    static int grid = 0;
    if (grid == 0) {
        if (n_in != 24 || ws_size < WS_END) { fprintf(stderr, "kernel_launch: n_in %d ws %zu (need %zu)\n", n_in, ws_size, (size_t)WS_END); grid = -1; return; }
        int dev = 0, cus = 0, per_cu = 0;
        hipGetDevice(&dev); hipDeviceGetAttribute(&cus, hipDeviceAttributeMultiprocessorCount, dev);
        if (hipFuncSetAttribute((const void*)mega, hipFuncAttributeMaxDynamicSharedMemorySize, LDS_BYTES) != hipSuccess) { fprintf(stderr, "hipFuncSetAttribute failed\n"); grid = -1; return; }
        if (hipOccupancyMaxActiveBlocksPerMultiprocessor(&per_cu, (const void*)mega, 512, LDS_BYTES) != hipSuccess || per_cu < 1) per_cu = 1;
        (void)hipGetLastError();
        grid = cus * per_cu;
    }
    if (grid < 0) return;
    (void)hipMemsetAsync((char*)d_ws + OFF_BAR, 0, 4096, stream);
    Args a{};
    for (int i = 0; i < 24; ++i) a.in[i] = (const float*)d_in[i];
    a.out = (float*)d_out; a.ws = (unsigned char*)d_ws;
#if MULTI_LAUNCH
    for (int ph = 0; ph < NPH; ++ph) {
        a.ph_lo = ph; a.ph_hi = ph + 1; a.coop = 0;
        hipLaunchKernelGGL(mega, dim3(grid), dim3(512), LDS_BYTES, stream, a);
    }
#else
    a.ph_lo = 0; a.ph_hi = NPH; a.coop = 1;
    void* args[] = {&a};
    hipError_t e = hipLaunchCooperativeKernel((void*)mega, dim3(grid), dim3(512), args, LDS_BYTES, stream);
    if (e != hipSuccess) fprintf(stderr, "cooperative launch failed: %s (grid %d)\n", hipGetErrorString(e), grid);
#endif
}
```

```cpp
#include <hip/hip_runtime.h>
#include <hip/hip_cooperative_groups.h>
#include <cstdio>
#include <cstdint>
namespace cg = cooperative_groups;

#ifndef MULTI_LAUNCH
#define MULTI_LAUNCH 0
#endif

#ifndef DEPHASE
#define DEPHASE 20
#endif
#ifndef BARREP
#define BARREP 1
#endif
#ifndef DUPM
#define DUPM 0
#endif
#ifndef PRO_PARTS
#define PRO_PARTS 7
#endif
#ifndef PHM
#define PHM 0xffff
#endif
#define PH_ON(b) (((PHM) >> (b)) & 1)
#define LAS __attribute__((address_space(3)))
typedef unsigned short bf16_t;
typedef short bf16x8 __attribute__((ext_vector_type(8)));
typedef float f32x4 __attribute__((ext_vector_type(4)));
typedef float f32x16 __attribute__((ext_vector_type(16)));
typedef unsigned u32x4 __attribute__((ext_vector_type(4)));
typedef unsigned u32x2 __attribute__((ext_vector_type(2)));

constexpr int M = 32768, T = 2048, D = 1024, FF = 2816, DEPTH = 4, PLE = 256;
constexpr int ZQLD = 768, ZLLD = 384, QLD = 384;
constexpr size_t HEADB = (size_t)16 * 64 * 4096;
constexpr float EPS = 1e-6f;
constexpr float LOG2E = 1.4426950408889634f;

constexpr size_t WL_GU1 = 0, WL_D1 = WL_GU1 + (size_t)5632 * 1024, WL_IN = WL_D1 + (size_t)1024 * 2816, WL_UQ = WL_IN + (size_t)2816 * 1024,
                 WL_UKV = WL_UQ + (size_t)512 * 256, WL_O = WL_UKV + (size_t)512 * 128, WL_GU2 = WL_O + (size_t)1024 * 1024, WL_D2 = WL_GU2 + (size_t)5632 * 1024,
                 WL_PG = WL_D2 + (size_t)1024 * 2816, WL_PP = WL_PG + (size_t)1024 * 1024, WL_SIZE = WL_PP + (size_t)1024 * 256;
constexpr size_t OFF_W = 0;
constexpr size_t OFF_XBA = OFF_W + WL_SIZE * 2 * DEPTH;
constexpr size_t OFF_XBB = OFF_XBA + (size_t)M * D * 2;
constexpr size_t OFF_H = OFF_XBB + (size_t)M * D * 2;
constexpr size_t OFF_ZQ = OFF_H;
constexpr size_t OFF_ZL = OFF_ZQ + (size_t)M * ZQLD * 2;
constexpr size_t OFF_KF = OFF_ZL + (size_t)M * ZLLD * 2;
constexpr size_t OFF_KPE = OFF_KF + 22 * HEADB;
constexpr size_t OFF_VT = OFF_H + (size_t)M * FF * 2;
constexpr size_t OFF_SSA = OFF_VT + 22 * HEADB;
constexpr size_t OFF_SSB = OFF_SSA + (size_t)M * 16 * 4;
constexpr size_t OFF_MST = OFF_SSB + (size_t)M * 16 * 4;
constexpr size_t OFF_CS64 = OFF_MST + (size_t)M * 8 * 4;
constexpr size_t OFF_CS32 = OFF_CS64 + (size_t)T * 64 * 4;
constexpr size_t OFF_BAR = OFF_CS32 + (size_t)T * 32 * 4;
constexpr size_t OFF_QM = OFF_BAR + 4096;
constexpr size_t WS_END = OFF_QM + (size_t)M * QLD * 2;
static_assert(OFF_KPE + (size_t)16 * 64 * 2048 <= OFF_VT, "zq|zl|KF|KPE inside the H region");
static_assert(WS_END <= 626121856, "workspace budget");

constexpr int LDS_BYTES = 147456;
constexpr int NPH = 2 + 9 * DEPTH;

__device__ __forceinline__ unsigned cvt_pk_bf16(float lo, float hi) { unsigned r; asm("v_cvt_pk_bf16_f32 %0, %1, %2" : "=v"(r) : "v"(lo), "v"(hi)); return r; }
__device__ __forceinline__ float bf_lo(unsigned u) { return __uint_as_float(u << 16); }
__device__ __forceinline__ float bf_hi(unsigned u) { return __uint_as_float(u & 0xffff0000u); }
__device__ __forceinline__ float sum4(f32x4 a) { return (a.x + a.y) + (a.z + a.w); }
__device__ __forceinline__ float dot4(f32x4 a) { return (a.x * a.x + a.y * a.y) + (a.z * a.z + a.w * a.w); }
__device__ __forceinline__ float rs16(const float* ss, int row) {
    const f32x4* p = (const f32x4*)(ss + (size_t)row * 16);
    const f32x4 a = p[0], b = p[1], c = p[2], d = p[3];
    return rsqrtf(((sum4(a) + sum4(b)) + (sum4(c) + sum4(d))) * (1.0f / 1024.0f) + EPS);
}
__device__ __forceinline__ int vlane() { int l; asm volatile("v_mbcnt_lo_u32_b32 %0, -1, 0\n\tv_mbcnt_hi_u32_b32 %0, -1, %0" : "=v"(l)); return l; }
__device__ __forceinline__ int ltid(int wv) { return (wv << 6) | vlane(); }
__device__ __forceinline__ int lbid() { int b = blockIdx.x; asm volatile("" : "+s"(b)); return b; }
__device__ __forceinline__ int lgrid() { int g = gridDim.x; asm volatile("" : "+s"(g)); return g; }
__device__ __forceinline__ float sigmoidf_(float v) { return __builtin_amdgcn_rcpf(1.0f + __expf(-v)); }

namespace pg8 {
constexpr int BM = 256, BK = 64, HALF = 128, HTB = HALF * BK * 2, STAGE_BYTES = 8 * HTB, NXCD = 8, WGM = 8;
__host__ __device__ __forceinline__ int lds_byte(int r, int c) { const int st = (r >> 4) * 2 + (c >> 5), rr = r & 15, cc = c & 31, ob = rr * 64 + cc * 2; return st * 1024 + (ob ^ (((ob >> 9) & 1) << 5)); }
__host__ __device__ __forceinline__ void stage_rc(int b, int& R, int& C) { const int st = b / 1024, sb = b % 1024, swz = sb ^ (((sb >> 9) & 1) << 5); R = (st >> 1) * 16 + swz / 64; C = (st & 1) * 32 + (swz % 64) / 2; }
__host__ __device__ __forceinline__ int perm32(int rho) { const int n = rho >> 4, i = rho & 15; return 8 * (i >> 2) + 4 * n + (i & 3); }

struct Unit { int pm, pn; };
struct Gemm { const bf16_t* A; const bf16_t* Bt; int lda, ldb, K; };

struct StaticOrder {
    int nM, nN, nwg, G, c;
    __device__ void init(int Mr, int Nc, int G_, int c_) { nM = Mr / BM; nN = Nc / BM; nwg = nM * nN; G = G_; c = c_; }
    __device__ bool next(int i, Unit& u) const {
        const long L = (long)i * G + c; if (L >= nwg) return false;
        int wgid = (int)L; { const int q = nwg / NXCD, r = nwg % NXCD, xcd = wgid % NXCD, off = wgid / NXCD; wgid = (xcd < r ? xcd * (q + 1) : r * (q + 1) + (xcd - r) * q) + off; }
        const int nig = WGM * nN, gid = wgid / nig, fm = gid * WGM, gsz = (nM - fm) < WGM ? (nM - fm) : WGM;
        u.pm = fm + ((wgid % nig) % gsz); u.pn = (wgid % nig) / gsz; return true;
    }
};

template <class Epi>
__device__ __forceinline__ void gemm_phase(LAS unsigned char* lds, const Gemm g, const StaticOrder& S, const Epi& E, int wv) {
    const int tid = ltid(wv);
    const int wid = wv, lane = tid & 63, wr = wid >> 2, wc = wid & 3, fr = lane & 15, fq = lane >> 4;
    const int K = g.K, nt = K / BK;
    unsigned voffA[2], voffB[2];
#pragma unroll
    for (int i = 0; i < 2; ++i) { int R, C; stage_rc(tid * 16 + i * 8192, R, C); const int Rb = (R & ~31) + perm32(R & 31);
        voffA[i] = (unsigned)(R * g.lda + C) * 2u; voffB[i] = (unsigned)(Rb * g.ldb + C) * 2u; }
    const size_t kstep = (size_t)(BK * 2);
    const size_t hstepA = (size_t)HALF * g.lda * 2, hstepB = (size_t)HALF * g.ldb * 2;
    const size_t tstepA = 2 * hstepA, tstepB = 2 * hstepB;
    const unsigned ldsw = (unsigned)wid * 1024u;
    const int aoff = lds_byte(wr * 64 + fr, fq * 8), boff = lds_byte(wc * 32 + fr, fq * 8);
#define PG8_SA(b, h) (((b) * 2 + (h)) * HTB)
#define PG8_SB(b, h) ((4 + (b) * 2 + (h)) * HTB)
#define PG8_STAGE(bufoff, gbase, voff) do { _Pragma("unroll") for (int _i = 0; _i < 2; ++_i) \
        __builtin_amdgcn_global_load_lds((const unsigned*)((const char*)(gbase) + (voff)[_i]), (LAS unsigned*)(lds + (bufoff) + ldsw + _i * 8192), 16, 0, 0); } while (0)
#define PG8_LDA(dst, b, h) do { _Pragma("unroll") for (int m = 0; m < 4; ++m) _Pragma("unroll") for (int k = 0; k < 2; ++k) dst[m][k] = *(const LAS bf16x8*)(lds + PG8_SA(b, h) + aoff + m * 2048 + k * 1024); } while (0)
#define PG8_LDB(dst, b, h) do { _Pragma("unroll") for (int n = 0; n < 2; ++n) _Pragma("unroll") for (int k = 0; k < 2; ++k) dst[n][k] = *(const LAS bf16x8*)(lds + PG8_SB(b, h) + boff + n * 2048 + k * 1024); } while (0)
#define PG8_MMA(ai, bj, At, Bt) do { __builtin_amdgcn_s_setprio(1); _Pragma("unroll") for (int m = 0; m < 4; ++m) _Pragma("unroll") for (int n = 0; n < 2; ++n) _Pragma("unroll") for (int k = 0; k < 2; ++k) \
        acc[ai][bj][m][n] = __builtin_amdgcn_mfma_f32_16x16x32_bf16(Bt[n][k], At[m][k], acc[ai][bj][m][n], 0, 0, 0); __builtin_amdgcn_s_setprio(0); } while (0)
#define PG8_WAIT_V(n) asm volatile("s_waitcnt vmcnt(" #n ")" ::: "memory")
#define PG8_WAIT_L(n) asm volatile("s_waitcnt lgkmcnt(" #n ")" ::: "memory")
#define PG8_BAR __builtin_amdgcn_s_barrier()
#define PG8_SCHED __builtin_amdgcn_sched_barrier(0)
    Unit cur, nxt; int ui = 0;
    if (!S.next(0, cur)) return;
    f32x4 acc[2][2][4][2];
#pragma unroll
    for (int a = 0; a < 2; ++a)
#pragma unroll
        for (int b = 0; b < 2; ++b)
#pragma unroll
            for (int m = 0; m < 4; ++m)
#pragma unroll
                for (int n = 0; n < 2; ++n) acc[a][b][m][n] = (f32x4){0.f, 0.f, 0.f, 0.f};
    bf16x8 At[4][2], B0[2][2], B1[2][2];
    const char* cA = (const char*)g.A + (size_t)cur.pm * tstepA; const char* cB = (const char*)g.Bt + (size_t)cur.pn * tstepB;
    PG8_STAGE(PG8_SB(0, 0), cB, voffB); PG8_STAGE(PG8_SB(0, 1), cB + hstepB, voffB); PG8_STAGE(PG8_SA(0, 0), cA, voffA); PG8_STAGE(PG8_SA(0, 1), cA + hstepA, voffA);
    if (wr == 1) PG8_BAR;
    PG8_WAIT_V(2); PG8_BAR;
    PG8_STAGE(PG8_SB(1, 0), cB + kstep, voffB); PG8_STAGE(PG8_SA(1, 0), cA + kstep, voffA); PG8_STAGE(PG8_SB(1, 1), cB + hstepB + kstep, voffB);
    PG8_WAIT_V(6); PG8_BAR;
    for (;;) {
        const bool has_next = S.next(ui + 1, nxt);
        const char* nA = has_next ? (const char*)g.A + (size_t)nxt.pm * tstepA : cA; const char* nB = has_next ? (const char*)g.Bt + (size_t)nxt.pn * tstepB : cB;
        for (int t = 0; t < nt; t += 2) {
            const bool last = (t == nt - 2);
            const char* a1 = cA + (size_t)(t + 1) * kstep;
            const char* a2 = last ? nA : cA + (size_t)(t + 2) * kstep; const char* b2 = last ? nB : cB + (size_t)(t + 2) * kstep;
            const char* a3 = a2 + kstep; const char* b3 = b2 + kstep;
            PG8_LDB(B0, 0, 0); PG8_LDB(B1, 0, 1); PG8_SCHED; PG8_LDA(At, 0, 0); PG8_STAGE(PG8_SA(1, 1), a1 + hstepA, voffA);
            PG8_WAIT_V(8); PG8_WAIT_L(0); PG8_BAR; PG8_MMA(0, 0, At, B0); PG8_MMA(0, 1, At, B1); PG8_BAR; PG8_SCHED;
            PG8_LDA(At, 0, 1); PG8_STAGE(PG8_SB(0, 0), b2, voffB); PG8_STAGE(PG8_SB(0, 1), b2 + hstepB, voffB); PG8_STAGE(PG8_SA(0, 0), a2, voffA);
            PG8_WAIT_V(8); PG8_WAIT_L(0); PG8_BAR; PG8_MMA(1, 0, At, B0); PG8_MMA(1, 1, At, B1); PG8_BAR; PG8_SCHED;
            PG8_LDB(B0, 1, 0); PG8_LDB(B1, 1, 1); PG8_SCHED; PG8_LDA(At, 1, 0); PG8_STAGE(PG8_SA(0, 1), a2 + hstepA, voffA);
            PG8_WAIT_V(8); PG8_WAIT_L(0); PG8_BAR; PG8_MMA(0, 0, At, B0); PG8_MMA(0, 1, At, B1); PG8_BAR; PG8_SCHED;
            PG8_LDA(At, 1, 1); PG8_STAGE(PG8_SB(1, 0), b3, voffB); PG8_STAGE(PG8_SB(1, 1), b3 + hstepB, voffB); PG8_STAGE(PG8_SA(1, 0), a3, voffA);
            PG8_WAIT_V(8); PG8_WAIT_L(0); PG8_BAR; PG8_MMA(1, 0, At, B0); PG8_MMA(1, 1, At, B1); PG8_BAR; PG8_SCHED;
        }
        if (wr == 0) PG8_BAR;
        E(acc, cur, wr, wc, fr, fq);
        if (!has_next) break;
#pragma unroll
        for (int a = 0; a < 2; ++a)
#pragma unroll
            for (int b = 0; b < 2; ++b)
#pragma unroll
                for (int m = 0; m < 4; ++m)
#pragma unroll
                    for (int n = 0; n < 2; ++n) acc[a][b][m][n] = (f32x4){0.f, 0.f, 0.f, 0.f};
        cur = nxt; cA = nA; cB = nB; ++ui;
        if (wr == 1) PG8_BAR;
    }
    PG8_WAIT_V(0);
    PG8_BAR;
#undef PG8_SA
#undef PG8_SB
#undef PG8_STAGE
#undef PG8_LDA
#undef PG8_LDB
#undef PG8_MMA
#undef PG8_WAIT_V
#undef PG8_WAIT_L
#undef PG8_BAR
#undef PG8_SCHED
}
}
using pg8::Unit;
typedef const f32x4 (&AccRef)[2][2][4][2];

struct EpiGU {
    const float* ss; bf16_t* H;
    __device__ __forceinline__ void operator()(AccRef acc, const Unit& u, int wr, int wc, int, int) const { const int lane_ = vlane(); const int fr = lane_ & 15, fq = lane_ >> 4;
#pragma unroll
        for (int ai = 0; ai < 2; ++ai)
#pragma unroll
            for (int m = 0; m < 4; ++m) {
                const int row = u.pm * 256 + ai * 128 + wr * 64 + m * 16 + fr;
                asm volatile("" ::: "memory");
                const float r = rs16(ss, row);
                const f32x4 g0 = acc[ai][0][m][0] * r, g1 = acc[ai][0][m][1] * r, v0 = acc[ai][1][m][0] * r, v1 = acc[ai][1][m][1] * r;
                u32x4 w;
                w.x = cvt_pk_bf16(g0.x * sigmoidf_(g0.x) * v0.x, g0.y * sigmoidf_(g0.y) * v0.y); w.y = cvt_pk_bf16(g0.z * sigmoidf_(g0.z) * v0.z, g0.w * sigmoidf_(g0.w) * v0.w);
                w.z = cvt_pk_bf16(g1.x * sigmoidf_(g1.x) * v1.x, g1.y * sigmoidf_(g1.y) * v1.y); w.w = cvt_pk_bf16(g1.z * sigmoidf_(g1.z) * v1.z, g1.w * sigmoidf_(g1.w) * v1.w);
                *(u32x4*)(H + (size_t)row * FF + u.pn * 128 + wc * 32 + fq * 8) = w;
            }
    }
};
struct EpiRes {
    float* X; bf16_t* xb; float* ssOut; float alpha;
    __device__ __forceinline__ void operator()(AccRef acc, const Unit& u, int wr, int wc, int, int) const { const int lane_ = vlane(); const int fr = lane_ & 15, fq = lane_ >> 4;
#pragma unroll
        for (int ai = 0; ai < 2; ++ai)
#pragma unroll
            for (int m = 0; m < 4; ++m) {
                const int row = u.pm * 256 + ai * 128 + wr * 64 + m * 16 + fr;
                asm volatile("" ::: "memory");
                float sq = 0.f;
#pragma unroll
                for (int bj = 0; bj < 2; ++bj) {
                    const size_t off = (size_t)row * D + u.pn * 256 + bj * 128 + wc * 32 + fq * 8;
                    f32x4 x0 = *(const f32x4*)(X + off), x1 = *(const f32x4*)(X + off + 4);
                    x0 += acc[ai][bj][m][0] * alpha; x1 += acc[ai][bj][m][1] * alpha;
                    *(f32x4*)(X + off) = x0; *(f32x4*)(X + off + 4) = x1;
                    sq += dot4(x0) + dot4(x1);
                    u32x4 w; w.x = cvt_pk_bf16(x0.x, x0.y); w.y = cvt_pk_bf16(x0.z, x0.w); w.z = cvt_pk_bf16(x1.x, x1.y); w.w = cvt_pk_bf16(x1.z, x1.w);
                    *(u32x4*)(xb + off) = w;
                }
                sq += __shfl_xor(sq, 16); sq += __shfl_xor(sq, 32);
                if (fq == 0) ssOut[(size_t)row * 16 + u.pn * 4 + wc] = sq;
            }
    }
};
struct EpiGate {
    float* X; const float* ssIn; bf16_t* ppxb; float* ssOut; float gsc;
    __device__ __forceinline__ void operator()(AccRef acc, const Unit& u, int wr, int wc, int, int) const { const int lane_ = vlane(); const int fr = lane_ & 15, fq = lane_ >> 4;
#pragma unroll
        for (int ai = 0; ai < 2; ++ai)
#pragma unroll
            for (int m = 0; m < 4; ++m) {
                const int row = u.pm * 256 + ai * 128 + wr * 64 + m * 16 + fr;
                asm volatile("" ::: "memory");
                const float r = rs16(ssIn, row);
                float sq = 0.f;
#pragma unroll
                for (int bj = 0; bj < 2; ++bj) {
                    const size_t off = (size_t)row * D + u.pn * 256 + bj * 128 + wc * 32 + fq * 8;
                    f32x4 x0 = *(const f32x4*)(X + off), x1 = *(const f32x4*)(X + off + 4);
                    const u32x4 pp = *(const u32x4*)(ppxb + off); const float gs = gsc;
                    const f32x4 a0 = acc[ai][bj][m][0] * r, a1 = acc[ai][bj][m][1] * r;
                    x0.x += sigmoidf_(a0.x) * (bf_lo(pp.x) * gs); x0.y += sigmoidf_(a0.y) * (bf_hi(pp.x) * gs); x0.z += sigmoidf_(a0.z) * (bf_lo(pp.y) * gs); x0.w += sigmoidf_(a0.w) * (bf_hi(pp.y) * gs);
                    x1.x += sigmoidf_(a1.x) * (bf_lo(pp.z) * gs); x1.y += sigmoidf_(a1.y) * (bf_hi(pp.z) * gs); x1.z += sigmoidf_(a1.z) * (bf_lo(pp.w) * gs); x1.w += sigmoidf_(a1.w) * (bf_hi(pp.w) * gs);
                    *(f32x4*)(X + off) = x0; *(f32x4*)(X + off + 4) = x1;
                    sq += dot4(x0) + dot4(x1);
                    u32x4 w; w.x = cvt_pk_bf16(x0.x, x0.y); w.y = cvt_pk_bf16(x0.z, x0.w); w.z = cvt_pk_bf16(x1.x, x1.y); w.w = cvt_pk_bf16(x1.z, x1.w);
                    *(u32x4*)(ppxb + off) = w;
                }
                sq += __shfl_xor(sq, 16); sq += __shfl_xor(sq, 32);
                if (fq == 0) ssOut[(size_t)row * 16 + u.pn * 4 + wc] = sq;
            }
    }
};
__device__ __forceinline__ void rope_rot(f32x4& v0, f32x4& v1, const float* cs) {
    const f32x4 c = *(const f32x4*)cs, s = *(const f32x4*)(cs + 4);
    const f32x4 a = v0 * c - v1 * s, b = v1 * c + v0 * s; v0 = a; v1 = b;
}
__device__ __forceinline__ void vstore1(unsigned char* vf, int vhead, int dd, int b, int ppos, bf16_t val);
struct EpiIn {
    const float* ss; unsigned char* ws; float* mst; const float* cs64; const float* cs32;
    __device__ __forceinline__ void operator()(AccRef acc, const Unit& u, int wr, int wc, int, int) const { const int lane_ = vlane(); const int fr = lane_ & 15, fq = lane_ >> 4;
#pragma unroll
        for (int ai = 0; ai < 2; ++ai)
#pragma unroll
            for (int m = 0; m < 4; ++m) {
                const int row = u.pm * 256 + ai * 128 + wr * 64 + m * 16 + fr;
                asm volatile("" ::: "memory");
                const float r = rs16(ss, row);
                const int pos = row & (T - 1), b = row >> 11;
                float sq = 0.f;
#pragma unroll
                for (int bj = 0; bj < 2; ++bj) {
                    const int gcol = u.pn * 256 + bj * 128 + wc * 32;
                    f32x4 v0 = acc[ai][bj][m][0] * r, v1 = acc[ai][bj][m][1] * r;
                    const bool r64 = (gcol >= 512 && gcol < 896) || (gcol >= 1024 && gcol < 1536);
                    if (r64) rope_rot(v0, v1, cs64 + ((size_t)pos * 8 + 4 * ((gcol >> 5) & 1) + fq) * 8);
                    if (gcol == 1920) rope_rot(v0, v1, cs32 + ((size_t)pos * 4 + fq) * 8);
                    if (u.pn == 6 || (u.pn == 7 && bj == 0)) sq += dot4(v0) + dot4(v1);
                    u32x4 w; w.x = cvt_pk_bf16(v0.x, v0.y); w.y = cvt_pk_bf16(v0.z, v0.w); w.z = cvt_pk_bf16(v1.x, v1.y); w.w = cvt_pk_bf16(v1.z, v1.w);
                    const int c8 = ((gcol & 63) >> 3) + fq;
                    const size_t frag = (size_t)(c8 >> 1) * 1024 + (size_t)((pos & 31) + 32 * (c8 & 1)) * 16;
                    const size_t rec = ((size_t)b * 64 + (pos >> 5)) * 4096;
                    if (gcol < 256) *(u32x4*)(ws + OFF_ZQ + ((size_t)row * ZQLD + gcol + fq * 8) * 2) = w;
                    else if (gcol < 512) *(u32x4*)(ws + OFF_KF + (size_t)((gcol - 256) >> 6) * HEADB + rec + frag) = w;
                    else if (gcol < 768) *(u32x4*)(ws + OFF_ZQ + ((size_t)row * ZQLD + (gcol - 256) + fq * 8) * 2) = w;
                    else if (gcol < 896) *(u32x4*)(ws + OFF_KF + (size_t)(4 + ((gcol - 768) >> 6)) * HEADB + rec + frag) = w;
                    else if (gcol < 1024) {
                        const int dd0 = (gcol - 896) + fq * 8; const unsigned ww[4] = {w.x, w.y, w.z, w.w};
#pragma unroll
                        for (int e = 0; e < 8; ++e) vstore1(ws + OFF_VT, 4 + (dd0 >> 6), (dd0 & 63) + e, b, pos, (bf16_t)((e & 1) ? (ww[e >> 1] >> 16) : (ww[e >> 1] & 0xffffu)));
                    }
                    else if (gcol < 1280) *(u32x4*)(ws + OFF_ZQ + ((size_t)row * ZQLD + (gcol - 512) + fq * 8) * 2) = w;
                    else if (gcol < 1536) {
                        const int hd = (gcol - 1280) >> 6;
                        *(u32x4*)(ws + OFF_KF + (size_t)(6 + hd) * HEADB + rec + frag) = w;
                        const int p4 = (pos & 3) * 512 + (pos >> 2), p16 = (pos & 15) * 128 + (pos >> 4);
                        *(u32x4*)(ws + OFF_KF + (size_t)(10 + hd) * HEADB + ((size_t)b * 64 + (p4 >> 5)) * 4096 + (size_t)(c8 >> 1) * 1024 + (size_t)((p4 & 31) + 32 * (c8 & 1)) * 16) = w;
                        *(u32x4*)(ws + OFF_KF + (size_t)(14 + hd) * HEADB + ((size_t)b * 64 + (p16 >> 5)) * 4096 + (size_t)(c8 >> 1) * 1024 + (size_t)((p16 & 31) + 32 * (c8 & 1)) * 16) = w;
                    }
                    else if (gcol < 1920) *(u32x4*)(ws + OFF_ZL + ((size_t)row * ZLLD + (gcol - 1536) + fq * 8) * 2) = w;
                    else if (gcol == 1920) *(u32x4*)(ws + OFF_KPE + ((size_t)b * 64 + (pos >> 5)) * 2048 + (size_t)(fq >> 1) * 1024 + (size_t)((pos & 31) + 32 * (fq & 1)) * 16) = w;
                }
                if (u.pn >= 6) {
                    sq += __shfl_xor(sq, 16); sq += __shfl_xor(sq, 32);
                    if (fq == 0) mst[(size_t)row * 8 + (u.pn - 6) * 4 + wc] = sq;
                }
            }
    }
};
__device__ __forceinline__ void vstore8(unsigned char* vf, int vhead, int dd, int tok0, u32x4 w) {
    const int b = tok0 >> 11, pos0 = tok0 & (T - 1), idx0 = pos0 & 31;
    unsigned char* p = vf + (size_t)vhead * HEADB + ((size_t)b * 64 + (pos0 >> 5)) * 4096 + (size_t)((dd >> 5) * 2 + (idx0 >> 4)) * 1024 + (size_t)(dd & 31) * 16 + ((idx0 >> 3) & 1) * 8;
    u32x2 lo; lo.x = w.x; lo.y = w.y; u32x2 hi; hi.x = w.z; hi.y = w.w;
    *(u32x2*)p = lo; *(u32x2*)(p + 512) = hi;
}
__device__ __forceinline__ void vstore1(unsigned char* vf, int vhead, int dd, int b, int ppos, bf16_t val) {
    const int idx = ppos & 31, r16 = idx & 15;
    unsigned char* p = vf + (size_t)vhead * HEADB + ((size_t)b * 64 + (ppos >> 5)) * 4096 + (size_t)((dd >> 5) * 2 + (idx >> 4)) * 1024 + (size_t)((dd & 31) + 32 * ((r16 >> 2) & 1)) * 16 + (r16 >> 3) * 8 + (r16 & 3) * 2;
    *(bf16_t*)p = val;
}
struct EpiVT {
    const float* ss; unsigned char* vf;
    __device__ __forceinline__ void operator()(AccRef acc, const Unit& u, int wr, int wc, int, int) const { const int lane_ = vlane(); const int fr = lane_ & 15, fq = lane_ >> 4;
#pragma unroll
        for (int bj = 0; bj < 2; ++bj) {
            const int tok0 = u.pn * 256 + bj * 128 + wc * 32 + fq * 8;
            float rs[8];
#pragma unroll
            for (int e = 0; e < 8; ++e) rs[e] = rs16(ss, tok0 + e);
#pragma unroll
            for (int ai = 0; ai < 2; ++ai) {
                const int rbase = u.pm * 256 + ai * 128;
                const bool dil = rbase >= 256;
#pragma unroll
                for (int m = 0; m < 4; ++m) {
                    const int row = rbase + wr * 64 + m * 16 + fr;
                    asm volatile("" ::: "memory");
                    const f32x4 a0 = acc[ai][bj][m][0], a1 = acc[ai][bj][m][1];
                    u32x4 w; w.x = cvt_pk_bf16(a0.x * rs[0], a0.y * rs[1]); w.y = cvt_pk_bf16(a0.z * rs[2], a0.w * rs[3]);
                    w.z = cvt_pk_bf16(a1.x * rs[4], a1.y * rs[5]); w.w = cvt_pk_bf16(a1.z * rs[6], a1.w * rs[7]);
                    const int vhead = (row >> 6) + (dil ? 2 : 0), dd = row & 63;
                    vstore8(vf, vhead, dd, tok0, w);
                    if (dil) {
                        const int b = tok0 >> 11, t0 = tok0 & (T - 1);
                        const unsigned ww[4] = {w.x, w.y, w.z, w.w};
#pragma unroll
                        for (int e = 0; e < 8; ++e) {
                            const int t = t0 + e; const bf16_t val = (bf16_t)((e & 1) ? (ww[e >> 1] >> 16) : (ww[e >> 1] & 0xffffu));
                            vstore1(vf, vhead + 4, dd, b, (t & 3) * 512 + (t >> 2), val);
                            vstore1(vf, vhead + 8, dd, b, (t & 15) * 128 + (t >> 4), val);
                        }
                    }
                }
            }
        }
    }
};
struct EpiQ {
    const float* mst; bf16_t* qm; const float* cs32;
    __device__ __forceinline__ void operator()(AccRef acc, const Unit& u, int wr, int wc, int, int) const { const int lane_ = vlane(); const int fr = lane_ & 15, fq = lane_ >> 4;
#pragma unroll
        for (int ai = 0; ai < 2; ++ai)
#pragma unroll
            for (int m = 0; m < 4; ++m) {
                const int row = u.pm * 256 + ai * 128 + wr * 64 + m * 16 + fr;
                asm volatile("" ::: "memory");
                const f32x4 st = *(const f32x4*)(mst + (size_t)row * 8);
                const float r = rsqrtf(sum4(st) * (1.0f / 256.0f) + EPS);
                const int pos = row & (T - 1);
#pragma unroll
                for (int bj = 0; bj < 2; ++bj) {
                    const int gcol = u.pn * 256 + bj * 128 + wc * 32;
                    if (gcol >= 384) continue;
                    f32x4 v0 = acc[ai][bj][m][0] * r, v1 = acc[ai][bj][m][1] * r;
                    if (((gcol >> 5) % 3) == 2) rope_rot(v0, v1, cs32 + ((size_t)pos * 4 + fq) * 8);
                    u32x4 w; w.x = cvt_pk_bf16(v0.x, v0.y); w.y = cvt_pk_bf16(v0.z, v0.w); w.z = cvt_pk_bf16(v1.x, v1.y); w.w = cvt_pk_bf16(v1.z, v1.w);
                    *(u32x4*)(qm + (size_t)row * QLD + gcol + fq * 8) = w;
                }
            }
    }
};
struct EpiK {
    const float* mst; unsigned char* ws;
    __device__ __forceinline__ void operator()(AccRef acc, const Unit& u, int wr, int wc, int, int) const { const int lane_ = vlane(); const int fr = lane_ & 15, fq = lane_ >> 4;
#pragma unroll
        for (int ai = 0; ai < 2; ++ai)
#pragma unroll
            for (int m = 0; m < 4; ++m) {
                const int row = u.pm * 256 + ai * 128 + wr * 64 + m * 16 + fr;
                asm volatile("" ::: "memory");
                const f32x4 st = *(const f32x4*)(mst + (size_t)row * 8 + 4);
                const float r = rsqrtf(sum4(st) * (1.0f / 128.0f) + EPS);
#pragma unroll
                for (int bj = 0; bj < 2; ++bj) {
                    const f32x4 v0 = acc[ai][bj][m][0] * r, v1 = acc[ai][bj][m][1] * r;
                    u32x4 w; w.x = cvt_pk_bf16(v0.x, v0.y); w.y = cvt_pk_bf16(v0.z, v0.w); w.z = cvt_pk_bf16(v1.x, v1.y); w.w = cvt_pk_bf16(v1.z, v1.w);
                    const int col0 = bj * 128 + wc * 32, c8 = ((col0 & 63) >> 3) + fq, pos = row & (T - 1);
                    *(u32x4*)(ws + OFF_KF + (size_t)(18 + (col0 >> 6)) * HEADB + ((size_t)(row >> 11) * 64 + (pos >> 5)) * 4096 + (size_t)(c8 >> 1) * 1024 + (size_t)((pos & 31) + 32 * (c8 & 1)) * 16) = w;
                }
            }
    }
};
struct EpiVTM {
    const float* mst; unsigned char* vf;
    __device__ __forceinline__ void operator()(AccRef acc, const Unit& u, int wr, int wc, int, int) const { const int lane_ = vlane(); const int fr = lane_ & 15, fq = lane_ >> 4;
#pragma unroll
        for (int bj = 0; bj < 2; ++bj) {
            const int tok0 = u.pn * 256 + bj * 128 + wc * 32 + fq * 8;
            float rs[8];
#pragma unroll
            for (int e = 0; e < 8; ++e) { const f32x4 st = *(const f32x4*)(mst + (size_t)(tok0 + e) * 8 + 4); rs[e] = rsqrtf(sum4(st) * (1.0f / 128.0f) + EPS); }
#pragma unroll
            for (int ai = 0; ai < 2; ++ai)
#pragma unroll
                for (int m = 0; m < 4; ++m) {
                    const int row = ai * 128 + wr * 64 + m * 16 + fr;
                    asm volatile("" ::: "memory");
                    const f32x4 a0 = acc[ai][bj][m][0], a1 = acc[ai][bj][m][1];
                    u32x4 w; w.x = cvt_pk_bf16(a0.x * rs[0], a0.y * rs[1]); w.y = cvt_pk_bf16(a0.z * rs[2], a0.w * rs[3]);
                    w.z = cvt_pk_bf16(a1.x * rs[4], a1.y * rs[5]); w.w = cvt_pk_bf16(a1.z * rs[6], a1.w * rs[7]);
                    vstore8(vf, 18 + (row >> 6), row & 63, tok0, w);
                }
        }
    }
};
struct EpiPP {
    bf16_t* O;
    __device__ __forceinline__ void operator()(AccRef acc, const Unit& u, int wr, int wc, int, int) const { const int lane_ = vlane(); const int fr = lane_ & 15, fq = lane_ >> 4;
#pragma unroll
        for (int ai = 0; ai < 2; ++ai)
#pragma unroll
            for (int m = 0; m < 4; ++m) {
                const int row = u.pm * 256 + ai * 128 + wr * 64 + m * 16 + fr;
                asm volatile("" ::: "memory");
#pragma unroll
                for (int bj = 0; bj < 2; ++bj) {
                    const f32x4 v0 = acc[ai][bj][m][0], v1 = acc[ai][bj][m][1];
                    u32x4 w; w.x = cvt_pk_bf16(v0.x, v0.y); w.y = cvt_pk_bf16(v0.z, v0.w); w.z = cvt_pk_bf16(v1.x, v1.y); w.w = cvt_pk_bf16(v1.z, v1.w);
                    *(u32x4*)(O + (size_t)row * D + u.pn * 256 + bj * 128 + wc * 32 + fq * 8) = w;
                }
            }
    }
};

template <class Epi>
__device__ __forceinline__ void run_gemm(int wv, LAS unsigned char* lds, const bf16_t* A, int lda, int rows, const bf16_t* Bt, int ldb, int cols, int K, int cshift, const Epi& E) {
    pg8::Gemm g{A, Bt, lda, ldb, K};
    pg8::StaticOrder S; const int G_ = lgrid(); S.init(rows, cols, G_, (lbid() + cshift) % G_);
    pg8::gemm_phase<Epi>(lds, g, S, E, wv);
}

__device__ __forceinline__ int p64(int d) { return d < 32 ? 8 * (d >> 2) + (d & 3) : 8 * ((d - 32) >> 2) + 4 + (d & 3); }
__device__ __forceinline__ int p32(int d) { return d < 16 ? 8 * (d >> 2) + (d & 3) : 8 * ((d - 16) >> 2) + 4 + (d & 3); }
__device__ __forceinline__ int maprow(int mapid, int c) {
    switch (mapid) {
        case 0: return c;
        case 1: return (c >> 7) * 256 + (c & 127);
        case 2: return (c >> 7) * 256 + 128 + (c & 127);
        case 3: {
            if (c < 768) return c < 512 ? c : 2048 + (c - 512);
            c -= 768;
            if (c < 512) return c < 384 ? 512 + (c >> 6) * 64 + p64(c & 63) : 896 + (c - 384);
            c -= 512;
            if (c < 768) return c < 512 ? 1024 + (c >> 6) * 64 + p64(c & 63) : 2048 + 256 + (c - 512);
            c -= 768;
            if (c < 256) return 1536 + c;
            if (c < 384) return 1792 + (c - 256);
            return 1920 + p32(c - 384);
        }
        case 4: { const int h = c / 96, e = c % 96; return e < 64 ? 96 * h + e : 96 * h + 64 + p32(e - 64); }
        default: { const int h = c >> 7, e = c & 127; return e < 64 ? 64 * h + e : 256 + 64 * h + (e - 64); }
    }
}
__device__ __forceinline__ void tr_item(const float* W, int K, int N, const float* gain, bf16_t* dst, int mapid, int item, LAS float* s, int wv) {
    const int tid = ltid(wv);
    const int ncb = (N + 255) >> 8, kb = item / ncb, cb = item % ncb, k0 = kb * 64, c0 = cb * 256;
#pragma unroll
    for (int i = 0; i < 8; ++i) {
        const int kk = i * 8 + (tid >> 6), col = (tid & 63) * 4;
        f32x4 v = (f32x4){0.f, 0.f, 0.f, 0.f};
        if (c0 + col < N) v = *(const f32x4*)(W + (size_t)(k0 + kk) * N + c0 + col);
        if (gain) v *= gain[k0 + kk];
        *(LAS f32x4*)(s + kk * 260 + col) = v;
    }
    __syncthreads();
    const int cc = tid & 255, kh = tid >> 8, c = c0 + cc;
    if (c < N) {
        const int drow = maprow(mapid, c);
        bf16_t* o = dst + (size_t)drow * K + k0 + kh * 32;
#pragma unroll
        for (int q = 0; q < 4; ++q) {
            const LAS float* sp = s + (kh * 32 + q * 8) * 260 + cc;
            u32x4 w; w.x = cvt_pk_bf16(sp[0], sp[260]); w.y = cvt_pk_bf16(sp[2 * 260], sp[3 * 260]); w.z = cvt_pk_bf16(sp[4 * 260], sp[5 * 260]); w.w = cvt_pk_bf16(sp[6 * 260], sp[7 * 260]);
            *(u32x4*)(o + q * 8) = w;
        }
    }
    __syncthreads();
}

struct Args { const float* in[24]; float* out; unsigned char* ws; int ph_lo, ph_hi, coop, pad; };
typedef const __attribute__((address_space(4))) Args* KA;
__device__ __forceinline__ KA kargs() { KA p = (KA)__builtin_amdgcn_kernarg_segment_ptr(); asm volatile("" : "+s"(p)); return p; }

__device__ __forceinline__ void zero_rows(bf16_t* base, int row0, int nrows, int K, int gt, int ngt) {
    const size_t n16 = (size_t)nrows * K / 8; u32x4* p = (u32x4*)(base + (size_t)row0 * K);
    for (size_t i = gt; i < n16; i += ngt) p[i] = (u32x4){0u, 0u, 0u, 0u};
}

__device__ __forceinline__ void prologue(KA a, LAS unsigned char* lds, int wv) {
    LAS float* s = (LAS float*)lds;
    const int G = lgrid(), bid = lbid(), tid = ltid(wv);
    bf16_t* Wbase = (bf16_t*)(a->ws + OFF_W);
#if PRO_PARTS & 1
    constexpr int I_FFN = 16 * 11, I_DN = 44 * 4, I_IN = 16 * 10, I_UQ = 4 * 2, I_UKV = 2 * 2, I_O = 16 * 4, I_PP = 4 * 4;
    constexpr int I_LAYER = 4 * I_FFN + 2 * I_DN + I_IN + I_UQ + I_UKV + 2 * I_O + I_PP;
    for (int it = bid; it < I_LAYER * DEPTH; it += G) {
        const int l = it / I_LAYER; int r = it % I_LAYER;
        int sel = 0;
        if (r >= I_FFN) { r -= I_FFN; sel = 1;
        if (r >= I_FFN) { r -= I_FFN; sel = 2;
        if (r >= I_DN) { r -= I_DN; sel = 3;
        if (r >= I_IN) { r -= I_IN; sel = 4;
        if (r >= I_UQ) { r -= I_UQ; sel = 5;
        if (r >= I_UKV) { r -= I_UKV; sel = 6;
        if (r >= I_O) { r -= I_O; sel = 7;
        if (r >= I_FFN) { r -= I_FFN; sel = 8;
        if (r >= I_FFN) { r -= I_FFN; sel = 9;
        if (r >= I_DN) { r -= I_DN; sel = 10;
        if (r >= I_O) { r -= I_O; sel = 11; } } } } } } } } } } }
        const float* W0; const float* g0 = nullptr; int K, N, mapid; size_t doff;
        switch (sel) {
            case 0: W0 = a->in[3]; g0 = a->in[2]; K = D; N = FF; doff = WL_GU1; mapid = 1; break;
            case 1: W0 = a->in[4]; g0 = a->in[2]; K = D; N = FF; doff = WL_GU1; mapid = 2; break;
            case 2: W0 = a->in[5]; K = FF; N = D; doff = WL_D1; mapid = 0; break;
            case 3: W0 = a->in[7]; g0 = a->in[6]; K = D; N = 2464; doff = WL_IN; mapid = 3; break;
            case 4: W0 = a->in[11]; g0 = a->in[10]; K = 256; N = 384; doff = WL_UQ; mapid = 4; break;
            case 5: W0 = a->in[13]; g0 = a->in[12]; K = 128; N = 512; doff = WL_UKV; mapid = 5; break;
            case 6: W0 = a->in[15]; g0 = a->in[14]; K = D; N = D; doff = WL_O; mapid = 0; break;
            case 7: W0 = a->in[17]; g0 = a->in[16]; K = D; N = FF; doff = WL_GU2; mapid = 1; break;
            case 8: W0 = a->in[18]; g0 = a->in[16]; K = D; N = FF; doff = WL_GU2; mapid = 2; break;
            case 9: W0 = a->in[19]; K = FF; N = D; doff = WL_D2; mapid = 0; break;
            case 10: W0 = a->in[21]; g0 = a->in[20]; K = D; N = D; doff = WL_PG; mapid = 0; break;
            default: W0 = a->in[22]; K = PLE; N = D; doff = WL_PP; mapid = 0; break;
        }
        const float* W = W0 + (size_t)l * K * N;
        const float* gain = g0 ? g0 + (size_t)l * K : nullptr;
        tr_item(W, K, N, gain, Wbase + (size_t)l * WL_SIZE + doff, mapid, r, s, wv);
    }
#endif
    const int gt = bid * 512 + tid, ngt = G * 512;
    for (int l = 0; l < DEPTH; ++l) {
        bf16_t* WL = Wbase + (size_t)l * WL_SIZE;
        zero_rows(WL + WL_IN, 1952, 96, D, gt, ngt);
        zero_rows(WL + WL_UQ, 384, 128, 256, gt, ngt);
    }
#if PRO_PARTS & 2
    float* cs64 = (float*)(a->ws + OFF_CS64); float* cs32 = (float*)(a->ws + OFF_CS32);
    for (int i = gt; i < T * 32; i += ngt) {
        const int pos = i >> 5, j = i & 31;
        const float inv = __builtin_amdgcn_exp2f(-(float)j * (13.287712379549449f / 32.0f)); const float ang = (float)pos * inv;
        const float rev = ang * 0.15915494309189535f, fr_ = rev - floorf(rev);
        float* p = cs64 + ((size_t)pos * 8 + (j >> 2)) * 8 + (j & 3);
        p[0] = __builtin_amdgcn_cosf(fr_); p[4] = __builtin_amdgcn_sinf(fr_);
    }
    for (int i = gt; i < T * 16; i += ngt) {
        const int pos = i >> 4, j = i & 15;
        const float inv = __builtin_amdgcn_exp2f(-(float)j * (13.287712379549449f / 16.0f)); const float ang = (float)pos * inv;
        const float rev = ang * 0.15915494309189535f, fr_ = rev - floorf(rev);
        float* p = cs32 + ((size_t)pos * 4 + (j >> 2)) * 8 + (j & 3);
        p[0] = __builtin_amdgcn_cosf(fr_); p[4] = __builtin_amdgcn_sinf(fr_);
    }
#endif
#if PRO_PARTS & 4
    const int lane = tid & 63, gw = bid * 8 + (tid >> 6), ngw = G * 8;
    bf16_t* xb = (bf16_t*)(a->ws + OFF_XBA); float* ss = (float*)(a->ws + OFF_SSA);
    for (int row = gw; row < M; row += ngw) {
        const f32x4* xr = (const f32x4*)(a->in[0] + (size_t)row * D) + lane; f32x4* orow = (f32x4*)(a->out + (size_t)row * D) + lane;
        float sq = 0.f;
#pragma unroll
        for (int j = 0; j < 4; ++j) {
            const f32x4 v = xr[64 * j]; orow[64 * j] = v; sq += dot4(v);
            u32x2 w; w.x = cvt_pk_bf16(v.x, v.y); w.y = cvt_pk_bf16(v.z, v.w);
            *(u32x2*)(xb + (size_t)row * D + 256 * j + lane * 4) = w;
        }
#pragma unroll
        for (int o = 1; o < 64; o <<= 1) sq += __shfl_xor(sq, o);
        if (lane < 16) ss[(size_t)row * 16 + lane] = lane == 0 ? sq : 0.f;
    }
#endif
}

__device__ __forceinline__ void convert_p(KA a, int layer, int wv) {
    const f32x4* src = (const f32x4*)(a->in[1] + (size_t)layer * M * PLE); u32x2* dst = (u32x2*)(a->ws + OFF_VT);
    const size_t n = (size_t)M * PLE / 4;
    const int tid_ = ltid(wv), bid_ = lbid(), G_ = lgrid();
    for (size_t i = (size_t)bid_ * 512 + tid_; i < n; i += (size_t)G_ * 512) {
        const f32x4 v = src[i]; u32x2 w; w.x = cvt_pk_bf16(v.x, v.y); w.y = cvt_pk_bf16(v.z, v.w); dst[i] = w;
    }
}

__device__ __forceinline__ void final_norm(KA a, int wv) {
    const int tid_ = ltid(wv); const int lane = tid_ & 63, gw = lbid() * 8 + (tid_ >> 6), ngw = lgrid() * 8;
    const float* ss = (const float*)(a->ws + OFF_SSA);
    f32x4 g[4];
#pragma unroll
    for (int j = 0; j < 4; ++j) g[j] = ((const f32x4*)a->in[23])[64 * j + lane];
    for (int row = gw; row < M; row += ngw) {
        const float r = rs16(ss, row);
        f32x4* orow = (f32x4*)(a->out + (size_t)row * D) + lane;
#pragma unroll
        for (int j = 0; j < 4; ++j) orow[64 * j] = orow[64 * j] * r * g[j];
    }
}

struct AttnP { const unsigned char* ws; const float* nab; const float* sink; };

template <int MODE>
__device__ __forceinline__ void attn_unit(const AttnP& P0, int unit, LAS float* xch, const LAS float* nabl, int wv) {
    const unsigned char* ws = P0.ws; asm volatile("" : "+s"(ws));
    constexpr int NS = MODE == 0 ? 6 : 4;
    const int lane = vlane(), w = wv, qs = w >> 2, h = w & 3, ql = lane & 31, hh = lane >> 5;
    const int lane16 = lane * 16;
    const int b = unit >> 5, rem = unit & 31;
    int qt, T0 = 0, rr = 0, qmin, qmax;
    if (MODE == 1) { T0 = 512 * (rem >> 3); rr = 2 * (rem & 7) + qs; qt = T0 + rr + 16 * ql; qmin = T0 + rr; qmax = qmin + 496; }
    else { qmin = 64 * rem + 32 * qs; qt = qmin + ql; qmax = qmin + 31; }
    const size_t tokbase = (size_t)b * T;
    const bf16_t* qrow; int khead, group;
    if (MODE == 0) { qrow = (const bf16_t*)(ws + OFF_QM) + (tokbase + qt) * QLD + 96 * h; khead = 18 + h; group = 3; }
    else if (MODE == 1) { qrow = (const bf16_t*)(ws + OFF_ZQ) + (tokbase + qt) * ZQLD + 512 + 64 * h; khead = 6 + h; group = 2; }
    else if (MODE == 2) { qrow = (const bf16_t*)(ws + OFF_ZQ) + (tokbase + qt) * ZQLD + 64 * h; khead = h; group = 0; }
    else { qrow = (const bf16_t*)(ws + OFF_ZQ) + (tokbase + qt) * ZQLD + 256 + 64 * h; khead = 4 + (h >> 1); group = 1; }
    const unsigned char* kfb = ws + OFF_KF + (size_t)b * 64 * 4096 + lane16;
    const unsigned char* vfb = ws + OFF_VT + (size_t)b * 64 * 4096 + lane16;
    const unsigned char* kpe = ws + OFF_KPE + (size_t)b * 64 * 2048 + lane16;
    bf16x8 qf[NS];
#pragma unroll
    for (int s = 0; s < NS; ++s) qf[s] = *(const bf16x8*)(qrow + 16 * s + 8 * hh);
    const float sc = (MODE == 0 ? 0.10206207261596577f : 0.125f) * LOG2E;
    f32x16 o0, o1;
#pragma unroll
    for (int e = 0; e < 16; ++e) { o0[e] = 0.f; o1[e] = 0.f; }
    float mrun = -1e20f, lrun = 0.f;
    if (MODE == 3) { mrun = P0.sink[h] * LOG2E; lrun = hh == 0 ? 1.f : 0.f; }
    const int qcol = qt & 63;
    const int nseg = MODE == 1 ? 3 : 1;
    for (int seg = 0; seg < nseg; ++seg) {
        int ntile, kb0, kstr, vb0, win, hd = khead;
        if (MODE == 0) { ntile = 64; kb0 = 0; kstr = 1; vb0 = 0; win = 1 << 20; }
        else if (MODE == 2) { ntile = 16; kb0 = 64 * min(max(rem - 4, 0), 24); kstr = 1; vb0 = kb0; win = 0; }
        else if (MODE == 3) { ntile = 9; kb0 = qmin - 128; kstr = 1; vb0 = kb0; win = 128; }
        else {
            if (seg == 0) { ntile = 20; kb0 = T0 - 64; kstr = 1; vb0 = kb0; win = 64; }
            else if (seg == 1) { ntile = 8; const int us = (T0 >> 2) - 64, r4 = rr & 3; kb0 = 4 * us + r4; kstr = 4; vb0 = r4 * 512 + us; win = 256; hd = khead + 4; }
            else { ntile = 5; const int nst = (T0 >> 4) - 64; kb0 = 16 * nst + rr; kstr = 16; vb0 = rr * 128 + nst; win = 1024; hd = khead + 8; }
        }
        const int kstep = 32 * kstr;
        int tlo = 0, thi = ntile;
        if (MODE == 1 || MODE == 3) { tlo = kb0 < 0 ? (-kb0 + kstep - 1) / kstep : 0; thi = min(ntile, (T - kb0 + kstep - 1) / kstep); }
        const unsigned char* kfh = kfb + (size_t)hd * HEADB; const unsigned char* vfh = vfb + (size_t)hd * HEADB;
        bf16x8 kf[NS], vf[4];
        {
            const int pt = (vb0 >> 5) + tlo;
#pragma unroll
            for (int s = 0; s < NS; ++s) kf[s] = (MODE == 0 && s >= 4) ? *(const bf16x8*)(kpe + (size_t)pt * 2048 + (s - 4) * 1024) : *(const bf16x8*)(kfh + (size_t)pt * 4096 + s * 1024);
#pragma unroll
            for (int j = 0; j < 4; ++j) vf[j] = *(const bf16x8*)(vfh + (size_t)pt * 4096 + j * 1024);
        }
        if (qs && seg == 0) __builtin_amdgcn_s_sleep(DEPHASE / 2);
        for (int tau = tlo; tau < thi; ++tau) {
            const int kb = kb0 + kstep * tau;
            bf16x8 kn[NS], vn[4];
            {
                const int pt = (vb0 >> 5) + min(tau + 1, thi - 1);
#pragma unroll
                for (int s = 0; s < NS; ++s) kn[s] = (MODE == 0 && s >= 4) ? *(const bf16x8*)(kpe + (size_t)pt * 2048 + (s - 4) * 1024) : *(const bf16x8*)(kfh + (size_t)pt * 4096 + s * 1024);
#pragma unroll
                for (int j = 0; j < 4; ++j) vn[j] = *(const bf16x8*)(vfh + (size_t)pt * 4096 + j * 1024);
            }
            f32x16 sacc;
#pragma unroll
            for (int e = 0; e < 16; ++e) sacc[e] = 0.f;
#pragma unroll
            for (int s = 0; s < NS; ++s) sacc = __builtin_amdgcn_mfma_f32_32x32x16_bf16(kf[s], qf[s], sacc, 0, 0, 0);
            if (MODE == 2) {
                const int c0 = 32 * (tau & 1), wsx = min(max(qcol - 8, 0), 48);
                const int mb = c0 - wsx + 4 * hh;
                const int drow = (kb >> 6) - rem + 7;
                const LAS float* bp = nabl + (h * 15 + drow) * 31 + c0 - qcol + 15 + 4 * hh;
#pragma unroll
                for (int e = 0; e < 16; ++e) {
                    const int o = 8 * (e >> 2) + (e & 3);
                    const float v = sacc[e] * sc + bp[o];
                    sacc[e] = (unsigned)(mb + o) < 16u ? v : -1e30f;
                }
            } else if (MODE != 0) {
                const bool full = (kb + 31 * kstr - qmin <= win) && (qmax - kb <= win);
                if (!full) {
                    const int mb = kb - qt + win + 4 * hh * kstr;
#pragma unroll
                    for (int e = 0; e < 16; ++e) {
                        const int o = (8 * (e >> 2) + (e & 3)) * kstr;
                        sacc[e] = (unsigned)(mb + o) <= (unsigned)(2 * win) ? sacc[e] : -1e30f;
                    }
                }
            }
            float tmax = fmaxf(fmaxf(sacc[0], sacc[1]), fmaxf(sacc[2], sacc[3]));
#pragma unroll
            for (int e = 4; e < 16; e += 4) tmax = fmaxf(tmax, fmaxf(fmaxf(sacc[e], sacc[e + 1]), fmaxf(sacc[e + 2], sacc[e + 3])));
            tmax = fmaxf(tmax, __shfl_xor(tmax, 32));
            if (MODE != 2) tmax *= sc;
            const float mnew = fmaxf(mrun, tmax);
            const bool grow = mnew > mrun;
            const float alpha = __builtin_amdgcn_exp2f(mrun - mnew);
            mrun = mnew;
            float psum = 0.f;
#pragma unroll
            for (int e = 0; e < 16; ++e) {
                const float p = MODE == 2 ? __builtin_amdgcn_exp2f(sacc[e] - mnew) : __builtin_amdgcn_exp2f(__builtin_fmaf(sacc[e], sc, -mnew));
                sacc[e] = p; psum += p;
            }
            lrun = lrun * alpha + psum;
            if (__builtin_amdgcn_ballot_w64(grow) != 0ull) {
#pragma unroll
                for (int e = 0; e < 16; ++e) { o0[e] *= alpha; o1[e] *= alpha; }
            }
            bf16x8 pb[2];
#pragma unroll
            for (int t = 0; t < 2; ++t) {
                u32x4 v; v.x = cvt_pk_bf16(sacc[8 * t + 0], sacc[8 * t + 1]); v.y = cvt_pk_bf16(sacc[8 * t + 2], sacc[8 * t + 3]);
                v.z = cvt_pk_bf16(sacc[8 * t + 4], sacc[8 * t + 5]); v.w = cvt_pk_bf16(sacc[8 * t + 6], sacc[8 * t + 7]);
                pb[t] = __builtin_bit_cast(bf16x8, v);
            }
            o0 = __builtin_amdgcn_mfma_f32_32x32x16_bf16(vf[0], pb[0], o0, 0, 0, 0);
            o0 = __builtin_amdgcn_mfma_f32_32x32x16_bf16(vf[1], pb[1], o0, 0, 0, 0);
            o1 = __builtin_amdgcn_mfma_f32_32x32x16_bf16(vf[2], pb[0], o1, 0, 0, 0);
            o1 = __builtin_amdgcn_mfma_f32_32x32x16_bf16(vf[3], pb[1], o1, 0, 0, 0);
#pragma unroll
            for (int s = 0; s < NS; ++s) kf[s] = kn[s];
#pragma unroll
            for (int j = 0; j < 4; ++j) vf[j] = vn[j];
        }
    }
    lrun += __shfl_xor(lrun, 32);
    const float inv = 1.0f / lrun;
    float sq = 0.f;
#pragma unroll
    for (int e = 0; e < 16; ++e) { o0[e] *= inv; o1[e] *= inv; sq += o0[e] * o0[e] + o1[e] * o1[e]; }
    sq += __shfl_xor(sq, 32);
    if (hh == 0) xch[w * 32 + ql] = sq;
    __syncthreads();
    const float tot = (xch[(qs * 4 + 0) * 32 + ql] + xch[(qs * 4 + 1) * 32 + ql]) + (xch[(qs * 4 + 2) * 32 + ql] + xch[(qs * 4 + 3) * 32 + ql]);
    const float rg = rsqrtf(tot * (1.0f / 256.0f) + EPS);
    bf16_t* yrow = (bf16_t*)(ws + OFF_XBA) + (tokbase + qt) * D + group * 256 + h * 64 + 4 * hh;
#pragma unroll
    for (int j = 0; j < 4; ++j) {
        u32x2 w0; w0.x = cvt_pk_bf16(o0[4 * j] * rg, o0[4 * j + 1] * rg); w0.y = cvt_pk_bf16(o0[4 * j + 2] * rg, o0[4 * j + 3] * rg);
        u32x2 w1; w1.x = cvt_pk_bf16(o1[4 * j] * rg, o1[4 * j + 1] * rg); w1.y = cvt_pk_bf16(o1[4 * j + 2] * rg, o1[4 * j + 3] * rg);
        *(u32x2*)(yrow + 8 * j) = w0; *(u32x2*)(yrow + 32 + 8 * j) = w1;
    }
}

__device__ __forceinline__ void sm_pv(f32x16& sacc, f32x16& o0, f32x16& o1, float& mrun, float& lrun, const bf16x8 (&vf)[4], float sc) {
    float tmax = fmaxf(fmaxf(sacc[0], sacc[1]), fmaxf(sacc[2], sacc[3]));
#pragma unroll
    for (int e = 4; e < 16; e += 4) tmax = fmaxf(tmax, fmaxf(fmaxf(sacc[e], sacc[e + 1]), fmaxf(sacc[e + 2], sacc[e + 3])));
    tmax = fmaxf(tmax, __shfl_xor(tmax, 32)) * sc;
    const float mnew = fmaxf(mrun, tmax);
    const bool grow = mnew > mrun;
    const float alpha = __builtin_amdgcn_exp2f(mrun - mnew);
    mrun = mnew;
    float psum = 0.f;
#pragma unroll
    for (int e = 0; e < 16; ++e) { const float p = __builtin_amdgcn_exp2f(__builtin_fmaf(sacc[e], sc, -mnew)); sacc[e] = p; psum += p; }
    lrun = lrun * alpha + psum;
    if (__builtin_amdgcn_ballot_w64(grow) != 0ull) {
#pragma unroll
        for (int e = 0; e < 16; ++e) { o0[e] *= alpha; o1[e] *= alpha; }
    }
    bf16x8 pb[2];
#pragma unroll
    for (int t = 0; t < 2; ++t) {
        u32x4 v; v.x = cvt_pk_bf16(sacc[8 * t + 0], sacc[8 * t + 1]); v.y = cvt_pk_bf16(sacc[8 * t + 2], sacc[8 * t + 3]);
        v.z = cvt_pk_bf16(sacc[8 * t + 4], sacc[8 * t + 5]); v.w = cvt_pk_bf16(sacc[8 * t + 6], sacc[8 * t + 7]);
        pb[t] = __builtin_bit_cast(bf16x8, v);
    }
    o0 = __builtin_amdgcn_mfma_f32_32x32x16_bf16(vf[0], pb[0], o0, 0, 0, 0);
    o0 = __builtin_amdgcn_mfma_f32_32x32x16_bf16(vf[1], pb[1], o0, 0, 0, 0);
    o1 = __builtin_amdgcn_mfma_f32_32x32x16_bf16(vf[2], pb[0], o1, 0, 0, 0);
    o1 = __builtin_amdgcn_mfma_f32_32x32x16_bf16(vf[3], pb[1], o1, 0, 0, 0);
}
__device__ __forceinline__ void attn_mla(const AttnP& P0, int unit, LAS float* xch, int wv) {
    const unsigned char* ws = P0.ws; asm volatile("" : "+s"(ws));
    const int lane = vlane(), w = wv, qs = w >> 2, h = w & 3, ql = lane & 31, hh = lane >> 5;
    const int lane16 = lane * 16;
    const int b = unit >> 4, q0 = 128 * (unit & 15) + 64 * qs;
    const size_t tokbase = (size_t)b * T;
    const bf16_t* qrA = (const bf16_t*)(ws + OFF_QM) + (tokbase + q0 + ql) * QLD + 96 * h;
    const bf16_t* qrB = qrA + 32 * QLD;
    const unsigned char* kfh = ws + OFF_KF + (size_t)(18 + h) * HEADB + (size_t)b * 64 * 4096 + lane16;
    const unsigned char* vfh = ws + OFF_VT + (size_t)(18 + h) * HEADB + (size_t)b * 64 * 4096 + lane16;
    const unsigned char* kpe = ws + OFF_KPE + (size_t)b * 64 * 2048 + lane16;
    bf16x8 qA[6], qB[6];
#pragma unroll
    for (int s = 0; s < 6; ++s) { qA[s] = *(const bf16x8*)(qrA + 16 * s + 8 * hh); qB[s] = *(const bf16x8*)(qrB + 16 * s + 8 * hh); }
    const float sc = 0.10206207261596577f * LOG2E;
    f32x16 oA0, oA1, oB0, oB1;
#pragma unroll
    for (int e = 0; e < 16; ++e) { oA0[e] = 0.f; oA1[e] = 0.f; oB0[e] = 0.f; oB1[e] = 0.f; }
    float mA = -1e20f, lA = 0.f, mB = -1e20f, lB = 0.f;
    bf16x8 kf[6], vf[4];
#pragma unroll
    for (int s = 0; s < 6; ++s) kf[s] = s >= 4 ? *(const bf16x8*)(kpe + (s - 4) * 1024) : *(const bf16x8*)(kfh + s * 1024);
#pragma unroll
    for (int j = 0; j < 4; ++j) vf[j] = *(const bf16x8*)(vfh + j * 1024);
    if (qs) __builtin_amdgcn_s_sleep(DEPHASE);
    for (int tau = 0; tau < 64; ++tau) {
        bf16x8 kn[6], vn[4];
        const int pt = min(tau + 1, 63);
#pragma unroll
        for (int s = 0; s < 6; ++s) kn[s] = s >= 4 ? *(const bf16x8*)(kpe + (size_t)pt * 2048 + (s - 4) * 1024) : *(const bf16x8*)(kfh + (size_t)pt * 4096 + s * 1024);
#pragma unroll
        for (int j = 0; j < 4; ++j) vn[j] = *(const bf16x8*)(vfh + (size_t)pt * 4096 + j * 1024);
        f32x16 sa, sb;
#pragma unroll
        for (int e = 0; e < 16; ++e) { sa[e] = 0.f; sb[e] = 0.f; }
#pragma unroll
        for (int s = 0; s < 6; ++s) { sa = __builtin_amdgcn_mfma_f32_32x32x16_bf16(kf[s], qA[s], sa, 0, 0, 0); sb = __builtin_amdgcn_mfma_f32_32x32x16_bf16(kf[s], qB[s], sb, 0, 0, 0); }
        sm_pv(sa, oA0, oA1, mA, lA, vf, sc);
        sm_pv(sb, oB0, oB1, mB, lB, vf, sc);
#pragma unroll
        for (int s = 0; s < 6; ++s) kf[s] = kn[s];
#pragma unroll
        for (int j = 0; j < 4; ++j) vf[j] = vn[j];
    }
    lA += __shfl_xor(lA, 32); lB += __shfl_xor(lB, 32);
    const float iA = 1.0f / lA, iB = 1.0f / lB;
    float sqA = 0.f, sqB = 0.f;
#pragma unroll
    for (int e = 0; e < 16; ++e) { oA0[e] *= iA; oA1[e] *= iA; oB0[e] *= iB; oB1[e] *= iB; sqA += oA0[e] * oA0[e] + oA1[e] * oA1[e]; sqB += oB0[e] * oB0[e] + oB1[e] * oB1[e]; }
    sqA += __shfl_xor(sqA, 32); sqB += __shfl_xor(sqB, 32);
    if (hh == 0) { xch[w * 64 + ql] = sqA; xch[w * 64 + 32 + ql] = sqB; }
    __syncthreads();
    const LAS float* xq = xch + qs * 256 + ql;
    const float rA = rsqrtf(((xq[0] + xq[64]) + (xq[128] + xq[192])) * (1.0f / 256.0f) + EPS);
    const float rB = rsqrtf(((xq[32] + xq[96]) + (xq[160] + xq[224])) * (1.0f / 256.0f) + EPS);
    bf16_t* yA = (bf16_t*)(ws + OFF_XBA) + (tokbase + q0 + ql) * D + 3 * 256 + h * 64 + 4 * hh;
    bf16_t* yB = yA + 32 * D;
#pragma unroll
    for (int j = 0; j < 4; ++j) {
        u32x2 w0; w0.x = cvt_pk_bf16(oA0[4 * j] * rA, oA0[4 * j + 1] * rA); w0.y = cvt_pk_bf16(oA0[4 * j + 2] * rA, oA0[4 * j + 3] * rA);
        u32x2 w1; w1.x = cvt_pk_bf16(oA1[4 * j] * rA, oA1[4 * j + 1] * rA); w1.y = cvt_pk_bf16(oA1[4 * j + 2] * rA, oA1[4 * j + 3] * rA);
        *(u32x2*)(yA + 8 * j) = w0; *(u32x2*)(yA + 32 + 8 * j) = w1;
        u32x2 w2; w2.x = cvt_pk_bf16(oB0[4 * j] * rB, oB0[4 * j + 1] * rB); w2.y = cvt_pk_bf16(oB0[4 * j + 2] * rB, oB0[4 * j + 3] * rB);
        u32x2 w3; w3.x = cvt_pk_bf16(oB1[4 * j] * rB, oB1[4 * j + 1] * rB); w3.y = cvt_pk_bf16(oB1[4 * j + 2] * rB, oB1[4 * j + 3] * rB);
        *(u32x2*)(yB + 8 * j) = w2; *(u32x2*)(yB + 32 + 8 * j) = w3;
    }
}

__device__ __forceinline__ void attn_phase(KA a, int layer, LAS unsigned char* lds, int wv) {
    AttnP P; P.ws = a->ws; P.nab = a->in[8] + (size_t)layer * 4 * 15 * 31; P.sink = a->in[9] + layer * 4;
    LAS float* xch = (LAS float*)lds;
    for (int i = ltid(wv); i < 4 * 15 * 31; i += 512) xch[1024 + i] = P.nab[i] * LOG2E;
    __syncthreads();
    int it = 0;
    const int G_ = lgrid(), bid_ = lbid();
    const int vcu = (G_ & 7) == 0 ? (bid_ & 7) * (G_ >> 3) + (bid_ >> 3) : bid_;
    for (int u = vcu; u < 256 + 3 * 512; u += G_, ++it) {
        LAS float* x = xch + (it & 1) * 512;
        if (u < 256) attn_mla(P, u, x, wv);
        else {
            const int mode = 1 + ((u - 256) >> 9), unit = (u - 256) & 511;
            if (mode == 1) attn_unit<1>(P, unit, x, xch + 1024, wv);
            else if (mode == 2) attn_unit<2>(P, unit, x, xch + 1024, wv);
            else attn_unit<3>(P, unit, x, xch + 1024, wv);
        }
    }
    __syncthreads();
}

__device__ __forceinline__ void grid_bar(unsigned* bar, unsigned seq, int wv) {
    asm volatile("s_waitcnt vmcnt(0) lgkmcnt(0)" ::: "memory");
    __builtin_amdgcn_s_barrier();
    if (wv == 0) {
        if (vlane() == 0) {
            const unsigned G = (unsigned)lgrid(), b = (unsigned)lbid(), g = b & 7u;
            const unsigned ng = (G - g + 7u) >> 3, ngroups = G < 8u ? G : 8u;
            unsigned* flag = bar + 64 * 9;
            __builtin_amdgcn_fence(__ATOMIC_RELEASE, "agent");
            asm volatile("s_waitcnt vmcnt(0)" ::: "memory");
            const unsigned old = __hip_atomic_fetch_add(bar + 64 * g, 1u, __ATOMIC_RELAXED, __HIP_MEMORY_SCOPE_AGENT);
            bool waitf = true;
            if (old + 1u == seq * ng) {
                __builtin_amdgcn_fence(__ATOMIC_SEQ_CST, "agent");
                const unsigned old2 = __hip_atomic_fetch_add(bar + 64 * 8, 1u, __ATOMIC_RELAXED, __HIP_MEMORY_SCOPE_AGENT);
                if (old2 + 1u == seq * ngroups) { __builtin_amdgcn_fence(__ATOMIC_SEQ_CST, "agent"); __hip_atomic_store(flag, seq, __ATOMIC_RELAXED, __HIP_MEMORY_SCOPE_AGENT); waitf = false; }
            }
            if (waitf) { unsigned spins = 0; while (__hip_atomic_load(flag, __ATOMIC_RELAXED, __HIP_MEMORY_SCOPE_AGENT) < seq) { __builtin_amdgcn_s_sleep(1); if (++spins > (1u << 26)) break; } }
            __builtin_amdgcn_fence(__ATOMIC_ACQUIRE, "agent");
            asm volatile("s_waitcnt vmcnt(0)" ::: "memory");
        }
    }
    __builtin_amdgcn_s_barrier();
    asm volatile("" ::: "memory");
}

template <int PH, bool ZERO = false>
__device__ __forceinline__ void run_phase(LAS unsigned char* lds, int wv) {
    KA a = kargs();
    unsigned char* ws = a->ws; asm volatile("" : "+s"(ws));
    bf16_t* Wbase = (bf16_t*)(ws + OFF_W);
    bf16_t* xbA = (bf16_t*)(ws + OFF_XBA); bf16_t* xbB = (bf16_t*)(ws + OFF_XBB);
    bf16_t* Hb = (bf16_t*)(ws + OFF_H); bf16_t* zl = (bf16_t*)(ws + OFF_ZL); bf16_t* qm = (bf16_t*)(ws + OFF_QM);
    unsigned char* vf = ws + OFF_VT;
    bf16_t* pb = (bf16_t*)(ws + OFF_VT);
    float* ssA = (float*)(ws + OFF_SSA); float* ssB = (float*)(ws + OFF_SSB); float* mst = (float*)(ws + OFF_MST);
    const float* cs64 = (const float*)(ws + OFF_CS64); const float* cs32 = (const float*)(ws + OFF_CS32);
    if constexpr (PH == 0) { if (PH_ON(0)) prologue(a, lds, wv); }
    else if constexpr (PH == NPH - 1) { if (PH_ON(1)) final_norm(a, wv); }
    else {
        constexpr int l = (PH - 1) / 9, k = (PH - 1) % 9;
        bf16_t* WL = Wbase + (size_t)l * WL_SIZE;
        if constexpr (k == 0) { if (PH_ON(2)) { EpiGU E{ssA, Hb}; run_gemm(wv, lds, xbA, D, M, WL + WL_GU1, D, 5632, D, 0, E); } }
        else if constexpr (k == 1) { if (PH_ON(3)) { EpiRes E{a->out, xbB, ssB, ZERO ? 0.f : 0.5f}; run_gemm(wv, lds, Hb, FF, M, WL + WL_D1, FF, D, FF, 0, E); } }
        else if constexpr (k == 2) {
            if (PH_ON(4)) { EpiIn E{ssB, ws, mst, cs64, cs32}; run_gemm(wv, lds, xbB, D, M, WL + WL_IN, D, 2048, D, 0, E); }
            if (PH_ON(5)) { EpiVT E{ssB, vf}; run_gemm(wv, lds, WL + WL_IN + (size_t)2048 * D, D, 512, xbB, D, M, D, 0, E); }
        }
        else if constexpr (k == 3) {
            if (PH_ON(6)) { EpiQ E{mst, qm, cs32}; run_gemm(wv, lds, zl, ZLLD, M, WL + WL_UQ, 256, 512, 256, 0, E); }
            if (PH_ON(7)) { EpiK E{mst, ws}; run_gemm(wv, lds, zl + 256, ZLLD, M, WL + WL_UKV, 128, 256, 128, 0, E); }
            if (PH_ON(8)) { EpiVTM E{mst, vf}; run_gemm(wv, lds, WL + WL_UKV + (size_t)256 * 128, 128, 256, zl + 256, ZLLD, M, 128, 128, E); }
        }
        else if constexpr (k == 4) { if (PH_ON(9)) attn_phase(a, l, lds, wv); }
        else if constexpr (k == 5) { if (PH_ON(3)) { EpiRes E{a->out, xbB, ssB, ZERO ? 0.f : 1.0f}; run_gemm(wv, lds, xbA, D, M, WL + WL_O, D, D, D, 0, E); } }
        else if constexpr (k == 6) { if (PH_ON(2)) { convert_p(a, l, wv); EpiGU E{ssB, Hb}; run_gemm(wv, lds, xbB, D, M, WL + WL_GU2, D, 5632, D, 0, E); } }
        else if constexpr (k == 7) {
            if (PH_ON(3)) { EpiRes E{a->out, xbB, ssB, ZERO ? 0.f : 0.5f}; run_gemm(wv, lds, Hb, FF, M, WL + WL_D2, FF, D, FF, 0, E); }
            if (PH_ON(10)) { EpiPP E{xbA}; run_gemm(wv, lds, pb, PLE, M, WL + WL_PP, PLE, D, PLE, 0, E); }
        }
        else { if (PH_ON(11)) { EpiGate E{a->out, ssB, xbA, ssA, ZERO ? 0.f : 1.0f}; run_gemm(wv, lds, xbB, D, M, WL + WL_PG, D, D, D, 0, E); } }
    }
}
template <int PH>
__device__ __forceinline__ void run_from(LAS unsigned char* lds, int ph_lo, int ph_hi, int wv) {
    if constexpr (PH < NPH) {
        if (PH >= ph_lo && PH < ph_hi) {
            run_phase<PH>(lds, wv);
            if constexpr (PH > 0 && PH < NPH - 1) { if constexpr ((DUPM >> ((PH - 1) % 9)) & 1) { __syncthreads(); run_phase<PH, true>(lds, wv); } }
            if constexpr (PH == 0 && ((DUPM >> 9) & 1)) { __syncthreads(); run_phase<PH>(lds, wv); }
            if (PH + 1 < ph_hi && kargs()->coop) {
                if constexpr (PH == 0) cg::this_grid().sync();
                else { for (int r_ = 0; r_ < BARREP; ++r_) grid_bar((unsigned*)(kargs()->ws + OFF_BAR), (unsigned)((PH - 1) * BARREP + r_ + 1), wv); }
            }
        }
        run_from<PH + 1>(lds, ph_lo, ph_hi, wv);
    }
}
__global__ void __launch_bounds__(512, 2) mega(Args a_unused) {
    extern __shared__ __attribute__((aligned(16))) unsigned char lds_raw[];
    LAS unsigned char* lds = (LAS unsigned char*)lds_raw;
    const int ph_lo = kargs()->ph_lo, ph_hi = kargs()->ph_hi;
    const int wv = __builtin_amdgcn_readfirstlane((int)threadIdx.x >> 6);
    run_from<0>(lds, ph_lo, ph_hi, wv);
}

extern "C" void kernel_launch(void* const* d_in, const int* in_sizes, int n_in, void* d_out, int out_size, void* d_ws, size_t ws_size, hipStream_t stream) {
    static int grid = 0;
    if (grid == 0) {
        if (n_in != 24 || ws_size < WS_END) { fprintf(stderr, "kernel_launch: n_in %d ws %zu (need %zu)\n", n_in, ws_size, (size_t)WS_END); grid = -1; return; }
        int dev = 0, cus = 0, per_cu = 0;
        hipGetDevice(&dev); hipDeviceGetAttribute(&cus, hipDeviceAttributeMultiprocessorCount, dev);
        if (hipFuncSetAttribute((const void*)mega, hipFuncAttributeMaxDynamicSharedMemorySize, LDS_BYTES) != hipSuccess) { fprintf(stderr, "hipFuncSetAttribute failed\n"); grid = -1; return; }
        if (hipOccupancyMaxActiveBlocksPerMultiprocessor(&per_cu, (const void*)mega, 512, LDS_BYTES) != hipSuccess || per_cu < 1) per_cu = 1;
        (void)hipGetLastError();
        grid = cus * per_cu;
    }
    if (grid < 0) return;
    (void)hipMemsetAsync((char*)d_ws + OFF_BAR, 0, 4096, stream);
    Args a{};
    for (int i = 0; i < 24; ++i) a.in[i] = (const float*)d_in[i];
    a.out = (float*)d_out; a.ws = (unsigned char*)d_ws;
#if MULTI_LAUNCH
    for (int ph = 0; ph < NPH; ++ph) {
        a.ph_lo = ph; a.ph_hi = ph + 1; a.coop = 0;
        hipLaunchKernelGGL(mega, dim3(grid), dim3(512), LDS_BYTES, stream, a);
    }
#else
    a.ph_lo = 0; a.ph_hi = NPH; a.coop = 1;
    void* args[] = {&a};
    hipError_t e = hipLaunchCooperativeKernel((void*)mega, dim3(grid), dim3(512), args, LDS_BYTES, stream);
    if (e != hipSuccess) fprintf(stderr, "cooperative launch failed: %s (grid %d)\n", hipGetErrorString(e), grid);
#endif
}
```

```cpp
#include <hip/hip_runtime.h>
#include <hip/hip_cooperative_groups.h>
#include <cstdio>
#include <cstdint>
namespace cg = cooperative_groups;

#ifndef MULTI_LAUNCH
#define MULTI_LAUNCH 0
#endif

#ifndef DEPHASE
#define DEPHASE 20
#endif
#ifndef BARREP
#define BARREP 1
#endif
#ifndef DUPM
#define DUPM 0
#endif
#ifndef PRO_PARTS
#define PRO_PARTS 7
#endif
#ifndef PHM
#define PHM 0xffff
#endif
#define PH_ON(b) (((PHM) >> (b)) & 1)
#define LAS __attribute__((address_space(3)))
typedef unsigned short bf16_t;
typedef short bf16x8 __attribute__((ext_vector_type(8)));
typedef float f32x4 __attribute__((ext_vector_type(4)));
typedef float f32x16 __attribute__((ext_vector_type(16)));
typedef unsigned u32x4 __attribute__((ext_vector_type(4)));
typedef unsigned u32x2 __attribute__((ext_vector_type(2)));

constexpr int M = 32768, T = 2048, D = 1024, FF = 2816, DEPTH = 4, PLE = 256;
constexpr int ZQLD = 768, ZLLD = 384, QLD = 384;
constexpr size_t HEADB = (size_t)16 * 64 * 4096;
constexpr float EPS = 1e-6f;
constexpr float LOG2E = 1.4426950408889634f;

constexpr size_t WL_GU1 = 0, WL_D1 = WL_GU1 + (size_t)5632 * 1024, WL_IN = WL_D1 + (size_t)1024 * 2816, WL_UQ = WL_IN + (size_t)2816 * 1024,
                 WL_UKV = WL_UQ + (size_t)512 * 256, WL_O = WL_UKV + (size_t)512 * 128, WL_GU2 = WL_O + (size_t)1024 * 1024, WL_D2 = WL_GU2 + (size_t)5632 * 1024,
                 WL_PG = WL_D2 + (size_t)1024 * 2816, WL_PP = WL_PG + (size_t)1024 * 1024, WL_SIZE = WL_PP + (size_t)1024 * 256;
constexpr size_t OFF_W = 0;
constexpr size_t OFF_XBA = OFF_W + WL_SIZE * 2 * DEPTH;
constexpr size_t OFF_XBB = OFF_XBA + (size_t)M * D * 2;
constexpr size_t OFF_H = OFF_XBB + (size_t)M * D * 2;
constexpr size_t OFF_ZQ = OFF_H;
constexpr size_t OFF_ZL = OFF_ZQ + (size_t)M * ZQLD * 2;
constexpr size_t OFF_KF = OFF_ZL + (size_t)M * ZLLD * 2;
constexpr size_t OFF_KPE = OFF_KF + 22 * HEADB;
constexpr size_t OFF_VT = OFF_H + (size_t)M * FF * 2;
constexpr size_t OFF_SSA = OFF_VT + 22 * HEADB;
constexpr size_t OFF_SSB = OFF_SSA + (size_t)M * 16 * 4;
constexpr size_t OFF_MST = OFF_SSB + (size_t)M * 16 * 4;
constexpr size_t OFF_CS64 = OFF_MST + (size_t)M * 8 * 4;
constexpr size_t OFF_CS32 = OFF_CS64 + (size_t)T * 64 * 4;
constexpr size_t OFF_BAR = OFF_CS32 + (size_t)T * 32 * 4;
constexpr size_t OFF_QM = OFF_BAR + 4096;
constexpr size_t WS_END = OFF_QM + (size_t)M * QLD * 2;
static_assert(OFF_KPE + (size_t)16 * 64 * 2048 <= OFF_VT, "zq|zl|KF|KPE inside the H region");
static_assert(WS_END <= 626121856, "workspace budget");

constexpr int LDS_BYTES = 147456;
constexpr int NPH = 2 + 9 * DEPTH;

__device__ __forceinline__ unsigned cvt_pk_bf16(float lo, float hi) { unsigned r; asm("v_cvt_pk_bf16_f32 %0, %1, %2" : "=v"(r) : "v"(lo), "v"(hi)); return r; }
__device__ __forceinline__ float bf_lo(unsigned u) { return __uint_as_float(u << 16); }
__device__ __forceinline__ float bf_hi(unsigned u) { return __uint_as_float(u & 0xffff0000u); }
__device__ __forceinline__ float sum4(f32x4 a) { return (a.x + a.y) + (a.z + a.w); }
__device__ __forceinline__ float dot4(f32x4 a) { return (a.x * a.x + a.y * a.y) + (a.z * a.z + a.w * a.w); }
__device__ __forceinline__ float rs16(const float* ss, int row) {
    const f32x4* p = (const f32x4*)(ss + (size_t)row * 16);
    const f32x4 a = p[0], b = p[1], c = p[2], d = p[3];
    return rsqrtf(((sum4(a) + sum4(b)) + (sum4(c) + sum4(d))) * (1.0f / 1024.0f) + EPS);
}
__device__ __forceinline__ int vlane() { int l; asm volatile("v_mbcnt_lo_u32_b32 %0, -1, 0\n\tv_mbcnt_hi_u32_b32 %0, -1, %0" : "=v"(l)); return l; }
__device__ __forceinline__ int ltid(int wv) { return (wv << 6) | vlane(); }
__device__ __forceinline__ int lbid() { int b = blockIdx.x; asm volatile("" : "+s"(b)); return b; }
__device__ __forceinline__ int lgrid() { int g = gridDim.x; asm volatile("" : "+s"(g)); return g; }
#define GAS __attribute__((address_space(1)))
__device__ __forceinline__ bf16x8 ldg16(const void* p) { return *(const GAS bf16x8*)p; }
__device__ __forceinline__ float xh_max(float x) { auto r = __builtin_amdgcn_permlane32_swap(__float_as_uint(x), __float_as_uint(x), false, false); return fmaxf(__uint_as_float(r[0]), __uint_as_float(r[1])); }
__device__ __forceinline__ float sigmoidf_(float v) { return __builtin_amdgcn_rcpf(1.0f + __expf(-v)); }

namespace pg8 {
constexpr int BM = 256, BK = 64, HALF = 128, HTB = HALF * BK * 2, STAGE_BYTES = 8 * HTB, NXCD = 8, WGM = 8;
__host__ __device__ __forceinline__ int lds_byte(int r, int c) { const int st = (r >> 4) * 2 + (c >> 5), rr = r & 15, cc = c & 31, ob = rr * 64 + cc * 2; return st * 1024 + (ob ^ (((ob >> 9) & 1) << 5)); }
__host__ __device__ __forceinline__ void stage_rc(int b, int& R, int& C) { const int st = b / 1024, sb = b % 1024, swz = sb ^ (((sb >> 9) & 1) << 5); R = (st >> 1) * 16 + swz / 64; C = (st & 1) * 32 + (swz % 64) / 2; }
__host__ __device__ __forceinline__ int perm32(int rho) { const int n = rho >> 4, i = rho & 15; return 8 * (i >> 2) + 4 * n + (i & 3); }

struct Unit { int pm, pn; };
struct Gemm { const bf16_t* A; const bf16_t* Bt; int lda, ldb, K; };

struct StaticOrder {
    int nM, nN, nwg, G, c;
    __device__ void init(int Mr, int Nc, int G_, int c_) { nM = Mr / BM; nN = Nc / BM; nwg = nM * nN; G = G_; c = c_; }
    __device__ bool next(int i, Unit& u) const {
        const long L = (long)i * G + c; if (L >= nwg) return false;
        int wgid = (int)L; { const int q = nwg / NXCD, r = nwg % NXCD, xcd = wgid % NXCD, off = wgid / NXCD; wgid = (xcd < r ? xcd * (q + 1) : r * (q + 1) + (xcd - r) * q) + off; }
        const int nig = WGM * nN, gid = wgid / nig, fm = gid * WGM, gsz = (nM - fm) < WGM ? (nM - fm) : WGM;
        u.pm = fm + ((wgid % nig) % gsz); u.pn = (wgid % nig) / gsz; return true;
    }
};

template <class Epi>
__device__ __forceinline__ void gemm_phase(LAS unsigned char* lds, const Gemm g, const StaticOrder& S, const Epi& E, int wv) {
    const int tid = ltid(wv);
    const int wid = wv, lane = tid & 63, wr = wid >> 2, wc = wid & 3, fr = lane & 15, fq = lane >> 4;
    const int K = g.K, nt = K / BK;
    unsigned voffA[2], voffB[2];
#pragma unroll
    for (int i = 0; i < 2; ++i) { int R, C; stage_rc(tid * 16 + i * 8192, R, C); const int Rb = (R & ~31) + perm32(R & 31);
        voffA[i] = (unsigned)(R * g.lda + C) * 2u; voffB[i] = (unsigned)(Rb * g.ldb + C) * 2u; }
    const size_t kstep = (size_t)(BK * 2);
    const size_t hstepA = (size_t)HALF * g.lda * 2, hstepB = (size_t)HALF * g.ldb * 2;
    const size_t tstepA = 2 * hstepA, tstepB = 2 * hstepB;
    const unsigned ldsw = (unsigned)wid * 1024u;
    const int aoff = lds_byte(wr * 64 + fr, fq * 8), boff = lds_byte(wc * 32 + fr, fq * 8);
#define PG8_SA(b, h) (((b) * 2 + (h)) * HTB)
#define PG8_SB(b, h) ((4 + (b) * 2 + (h)) * HTB)
#define PG8_STAGE(bufoff, gbase, voff) do { _Pragma("unroll") for (int _i = 0; _i < 2; ++_i) \
        __builtin_amdgcn_global_load_lds((const unsigned*)((const char*)(gbase) + (voff)[_i]), (LAS unsigned*)(lds + (bufoff) + ldsw + _i * 8192), 16, 0, 0); } while (0)
#define PG8_LDA(dst, b, h) do { _Pragma("unroll") for (int m = 0; m < 4; ++m) _Pragma("unroll") for (int k = 0; k < 2; ++k) dst[m][k] = *(const LAS bf16x8*)(lds + PG8_SA(b, h) + aoff + m * 2048 + k * 1024); } while (0)
#define PG8_LDB(dst, b, h) do { _Pragma("unroll") for (int n = 0; n < 2; ++n) _Pragma("unroll") for (int k = 0; k < 2; ++k) dst[n][k] = *(const LAS bf16x8*)(lds + PG8_SB(b, h) + boff + n * 2048 + k * 1024); } while (0)
#define PG8_MMA(ai, bj, At, Bt) do { __builtin_amdgcn_s_setprio(1); _Pragma("unroll") for (int m = 0; m < 4; ++m) _Pragma("unroll") for (int n = 0; n < 2; ++n) _Pragma("unroll") for (int k = 0; k < 2; ++k) \
        acc[ai][bj][m][n] = __builtin_amdgcn_mfma_f32_16x16x32_bf16(Bt[n][k], At[m][k], acc[ai][bj][m][n], 0, 0, 0); __builtin_amdgcn_s_setprio(0); } while (0)
#define PG8_WAIT_V(n) asm volatile("s_waitcnt vmcnt(" #n ")" ::: "memory")
#define PG8_WAIT_L(n) asm volatile("s_waitcnt lgkmcnt(" #n ")" ::: "memory")
#define PG8_BAR __builtin_amdgcn_s_barrier()
#define PG8_SCHED __builtin_amdgcn_sched_barrier(0)
    Unit cur, nxt; int ui = 0;
    if (!S.next(0, cur)) return;
    f32x4 acc[2][2][4][2];
#pragma unroll
    for (int a = 0; a < 2; ++a)
#pragma unroll
        for (int b = 0; b < 2; ++b)
#pragma unroll
            for (int m = 0; m < 4; ++m)
#pragma unroll
                for (int n = 0; n < 2; ++n) acc[a][b][m][n] = (f32x4){0.f, 0.f, 0.f, 0.f};
    bf16x8 At[4][2], B0[2][2], B1[2][2];
    const char* cA = (const char*)g.A + (size_t)cur.pm * tstepA; const char* cB = (const char*)g.Bt + (size_t)cur.pn * tstepB;
    PG8_STAGE(PG8_SB(0, 0), cB, voffB); PG8_STAGE(PG8_SB(0, 1), cB + hstepB, voffB); PG8_STAGE(PG8_SA(0, 0), cA, voffA); PG8_STAGE(PG8_SA(0, 1), cA + hstepA, voffA);
    if (wr == 1) PG8_BAR;
    PG8_WAIT_V(2); PG8_BAR;
    PG8_STAGE(PG8_SB(1, 0), cB + kstep, voffB); PG8_STAGE(PG8_SA(1, 0), cA + kstep, voffA); PG8_STAGE(PG8_SB(1, 1), cB + hstepB + kstep, voffB);
    PG8_WAIT_V(6); PG8_BAR;
    for (;;) {
        const bool has_next = S.next(ui + 1, nxt);
        const char* nA = has_next ? (const char*)g.A + (size_t)nxt.pm * tstepA : cA; const char* nB = has_next ? (const char*)g.Bt + (size_t)nxt.pn * tstepB : cB;
        for (int t = 0; t < nt; t += 2) {
            const bool last = (t == nt - 2);
            const char* a1 = cA + (size_t)(t + 1) * kstep;
            const char* a2 = last ? nA : cA + (size_t)(t + 2) * kstep; const char* b2 = last ? nB : cB + (size_t)(t + 2) * kstep;
            const char* a3 = a2 + kstep; const char* b3 = b2 + kstep;
            PG8_LDB(B0, 0, 0); PG8_LDB(B1, 0, 1); PG8_SCHED; PG8_LDA(At, 0, 0); PG8_STAGE(PG8_SA(1, 1), a1 + hstepA, voffA);
            PG8_WAIT_V(8); PG8_WAIT_L(0); PG8_BAR; PG8_MMA(0, 0, At, B0); PG8_MMA(0, 1, At, B1); PG8_BAR; PG8_SCHED;
            PG8_LDA(At, 0, 1); PG8_STAGE(PG8_SB(0, 0), b2, voffB); PG8_STAGE(PG8_SB(0, 1), b2 + hstepB, voffB); PG8_STAGE(PG8_SA(0, 0), a2, voffA);
            PG8_WAIT_V(8); PG8_WAIT_L(0); PG8_BAR; PG8_MMA(1, 0, At, B0); PG8_MMA(1, 1, At, B1); PG8_BAR; PG8_SCHED;
            PG8_LDB(B0, 1, 0); PG8_LDB(B1, 1, 1); PG8_SCHED; PG8_LDA(At, 1, 0); PG8_STAGE(PG8_SA(0, 1), a2 + hstepA, voffA);
            PG8_WAIT_V(8); PG8_WAIT_L(0); PG8_BAR; PG8_MMA(0, 0, At, B0); PG8_MMA(0, 1, At, B1); PG8_BAR; PG8_SCHED;
            PG8_LDA(At, 1, 1); PG8_STAGE(PG8_SB(1, 0), b3, voffB); PG8_STAGE(PG8_SB(1, 1), b3 + hstepB, voffB); PG8_STAGE(PG8_SA(1, 0), a3, voffA);
            PG8_WAIT_V(8); PG8_WAIT_L(0); PG8_BAR; PG8_MMA(1, 0, At, B0); PG8_MMA(1, 1, At, B1); PG8_BAR; PG8_SCHED;
        }
        if (wr == 0) PG8_BAR;
        E(acc, cur, wr, wc, fr, fq);
        if (!has_next) break;
#pragma unroll
        for (int a = 0; a < 2; ++a)
#pragma unroll
            for (int b = 0; b < 2; ++b)
#pragma unroll
                for (int m = 0; m < 4; ++m)
#pragma unroll
                    for (int n = 0; n < 2; ++n) acc[a][b][m][n] = (f32x4){0.f, 0.f, 0.f, 0.f};
        cur = nxt; cA = nA; cB = nB; ++ui;
        if (wr == 1) PG8_BAR;
    }
    PG8_WAIT_V(0);
    PG8_BAR;
#undef PG8_SA
#undef PG8_SB
#undef PG8_STAGE
#undef PG8_LDA
#undef PG8_LDB
#undef PG8_MMA
#undef PG8_WAIT_V
#undef PG8_WAIT_L
#undef PG8_BAR
#undef PG8_SCHED
}
}
using pg8::Unit;
typedef const f32x4 (&AccRef)[2][2][4][2];

struct EpiGU {
    const float* ss; bf16_t* H;
    __device__ __forceinline__ void operator()(AccRef acc, const Unit& u, int wr, int wc, int, int) const { const int lane_ = vlane(); const int fr = lane_ & 15, fq = lane_ >> 4;
#pragma unroll
        for (int ai = 0; ai < 2; ++ai)
#pragma unroll
            for (int m = 0; m < 4; ++m) {
                const int row = u.pm * 256 + ai * 128 + wr * 64 + m * 16 + fr;
                asm volatile("" ::: "memory");
                const float r = rs16(ss, row);
                const f32x4 g0 = acc[ai][0][m][0] * r, g1 = acc[ai][0][m][1] * r, v0 = acc[ai][1][m][0] * r, v1 = acc[ai][1][m][1] * r;
                u32x4 w;
                w.x = cvt_pk_bf16(g0.x * sigmoidf_(g0.x) * v0.x, g0.y * sigmoidf_(g0.y) * v0.y); w.y = cvt_pk_bf16(g0.z * sigmoidf_(g0.z) * v0.z, g0.w * sigmoidf_(g0.w) * v0.w);
                w.z = cvt_pk_bf16(g1.x * sigmoidf_(g1.x) * v1.x, g1.y * sigmoidf_(g1.y) * v1.y); w.w = cvt_pk_bf16(g1.z * sigmoidf_(g1.z) * v1.z, g1.w * sigmoidf_(g1.w) * v1.w);
                *(u32x4*)(H + (size_t)row * FF + u.pn * 128 + wc * 32 + fq * 8) = w;
            }
    }
};
struct EpiRes {
    float* X; bf16_t* xb; float* ssOut; float alpha;
    __device__ __forceinline__ void operator()(AccRef acc, const Unit& u, int wr, int wc, int, int) const { const int lane_ = vlane(); const int fr = lane_ & 15, fq = lane_ >> 4;
#pragma unroll
        for (int ai = 0; ai < 2; ++ai)
#pragma unroll
            for (int m = 0; m < 4; ++m) {
                const int row = u.pm * 256 + ai * 128 + wr * 64 + m * 16 + fr;
                asm volatile("" ::: "memory");
                float sq = 0.f;
#pragma unroll
                for (int bj = 0; bj < 2; ++bj) {
                    const size_t off = (size_t)row * D + u.pn * 256 + bj * 128 + wc * 32 + fq * 8;
                    f32x4 x0 = *(const f32x4*)(X + off), x1 = *(const f32x4*)(X + off + 4);
                    x0 += acc[ai][bj][m][0] * alpha; x1 += acc[ai][bj][m][1] * alpha;
                    *(f32x4*)(X + off) = x0; *(f32x4*)(X + off + 4) = x1;
                    sq += dot4(x0) + dot4(x1);
                    u32x4 w; w.x = cvt_pk_bf16(x0.x, x0.y); w.y = cvt_pk_bf16(x0.z, x0.w); w.z = cvt_pk_bf16(x1.x, x1.y); w.w = cvt_pk_bf16(x1.z, x1.w);
                    *(u32x4*)(xb + off) = w;
                }
                sq += __shfl_xor(sq, 16); sq += __shfl_xor(sq, 32);
                if (fq == 0) ssOut[(size_t)row * 16 + u.pn * 4 + wc] = sq;
            }
    }
};
struct EpiGate {
    float* X; const float* ssIn; bf16_t* ppxb; float* ssOut; float gsc;
    __device__ __forceinline__ void operator()(AccRef acc, const Unit& u, int wr, int wc, int, int) const { const int lane_ = vlane(); const int fr = lane_ & 15, fq = lane_ >> 4;
#pragma unroll
        for (int ai = 0; ai < 2; ++ai)
#pragma unroll
            for (int m = 0; m < 4; ++m) {
                const int row = u.pm * 256 + ai * 128 + wr * 64 + m * 16 + fr;
                asm volatile("" ::: "memory");
                const float r = rs16(ssIn, row);
                float sq = 0.f;
#pragma unroll
                for (int bj = 0; bj < 2; ++bj) {
                    const size_t off = (size_t)row * D + u.pn * 256 + bj * 128 + wc * 32 + fq * 8;
                    f32x4 x0 = *(const f32x4*)(X + off), x1 = *(const f32x4*)(X + off + 4);
                    const u32x4 pp = *(const u32x4*)(ppxb + off); const float gs = gsc;
                    const f32x4 a0 = acc[ai][bj][m][0] * r, a1 = acc[ai][bj][m][1] * r;
                    x0.x += sigmoidf_(a0.x) * (bf_lo(pp.x) * gs); x0.y += sigmoidf_(a0.y) * (bf_hi(pp.x) * gs); x0.z += sigmoidf_(a0.z) * (bf_lo(pp.y) * gs); x0.w += sigmoidf_(a0.w) * (bf_hi(pp.y) * gs);
                    x1.x += sigmoidf_(a1.x) * (bf_lo(pp.z) * gs); x1.y += sigmoidf_(a1.y) * (bf_hi(pp.z) * gs); x1.z += sigmoidf_(a1.z) * (bf_lo(pp.w) * gs); x1.w += sigmoidf_(a1.w) * (bf_hi(pp.w) * gs);
                    *(f32x4*)(X + off) = x0; *(f32x4*)(X + off + 4) = x1;
                    sq += dot4(x0) + dot4(x1);
                    u32x4 w; w.x = cvt_pk_bf16(x0.x, x0.y); w.y = cvt_pk_bf16(x0.z, x0.w); w.z = cvt_pk_bf16(x1.x, x1.y); w.w = cvt_pk_bf16(x1.z, x1.w);
                    *(u32x4*)(ppxb + off) = w;
                }
                sq += __shfl_xor(sq, 16); sq += __shfl_xor(sq, 32);
                if (fq == 0) ssOut[(size_t)row * 16 + u.pn * 4 + wc] = sq;
            }
    }
};
__device__ __forceinline__ void rope_rot(f32x4& v0, f32x4& v1, const float* cs) {
    const f32x4 c = *(const f32x4*)cs, s = *(const f32x4*)(cs + 4);
    const f32x4 a = v0 * c - v1 * s, b = v1 * c + v0 * s; v0 = a; v1 = b;
}
__device__ __forceinline__ void vstore1(unsigned char* vf, int vhead, int dd, int b, int ppos, bf16_t val);
struct EpiIn {
    const float* ss; unsigned char* ws; float* mst; const float* cs64; const float* cs32;
    __device__ __forceinline__ void operator()(AccRef acc, const Unit& u, int wr, int wc, int, int) const { const int lane_ = vlane(); const int fr = lane_ & 15, fq = lane_ >> 4;
#pragma unroll
        for (int ai = 0; ai < 2; ++ai)
#pragma unroll
            for (int m = 0; m < 4; ++m) {
                const int row = u.pm * 256 + ai * 128 + wr * 64 + m * 16 + fr;
                asm volatile("" ::: "memory");
                const float r = rs16(ss, row);
                const int pos = row & (T - 1), b = row >> 11;
                float sq = 0.f;
#pragma unroll
                for (int bj = 0; bj < 2; ++bj) {
                    const int gcol = u.pn * 256 + bj * 128 + wc * 32;
                    f32x4 v0 = acc[ai][bj][m][0] * r, v1 = acc[ai][bj][m][1] * r;
                    const bool r64 = (gcol >= 512 && gcol < 896) || (gcol >= 1024 && gcol < 1536);
                    if (r64) rope_rot(v0, v1, cs64 + ((size_t)pos * 8 + 4 * ((gcol >> 5) & 1) + fq) * 8);
                    if (gcol == 1920) rope_rot(v0, v1, cs32 + ((size_t)pos * 4 + fq) * 8);
                    if (u.pn == 6 || (u.pn == 7 && bj == 0)) sq += dot4(v0) + dot4(v1);
                    u32x4 w; w.x = cvt_pk_bf16(v0.x, v0.y); w.y = cvt_pk_bf16(v0.z, v0.w); w.z = cvt_pk_bf16(v1.x, v1.y); w.w = cvt_pk_bf16(v1.z, v1.w);
                    const int c8 = ((gcol & 63) >> 3) + fq;
                    const size_t frag = (size_t)(c8 >> 1) * 1024 + (size_t)((pos & 31) + 32 * (c8 & 1)) * 16;
                    const size_t rec = ((size_t)b * 64 + (pos >> 5)) * 4096;
                    if (gcol < 256) *(u32x4*)(ws + OFF_ZQ + ((size_t)row * ZQLD + gcol + fq * 8) * 2) = w;
                    else if (gcol < 512) *(u32x4*)(ws + OFF_KF + (size_t)((gcol - 256) >> 6) * HEADB + rec + frag) = w;
                    else if (gcol < 768) *(u32x4*)(ws + OFF_ZQ + ((size_t)row * ZQLD + (gcol - 256) + fq * 8) * 2) = w;
                    else if (gcol < 896) *(u32x4*)(ws + OFF_KF + (size_t)(4 + ((gcol - 768) >> 6)) * HEADB + rec + frag) = w;
                    else if (gcol < 1024) {
                        const int dd0 = (gcol - 896) + fq * 8; const unsigned ww[4] = {w.x, w.y, w.z, w.w};
#pragma unroll
                        for (int e = 0; e < 8; ++e) vstore1(ws + OFF_VT, 4 + (dd0 >> 6), (dd0 & 63) + e, b, pos, (bf16_t)((e & 1) ? (ww[e >> 1] >> 16) : (ww[e >> 1] & 0xffffu)));
                    }
                    else if (gcol < 1280) *(u32x4*)(ws + OFF_ZQ + ((size_t)row * ZQLD + (gcol - 512) + fq * 8) * 2) = w;
                    else if (gcol < 1536) {
                        const int hd = (gcol - 1280) >> 6;
                        *(u32x4*)(ws + OFF_KF + (size_t)(6 + hd) * HEADB + rec + frag) = w;
                        const int p4 = (pos & 3) * 512 + (pos >> 2), p16 = (pos & 15) * 128 + (pos >> 4);
                        *(u32x4*)(ws + OFF_KF + (size_t)(10 + hd) * HEADB + ((size_t)b * 64 + (p4 >> 5)) * 4096 + (size_t)(c8 >> 1) * 1024 + (size_t)((p4 & 31) + 32 * (c8 & 1)) * 16) = w;
                        *(u32x4*)(ws + OFF_KF + (size_t)(14 + hd) * HEADB + ((size_t)b * 64 + (p16 >> 5)) * 4096 + (size_t)(c8 >> 1) * 1024 + (size_t)((p16 & 31) + 32 * (c8 & 1)) * 16) = w;
                    }
                    else if (gcol < 1920) *(u32x4*)(ws + OFF_ZL + ((size_t)row * ZLLD + (gcol - 1536) + fq * 8) * 2) = w;
                    else if (gcol == 1920) *(u32x4*)(ws + OFF_KPE + ((size_t)b * 64 + (pos >> 5)) * 2048 + (size_t)(fq >> 1) * 1024 + (size_t)((pos & 31) + 32 * (fq & 1)) * 16) = w;
                }
                if (u.pn >= 6) {
                    sq += __shfl_xor(sq, 16); sq += __shfl_xor(sq, 32);
                    if (fq == 0) mst[(size_t)row * 8 + (u.pn - 6) * 4 + wc] = sq;
                }
            }
    }
};
__device__ __forceinline__ void vstore8(unsigned char* vf, int vhead, int dd, int tok0, u32x4 w) {
    const int b = tok0 >> 11, pos0 = tok0 & (T - 1), idx0 = pos0 & 31;
    unsigned char* p = vf + (size_t)vhead * HEADB + ((size_t)b * 64 + (pos0 >> 5)) * 4096 + (size_t)((dd >> 5) * 2 + (idx0 >> 4)) * 1024 + (size_t)(dd & 31) * 16 + ((idx0 >> 3) & 1) * 8;
    u32x2 lo; lo.x = w.x; lo.y = w.y; u32x2 hi; hi.x = w.z; hi.y = w.w;
    *(u32x2*)p = lo; *(u32x2*)(p + 512) = hi;
}
__device__ __forceinline__ void vstore1(unsigned char* vf, int vhead, int dd, int b, int ppos, bf16_t val) {
    const int idx = ppos & 31, r16 = idx & 15;
    unsigned char* p = vf + (size_t)vhead * HEADB + ((size_t)b * 64 + (ppos >> 5)) * 4096 + (size_t)((dd >> 5) * 2 + (idx >> 4)) * 1024 + (size_t)((dd & 31) + 32 * ((r16 >> 2) & 1)) * 16 + (r16 >> 3) * 8 + (r16 & 3) * 2;
    *(bf16_t*)p = val;
}
struct EpiVT {
    const float* ss; unsigned char* vf;
    __device__ __forceinline__ void operator()(AccRef acc, const Unit& u, int wr, int wc, int, int) const { const int lane_ = vlane(); const int fr = lane_ & 15, fq = lane_ >> 4;
#pragma unroll
        for (int bj = 0; bj < 2; ++bj) {
            const int tok0 = u.pn * 256 + bj * 128 + wc * 32 + fq * 8;
            float rs[8];
#pragma unroll
            for (int e = 0; e < 8; ++e) rs[e] = rs16(ss, tok0 + e);
#pragma unroll
            for (int ai = 0; ai < 2; ++ai) {
                const int rbase = u.pm * 256 + ai * 128;
                const bool dil = rbase >= 256;
#pragma unroll
                for (int m = 0; m < 4; ++m) {
                    const int row = rbase + wr * 64 + m * 16 + fr;
                    asm volatile("" ::: "memory");
                    const f32x4 a0 = acc[ai][bj][m][0], a1 = acc[ai][bj][m][1];
                    u32x4 w; w.x = cvt_pk_bf16(a0.x * rs[0], a0.y * rs[1]); w.y = cvt_pk_bf16(a0.z * rs[2], a0.w * rs[3]);
                    w.z = cvt_pk_bf16(a1.x * rs[4], a1.y * rs[5]); w.w = cvt_pk_bf16(a1.z * rs[6], a1.w * rs[7]);
                    const int vhead = (row >> 6) + (dil ? 2 : 0), dd = row & 63;
                    vstore8(vf, vhead, dd, tok0, w);
                    if (dil) {
                        const int b = tok0 >> 11, t0 = tok0 & (T - 1);
                        const unsigned ww[4] = {w.x, w.y, w.z, w.w};
#pragma unroll
                        for (int e = 0; e < 8; ++e) {
                            const int t = t0 + e; const bf16_t val = (bf16_t)((e & 1) ? (ww[e >> 1] >> 16) : (ww[e >> 1] & 0xffffu));
                            vstore1(vf, vhead + 4, dd, b, (t & 3) * 512 + (t >> 2), val);
                            vstore1(vf, vhead + 8, dd, b, (t & 15) * 128 + (t >> 4), val);
                        }
                    }
                }
            }
        }
    }
};
struct EpiQ {
    const float* mst; bf16_t* qm; const float* cs32;
    __device__ __forceinline__ void operator()(AccRef acc, const Unit& u, int wr, int wc, int, int) const { const int lane_ = vlane(); const int fr = lane_ & 15, fq = lane_ >> 4;
#pragma unroll
        for (int ai = 0; ai < 2; ++ai)
#pragma unroll
            for (int m = 0; m < 4; ++m) {
                const int row = u.pm * 256 + ai * 128 + wr * 64 + m * 16 + fr;
                asm volatile("" ::: "memory");
                const f32x4 st = *(const f32x4*)(mst + (size_t)row * 8);
                const float r = rsqrtf(sum4(st) * (1.0f / 256.0f) + EPS);
                const int pos = row & (T - 1);
#pragma unroll
                for (int bj = 0; bj < 2; ++bj) {
                    const int gcol = u.pn * 256 + bj * 128 + wc * 32;
                    if (gcol >= 384) continue;
                    f32x4 v0 = acc[ai][bj][m][0] * r, v1 = acc[ai][bj][m][1] * r;
                    if (((gcol >> 5) % 3) == 2) rope_rot(v0, v1, cs32 + ((size_t)pos * 4 + fq) * 8);
                    u32x4 w; w.x = cvt_pk_bf16(v0.x, v0.y); w.y = cvt_pk_bf16(v0.z, v0.w); w.z = cvt_pk_bf16(v1.x, v1.y); w.w = cvt_pk_bf16(v1.z, v1.w);
                    *(u32x4*)(qm + (size_t)row * QLD + gcol + fq * 8) = w;
                }
            }
    }
};
struct EpiK {
    const float* mst; unsigned char* ws;
    __device__ __forceinline__ void operator()(AccRef acc, const Unit& u, int wr, int wc, int, int) const { const int lane_ = vlane(); const int fr = lane_ & 15, fq = lane_ >> 4;
#pragma unroll
        for (int ai = 0; ai < 2; ++ai)
#pragma unroll
            for (int m = 0; m < 4; ++m) {
                const int row = u.pm * 256 + ai * 128 + wr * 64 + m * 16 + fr;
                asm volatile("" ::: "memory");
                const f32x4 st = *(const f32x4*)(mst + (size_t)row * 8 + 4);
                const float r = rsqrtf(sum4(st) * (1.0f / 128.0f) + EPS);
#pragma unroll
                for (int bj = 0; bj < 2; ++bj) {
                    const f32x4 v0 = acc[ai][bj][m][0] * r, v1 = acc[ai][bj][m][1] * r;
                    u32x4 w; w.x = cvt_pk_bf16(v0.x, v0.y); w.y = cvt_pk_bf16(v0.z, v0.w); w.z = cvt_pk_bf16(v1.x, v1.y); w.w = cvt_pk_bf16(v1.z, v1.w);
                    const int col0 = bj * 128 + wc * 32, c8 = ((col0 & 63) >> 3) + fq, pos = row & (T - 1);
                    *(u32x4*)(ws + OFF_KF + (size_t)(18 + (col0 >> 6)) * HEADB + ((size_t)(row >> 11) * 64 + (pos >> 5)) * 4096 + (size_t)(c8 >> 1) * 1024 + (size_t)((pos & 31) + 32 * (c8 & 1)) * 16) = w;
                }
            }
    }
};
struct EpiVTM {
    const float* mst; unsigned char* vf;
    __device__ __forceinline__ void operator()(AccRef acc, const Unit& u, int wr, int wc, int, int) const { const int lane_ = vlane(); const int fr = lane_ & 15, fq = lane_ >> 4;
#pragma unroll
        for (int bj = 0; bj < 2; ++bj) {
            const int tok0 = u.pn * 256 + bj * 128 + wc * 32 + fq * 8;
            float rs[8];
#pragma unroll
            for (int e = 0; e < 8; ++e) { const f32x4 st = *(const f32x4*)(mst + (size_t)(tok0 + e) * 8 + 4); rs[e] = rsqrtf(sum4(st) * (1.0f / 128.0f) + EPS); }
#pragma unroll
            for (int ai = 0; ai < 2; ++ai)
#pragma unroll
                for (int m = 0; m < 4; ++m) {
                    const int row = ai * 128 + wr * 64 + m * 16 + fr;
                    asm volatile("" ::: "memory");
                    const f32x4 a0 = acc[ai][bj][m][0], a1 = acc[ai][bj][m][1];
                    u32x4 w; w.x = cvt_pk_bf16(a0.x * rs[0], a0.y * rs[1]); w.y = cvt_pk_bf16(a0.z * rs[2], a0.w * rs[3]);
                    w.z = cvt_pk_bf16(a1.x * rs[4], a1.y * rs[5]); w.w = cvt_pk_bf16(a1.z * rs[6], a1.w * rs[7]);
                    vstore8(vf, 18 + (row >> 6), row & 63, tok0, w);
                }
        }
    }
};
struct EpiPP {
    bf16_t* O;
    __device__ __forceinline__ void operator()(AccRef acc, const Unit& u, int wr, int wc, int, int) const { const int lane_ = vlane(); const int fr = lane_ & 15, fq = lane_ >> 4;
#pragma unroll
        for (int ai = 0; ai < 2; ++ai)
#pragma unroll
            for (int m = 0; m < 4; ++m) {
                const int row = u.pm * 256 + ai * 128 + wr * 64 + m * 16 + fr;
                asm volatile("" ::: "memory");
#pragma unroll
                for (int bj = 0; bj < 2; ++bj) {
                    const f32x4 v0 = acc[ai][bj][m][0], v1 = acc[ai][bj][m][1];
                    u32x4 w; w.x = cvt_pk_bf16(v0.x, v0.y); w.y = cvt_pk_bf16(v0.z, v0.w); w.z = cvt_pk_bf16(v1.x, v1.y); w.w = cvt_pk_bf16(v1.z, v1.w);
                    *(u32x4*)(O + (size_t)row * D + u.pn * 256 + bj * 128 + wc * 32 + fq * 8) = w;
                }
            }
    }
};

template <class Epi>
__device__ __forceinline__ void run_gemm(int wv, LAS unsigned char* lds, const bf16_t* A, int lda, int rows, const bf16_t* Bt, int ldb, int cols, int K, int cshift, const Epi& E) {
    pg8::Gemm g{A, Bt, lda, ldb, K};
    pg8::StaticOrder S; const int G_ = lgrid(); S.init(rows, cols, G_, (lbid() + cshift) % G_);
    pg8::gemm_phase<Epi>(lds, g, S, E, wv);
}

__device__ __forceinline__ int p64(int d) { return d < 32 ? 8 * (d >> 2) + (d & 3) : 8 * ((d - 32) >> 2) + 4 + (d & 3); }
__device__ __forceinline__ int p32(int d) { return d < 16 ? 8 * (d >> 2) + (d & 3) : 8 * ((d - 16) >> 2) + 4 + (d & 3); }
__device__ __forceinline__ int maprow(int mapid, int c) {
    switch (mapid) {
        case 0: return c;
        case 1: return (c >> 7) * 256 + (c & 127);
        case 2: return (c >> 7) * 256 + 128 + (c & 127);
        case 3: {
            if (c < 768) return c < 512 ? c : 2048 + (c - 512);
            c -= 768;
            if (c < 512) return c < 384 ? 512 + (c >> 6) * 64 + p64(c & 63) : 896 + (c - 384);
            c -= 512;
            if (c < 768) return c < 512 ? 1024 + (c >> 6) * 64 + p64(c & 63) : 2048 + 256 + (c - 512);
            c -= 768;
            if (c < 256) return 1536 + c;
            if (c < 384) return 1792 + (c - 256);
            return 1920 + p32(c - 384);
        }
        case 4: { const int h = c / 96, e = c % 96; return e < 64 ? 96 * h + e : 96 * h + 64 + p32(e - 64); }
        default: { const int h = c >> 7, e = c & 127; return e < 64 ? 64 * h + e : 256 + 64 * h + (e - 64); }
    }
}
__device__ __forceinline__ void tr_item(const float* W, int K, int N, const float* gain, bf16_t* dst, int mapid, int item, LAS float* s, int wv) {
    const int tid = ltid(wv);
    const int ncb = (N + 255) >> 8, kb = item / ncb, cb = item % ncb, k0 = kb * 64, c0 = cb * 256;
#pragma unroll
    for (int i = 0; i < 8; ++i) {
        const int kk = i * 8 + (tid >> 6), col = (tid & 63) * 4;
        f32x4 v = (f32x4){0.f, 0.f, 0.f, 0.f};
        if (c0 + col < N) v = *(const f32x4*)(W + (size_t)(k0 + kk) * N + c0 + col);
        if (gain) v *= gain[k0 + kk];
        *(LAS f32x4*)(s + kk * 260 + col) = v;
    }
    __syncthreads();
    const int cc = tid & 255, kh = tid >> 8, c = c0 + cc;
    if (c < N) {
        const int drow = maprow(mapid, c);
        bf16_t* o = dst + (size_t)drow * K + k0 + kh * 32;
#pragma unroll
        for (int q = 0; q < 4; ++q) {
            const LAS float* sp = s + (kh * 32 + q * 8) * 260 + cc;
            u32x4 w; w.x = cvt_pk_bf16(sp[0], sp[260]); w.y = cvt_pk_bf16(sp[2 * 260], sp[3 * 260]); w.z = cvt_pk_bf16(sp[4 * 260], sp[5 * 260]); w.w = cvt_pk_bf16(sp[6 * 260], sp[7 * 260]);
            *(u32x4*)(o + q * 8) = w;
        }
    }
    __syncthreads();
}

struct Args { const float* in[24]; float* out; unsigned char* ws; int ph_lo, ph_hi, coop, pad; };
typedef const __attribute__((address_space(4))) Args* KA;
__device__ __forceinline__ KA kargs() { KA p = (KA)__builtin_amdgcn_kernarg_segment_ptr(); asm volatile("" : "+s"(p)); return p; }

__device__ __forceinline__ void zero_rows(bf16_t* base, int row0, int nrows, int K, int gt, int ngt) {
    const size_t n16 = (size_t)nrows * K / 8; u32x4* p = (u32x4*)(base + (size_t)row0 * K);
    for (size_t i = gt; i < n16; i += ngt) p[i] = (u32x4){0u, 0u, 0u, 0u};
}

__device__ __forceinline__ void prologue(KA a, LAS unsigned char* lds, int wv) {
    LAS float* s = (LAS float*)lds;
    const int G = lgrid(), bid = lbid(), tid = ltid(wv);
    bf16_t* Wbase = (bf16_t*)(a->ws + OFF_W);
#if PRO_PARTS & 1
    constexpr int I_FFN = 16 * 11, I_DN = 44 * 4, I_IN = 16 * 10, I_UQ = 4 * 2, I_UKV = 2 * 2, I_O = 16 * 4, I_PP = 4 * 4;
    constexpr int I_LAYER = 4 * I_FFN + 2 * I_DN + I_IN + I_UQ + I_UKV + 2 * I_O + I_PP;
    for (int it = bid; it < I_LAYER * DEPTH; it += G) {
        const int l = it / I_LAYER; int r = it % I_LAYER;
        int sel = 0;
        if (r >= I_FFN) { r -= I_FFN; sel = 1;
        if (r >= I_FFN) { r -= I_FFN; sel = 2;
        if (r >= I_DN) { r -= I_DN; sel = 3;
        if (r >= I_IN) { r -= I_IN; sel = 4;
        if (r >= I_UQ) { r -= I_UQ; sel = 5;
        if (r >= I_UKV) { r -= I_UKV; sel = 6;
        if (r >= I_O) { r -= I_O; sel = 7;
        if (r >= I_FFN) { r -= I_FFN; sel = 8;
        if (r >= I_FFN) { r -= I_FFN; sel = 9;
        if (r >= I_DN) { r -= I_DN; sel = 10;
        if (r >= I_O) { r -= I_O; sel = 11; } } } } } } } } } } }
        const float* W0; const float* g0 = nullptr; int K, N, mapid; size_t doff;
        switch (sel) {
            case 0: W0 = a->in[3]; g0 = a->in[2]; K = D; N = FF; doff = WL_GU1; mapid = 1; break;
            case 1: W0 = a->in[4]; g0 = a->in[2]; K = D; N = FF; doff = WL_GU1; mapid = 2; break;
            case 2: W0 = a->in[5]; K = FF; N = D; doff = WL_D1; mapid = 0; break;
            case 3: W0 = a->in[7]; g0 = a->in[6]; K = D; N = 2464; doff = WL_IN; mapid = 3; break;
            case 4: W0 = a->in[11]; g0 = a->in[10]; K = 256; N = 384; doff = WL_UQ; mapid = 4; break;
            case 5: W0 = a->in[13]; g0 = a->in[12]; K = 128; N = 512; doff = WL_UKV; mapid = 5; break;
            case 6: W0 = a->in[15]; g0 = a->in[14]; K = D; N = D; doff = WL_O; mapid = 0; break;
            case 7: W0 = a->in[17]; g0 = a->in[16]; K = D; N = FF; doff = WL_GU2; mapid = 1; break;
            case 8: W0 = a->in[18]; g0 = a->in[16]; K = D; N = FF; doff = WL_GU2; mapid = 2; break;
            case 9: W0 = a->in[19]; K = FF; N = D; doff = WL_D2; mapid = 0; break;
            case 10: W0 = a->in[21]; g0 = a->in[20]; K = D; N = D; doff = WL_PG; mapid = 0; break;
            default: W0 = a->in[22]; K = PLE; N = D; doff = WL_PP; mapid = 0; break;
        }
        const float* W = W0 + (size_t)l * K * N;
        const float* gain = g0 ? g0 + (size_t)l * K : nullptr;
        tr_item(W, K, N, gain, Wbase + (size_t)l * WL_SIZE + doff, mapid, r, s, wv);
    }
#endif
    const int gt = bid * 512 + tid, ngt = G * 512;
    for (int l = 0; l < DEPTH; ++l) {
        bf16_t* WL = Wbase + (size_t)l * WL_SIZE;
        zero_rows(WL + WL_IN, 1952, 96, D, gt, ngt);
        zero_rows(WL + WL_UQ, 384, 128, 256, gt, ngt);
    }
#if PRO_PARTS & 2
    float* cs64 = (float*)(a->ws + OFF_CS64); float* cs32 = (float*)(a->ws + OFF_CS32);
    for (int i = gt; i < T * 32; i += ngt) {
        const int pos = i >> 5, j = i & 31;
        const float inv = __builtin_amdgcn_exp2f(-(float)j * (13.287712379549449f / 32.0f)); const float ang = (float)pos * inv;
        const float rev = ang * 0.15915494309189535f, fr_ = rev - floorf(rev);
        float* p = cs64 + ((size_t)pos * 8 + (j >> 2)) * 8 + (j & 3);
        p[0] = __builtin_amdgcn_cosf(fr_); p[4] = __builtin_amdgcn_sinf(fr_);
    }
    for (int i = gt; i < T * 16; i += ngt) {
        const int pos = i >> 4, j = i & 15;
        const float inv = __builtin_amdgcn_exp2f(-(float)j * (13.287712379549449f / 16.0f)); const float ang = (float)pos * inv;
        const float rev = ang * 0.15915494309189535f, fr_ = rev - floorf(rev);
        float* p = cs32 + ((size_t)pos * 4 + (j >> 2)) * 8 + (j & 3);
        p[0] = __builtin_amdgcn_cosf(fr_); p[4] = __builtin_amdgcn_sinf(fr_);
    }
#endif
#if PRO_PARTS & 4
    const int lane = tid & 63, gw = bid * 8 + (tid >> 6), ngw = G * 8;
    bf16_t* xb = (bf16_t*)(a->ws + OFF_XBA); float* ss = (float*)(a->ws + OFF_SSA);
    for (int row = gw; row < M; row += ngw) {
        const f32x4* xr = (const f32x4*)(a->in[0] + (size_t)row * D) + lane; f32x4* orow = (f32x4*)(a->out + (size_t)row * D) + lane;
        float sq = 0.f;
#pragma unroll
        for (int j = 0; j < 4; ++j) {
            const f32x4 v = xr[64 * j]; orow[64 * j] = v; sq += dot4(v);
            u32x2 w; w.x = cvt_pk_bf16(v.x, v.y); w.y = cvt_pk_bf16(v.z, v.w);
            *(u32x2*)(xb + (size_t)row * D + 256 * j + lane * 4) = w;
        }
#pragma unroll
        for (int o = 1; o < 64; o <<= 1) sq += __shfl_xor(sq, o);
        if (lane < 16) ss[(size_t)row * 16 + lane] = lane == 0 ? sq : 0.f;
    }
#endif
}

__device__ __forceinline__ void convert_p(KA a, int layer, int wv) {
    const f32x4* src = (const f32x4*)(a->in[1] + (size_t)layer * M * PLE); u32x2* dst = (u32x2*)(a->ws + OFF_VT);
    const size_t n = (size_t)M * PLE / 4;
    const int tid_ = ltid(wv), bid_ = lbid(), G_ = lgrid();
    for (size_t i = (size_t)bid_ * 512 + tid_; i < n; i += (size_t)G_ * 512) {
        const f32x4 v = src[i]; u32x2 w; w.x = cvt_pk_bf16(v.x, v.y); w.y = cvt_pk_bf16(v.z, v.w); dst[i] = w;
    }
}

__device__ __forceinline__ void final_norm(KA a, int wv) {
    const int tid_ = ltid(wv); const int lane = tid_ & 63, gw = lbid() * 8 + (tid_ >> 6), ngw = lgrid() * 8;
    const float* ss = (const float*)(a->ws + OFF_SSA);
    f32x4 g[4];
#pragma unroll
    for (int j = 0; j < 4; ++j) g[j] = ((const f32x4*)a->in[23])[64 * j + lane];
    for (int row = gw; row < M; row += ngw) {
        const float r = rs16(ss, row);
        f32x4* orow = (f32x4*)(a->out + (size_t)row * D) + lane;
#pragma unroll
        for (int j = 0; j < 4; ++j) orow[64 * j] = orow[64 * j] * r * g[j];
    }
}

struct AttnP { const unsigned char* ws; const float* nab; const float* sink; };

template <int MODE>
__device__ __forceinline__ void attn_unit(const AttnP& P0, int unit, LAS float* xch, const LAS float* nabl, int wv) {
    const unsigned char* ws = P0.ws; asm volatile("" : "+s"(ws));
    constexpr int NS = MODE == 0 ? 6 : 4;
    const int lane = vlane(), w = wv, qs = w >> 2, h = w & 3, ql = lane & 31, hh = lane >> 5;
    const int lane16 = lane * 16;
    const int b = unit >> 5, rem = unit & 31;
    int qt, T0 = 0, rr = 0, qmin, qmax;
    if (MODE == 1) { T0 = 512 * (rem >> 3); rr = 2 * (rem & 7) + qs; qt = T0 + rr + 16 * ql; qmin = T0 + rr; qmax = qmin + 496; }
    else { qmin = 64 * rem + 32 * qs; qt = qmin + ql; qmax = qmin + 31; }
    const size_t tokbase = (size_t)b * T;
    const bf16_t* qrow; int khead, group;
    if (MODE == 0) { qrow = (const bf16_t*)(ws + OFF_QM) + (tokbase + qt) * QLD + 96 * h; khead = 18 + h; group = 3; }
    else if (MODE == 1) { qrow = (const bf16_t*)(ws + OFF_ZQ) + (tokbase + qt) * ZQLD + 512 + 64 * h; khead = 6 + h; group = 2; }
    else if (MODE == 2) { qrow = (const bf16_t*)(ws + OFF_ZQ) + (tokbase + qt) * ZQLD + 64 * h; khead = h; group = 0; }
    else { qrow = (const bf16_t*)(ws + OFF_ZQ) + (tokbase + qt) * ZQLD + 256 + 64 * h; khead = 4 + (h >> 1); group = 1; }
    const unsigned char* kfb = ws + OFF_KF + (size_t)b * 64 * 4096 + lane16;
    const unsigned char* vfb = ws + OFF_VT + (size_t)b * 64 * 4096 + lane16;
    const unsigned char* kpe = ws + OFF_KPE + (size_t)b * 64 * 2048 + lane16;
    bf16x8 qf[NS];
#pragma unroll
    for (int s = 0; s < NS; ++s) qf[s] = *(const bf16x8*)(qrow + 16 * s + 8 * hh);
    const float sc = (MODE == 0 ? 0.10206207261596577f : 0.125f) * LOG2E;
    f32x16 o0, o1;
#pragma unroll
    for (int e = 0; e < 16; ++e) { o0[e] = 0.f; o1[e] = 0.f; }
    float mrun = -1e20f, lrun = 0.f;
    if (MODE == 3) { mrun = P0.sink[h] * LOG2E; lrun = hh == 0 ? 1.f : 0.f; }
    const int qcol = qt & 63;
    const int nseg = MODE == 1 ? 3 : 1;
    for (int seg = 0; seg < nseg; ++seg) {
        int ntile, kb0, kstr, vb0, win, hd = khead;
        if (MODE == 0) { ntile = 64; kb0 = 0; kstr = 1; vb0 = 0; win = 1 << 20; }
        else if (MODE == 2) { ntile = 16; kb0 = 64 * min(max(rem - 4, 0), 24); kstr = 1; vb0 = kb0; win = 0; }
        else if (MODE == 3) { ntile = 9; kb0 = qmin - 128; kstr = 1; vb0 = kb0; win = 128; }
        else {
            if (seg == 0) { ntile = 20; kb0 = T0 - 64; kstr = 1; vb0 = kb0; win = 64; }
            else if (seg == 1) { ntile = 8; const int us = (T0 >> 2) - 64, r4 = rr & 3; kb0 = 4 * us + r4; kstr = 4; vb0 = r4 * 512 + us; win = 256; hd = khead + 4; }
            else { ntile = 5; const int nst = (T0 >> 4) - 64; kb0 = 16 * nst + rr; kstr = 16; vb0 = rr * 128 + nst; win = 1024; hd = khead + 8; }
        }
        const int kstep = 32 * kstr;
        int tlo = 0, thi = ntile;
        if (MODE == 1 || MODE == 3) { tlo = kb0 < 0 ? (-kb0 + kstep - 1) / kstep : 0; thi = min(ntile, (T - kb0 + kstep - 1) / kstep); }
        const unsigned char* kfh = kfb + (size_t)hd * HEADB; const unsigned char* vfh = vfb + (size_t)hd * HEADB;
        bf16x8 kf[NS], vf[4];
        {
            const int pt = (vb0 >> 5) + tlo;
#pragma unroll
            for (int s = 0; s < NS; ++s) kf[s] = (MODE == 0 && s >= 4) ? *(const bf16x8*)(kpe + (size_t)pt * 2048 + (s - 4) * 1024) : *(const bf16x8*)(kfh + (size_t)pt * 4096 + s * 1024);
#pragma unroll
            for (int j = 0; j < 4; ++j) vf[j] = *(const bf16x8*)(vfh + (size_t)pt * 4096 + j * 1024);
        }
        if (qs && seg == 0) __builtin_amdgcn_s_sleep(DEPHASE / 2);
        for (int tau = tlo; tau < thi; ++tau) {
            const int kb = kb0 + kstep * tau;
            bf16x8 kn[NS], vn[4];
            {
                const int pt = (vb0 >> 5) + min(tau + 1, thi - 1);
#pragma unroll
                for (int s = 0; s < NS; ++s) kn[s] = (MODE == 0 && s >= 4) ? *(const bf16x8*)(kpe + (size_t)pt * 2048 + (s - 4) * 1024) : *(const bf16x8*)(kfh + (size_t)pt * 4096 + s * 1024);
#pragma unroll
                for (int j = 0; j < 4; ++j) vn[j] = *(const bf16x8*)(vfh + (size_t)pt * 4096 + j * 1024);
            }
            f32x16 sacc;
#pragma unroll
            for (int e = 0; e < 16; ++e) sacc[e] = 0.f;
#pragma unroll
            for (int s = 0; s < NS; ++s) sacc = __builtin_amdgcn_mfma_f32_32x32x16_bf16(kf[s], qf[s], sacc, 0, 0, 0);
            if (MODE == 2) {
                const int c0 = 32 * (tau & 1), wsx = min(max(qcol - 8, 0), 48);
                const int mb = c0 - wsx + 4 * hh;
                const int drow = (kb >> 6) - rem + 7;
                const LAS float* bp = nabl + (h * 15 + drow) * 31 + c0 - qcol + 15 + 4 * hh;
#pragma unroll
                for (int e = 0; e < 16; ++e) {
                    const int o = 8 * (e >> 2) + (e & 3);
                    const float v = sacc[e] * sc + bp[o];
                    sacc[e] = (unsigned)(mb + o) < 16u ? v : -1e30f;
                }
            } else if (MODE != 0) {
                const bool full = (kb + 31 * kstr - qmin <= win) && (qmax - kb <= win);
                if (!full) {
                    const int mb = kb - qt + win + 4 * hh * kstr;
#pragma unroll
                    for (int e = 0; e < 16; ++e) {
                        const int o = (8 * (e >> 2) + (e & 3)) * kstr;
                        sacc[e] = (unsigned)(mb + o) <= (unsigned)(2 * win) ? sacc[e] : -1e30f;
                    }
                }
            }
            float tmax = fmaxf(fmaxf(sacc[0], sacc[1]), fmaxf(sacc[2], sacc[3]));
#pragma unroll
            for (int e = 4; e < 16; e += 4) tmax = fmaxf(tmax, fmaxf(fmaxf(sacc[e], sacc[e + 1]), fmaxf(sacc[e + 2], sacc[e + 3])));
            tmax = fmaxf(tmax, __shfl_xor(tmax, 32));
            if (MODE != 2) tmax *= sc;
            const float mnew = fmaxf(mrun, tmax);
            const bool grow = mnew > mrun;
            const float alpha = __builtin_amdgcn_exp2f(mrun - mnew);
            mrun = mnew;
            float psum = 0.f;
#pragma unroll
            for (int e = 0; e < 16; ++e) {
                const float p = MODE == 2 ? __builtin_amdgcn_exp2f(sacc[e] - mnew) : __builtin_amdgcn_exp2f(__builtin_fmaf(sacc[e], sc, -mnew));
                sacc[e] = p; psum += p;
            }
            lrun = lrun * alpha + psum;
            if (__builtin_amdgcn_ballot_w64(grow) != 0ull) {
#pragma unroll
                for (int e = 0; e < 16; ++e) { o0[e] *= alpha; o1[e] *= alpha; }
            }
            bf16x8 pb[2];
#pragma unroll
            for (int t = 0; t < 2; ++t) {
                u32x4 v; v.x = cvt_pk_bf16(sacc[8 * t + 0], sacc[8 * t + 1]); v.y = cvt_pk_bf16(sacc[8 * t + 2], sacc[8 * t + 3]);
                v.z = cvt_pk_bf16(sacc[8 * t + 4], sacc[8 * t + 5]); v.w = cvt_pk_bf16(sacc[8 * t + 6], sacc[8 * t + 7]);
                pb[t] = __builtin_bit_cast(bf16x8, v);
            }
            o0 = __builtin_amdgcn_mfma_f32_32x32x16_bf16(vf[0], pb[0], o0, 0, 0, 0);
            o0 = __builtin_amdgcn_mfma_f32_32x32x16_bf16(vf[1], pb[1], o0, 0, 0, 0);
            o1 = __builtin_amdgcn_mfma_f32_32x32x16_bf16(vf[2], pb[0], o1, 0, 0, 0);
            o1 = __builtin_amdgcn_mfma_f32_32x32x16_bf16(vf[3], pb[1], o1, 0, 0, 0);
#pragma unroll
            for (int s = 0; s < NS; ++s) kf[s] = kn[s];
#pragma unroll
            for (int j = 0; j < 4; ++j) vf[j] = vn[j];
        }
    }
    lrun += __shfl_xor(lrun, 32);
    const float inv = 1.0f / lrun;
    float sq = 0.f;
#pragma unroll
    for (int e = 0; e < 16; ++e) { o0[e] *= inv; o1[e] *= inv; sq += o0[e] * o0[e] + o1[e] * o1[e]; }
    sq += __shfl_xor(sq, 32);
    if (hh == 0) xch[w * 32 + ql] = sq;
    __syncthreads();
    const float tot = (xch[(qs * 4 + 0) * 32 + ql] + xch[(qs * 4 + 1) * 32 + ql]) + (xch[(qs * 4 + 2) * 32 + ql] + xch[(qs * 4 + 3) * 32 + ql]);
    const float rg = rsqrtf(tot * (1.0f / 256.0f) + EPS);
    bf16_t* yrow = (bf16_t*)(ws + OFF_XBA) + (tokbase + qt) * D + group * 256 + h * 64 + 4 * hh;
#pragma unroll
    for (int j = 0; j < 4; ++j) {
        u32x2 w0; w0.x = cvt_pk_bf16(o0[4 * j] * rg, o0[4 * j + 1] * rg); w0.y = cvt_pk_bf16(o0[4 * j + 2] * rg, o0[4 * j + 3] * rg);
        u32x2 w1; w1.x = cvt_pk_bf16(o1[4 * j] * rg, o1[4 * j + 1] * rg); w1.y = cvt_pk_bf16(o1[4 * j + 2] * rg, o1[4 * j + 3] * rg);
        *(u32x2*)(yrow + 8 * j) = w0; *(u32x2*)(yrow + 32 + 8 * j) = w1;
    }
}

__device__ __forceinline__ void sm_pv(f32x16& sacc, f32x16& o0, f32x16& o1, float& mrun, float& lrun, const bf16x8 (&vf)[4], float sc) {
    float tmax = fmaxf(fmaxf(sacc[0], sacc[1]), fmaxf(sacc[2], sacc[3]));
#pragma unroll
    for (int e = 4; e < 16; e += 4) tmax = fmaxf(tmax, fmaxf(fmaxf(sacc[e], sacc[e + 1]), fmaxf(sacc[e + 2], sacc[e + 3])));
    tmax = xh_max(tmax) * sc;
    const float mnew = fmaxf(mrun, tmax);
    const bool grow = mnew > mrun;
    const float alpha = __builtin_amdgcn_exp2f(mrun - mnew);
    mrun = mnew;
    float psum = 0.f;
#pragma unroll
    for (int e = 0; e < 16; ++e) { const float p = __builtin_amdgcn_exp2f(__builtin_fmaf(sacc[e], sc, -mnew)); sacc[e] = p; psum += p; }
    lrun = lrun * alpha + psum;
    if (__builtin_amdgcn_ballot_w64(grow) != 0ull) {
#pragma unroll
        for (int e = 0; e < 16; ++e) { o0[e] *= alpha; o1[e] *= alpha; }
    }
    bf16x8 pb[2];
#pragma unroll
    for (int t = 0; t < 2; ++t) {
        u32x4 v; v.x = cvt_pk_bf16(sacc[8 * t + 0], sacc[8 * t + 1]); v.y = cvt_pk_bf16(sacc[8 * t + 2], sacc[8 * t + 3]);
        v.z = cvt_pk_bf16(sacc[8 * t + 4], sacc[8 * t + 5]); v.w = cvt_pk_bf16(sacc[8 * t + 6], sacc[8 * t + 7]);
        pb[t] = __builtin_bit_cast(bf16x8, v);
    }
    o0 = __builtin_amdgcn_mfma_f32_32x32x16_bf16(vf[0], pb[0], o0, 0, 0, 0);
    o0 = __builtin_amdgcn_mfma_f32_32x32x16_bf16(vf[1], pb[1], o0, 0, 0, 0);
    o1 = __builtin_amdgcn_mfma_f32_32x32x16_bf16(vf[2], pb[0], o1, 0, 0, 0);
    o1 = __builtin_amdgcn_mfma_f32_32x32x16_bf16(vf[3], pb[1], o1, 0, 0, 0);
}
__device__ __forceinline__ void attn_mla(const AttnP& P0, int unit, LAS float* xch, int wv) {
    const unsigned char* ws = P0.ws; asm volatile("" : "+s"(ws));
    const int lane = vlane(), w = wv, qs = w >> 2, h = w & 3, ql = lane & 31, hh = lane >> 5;
    const int lane16 = lane * 16;
    const int b = unit >> 4, q0 = 128 * (unit & 15) + 64 * qs;
    const size_t tokbase = (size_t)b * T;
    const bf16_t* qrA = (const bf16_t*)(ws + OFF_QM) + (tokbase + q0 + ql) * QLD + 96 * h;
    const bf16_t* qrB = qrA + 32 * QLD;
    const unsigned char* kfh = ws + OFF_KF + (size_t)(18 + h) * HEADB + (size_t)b * 64 * 4096 + lane16;
    const unsigned char* vfh = ws + OFF_VT + (size_t)(18 + h) * HEADB + (size_t)b * 64 * 4096 + lane16;
    const unsigned char* kpe = ws + OFF_KPE + (size_t)b * 64 * 2048 + lane16;
    bf16x8 qA[6], qB[6];
#pragma unroll
    for (int s = 0; s < 6; ++s) { qA[s] = *(const bf16x8*)(qrA + 16 * s + 8 * hh); qB[s] = *(const bf16x8*)(qrB + 16 * s + 8 * hh); }
    const float sc = 0.10206207261596577f * LOG2E;
    f32x16 oA0, oA1, oB0, oB1;
#pragma unroll
    for (int e = 0; e < 16; ++e) { oA0[e] = 0.f; oA1[e] = 0.f; oB0[e] = 0.f; oB1[e] = 0.f; }
    float mA = -1e20f, lA = 0.f, mB = -1e20f, lB = 0.f;
    bf16x8 kf[6], vf[4];
#pragma unroll
    for (int s = 0; s < 6; ++s) kf[s] = s >= 4 ? ldg16(kpe + (s - 4) * 1024) : ldg16(kfh + s * 1024);
#pragma unroll
    for (int j = 0; j < 4; ++j) vf[j] = ldg16(vfh + j * 1024);
    if (qs) __builtin_amdgcn_s_sleep(DEPHASE);
    for (int tau = 0; tau < 64; ++tau) {
        const int pt = min(tau + 1, 63);
        f32x16 sa, sb;
#pragma unroll
        for (int e = 0; e < 16; ++e) { sa[e] = 0.f; sb[e] = 0.f; }
#pragma unroll
        for (int s = 0; s < 6; ++s) { sa = __builtin_amdgcn_mfma_f32_32x32x16_bf16(kf[s], qA[s], sa, 0, 0, 0); sb = __builtin_amdgcn_mfma_f32_32x32x16_bf16(kf[s], qB[s], sb, 0, 0, 0); }
#pragma unroll
        for (int s = 0; s < 6; ++s) kf[s] = s >= 4 ? ldg16(kpe + (size_t)pt * 2048 + (s - 4) * 1024) : ldg16(kfh + (size_t)pt * 4096 + s * 1024);
        sm_pv(sa, oA0, oA1, mA, lA, vf, sc);
        sm_pv(sb, oB0, oB1, mB, lB, vf, sc);
#pragma unroll
        for (int j = 0; j < 4; ++j) vf[j] = ldg16(vfh + (size_t)pt * 4096 + j * 1024);
    }
    lA += __shfl_xor(lA, 32); lB += __shfl_xor(lB, 32);
    const float iA = 1.0f / lA, iB = 1.0f / lB;
    float sqA = 0.f, sqB = 0.f;
#pragma unroll
    for (int e = 0; e < 16; ++e) { oA0[e] *= iA; oA1[e] *= iA; oB0[e] *= iB; oB1[e] *= iB; sqA += oA0[e] * oA0[e] + oA1[e] * oA1[e]; sqB += oB0[e] * oB0[e] + oB1[e] * oB1[e]; }
    sqA += __shfl_xor(sqA, 32); sqB += __shfl_xor(sqB, 32);
    if (hh == 0) { xch[w * 64 + ql] = sqA; xch[w * 64 + 32 + ql] = sqB; }
    __syncthreads();
    const LAS float* xq = xch + qs * 256 + ql;
    const float rA = rsqrtf(((xq[0] + xq[64]) + (xq[128] + xq[192])) * (1.0f / 256.0f) + EPS);
    const float rB = rsqrtf(((xq[32] + xq[96]) + (xq[160] + xq[224])) * (1.0f / 256.0f) + EPS);
    bf16_t* yA = (bf16_t*)(ws + OFF_XBA) + (tokbase + q0 + ql) * D + 3 * 256 + h * 64 + 4 * hh;
    bf16_t* yB = yA + 32 * D;
#pragma unroll
    for (int j = 0; j < 4; ++j) {
        u32x2 w0; w0.x = cvt_pk_bf16(oA0[4 * j] * rA, oA0[4 * j + 1] * rA); w0.y = cvt_pk_bf16(oA0[4 * j + 2] * rA, oA0[4 * j + 3] * rA);
        u32x2 w1; w1.x = cvt_pk_bf16(oA1[4 * j] * rA, oA1[4 * j + 1] * rA); w1.y = cvt_pk_bf16(oA1[4 * j + 2] * rA, oA1[4 * j + 3] * rA);
        *(u32x2*)(yA + 8 * j) = w0; *(u32x2*)(yA + 32 + 8 * j) = w1;
        u32x2 w2; w2.x = cvt_pk_bf16(oB0[4 * j] * rB, oB0[4 * j + 1] * rB); w2.y = cvt_pk_bf16(oB0[4 * j + 2] * rB, oB0[4 * j + 3] * rB);
        u32x2 w3; w3.x = cvt_pk_bf16(oB1[4 * j] * rB, oB1[4 * j + 1] * rB); w3.y = cvt_pk_bf16(oB1[4 * j + 2] * rB, oB1[4 * j + 3] * rB);
        *(u32x2*)(yB + 8 * j) = w2; *(u32x2*)(yB + 32 + 8 * j) = w3;
    }
}

__device__ __forceinline__ void attn_phase(KA a, int layer, LAS unsigned char* lds, int wv) {
    AttnP P; P.ws = a->ws; P.nab = a->in[8] + (size_t)layer * 4 * 15 * 31; P.sink = a->in[9] + layer * 4;
    LAS float* xch = (LAS float*)lds;
    for (int i = ltid(wv); i < 4 * 15 * 31; i += 512) xch[1024 + i] = P.nab[i] * LOG2E;
    __syncthreads();
    int it = 0;
    const int G_ = lgrid(), bid_ = lbid();
    const int vcu = (G_ & 7) == 0 ? (bid_ & 7) * (G_ >> 3) + (bid_ >> 3) : bid_;
    for (int u = vcu; u < 256 + 3 * 512; u += G_, ++it) {
        LAS float* x = xch + (it & 1) * 512;
        if (u < 256) attn_mla(P, u, x, wv);
        else {
            const int mode = 1 + ((u - 256) >> 9), unit = (u - 256) & 511;
            if (mode == 1) attn_unit<1>(P, unit, x, xch + 1024, wv);
            else if (mode == 2) attn_unit<2>(P, unit, x, xch + 1024, wv);
            else attn_unit<3>(P, unit, x, xch + 1024, wv);
        }
    }
    __syncthreads();
}

__device__ __forceinline__ void grid_bar(unsigned* bar, unsigned seq, int wv) {
    asm volatile("s_waitcnt vmcnt(0) lgkmcnt(0)" ::: "memory");
    __builtin_amdgcn_s_barrier();
    if (wv == 0) {
        if (vlane() == 0) {
            const unsigned G = (unsigned)lgrid(), b = (unsigned)lbid(), g = b & 7u;
            const unsigned ng = (G - g + 7u) >> 3, ngroups = G < 8u ? G : 8u;
            unsigned* flag = bar + 64 * 9;
            __builtin_amdgcn_fence(__ATOMIC_RELEASE, "agent");
            asm volatile("s_waitcnt vmcnt(0)" ::: "memory");
            const unsigned old = __hip_atomic_fetch_add(bar + 64 * g, 1u, __ATOMIC_RELAXED, __HIP_MEMORY_SCOPE_AGENT);
            bool waitf = true;
            if (old + 1u == seq * ng) {
                __builtin_amdgcn_fence(__ATOMIC_SEQ_CST, "agent");
                const unsigned old2 = __hip_atomic_fetch_add(bar + 64 * 8, 1u, __ATOMIC_RELAXED, __HIP_MEMORY_SCOPE_AGENT);
                if (old2 + 1u == seq * ngroups) { __builtin_amdgcn_fence(__ATOMIC_SEQ_CST, "agent"); __hip_atomic_store(flag, seq, __ATOMIC_RELAXED, __HIP_MEMORY_SCOPE_AGENT); waitf = false; }
            }
            if (waitf) { unsigned spins = 0; while (__hip_atomic_load(flag, __ATOMIC_RELAXED, __HIP_MEMORY_SCOPE_AGENT) < seq) { __builtin_amdgcn_s_sleep(1); if (++spins > (1u << 26)) break; } }
            __builtin_amdgcn_fence(__ATOMIC_ACQUIRE, "agent");
            asm volatile("s_waitcnt vmcnt(0)" ::: "memory");
        }
    }
    __builtin_amdgcn_s_barrier();
    asm volatile("" ::: "memory");
}

template <int PH, bool ZERO = false>
__device__ __forceinline__ void run_phase(LAS unsigned char* lds, int wv) {
    KA a = kargs();
    unsigned char* ws = a->ws; asm volatile("" : "+s"(ws));
    bf16_t* Wbase = (bf16_t*)(ws + OFF_W);
    bf16_t* xbA = (bf16_t*)(ws + OFF_XBA); bf16_t* xbB = (bf16_t*)(ws + OFF_XBB);
    bf16_t* Hb = (bf16_t*)(ws + OFF_H); bf16_t* zl = (bf16_t*)(ws + OFF_ZL); bf16_t* qm = (bf16_t*)(ws + OFF_QM);
    unsigned char* vf = ws + OFF_VT;
    bf16_t* pb = (bf16_t*)(ws + OFF_VT);
    float* ssA = (float*)(ws + OFF_SSA); float* ssB = (float*)(ws + OFF_SSB); float* mst = (float*)(ws + OFF_MST);
    const float* cs64 = (const float*)(ws + OFF_CS64); const float* cs32 = (const float*)(ws + OFF_CS32);
    if constexpr (PH == 0) { if (PH_ON(0)) prologue(a, lds, wv); }
    else if constexpr (PH == NPH - 1) { if (PH_ON(1)) final_norm(a, wv); }
    else {
        constexpr int l = (PH - 1) / 9, k = (PH - 1) % 9;
        bf16_t* WL = Wbase + (size_t)l * WL_SIZE;
        if constexpr (k == 0) { if (PH_ON(2)) { EpiGU E{ssA, Hb}; run_gemm(wv, lds, xbA, D, M, WL + WL_GU1, D, 5632, D, 0, E); } }
        else if constexpr (k == 1) { if (PH_ON(3)) { EpiRes E{a->out, xbB, ssB, ZERO ? 0.f : 0.5f}; run_gemm(wv, lds, Hb, FF, M, WL + WL_D1, FF, D, FF, 0, E); } }
        else if constexpr (k == 2) {
            if (PH_ON(4)) { EpiIn E{ssB, ws, mst, cs64, cs32}; run_gemm(wv, lds, xbB, D, M, WL + WL_IN, D, 2048, D, 0, E); }
            if (PH_ON(5)) { EpiVT E{ssB, vf}; run_gemm(wv, lds, WL + WL_IN + (size_t)2048 * D, D, 512, xbB, D, M, D, 0, E); }
        }
        else if constexpr (k == 3) {
            if (PH_ON(6)) { EpiQ E{mst, qm, cs32}; run_gemm(wv, lds, zl, ZLLD, M, WL + WL_UQ, 256, 512, 256, 0, E); }
            if (PH_ON(7)) { EpiK E{mst, ws}; run_gemm(wv, lds, zl + 256, ZLLD, M, WL + WL_UKV, 128, 256, 128, 0, E); }
            if (PH_ON(8)) { EpiVTM E{mst, vf}; run_gemm(wv, lds, WL + WL_UKV + (size_t)256 * 128, 128, 256, zl + 256, ZLLD, M, 128, 128, E); }
        }
        else if constexpr (k == 4) { if (PH_ON(9)) attn_phase(a, l, lds, wv); }
        else if constexpr (k == 5) { if (PH_ON(3)) { EpiRes E{a->out, xbB, ssB, ZERO ? 0.f : 1.0f}; run_gemm(wv, lds, xbA, D, M, WL + WL_O, D, D, D, 0, E); } }
        else if constexpr (k == 6) { if (PH_ON(2)) { convert_p(a, l, wv); EpiGU E{ssB, Hb}; run_gemm(wv, lds, xbB, D, M, WL + WL_GU2, D, 5632, D, 0, E); } }
        else if constexpr (k == 7) {
            if (PH_ON(3)) { EpiRes E{a->out, xbB, ssB, ZERO ? 0.f : 0.5f}; run_gemm(wv, lds, Hb, FF, M, WL + WL_D2, FF, D, FF, 0, E); }
            if (PH_ON(10)) { EpiPP E{xbA}; run_gemm(wv, lds, pb, PLE, M, WL + WL_PP, PLE, D, PLE, 0, E); }
        }
        else { if (PH_ON(11)) { EpiGate E{a->out, ssB, xbA, ssA, ZERO ? 0.f : 1.0f}; run_gemm(wv, lds, xbB, D, M, WL + WL_PG, D, D, D, 0, E); } }
    }
}
template <int PH>
__device__ __forceinline__ void run_from(LAS unsigned char* lds, int ph_lo, int ph_hi, int wv) {
    if constexpr (PH < NPH) {
        if (PH >= ph_lo && PH < ph_hi) {
            run_phase<PH>(lds, wv);
            if constexpr (PH > 0 && PH < NPH - 1) { if constexpr ((DUPM >> ((PH - 1) % 9)) & 1) { __syncthreads(); run_phase<PH, true>(lds, wv); } }
            if constexpr (PH == 0 && ((DUPM >> 9) & 1)) { __syncthreads(); run_phase<PH>(lds, wv); }
            if (PH + 1 < ph_hi && kargs()->coop) {
                if constexpr (PH == 0) cg::this_grid().sync();
                else { for (int r_ = 0; r_ < BARREP; ++r_) grid_bar((unsigned*)(kargs()->ws + OFF_BAR), (unsigned)((PH - 1) * BARREP + r_ + 1), wv); }
            }
        }
        run_from<PH + 1>(lds, ph_lo, ph_hi, wv);
    }
}
__global__ void __launch_bounds__(512, 2) mega(Args a_unused) {
    extern __shared__ __attribute__((aligned(16))) unsigned char lds_raw[];
    LAS unsigned char* lds = (LAS unsigned char*)lds_raw;
    const int ph_lo = kargs()->ph_lo, ph_hi = kargs()->ph_hi;
    const int wv = __builtin_amdgcn_readfirstlane((int)threadIdx.x >> 6);
    run_from<0>(lds, ph_lo, ph_hi, wv);
}

extern "C" void kernel_launch(void* const* d_in, const int* in_sizes, int n_in, void* d_out, int out_size, void* d_ws, size_t ws_size, hipStream_t stream) {
    static int grid = 0;
    if (grid == 0) {
        if (n_in != 24 || ws_size < WS_END) { fprintf(stderr, "kernel_launch: n_in %d ws %zu (need %zu)\n", n_in, ws_size, (size_t)WS_END); grid = -1; return; }
        int dev = 0, cus = 0, per_cu = 0;
        hipGetDevice(&dev); hipDeviceGetAttribute(&cus, hipDeviceAttributeMultiprocessorCount, dev);
        if (hipFuncSetAttribute((const void*)mega, hipFuncAttributeMaxDynamicSharedMemorySize, LDS_BYTES) != hipSuccess) { fprintf(stderr, "hipFuncSetAttribute failed\n"); grid = -1; return; }
        if (hipOccupancyMaxActiveBlocksPerMultiprocessor(&per_cu, (const void*)mega, 512, LDS_BYTES) != hipSuccess || per_cu < 1) per_cu = 1;
        (void)hipGetLastError();
        grid = cus * per_cu;
    }
    if (grid < 0) return;
    (void)hipMemsetAsync((char*)d_ws + OFF_BAR, 0, 4096, stream);
    Args a{};
    for (int i = 0; i < 24; ++i) a.in[i] = (const float*)d_in[i];
    a.out = (float*)d_out; a.ws = (unsigned char*)d_ws;
#if MULTI_LAUNCH
    for (int ph = 0; ph < NPH; ++ph) {
        a.ph_lo = ph; a.ph_hi = ph + 1; a.coop = 0;
        hipLaunchKernelGGL(mega, dim3(grid), dim3(512), LDS_BYTES, stream, a);
    }
#else
    a.ph_lo = 0; a.ph_hi = NPH; a.coop = 1;
    void* args[] = {&a};
    hipError_t e = hipLaunchCooperativeKernel((void*)mega, dim3(grid), dim3(512), args, LDS_BYTES, stream);
    if (e != hipSuccess) fprintf(stderr, "cooperative launch failed: %s (grid %d)\n", hipGetErrorString(e), grid);
#endif
}
```

```cpp
#include <hip/hip_runtime.h>
#include <hip/hip_cooperative_groups.h>
#include <cstdio>
#include <cstdint>
namespace cg = cooperative_groups;

#ifndef MULTI_LAUNCH
#define MULTI_LAUNCH 0
#endif

#ifndef DEPHASE
#define DEPHASE 20
#endif
#ifndef BARREP
#define BARREP 1
#endif
#ifndef DUPM
#define DUPM 0
#endif
#ifndef PRO_PARTS
#define PRO_PARTS 7
#endif
#ifndef PHM
#define PHM 0xffff
#endif
#define PH_ON(b) (((PHM) >> (b)) & 1)
#define LAS __attribute__((address_space(3)))
typedef unsigned short bf16_t;
typedef short bf16x8 __attribute__((ext_vector_type(8)));
typedef float f32x4 __attribute__((ext_vector_type(4)));
typedef float f32x16 __attribute__((ext_vector_type(16)));
typedef unsigned u32x4 __attribute__((ext_vector_type(4)));
typedef unsigned u32x2 __attribute__((ext_vector_type(2)));

constexpr int M = 32768, T = 2048, D = 1024, FF = 2816, DEPTH = 4, PLE = 256;
constexpr int ZQLD = 768, ZLLD = 384, QLD = 384;
constexpr size_t HEADB = (size_t)16 * 64 * 4096;
constexpr float EPS = 1e-6f;
constexpr float LOG2E = 1.4426950408889634f;

constexpr size_t WL_GU1 = 0, WL_D1 = WL_GU1 + (size_t)5632 * 1024, WL_IN = WL_D1 + (size_t)1024 * 2816, WL_UQ = WL_IN + (size_t)2816 * 1024,
                 WL_UKV = WL_UQ + (size_t)512 * 256, WL_O = WL_UKV + (size_t)512 * 128, WL_GU2 = WL_O + (size_t)1024 * 1024, WL_D2 = WL_GU2 + (size_t)5632 * 1024,
                 WL_PG = WL_D2 + (size_t)1024 * 2816, WL_PP = WL_PG + (size_t)1024 * 1024, WL_SIZE = WL_PP + (size_t)1024 * 256;
constexpr size_t OFF_W = 0;
constexpr size_t OFF_XBA = OFF_W + WL_SIZE * 2 * DEPTH;
constexpr size_t OFF_XBB = OFF_XBA + (size_t)M * D * 2;
constexpr size_t OFF_H = OFF_XBB + (size_t)M * D * 2;
constexpr size_t OFF_ZQ = OFF_H;
constexpr size_t OFF_ZL = OFF_ZQ + (size_t)M * ZQLD * 2;
constexpr size_t OFF_KF = OFF_ZL + (size_t)M * ZLLD * 2;
constexpr size_t OFF_KPE = OFF_KF + 22 * HEADB;
constexpr size_t OFF_VT = OFF_H + (size_t)M * FF * 2;
constexpr size_t OFF_SSA = OFF_VT + 22 * HEADB;
constexpr size_t OFF_SSB = OFF_SSA + (size_t)M * 16 * 4;
constexpr size_t OFF_MST = OFF_SSB + (size_t)M * 16 * 4;
constexpr size_t OFF_CS64 = OFF_MST + (size_t)M * 8 * 4;
constexpr size_t OFF_CS32 = OFF_CS64 + (size_t)T * 64 * 4;
constexpr size_t OFF_BAR = OFF_CS32 + (size_t)T * 32 * 4;
constexpr size_t OFF_QM = OFF_BAR + 4096;
constexpr size_t WS_END = OFF_QM + (size_t)M * QLD * 2;
static_assert(OFF_KPE + (size_t)16 * 64 * 2048 <= OFF_VT, "zq|zl|KF|KPE inside the H region");
static_assert(WS_END <= 626121856, "workspace budget");

constexpr int LDS_BYTES = 147456;
constexpr int NPH = 2 + 9 * DEPTH;

__device__ __forceinline__ unsigned cvt_pk_bf16(float lo, float hi) { unsigned r; asm("v_cvt_pk_bf16_f32 %0, %1, %2" : "=v"(r) : "v"(lo), "v"(hi)); return r; }
__device__ __forceinline__ float bf_lo(unsigned u) { return __uint_as_float(u << 16); }
__device__ __forceinline__ float bf_hi(unsigned u) { return __uint_as_float(u & 0xffff0000u); }
__device__ __forceinline__ float sum4(f32x4 a) { return (a.x + a.y) + (a.z + a.w); }
__device__ __forceinline__ float dot4(f32x4 a) { return (a.x * a.x + a.y * a.y) + (a.z * a.z + a.w * a.w); }
__device__ __forceinline__ float rs16(const float* ss, int row) {
    const f32x4* p = (const f32x4*)(ss + (size_t)row * 16);
    const f32x4 a = p[0], b = p[1], c = p[2], d = p[3];
    return rsqrtf(((sum4(a) + sum4(b)) + (sum4(c) + sum4(d))) * (1.0f / 1024.0f) + EPS);
}
__device__ __forceinline__ int vlane() { int l; asm volatile("v_mbcnt_lo_u32_b32 %0, -1, 0\n\tv_mbcnt_hi_u32_b32 %0, -1, %0" : "=v"(l)); return l; }
__device__ __forceinline__ int ltid(int wv) { return (wv << 6) | vlane(); }
__device__ __forceinline__ int lbid() { int b = blockIdx.x; asm volatile("" : "+s"(b)); return b; }
__device__ __forceinline__ int lgrid() { int g = gridDim.x; asm volatile("" : "+s"(g)); return g; }
#define GAS __attribute__((address_space(1)))
__device__ __forceinline__ bf16x8 ldg16(const void* p) { return *(const GAS bf16x8*)p; }
__device__ __forceinline__ float xh_max(float x) { auto r = __builtin_amdgcn_permlane32_swap(__float_as_uint(x), __float_as_uint(x), false, false); return fmaxf(__uint_as_float(r[0]), __uint_as_float(r[1])); }
__device__ __forceinline__ float sigmoidf_(float v) { return __builtin_amdgcn_rcpf(1.0f + __expf(-v)); }

namespace pg8 {
constexpr int BM = 256, BK = 64, HALF = 128, HTB = HALF * BK * 2, STAGE_BYTES = 8 * HTB, NXCD = 8, WGM = 8;
__host__ __device__ __forceinline__ int lds_byte(int r, int c) { const int st = (r >> 4) * 2 + (c >> 5), rr = r & 15, cc = c & 31, ob = rr * 64 + cc * 2; return st * 1024 + (ob ^ (((ob >> 9) & 1) << 5)); }
__host__ __device__ __forceinline__ void stage_rc(int b, int& R, int& C) { const int st = b / 1024, sb = b % 1024, swz = sb ^ (((sb >> 9) & 1) << 5); R = (st >> 1) * 16 + swz / 64; C = (st & 1) * 32 + (swz % 64) / 2; }
__host__ __device__ __forceinline__ int perm32(int rho) { const int n = rho >> 4, i = rho & 15; return 8 * (i >> 2) + 4 * n + (i & 3); }

struct Unit { int pm, pn; };
struct Gemm { const bf16_t* A; const bf16_t* Bt; int lda, ldb, K; };

struct StaticOrder {
    int nM, nN, nwg, G, c;
    __device__ void init(int Mr, int Nc, int G_, int c_) { nM = Mr / BM; nN = Nc / BM; nwg = nM * nN; G = G_; c = c_; }
    __device__ bool next(int i, Unit& u) const {
        const long L = (long)i * G + c; if (L >= nwg) return false;
        int wgid = (int)L; { const int q = nwg / NXCD, r = nwg % NXCD, xcd = wgid % NXCD, off = wgid / NXCD; wgid = (xcd < r ? xcd * (q + 1) : r * (q + 1) + (xcd - r) * q) + off; }
        const int nig = WGM * nN, gid = wgid / nig, fm = gid * WGM, gsz = (nM - fm) < WGM ? (nM - fm) : WGM;
        u.pm = fm + ((wgid % nig) % gsz); u.pn = (wgid % nig) / gsz; return true;
    }
};

template <class Epi>
__device__ __forceinline__ void gemm_phase(LAS unsigned char* lds, const Gemm g, const StaticOrder& S, const Epi& E, int wv) {
    const int tid = ltid(wv);
    const int wid = wv, lane = tid & 63, wr = wid >> 2, wc = wid & 3, fr = lane & 15, fq = lane >> 4;
    const int K = g.K, nt = K / BK;
    unsigned voffA[2], voffB[2];
#pragma unroll
    for (int i = 0; i < 2; ++i) { int R, C; stage_rc(tid * 16 + i * 8192, R, C); const int Rb = (R & ~31) + perm32(R & 31);
        voffA[i] = (unsigned)(R * g.lda + C) * 2u; voffB[i] = (unsigned)(Rb * g.ldb + C) * 2u; }
    const size_t kstep = (size_t)(BK * 2);
    const size_t hstepA = (size_t)HALF * g.lda * 2, hstepB = (size_t)HALF * g.ldb * 2;
    const size_t tstepA = 2 * hstepA, tstepB = 2 * hstepB;
    const unsigned ldsw = (unsigned)wid * 1024u;
    const int aoff = lds_byte(wr * 64 + fr, fq * 8), boff = lds_byte(wc * 32 + fr, fq * 8);
#define PG8_SA(b, h) (((b) * 2 + (h)) * HTB)
#define PG8_SB(b, h) ((4 + (b) * 2 + (h)) * HTB)
#define PG8_STAGE(bufoff, gbase, voff) do { _Pragma("unroll") for (int _i = 0; _i < 2; ++_i) \
        __builtin_amdgcn_global_load_lds((const unsigned*)((const char*)(gbase) + (voff)[_i]), (LAS unsigned*)(lds + (bufoff) + ldsw + _i * 8192), 16, 0, 0); } while (0)
#define PG8_LDA(dst, b, h) do { _Pragma("unroll") for (int m = 0; m < 4; ++m) _Pragma("unroll") for (int k = 0; k < 2; ++k) dst[m][k] = *(const LAS bf16x8*)(lds + PG8_SA(b, h) + aoff + m * 2048 + k * 1024); } while (0)
#define PG8_LDB(dst, b, h) do { _Pragma("unroll") for (int n = 0; n < 2; ++n) _Pragma("unroll") for (int k = 0; k < 2; ++k) dst[n][k] = *(const LAS bf16x8*)(lds + PG8_SB(b, h) + boff + n * 2048 + k * 1024); } while (0)
#define PG8_MMA(ai, bj, At, Bt) do { __builtin_amdgcn_s_setprio(1); _Pragma("unroll") for (int m = 0; m < 4; ++m) _Pragma("unroll") for (int n = 0; n < 2; ++n) _Pragma("unroll") for (int k = 0; k < 2; ++k) \
        acc[ai][bj][m][n] = __builtin_amdgcn_mfma_f32_16x16x32_bf16(Bt[n][k], At[m][k], acc[ai][bj][m][n], 0, 0, 0); __builtin_amdgcn_s_setprio(0); } while (0)
#define PG8_WAIT_V(n) asm volatile("s_waitcnt vmcnt(" #n ")" ::: "memory")
#define PG8_WAIT_L(n) asm volatile("s_waitcnt lgkmcnt(" #n ")" ::: "memory")
#define PG8_BAR __builtin_amdgcn_s_barrier()
#define PG8_SCHED __builtin_amdgcn_sched_barrier(0)
    Unit cur, nxt; int ui = 0;
    if (!S.next(0, cur)) return;
    f32x4 acc[2][2][4][2];
#pragma unroll
    for (int a = 0; a < 2; ++a)
#pragma unroll
        for (int b = 0; b < 2; ++b)
#pragma unroll
            for (int m = 0; m < 4; ++m)
#pragma unroll
                for (int n = 0; n < 2; ++n) acc[a][b][m][n] = (f32x4){0.f, 0.f, 0.f, 0.f};
    bf16x8 At[4][2], B0[2][2], B1[2][2];
    const char* cA = (const char*)g.A + (size_t)cur.pm * tstepA; const char* cB = (const char*)g.Bt + (size_t)cur.pn * tstepB;
    PG8_STAGE(PG8_SB(0, 0), cB, voffB); PG8_STAGE(PG8_SB(0, 1), cB + hstepB, voffB); PG8_STAGE(PG8_SA(0, 0), cA, voffA); PG8_STAGE(PG8_SA(0, 1), cA + hstepA, voffA);
    if (wr == 1) PG8_BAR;
    PG8_WAIT_V(2); PG8_BAR;
    PG8_STAGE(PG8_SB(1, 0), cB + kstep, voffB); PG8_STAGE(PG8_SA(1, 0), cA + kstep, voffA); PG8_STAGE(PG8_SB(1, 1), cB + hstepB + kstep, voffB);
    PG8_WAIT_V(6); PG8_BAR;
    for (;;) {
        const bool has_next = S.next(ui + 1, nxt);
        const char* nA = has_next ? (const char*)g.A + (size_t)nxt.pm * tstepA : cA; const char* nB = has_next ? (const char*)g.Bt + (size_t)nxt.pn * tstepB : cB;
        for (int t = 0; t < nt; t += 2) {
            const bool last = (t == nt - 2);
            const char* a1 = cA + (size_t)(t + 1) * kstep;
            const char* a2 = last ? nA : cA + (size_t)(t + 2) * kstep; const char* b2 = last ? nB : cB + (size_t)(t + 2) * kstep;
            const char* a3 = a2 + kstep; const char* b3 = b2 + kstep;
            PG8_LDB(B0, 0, 0); PG8_LDB(B1, 0, 1); PG8_SCHED; PG8_LDA(At, 0, 0); PG8_STAGE(PG8_SA(1, 1), a1 + hstepA, voffA);
            PG8_WAIT_V(8); PG8_WAIT_L(0); PG8_BAR; PG8_MMA(0, 0, At, B0); PG8_MMA(0, 1, At, B1); PG8_BAR; PG8_SCHED;
            PG8_LDA(At, 0, 1); PG8_STAGE(PG8_SB(0, 0), b2, voffB); PG8_STAGE(PG8_SB(0, 1), b2 + hstepB, voffB); PG8_STAGE(PG8_SA(0, 0), a2, voffA);
            PG8_WAIT_V(8); PG8_WAIT_L(0); PG8_BAR; PG8_MMA(1, 0, At, B0); PG8_MMA(1, 1, At, B1); PG8_BAR; PG8_SCHED;
            PG8_LDB(B0, 1, 0); PG8_LDB(B1, 1, 1); PG8_SCHED; PG8_LDA(At, 1, 0); PG8_STAGE(PG8_SA(0, 1), a2 + hstepA, voffA);
            PG8_WAIT_V(8); PG8_WAIT_L(0); PG8_BAR; PG8_MMA(0, 0, At, B0); PG8_MMA(0, 1, At, B1); PG8_BAR; PG8_SCHED;
            PG8_LDA(At, 1, 1); PG8_STAGE(PG8_SB(1, 0), b3, voffB); PG8_STAGE(PG8_SB(1, 1), b3 + hstepB, voffB); PG8_STAGE(PG8_SA(1, 0), a3, voffA);
            PG8_WAIT_V(8); PG8_WAIT_L(0); PG8_BAR; PG8_MMA(1, 0, At, B0); PG8_MMA(1, 1, At, B1); PG8_BAR; PG8_SCHED;
        }
        if (wr == 0) PG8_BAR;
        E(acc, cur, wr, wc, fr, fq);
        if (!has_next) break;
#pragma unroll
        for (int a = 0; a < 2; ++a)
#pragma unroll
            for (int b = 0; b < 2; ++b)
#pragma unroll
                for (int m = 0; m < 4; ++m)
#pragma unroll
                    for (int n = 0; n < 2; ++n) acc[a][b][m][n] = (f32x4){0.f, 0.f, 0.f, 0.f};
        cur = nxt; cA = nA; cB = nB; ++ui;
        if (wr == 1) PG8_BAR;
    }
    PG8_WAIT_V(0);
    PG8_BAR;
#undef PG8_SA
#undef PG8_SB
#undef PG8_STAGE
#undef PG8_LDA
#undef PG8_LDB
#undef PG8_MMA
#undef PG8_WAIT_V
#undef PG8_WAIT_L
#undef PG8_BAR
#undef PG8_SCHED
}
}
using pg8::Unit;
typedef const f32x4 (&AccRef)[2][2][4][2];

struct EpiGU {
    const float* ss; bf16_t* H;
    __device__ __forceinline__ void operator()(AccRef acc, const Unit& u, int wr, int wc, int, int) const { const int lane_ = vlane(); const int fr = lane_ & 15, fq = lane_ >> 4;
#pragma unroll
        for (int ai = 0; ai < 2; ++ai)
#pragma unroll
            for (int m = 0; m < 4; ++m) {
                const int row = u.pm * 256 + ai * 128 + wr * 64 + m * 16 + fr;
                asm volatile("" ::: "memory");
                const float r = rs16(ss, row);
                const f32x4 g0 = acc[ai][0][m][0] * r, g1 = acc[ai][0][m][1] * r, v0 = acc[ai][1][m][0] * r, v1 = acc[ai][1][m][1] * r;
                u32x4 w;
                w.x = cvt_pk_bf16(g0.x * sigmoidf_(g0.x) * v0.x, g0.y * sigmoidf_(g0.y) * v0.y); w.y = cvt_pk_bf16(g0.z * sigmoidf_(g0.z) * v0.z, g0.w * sigmoidf_(g0.w) * v0.w);
                w.z = cvt_pk_bf16(g1.x * sigmoidf_(g1.x) * v1.x, g1.y * sigmoidf_(g1.y) * v1.y); w.w = cvt_pk_bf16(g1.z * sigmoidf_(g1.z) * v1.z, g1.w * sigmoidf_(g1.w) * v1.w);
                *(u32x4*)(H + (size_t)row * FF + u.pn * 128 + wc * 32 + fq * 8) = w;
            }
    }
};
struct EpiRes {
    float* X; bf16_t* xb; float* ssOut; float alpha;
    __device__ __forceinline__ void operator()(AccRef acc, const Unit& u, int wr, int wc, int, int) const { const int lane_ = vlane(); const int fr = lane_ & 15, fq = lane_ >> 4;
#pragma unroll
        for (int ai = 0; ai < 2; ++ai)
#pragma unroll
            for (int m = 0; m < 4; ++m) {
                const int row = u.pm * 256 + ai * 128 + wr * 64 + m * 16 + fr;
                asm volatile("" ::: "memory");
                float sq = 0.f;
#pragma unroll
                for (int bj = 0; bj < 2; ++bj) {
                    const size_t off = (size_t)row * D + u.pn * 256 + bj * 128 + wc * 32 + fq * 8;
                    f32x4 x0 = *(const f32x4*)(X + off), x1 = *(const f32x4*)(X + off + 4);
                    x0 += acc[ai][bj][m][0] * alpha; x1 += acc[ai][bj][m][1] * alpha;
                    *(f32x4*)(X + off) = x0; *(f32x4*)(X + off + 4) = x1;
                    sq += dot4(x0) + dot4(x1);
                    u32x4 w; w.x = cvt_pk_bf16(x0.x, x0.y); w.y = cvt_pk_bf16(x0.z, x0.w); w.z = cvt_pk_bf16(x1.x, x1.y); w.w = cvt_pk_bf16(x1.z, x1.w);
                    *(u32x4*)(xb + off) = w;
                }
                sq += __shfl_xor(sq, 16); sq += __shfl_xor(sq, 32);
                if (fq == 0) ssOut[(size_t)row * 16 + u.pn * 4 + wc] = sq;
            }
    }
};
struct EpiGate {
    float* X; const float* ssIn; bf16_t* ppxb; float* ssOut; float gsc;
    __device__ __forceinline__ void operator()(AccRef acc, const Unit& u, int wr, int wc, int, int) const { const int lane_ = vlane(); const int fr = lane_ & 15, fq = lane_ >> 4;
#pragma unroll
        for (int ai = 0; ai < 2; ++ai)
#pragma unroll
            for (int m = 0; m < 4; ++m) {
                const int row = u.pm * 256 + ai * 128 + wr * 64 + m * 16 + fr;
                asm volatile("" ::: "memory");
                const float r = rs16(ssIn, row);
                float sq = 0.f;
#pragma unroll
                for (int bj = 0; bj < 2; ++bj) {
                    const size_t off = (size_t)row * D + u.pn * 256 + bj * 128 + wc * 32 + fq * 8;
                    f32x4 x0 = *(const f32x4*)(X + off), x1 = *(const f32x4*)(X + off + 4);
                    const u32x4 pp = *(const u32x4*)(ppxb + off); const float gs = gsc;
                    const f32x4 a0 = acc[ai][bj][m][0] * r, a1 = acc[ai][bj][m][1] * r;
                    x0.x += sigmoidf_(a0.x) * (bf_lo(pp.x) * gs); x0.y += sigmoidf_(a0.y) * (bf_hi(pp.x) * gs); x0.z += sigmoidf_(a0.z) * (bf_lo(pp.y) * gs); x0.w += sigmoidf_(a0.w) * (bf_hi(pp.y) * gs);
                    x1.x += sigmoidf_(a1.x) * (bf_lo(pp.z) * gs); x1.y += sigmoidf_(a1.y) * (bf_hi(pp.z) * gs); x1.z += sigmoidf_(a1.z) * (bf_lo(pp.w) * gs); x1.w += sigmoidf_(a1.w) * (bf_hi(pp.w) * gs);
                    *(f32x4*)(X + off) = x0; *(f32x4*)(X + off + 4) = x1;
                    sq += dot4(x0) + dot4(x1);
                    u32x4 w; w.x = cvt_pk_bf16(x0.x, x0.y); w.y = cvt_pk_bf16(x0.z, x0.w); w.z = cvt_pk_bf16(x1.x, x1.y); w.w = cvt_pk_bf16(x1.z, x1.w);
                    *(u32x4*)(ppxb + off) = w;
                }
                sq += __shfl_xor(sq, 16); sq += __shfl_xor(sq, 32);
                if (fq == 0) ssOut[(size_t)row * 16 + u.pn * 4 + wc] = sq;
            }
    }
};
__device__ __forceinline__ void rope_rot(f32x4& v0, f32x4& v1, const float* cs) {
    const f32x4 c = *(const f32x4*)cs, s = *(const f32x4*)(cs + 4);
    const f32x4 a = v0 * c - v1 * s, b = v1 * c + v0 * s; v0 = a; v1 = b;
}
__device__ __forceinline__ void vstore1(unsigned char* vf, int vhead, int dd, int b, int ppos, bf16_t val);
struct EpiIn {
    const float* ss; unsigned char* ws; float* mst; const float* cs64; const float* cs32;
    __device__ __forceinline__ void operator()(AccRef acc, const Unit& u, int wr, int wc, int, int) const { const int lane_ = vlane(); const int fr = lane_ & 15, fq = lane_ >> 4;
#pragma unroll
        for (int ai = 0; ai < 2; ++ai)
#pragma unroll
            for (int m = 0; m < 4; ++m) {
                const int row = u.pm * 256 + ai * 128 + wr * 64 + m * 16 + fr;
                asm volatile("" ::: "memory");
                const float r = rs16(ss, row);
                const int pos = row & (T - 1), b = row >> 11;
                float sq = 0.f;
#pragma unroll
                for (int bj = 0; bj < 2; ++bj) {
                    const int gcol = u.pn * 256 + bj * 128 + wc * 32;
                    f32x4 v0 = acc[ai][bj][m][0] * r, v1 = acc[ai][bj][m][1] * r;
                    const bool r64 = (gcol >= 512 && gcol < 896) || (gcol >= 1024 && gcol < 1536);
                    if (r64) rope_rot(v0, v1, cs64 + ((size_t)pos * 8 + 4 * ((gcol >> 5) & 1) + fq) * 8);
                    if (gcol == 1920) rope_rot(v0, v1, cs32 + ((size_t)pos * 4 + fq) * 8);
                    if (u.pn == 6 || (u.pn == 7 && bj == 0)) sq += dot4(v0) + dot4(v1);
                    u32x4 w; w.x = cvt_pk_bf16(v0.x, v0.y); w.y = cvt_pk_bf16(v0.z, v0.w); w.z = cvt_pk_bf16(v1.x, v1.y); w.w = cvt_pk_bf16(v1.z, v1.w);
                    const int c8 = ((gcol & 63) >> 3) + fq;
                    const size_t frag = (size_t)(c8 >> 1) * 1024 + (size_t)((pos & 31) + 32 * (c8 & 1)) * 16;
                    const size_t rec = ((size_t)b * 64 + (pos >> 5)) * 4096;
                    if (gcol < 256) *(u32x4*)(ws + OFF_ZQ + ((size_t)row * ZQLD + gcol + fq * 8) * 2) = w;
                    else if (gcol < 512) *(u32x4*)(ws + OFF_KF + (size_t)((gcol - 256) >> 6) * HEADB + rec + frag) = w;
                    else if (gcol < 768) *(u32x4*)(ws + OFF_ZQ + ((size_t)row * ZQLD + (gcol - 256) + fq * 8) * 2) = w;
                    else if (gcol < 896) *(u32x4*)(ws + OFF_KF + (size_t)(4 + ((gcol - 768) >> 6)) * HEADB + rec + frag) = w;
                    else if (gcol < 1024) {
                        const int dd0 = (gcol - 896) + fq * 8; const unsigned ww[4] = {w.x, w.y, w.z, w.w};
#pragma unroll
                        for (int e = 0; e < 8; ++e) vstore1(ws + OFF_VT, 4 + (dd0 >> 6), (dd0 & 63) + e, b, pos, (bf16_t)((e & 1) ? (ww[e >> 1] >> 16) : (ww[e >> 1] & 0xffffu)));
                    }
                    else if (gcol < 1280) *(u32x4*)(ws + OFF_ZQ + ((size_t)row * ZQLD + (gcol - 512) + fq * 8) * 2) = w;
                    else if (gcol < 1536) {
                        const int hd = (gcol - 1280) >> 6;
                        *(u32x4*)(ws + OFF_KF + (size_t)(6 + hd) * HEADB + rec + frag) = w;
                        const int p4 = (pos & 3) * 512 + (pos >> 2), p16 = (pos & 15) * 128 + (pos >> 4);
                        *(u32x4*)(ws + OFF_KF + (size_t)(10 + hd) * HEADB + ((size_t)b * 64 + (p4 >> 5)) * 4096 + (size_t)(c8 >> 1) * 1024 + (size_t)((p4 & 31) + 32 * (c8 & 1)) * 16) = w;
                        *(u32x4*)(ws + OFF_KF + (size_t)(14 + hd) * HEADB + ((size_t)b * 64 + (p16 >> 5)) * 4096 + (size_t)(c8 >> 1) * 1024 + (size_t)((p16 & 31) + 32 * (c8 & 1)) * 16) = w;
                    }
                    else if (gcol < 1920) *(u32x4*)(ws + OFF_ZL + ((size_t)row * ZLLD + (gcol - 1536) + fq * 8) * 2) = w;
                    else if (gcol == 1920) *(u32x4*)(ws + OFF_KPE + ((size_t)b * 64 + (pos >> 5)) * 2048 + (size_t)(fq >> 1) * 1024 + (size_t)((pos & 31) + 32 * (fq & 1)) * 16) = w;
                }
                if (u.pn >= 6) {
                    sq += __shfl_xor(sq, 16); sq += __shfl_xor(sq, 32);
                    if (fq == 0) mst[(size_t)row * 8 + (u.pn - 6) * 4 + wc] = sq;
                }
            }
    }
};
__device__ __forceinline__ void vstore8(unsigned char* vf, int vhead, int dd, int tok0, u32x4 w) {
    const int b = tok0 >> 11, pos0 = tok0 & (T - 1), idx0 = pos0 & 31;
    unsigned char* p = vf + (size_t)vhead * HEADB + ((size_t)b * 64 + (pos0 >> 5)) * 4096 + (size_t)((dd >> 5) * 2 + (idx0 >> 4)) * 1024 + (size_t)(dd & 31) * 16 + ((idx0 >> 3) & 1) * 8;
    u32x2 lo; lo.x = w.x; lo.y = w.y; u32x2 hi; hi.x = w.z; hi.y = w.w;
    *(u32x2*)p = lo; *(u32x2*)(p + 512) = hi;
}
__device__ __forceinline__ void vstore1(unsigned char* vf, int vhead, int dd, int b, int ppos, bf16_t val) {
    const int idx = ppos & 31, r16 = idx & 15;
    unsigned char* p = vf + (size_t)vhead * HEADB + ((size_t)b * 64 + (ppos >> 5)) * 4096 + (size_t)((dd >> 5) * 2 + (idx >> 4)) * 1024 + (size_t)((dd & 31) + 32 * ((r16 >> 2) & 1)) * 16 + (r16 >> 3) * 8 + (r16 & 3) * 2;
    *(bf16_t*)p = val;
}
struct EpiVT {
    const float* ss; unsigned char* vf;
    __device__ __forceinline__ void operator()(AccRef acc, const Unit& u, int wr, int wc, int, int) const { const int lane_ = vlane(); const int fr = lane_ & 15, fq = lane_ >> 4;
#pragma unroll
        for (int bj = 0; bj < 2; ++bj) {
            const int tok0 = u.pn * 256 + bj * 128 + wc * 32 + fq * 8;
            float rs[8];
#pragma unroll
            for (int e = 0; e < 8; ++e) rs[e] = rs16(ss, tok0 + e);
#pragma unroll
            for (int ai = 0; ai < 2; ++ai) {
                const int rbase = u.pm * 256 + ai * 128;
                const bool dil = rbase >= 256;
#pragma unroll
                for (int m = 0; m < 4; ++m) {
                    const int row = rbase + wr * 64 + m * 16 + fr;
                    asm volatile("" ::: "memory");
                    const f32x4 a0 = acc[ai][bj][m][0], a1 = acc[ai][bj][m][1];
                    u32x4 w; w.x = cvt_pk_bf16(a0.x * rs[0], a0.y * rs[1]); w.y = cvt_pk_bf16(a0.z * rs[2], a0.w * rs[3]);
                    w.z = cvt_pk_bf16(a1.x * rs[4], a1.y * rs[5]); w.w = cvt_pk_bf16(a1.z * rs[6], a1.w * rs[7]);
                    const int vhead = (row >> 6) + (dil ? 2 : 0), dd = row & 63;
                    vstore8(vf, vhead, dd, tok0, w);
                    if (dil) {
                        const int b = tok0 >> 11, t0 = tok0 & (T - 1);
                        const unsigned ww[4] = {w.x, w.y, w.z, w.w};
#pragma unroll
                        for (int e = 0; e < 8; ++e) {
                            const int t = t0 + e; const bf16_t val = (bf16_t)((e & 1) ? (ww[e >> 1] >> 16) : (ww[e >> 1] & 0xffffu));
                            vstore1(vf, vhead + 4, dd, b, (t & 3) * 512 + (t >> 2), val);
                            vstore1(vf, vhead + 8, dd, b, (t & 15) * 128 + (t >> 4), val);
                        }
                    }
                }
            }
        }
    }
};
struct EpiQ {
    const float* mst; bf16_t* qm; const float* cs32;
    __device__ __forceinline__ void operator()(AccRef acc, const Unit& u, int wr, int wc, int, int) const { const int lane_ = vlane(); const int fr = lane_ & 15, fq = lane_ >> 4;
#pragma unroll
        for (int ai = 0; ai < 2; ++ai)
#pragma unroll
            for (int m = 0; m < 4; ++m) {
                const int row = u.pm * 256 + ai * 128 + wr * 64 + m * 16 + fr;
                asm volatile("" ::: "memory");
                const f32x4 st = *(const f32x4*)(mst + (size_t)row * 8);
                const float r = rsqrtf(sum4(st) * (1.0f / 256.0f) + EPS);
                const int pos = row & (T - 1);
#pragma unroll
                for (int bj = 0; bj < 2; ++bj) {
                    const int gcol = u.pn * 256 + bj * 128 + wc * 32;
                    if (gcol >= 384) continue;
                    f32x4 v0 = acc[ai][bj][m][0] * r, v1 = acc[ai][bj][m][1] * r;
                    if (((gcol >> 5) % 3) == 2) rope_rot(v0, v1, cs32 + ((size_t)pos * 4 + fq) * 8);
                    u32x4 w; w.x = cvt_pk_bf16(v0.x, v0.y); w.y = cvt_pk_bf16(v0.z, v0.w); w.z = cvt_pk_bf16(v1.x, v1.y); w.w = cvt_pk_bf16(v1.z, v1.w);
                    *(u32x4*)(qm + (size_t)row * QLD + gcol + fq * 8) = w;
                }
            }
    }
};
struct EpiK {
    const float* mst; unsigned char* ws;
    __device__ __forceinline__ void operator()(AccRef acc, const Unit& u, int wr, int wc, int, int) const { const int lane_ = vlane(); const int fr = lane_ & 15, fq = lane_ >> 4;
#pragma unroll
        for (int ai = 0; ai < 2; ++ai)
#pragma unroll
            for (int m = 0; m < 4; ++m) {
                const int row = u.pm * 256 + ai * 128 + wr * 64 + m * 16 + fr;
                asm volatile("" ::: "memory");
                const f32x4 st = *(const f32x4*)(mst + (size_t)row * 8 + 4);
                const float r = rsqrtf(sum4(st) * (1.0f / 128.0f) + EPS);
#pragma unroll
                for (int bj = 0; bj < 2; ++bj) {
                    const f32x4 v0 = acc[ai][bj][m][0] * r, v1 = acc[ai][bj][m][1] * r;
                    u32x4 w; w.x = cvt_pk_bf16(v0.x, v0.y); w.y = cvt_pk_bf16(v0.z, v0.w); w.z = cvt_pk_bf16(v1.x, v1.y); w.w = cvt_pk_bf16(v1.z, v1.w);
                    const int col0 = bj * 128 + wc * 32, c8 = ((col0 & 63) >> 3) + fq, pos = row & (T - 1);
                    *(u32x4*)(ws + OFF_KF + (size_t)(18 + (col0 >> 6)) * HEADB + ((size_t)(row >> 11) * 64 + (pos >> 5)) * 4096 + (size_t)(c8 >> 1) * 1024 + (size_t)((pos & 31) + 32 * (c8 & 1)) * 16) = w;
                }
            }
    }
};
struct EpiVTM {
    const float* mst; unsigned char* vf;
    __device__ __forceinline__ void operator()(AccRef acc, const Unit& u, int wr, int wc, int, int) const { const int lane_ = vlane(); const int fr = lane_ & 15, fq = lane_ >> 4;
#pragma unroll
        for (int bj = 0; bj < 2; ++bj) {
            const int tok0 = u.pn * 256 + bj * 128 + wc * 32 + fq * 8;
            float rs[8];
#pragma unroll
            for (int e = 0; e < 8; ++e) { const f32x4 st = *(const f32x4*)(mst + (size_t)(tok0 + e) * 8 + 4); rs[e] = rsqrtf(sum4(st) * (1.0f / 128.0f) + EPS); }
#pragma unroll
            for (int ai = 0; ai < 2; ++ai)
#pragma unroll
                for (int m = 0; m < 4; ++m) {
                    const int row = ai * 128 + wr * 64 + m * 16 + fr;
                    asm volatile("" ::: "memory");
                    const f32x4 a0 = acc[ai][bj][m][0], a1 = acc[ai][bj][m][1];
                    u32x4 w; w.x = cvt_pk_bf16(a0.x * rs[0], a0.y * rs[1]); w.y = cvt_pk_bf16(a0.z * rs[2], a0.w * rs[3]);
                    w.z = cvt_pk_bf16(a1.x * rs[4], a1.y * rs[5]); w.w = cvt_pk_bf16(a1.z * rs[6], a1.w * rs[7]);
                    vstore8(vf, 18 + (row >> 6), row & 63, tok0, w);
                }
        }
    }
};
struct EpiPP {
    bf16_t* O;
    __device__ __forceinline__ void operator()(AccRef acc, const Unit& u, int wr, int wc, int, int) const { const int lane_ = vlane(); const int fr = lane_ & 15, fq = lane_ >> 4;
#pragma unroll
        for (int ai = 0; ai < 2; ++ai)
#pragma unroll
            for (int m = 0; m < 4; ++m) {
                const int row = u.pm * 256 + ai * 128 + wr * 64 + m * 16 + fr;
                asm volatile("" ::: "memory");
#pragma unroll
                for (int bj = 0; bj < 2; ++bj) {
                    const f32x4 v0 = acc[ai][bj][m][0], v1 = acc[ai][bj][m][1];
                    u32x4 w; w.x = cvt_pk_bf16(v0.x, v0.y); w.y = cvt_pk_bf16(v0.z, v0.w); w.z = cvt_pk_bf16(v1.x, v1.y); w.w = cvt_pk_bf16(v1.z, v1.w);
                    *(u32x4*)(O + (size_t)row * D + u.pn * 256 + bj * 128 + wc * 32 + fq * 8) = w;
                }
            }
    }
};

template <class Epi>
__device__ __forceinline__ void run_gemm(int wv, LAS unsigned char* lds, const bf16_t* A, int lda, int rows, const bf16_t* Bt, int ldb, int cols, int K, int cshift, const Epi& E) {
    pg8::Gemm g{A, Bt, lda, ldb, K};
    pg8::StaticOrder S; const int G_ = lgrid(); S.init(rows, cols, G_, (lbid() + cshift) % G_);
    pg8::gemm_phase<Epi>(lds, g, S, E, wv);
}

__device__ __forceinline__ int p64(int d) { return d < 32 ? 8 * (d >> 2) + (d & 3) : 8 * ((d - 32) >> 2) + 4 + (d & 3); }
__device__ __forceinline__ int p32(int d) { return d < 16 ? 8 * (d >> 2) + (d & 3) : 8 * ((d - 16) >> 2) + 4 + (d & 3); }
__device__ __forceinline__ int maprow(int mapid, int c) {
    switch (mapid) {
        case 0: return c;
        case 1: return (c >> 7) * 256 + (c & 127);
        case 2: return (c >> 7) * 256 + 128 + (c & 127);
        case 3: {
            if (c < 768) return c < 512 ? c : 2048 + (c - 512);
            c -= 768;
            if (c < 512) return c < 384 ? 512 + (c >> 6) * 64 + p64(c & 63) : 896 + (c - 384);
            c -= 512;
            if (c < 768) return c < 512 ? 1024 + (c >> 6) * 64 + p64(c & 63) : 2048 + 256 + (c - 512);
            c -= 768;
            if (c < 256) return 1536 + c;
            if (c < 384) return 1792 + (c - 256);
            return 1920 + p32(c - 384);
        }
        case 4: { const int h = c / 96, e = c % 96; return e < 64 ? 96 * h + e : 96 * h + 64 + p32(e - 64); }
        default: { const int h = c >> 7, e = c & 127; return e < 64 ? 64 * h + e : 256 + 64 * h + (e - 64); }
    }
}
__device__ __forceinline__ void tr_item(const float* W, int K, int N, const float* gain, bf16_t* dst, int mapid, int item, LAS float* s, int wv) {
    const int tid = ltid(wv);
    const int ncb = (N + 255) >> 8, kb = item / ncb, cb = item % ncb, k0 = kb * 64, c0 = cb * 256;
#pragma unroll
    for (int i = 0; i < 8; ++i) {
        const int kk = i * 8 + (tid >> 6), col = (tid & 63) * 4;
        f32x4 v = (f32x4){0.f, 0.f, 0.f, 0.f};
        if (c0 + col < N) v = *(const f32x4*)(W + (size_t)(k0 + kk) * N + c0 + col);
        if (gain) v *= gain[k0 + kk];
        *(LAS f32x4*)(s + kk * 260 + col) = v;
    }
    __syncthreads();
    const int cc = tid & 255, kh = tid >> 8, c = c0 + cc;
    if (c < N) {
        const int drow = maprow(mapid, c);
        bf16_t* o = dst + (size_t)drow * K + k0 + kh * 32;
#pragma unroll
        for (int q = 0; q < 4; ++q) {
            const LAS float* sp = s + (kh * 32 + q * 8) * 260 + cc;
            u32x4 w; w.x = cvt_pk_bf16(sp[0], sp[260]); w.y = cvt_pk_bf16(sp[2 * 260], sp[3 * 260]); w.z = cvt_pk_bf16(sp[4 * 260], sp[5 * 260]); w.w = cvt_pk_bf16(sp[6 * 260], sp[7 * 260]);
            *(u32x4*)(o + q * 8) = w;
        }
    }
    __syncthreads();
}

struct Args { const float* in[24]; float* out; unsigned char* ws; int ph_lo, ph_hi, coop, pad; };
typedef const __attribute__((address_space(4))) Args* KA;
__device__ __forceinline__ KA kargs() { KA p = (KA)__builtin_amdgcn_kernarg_segment_ptr(); asm volatile("" : "+s"(p)); return p; }

__device__ __forceinline__ void zero_rows(bf16_t* base, int row0, int nrows, int K, int gt, int ngt) {
    const size_t n16 = (size_t)nrows * K / 8; u32x4* p = (u32x4*)(base + (size_t)row0 * K);
    for (size_t i = gt; i < n16; i += ngt) p[i] = (u32x4){0u, 0u, 0u, 0u};
}

__device__ __forceinline__ void prologue(KA a, LAS unsigned char* lds, int wv) {
    LAS float* s = (LAS float*)lds;
    const int G = lgrid(), bid = lbid(), tid = ltid(wv);
    bf16_t* Wbase = (bf16_t*)(a->ws + OFF_W);
#if PRO_PARTS & 1
    constexpr int I_FFN = 16 * 11, I_DN = 44 * 4, I_IN = 16 * 10, I_UQ = 4 * 2, I_UKV = 2 * 2, I_O = 16 * 4, I_PP = 4 * 4;
    constexpr int I_LAYER = 4 * I_FFN + 2 * I_DN + I_IN + I_UQ + I_UKV + 2 * I_O + I_PP;
    for (int it = bid; it < I_LAYER * DEPTH; it += G) {
        const int l = it / I_LAYER; int r = it % I_LAYER;
        int sel = 0;
        if (r >= I_FFN) { r -= I_FFN; sel = 1;
        if (r >= I_FFN) { r -= I_FFN; sel = 2;
        if (r >= I_DN) { r -= I_DN; sel = 3;
        if (r >= I_IN) { r -= I_IN; sel = 4;
        if (r >= I_UQ) { r -= I_UQ; sel = 5;
        if (r >= I_UKV) { r -= I_UKV; sel = 6;
        if (r >= I_O) { r -= I_O; sel = 7;
        if (r >= I_FFN) { r -= I_FFN; sel = 8;
        if (r >= I_FFN) { r -= I_FFN; sel = 9;
        if (r >= I_DN) { r -= I_DN; sel = 10;
        if (r >= I_O) { r -= I_O; sel = 11; } } } } } } } } } } }
        const float* W0; const float* g0 = nullptr; int K, N, mapid; size_t doff;
        switch (sel) {
            case 0: W0 = a->in[3]; g0 = a->in[2]; K = D; N = FF; doff = WL_GU1; mapid = 1; break;
            case 1: W0 = a->in[4]; g0 = a->in[2]; K = D; N = FF; doff = WL_GU1; mapid = 2; break;
            case 2: W0 = a->in[5]; K = FF; N = D; doff = WL_D1; mapid = 0; break;
            case 3: W0 = a->in[7]; g0 = a->in[6]; K = D; N = 2464; doff = WL_IN; mapid = 3; break;
            case 4: W0 = a->in[11]; g0 = a->in[10]; K = 256; N = 384; doff = WL_UQ; mapid = 4; break;
            case 5: W0 = a->in[13]; g0 = a->in[12]; K = 128; N = 512; doff = WL_UKV; mapid = 5; break;
            case 6: W0 = a->in[15]; g0 = a->in[14]; K = D; N = D; doff = WL_O; mapid = 0; break;
            case 7: W0 = a->in[17]; g0 = a->in[16]; K = D; N = FF; doff = WL_GU2; mapid = 1; break;
            case 8: W0 = a->in[18]; g0 = a->in[16]; K = D; N = FF; doff = WL_GU2; mapid = 2; break;
            case 9: W0 = a->in[19]; K = FF; N = D; doff = WL_D2; mapid = 0; break;
            case 10: W0 = a->in[21]; g0 = a->in[20]; K = D; N = D; doff = WL_PG; mapid = 0; break;
            default: W0 = a->in[22]; K = PLE; N = D; doff = WL_PP; mapid = 0; break;
        }
        const float* W = W0 + (size_t)l * K * N;
        const float* gain = g0 ? g0 + (size_t)l * K : nullptr;
        tr_item(W, K, N, gain, Wbase + (size_t)l * WL_SIZE + doff, mapid, r, s, wv);
    }
#endif
    const int gt = bid * 512 + tid, ngt = G * 512;
    for (int l = 0; l < DEPTH; ++l) {
        bf16_t* WL = Wbase + (size_t)l * WL_SIZE;
        zero_rows(WL + WL_IN, 1952, 96, D, gt, ngt);
        zero_rows(WL + WL_UQ, 384, 128, 256, gt, ngt);
    }
#if PRO_PARTS & 2
    float* cs64 = (float*)(a->ws + OFF_CS64); float* cs32 = (float*)(a->ws + OFF_CS32);
    for (int i = gt; i < T * 32; i += ngt) {
        const int pos = i >> 5, j = i & 31;
        const float inv = __builtin_amdgcn_exp2f(-(float)j * (13.287712379549449f / 32.0f)); const float ang = (float)pos * inv;
        const float rev = ang * 0.15915494309189535f, fr_ = rev - floorf(rev);
        float* p = cs64 + ((size_t)pos * 8 + (j >> 2)) * 8 + (j & 3);
        p[0] = __builtin_amdgcn_cosf(fr_); p[4] = __builtin_amdgcn_sinf(fr_);
    }
    for (int i = gt; i < T * 16; i += ngt) {
        const int pos = i >> 4, j = i & 15;
        const float inv = __builtin_amdgcn_exp2f(-(float)j * (13.287712379549449f / 16.0f)); const float ang = (float)pos * inv;
        const float rev = ang * 0.15915494309189535f, fr_ = rev - floorf(rev);
        float* p = cs32 + ((size_t)pos * 4 + (j >> 2)) * 8 + (j & 3);
        p[0] = __builtin_amdgcn_cosf(fr_); p[4] = __builtin_amdgcn_sinf(fr_);
    }
#endif
#if PRO_PARTS & 4
    const int lane = tid & 63, gw = bid * 8 + (tid >> 6), ngw = G * 8;
    bf16_t* xb = (bf16_t*)(a->ws + OFF_XBA); float* ss = (float*)(a->ws + OFF_SSA);
    for (int row = gw; row < M; row += ngw) {
        const f32x4* xr = (const f32x4*)(a->in[0] + (size_t)row * D) + lane; f32x4* orow = (f32x4*)(a->out + (size_t)row * D) + lane;
        float sq = 0.f;
#pragma unroll
        for (int j = 0; j < 4; ++j) {
            const f32x4 v = xr[64 * j]; orow[64 * j] = v; sq += dot4(v);
            u32x2 w; w.x = cvt_pk_bf16(v.x, v.y); w.y = cvt_pk_bf16(v.z, v.w);
            *(u32x2*)(xb + (size_t)row * D + 256 * j + lane * 4) = w;
        }
#pragma unroll
        for (int o = 1; o < 64; o <<= 1) sq += __shfl_xor(sq, o);
        if (lane < 16) ss[(size_t)row * 16 + lane] = lane == 0 ? sq : 0.f;
    }
#endif
}

__device__ __forceinline__ void convert_p(KA a, int layer, int wv) {
    const f32x4* src = (const f32x4*)(a->in[1] + (size_t)layer * M * PLE); u32x2* dst = (u32x2*)(a->ws + OFF_VT);
    const size_t n = (size_t)M * PLE / 4;
    const int tid_ = ltid(wv), bid_ = lbid(), G_ = lgrid();
    for (size_t i = (size_t)bid_ * 512 + tid_; i < n; i += (size_t)G_ * 512) {
        const f32x4 v = src[i]; u32x2 w; w.x = cvt_pk_bf16(v.x, v.y); w.y = cvt_pk_bf16(v.z, v.w); dst[i] = w;
    }
}

__device__ __forceinline__ void final_norm(KA a, int wv) {
    const int tid_ = ltid(wv); const int lane = tid_ & 63, gw = lbid() * 8 + (tid_ >> 6), ngw = lgrid() * 8;
    const float* ss = (const float*)(a->ws + OFF_SSA);
    f32x4 g[4];
#pragma unroll
    for (int j = 0; j < 4; ++j) g[j] = ((const f32x4*)a->in[23])[64 * j + lane];
    for (int row = gw; row < M; row += ngw) {
        const float r = rs16(ss, row);
        f32x4* orow = (f32x4*)(a->out + (size_t)row * D) + lane;
#pragma unroll
        for (int j = 0; j < 4; ++j) orow[64 * j] = orow[64 * j] * r * g[j];
    }
}

struct AttnP { const unsigned char* ws; const float* nab; const float* sink; };

template <int MODE>
__device__ __forceinline__ void attn_unit(const AttnP& P0, int unit, LAS float* xch, const LAS float* nabl, int wv) {
    const unsigned char* ws = P0.ws; asm volatile("" : "+s"(ws));
    constexpr int NS = MODE == 0 ? 6 : 4;
    const int lane = vlane(), w = wv, qs = w >> 2, h = w & 3, ql = lane & 31, hh = lane >> 5;
    const int lane16 = lane * 16;
    const int b = unit >> 5, rem = unit & 31;
    int qt, T0 = 0, rr = 0, qmin, qmax;
    if (MODE == 1) { T0 = 512 * (rem >> 3); rr = 2 * (rem & 7) + qs; qt = T0 + rr + 16 * ql; qmin = T0 + rr; qmax = qmin + 496; }
    else { qmin = 64 * rem + 32 * qs; qt = qmin + ql; qmax = qmin + 31; }
    const size_t tokbase = (size_t)b * T;
    const bf16_t* qrow; int khead, group;
    if (MODE == 0) { qrow = (const bf16_t*)(ws + OFF_QM) + (tokbase + qt) * QLD + 96 * h; khead = 18 + h; group = 3; }
    else if (MODE == 1) { qrow = (const bf16_t*)(ws + OFF_ZQ) + (tokbase + qt) * ZQLD + 512 + 64 * h; khead = 6 + h; group = 2; }
    else if (MODE == 2) { qrow = (const bf16_t*)(ws + OFF_ZQ) + (tokbase + qt) * ZQLD + 64 * h; khead = h; group = 0; }
    else { qrow = (const bf16_t*)(ws + OFF_ZQ) + (tokbase + qt) * ZQLD + 256 + 64 * h; khead = 4 + (h >> 1); group = 1; }
    const unsigned char* kfb = ws + OFF_KF + (size_t)b * 64 * 4096 + lane16;
    const unsigned char* vfb = ws + OFF_VT + (size_t)b * 64 * 4096 + lane16;
    const unsigned char* kpe = ws + OFF_KPE + (size_t)b * 64 * 2048 + lane16;
    bf16x8 qf[NS];
#pragma unroll
    for (int s = 0; s < NS; ++s) qf[s] = *(const bf16x8*)(qrow + 16 * s + 8 * hh);
    const float sc = (MODE == 0 ? 0.10206207261596577f : 0.125f) * LOG2E;
    f32x16 o0, o1;
#pragma unroll
    for (int e = 0; e < 16; ++e) { o0[e] = 0.f; o1[e] = 0.f; }
    float mrun = -1e20f, lrun = 0.f;
    if (MODE == 3) { mrun = P0.sink[h] * LOG2E; lrun = hh == 0 ? 1.f : 0.f; }
    const int qcol = qt & 63;
    const int nseg = MODE == 1 ? 3 : 1;
    for (int seg = 0; seg < nseg; ++seg) {
        int ntile, kb0, kstr, vb0, win, hd = khead;
        if (MODE == 0) { ntile = 64; kb0 = 0; kstr = 1; vb0 = 0; win = 1 << 20; }
        else if (MODE == 2) { ntile = 16; kb0 = 64 * min(max(rem - 4, 0), 24); kstr = 1; vb0 = kb0; win = 0; }
        else if (MODE == 3) { ntile = 9; kb0 = qmin - 128; kstr = 1; vb0 = kb0; win = 128; }
        else {
            if (seg == 0) { ntile = 20; kb0 = T0 - 64; kstr = 1; vb0 = kb0; win = 64; }
            else if (seg == 1) { ntile = 8; const int us = (T0 >> 2) - 64, r4 = rr & 3; kb0 = 4 * us + r4; kstr = 4; vb0 = r4 * 512 + us; win = 256; hd = khead + 4; }
            else { ntile = 5; const int nst = (T0 >> 4) - 64; kb0 = 16 * nst + rr; kstr = 16; vb0 = rr * 128 + nst; win = 1024; hd = khead + 8; }
        }
        const int kstep = 32 * kstr;
        int tlo = 0, thi = ntile;
        if (MODE == 1 || MODE == 3) { tlo = kb0 < 0 ? (-kb0 + kstep - 1) / kstep : 0; thi = min(ntile, (T - kb0 + kstep - 1) / kstep); }
        const unsigned char* kfh = kfb + (size_t)hd * HEADB; const unsigned char* vfh = vfb + (size_t)hd * HEADB;
        bf16x8 kf[NS], vf[4];
        {
            const int pt = (vb0 >> 5) + tlo;
#pragma unroll
            for (int s = 0; s < NS; ++s) kf[s] = (MODE == 0 && s >= 4) ? *(const bf16x8*)(kpe + (size_t)pt * 2048 + (s - 4) * 1024) : *(const bf16x8*)(kfh + (size_t)pt * 4096 + s * 1024);
#pragma unroll
            for (int j = 0; j < 4; ++j) vf[j] = *(const bf16x8*)(vfh + (size_t)pt * 4096 + j * 1024);
        }
        if (qs && seg == 0) __builtin_amdgcn_s_sleep(DEPHASE / 2);
        for (int tau = tlo; tau < thi; ++tau) {
            const int kb = kb0 + kstep * tau;
            bf16x8 kn[NS], vn[4];
            {
                const int pt = (vb0 >> 5) + min(tau + 1, thi - 1);
#pragma unroll
                for (int s = 0; s < NS; ++s) kn[s] = (MODE == 0 && s >= 4) ? *(const bf16x8*)(kpe + (size_t)pt * 2048 + (s - 4) * 1024) : *(const bf16x8*)(kfh + (size_t)pt * 4096 + s * 1024);
#pragma unroll
                for (int j = 0; j < 4; ++j) vn[j] = *(const bf16x8*)(vfh + (size_t)pt * 4096 + j * 1024);
            }
            f32x16 sacc;
#pragma unroll
            for (int e = 0; e < 16; ++e) sacc[e] = 0.f;
#pragma unroll
            for (int s = 0; s < NS; ++s) sacc = __builtin_amdgcn_mfma_f32_32x32x16_bf16(kf[s], qf[s], sacc, 0, 0, 0);
            if (MODE == 2) {
                const int c0 = 32 * (tau & 1), wsx = min(max(qcol - 8, 0), 48);
                const int mb = c0 - wsx + 4 * hh;
                const int drow = (kb >> 6) - rem + 7;
                const LAS float* bp = nabl + (h * 15 + drow) * 31 + c0 - qcol + 15 + 4 * hh;
#pragma unroll
                for (int e = 0; e < 16; ++e) {
                    const int o = 8 * (e >> 2) + (e & 3);
                    const float v = sacc[e] * sc + bp[o];
                    sacc[e] = (unsigned)(mb + o) < 16u ? v : -1e30f;
                }
            } else if (MODE != 0) {
                const bool full = (kb + 31 * kstr - qmin <= win) && (qmax - kb <= win);
                if (!full) {
                    const int mb = kb - qt + win + 4 * hh * kstr;
#pragma unroll
                    for (int e = 0; e < 16; ++e) {
                        const int o = (8 * (e >> 2) + (e & 3)) * kstr;
                        sacc[e] = (unsigned)(mb + o) <= (unsigned)(2 * win) ? sacc[e] : -1e30f;
                    }
                }
            }
            float tmax = fmaxf(fmaxf(sacc[0], sacc[1]), fmaxf(sacc[2], sacc[3]));
#pragma unroll
            for (int e = 4; e < 16; e += 4) tmax = fmaxf(tmax, fmaxf(fmaxf(sacc[e], sacc[e + 1]), fmaxf(sacc[e + 2], sacc[e + 3])));
            tmax = fmaxf(tmax, __shfl_xor(tmax, 32));
            if (MODE != 2) tmax *= sc;
            const float mnew = fmaxf(mrun, tmax);
            const bool grow = mnew > mrun;
            const float alpha = __builtin_amdgcn_exp2f(mrun - mnew);
            mrun = mnew;
            float psum = 0.f;
#pragma unroll
            for (int e = 0; e < 16; ++e) {
                const float p = MODE == 2 ? __builtin_amdgcn_exp2f(sacc[e] - mnew) : __builtin_amdgcn_exp2f(__builtin_fmaf(sacc[e], sc, -mnew));
                sacc[e] = p; psum += p;
            }
            lrun = lrun * alpha + psum;
            if (__builtin_amdgcn_ballot_w64(grow) != 0ull) {
#pragma unroll
                for (int e = 0; e < 16; ++e) { o0[e] *= alpha; o1[e] *= alpha; }
            }
            bf16x8 pb[2];
#pragma unroll
            for (int t = 0; t < 2; ++t) {
                u32x4 v; v.x = cvt_pk_bf16(sacc[8 * t + 0], sacc[8 * t + 1]); v.y = cvt_pk_bf16(sacc[8 * t + 2], sacc[8 * t + 3]);
                v.z = cvt_pk_bf16(sacc[8 * t + 4], sacc[8 * t + 5]); v.w = cvt_pk_bf16(sacc[8 * t + 6], sacc[8 * t + 7]);
                pb[t] = __builtin_bit_cast(bf16x8, v);
            }
            o0 = __builtin_amdgcn_mfma_f32_32x32x16_bf16(vf[0], pb[0], o0, 0, 0, 0);
            o0 = __builtin_amdgcn_mfma_f32_32x32x16_bf16(vf[1], pb[1], o0, 0, 0, 0);
            o1 = __builtin_amdgcn_mfma_f32_32x32x16_bf16(vf[2], pb[0], o1, 0, 0, 0);
            o1 = __builtin_amdgcn_mfma_f32_32x32x16_bf16(vf[3], pb[1], o1, 0, 0, 0);
#pragma unroll
            for (int s = 0; s < NS; ++s) kf[s] = kn[s];
#pragma unroll
            for (int j = 0; j < 4; ++j) vf[j] = vn[j];
        }
    }
    lrun += __shfl_xor(lrun, 32);
    const float inv = 1.0f / lrun;
    float sq = 0.f;
#pragma unroll
    for (int e = 0; e < 16; ++e) { o0[e] *= inv; o1[e] *= inv; sq += o0[e] * o0[e] + o1[e] * o1[e]; }
    sq += __shfl_xor(sq, 32);
    if (hh == 0) xch[w * 32 + ql] = sq;
    __syncthreads();
    const float tot = (xch[(qs * 4 + 0) * 32 + ql] + xch[(qs * 4 + 1) * 32 + ql]) + (xch[(qs * 4 + 2) * 32 + ql] + xch[(qs * 4 + 3) * 32 + ql]);
    const float rg = rsqrtf(tot * (1.0f / 256.0f) + EPS);
    bf16_t* yrow = (bf16_t*)(ws + OFF_XBA) + (tokbase + qt) * D + group * 256 + h * 64 + 4 * hh;
#pragma unroll
    for (int j = 0; j < 4; ++j) {
        u32x2 w0; w0.x = cvt_pk_bf16(o0[4 * j] * rg, o0[4 * j + 1] * rg); w0.y = cvt_pk_bf16(o0[4 * j + 2] * rg, o0[4 * j + 3] * rg);
        u32x2 w1; w1.x = cvt_pk_bf16(o1[4 * j] * rg, o1[4 * j + 1] * rg); w1.y = cvt_pk_bf16(o1[4 * j + 2] * rg, o1[4 * j + 3] * rg);
        *(u32x2*)(yrow + 8 * j) = w0; *(u32x2*)(yrow + 32 + 8 * j) = w1;
    }
}

__device__ __forceinline__ void sm_pv(f32x16& sacc, f32x16& o0, f32x16& o1, float& mrun, float& lrun, const bf16x8 (&vf)[4], float sc) {
    float tmax = fmaxf(fmaxf(sacc[0], sacc[1]), fmaxf(sacc[2], sacc[3]));
#pragma unroll
    for (int e = 4; e < 16; e += 4) tmax = fmaxf(tmax, fmaxf(fmaxf(sacc[e], sacc[e + 1]), fmaxf(sacc[e + 2], sacc[e + 3])));
    tmax = xh_max(tmax) * sc;
    if (__builtin_amdgcn_ballot_w64(tmax - mrun > 11.541560327111707f) != 0ull) {
        const float mnew = fmaxf(mrun, tmax), alpha = __builtin_amdgcn_exp2f(mrun - mnew);
        mrun = mnew; lrun *= alpha;
#pragma unroll
        for (int e = 0; e < 16; ++e) { o0[e] *= alpha; o1[e] *= alpha; }
    }
    const float nm = -mrun;
    float psum = 0.f;
#pragma unroll
    for (int e = 0; e < 16; ++e) { const float p = __builtin_amdgcn_exp2f(__builtin_fmaf(sacc[e], sc, nm)); sacc[e] = p; psum += p; }
    lrun += psum;
    bf16x8 pb[2];
#pragma unroll
    for (int t = 0; t < 2; ++t) {
        u32x4 v; v.x = cvt_pk_bf16(sacc[8 * t + 0], sacc[8 * t + 1]); v.y = cvt_pk_bf16(sacc[8 * t + 2], sacc[8 * t + 3]);
        v.z = cvt_pk_bf16(sacc[8 * t + 4], sacc[8 * t + 5]); v.w = cvt_pk_bf16(sacc[8 * t + 6], sacc[8 * t + 7]);
        pb[t] = __builtin_bit_cast(bf16x8, v);
    }
    o0 = __builtin_amdgcn_mfma_f32_32x32x16_bf16(vf[0], pb[0], o0, 0, 0, 0);
    o0 = __builtin_amdgcn_mfma_f32_32x32x16_bf16(vf[1], pb[1], o0, 0, 0, 0);
    o1 = __builtin_amdgcn_mfma_f32_32x32x16_bf16(vf[2], pb[0], o1, 0, 0, 0);
    o1 = __builtin_amdgcn_mfma_f32_32x32x16_bf16(vf[3], pb[1], o1, 0, 0, 0);
}
__device__ __forceinline__ void attn_mla(const AttnP& P0, int unit, LAS float* xch, int wv) {
    const unsigned char* ws = P0.ws; asm volatile("" : "+s"(ws));
    const int lane = vlane(), w = wv, qs = w >> 2, h = w & 3, ql = lane & 31, hh = lane >> 5;
    const int lane16 = lane * 16;
    const int b = unit >> 4, q0 = 128 * (unit & 15) + 64 * qs;
    const size_t tokbase = (size_t)b * T;
    const bf16_t* qrA = (const bf16_t*)(ws + OFF_QM) + (tokbase + q0 + ql) * QLD + 96 * h;
    const bf16_t* qrB = qrA + 32 * QLD;
    const unsigned char* kfh = ws + OFF_KF + (size_t)(18 + h) * HEADB + (size_t)b * 64 * 4096 + lane16;
    const unsigned char* vfh = ws + OFF_VT + (size_t)(18 + h) * HEADB + (size_t)b * 64 * 4096 + lane16;
    const unsigned char* kpe = ws + OFF_KPE + (size_t)b * 64 * 2048 + lane16;
    bf16x8 qA[6], qB[6];
#pragma unroll
    for (int s = 0; s < 6; ++s) { qA[s] = *(const bf16x8*)(qrA + 16 * s + 8 * hh); qB[s] = *(const bf16x8*)(qrB + 16 * s + 8 * hh); }
    const float sc = 0.10206207261596577f * LOG2E;
    f32x16 oA0, oA1, oB0, oB1;
#pragma unroll
    for (int e = 0; e < 16; ++e) { oA0[e] = 0.f; oA1[e] = 0.f; oB0[e] = 0.f; oB1[e] = 0.f; }
    float mA = -1e20f, lA = 0.f, mB = -1e20f, lB = 0.f;
    bf16x8 kf[6], vf[4];
#pragma unroll
    for (int s = 0; s < 6; ++s) kf[s] = s >= 4 ? ldg16(kpe + (s - 4) * 1024) : ldg16(kfh + s * 1024);
#pragma unroll
    for (int j = 0; j < 4; ++j) vf[j] = ldg16(vfh + j * 1024);
    if (qs) __builtin_amdgcn_s_sleep(DEPHASE);
    for (int tau = 0; tau < 64; ++tau) {
        const int pt = min(tau + 1, 63);
        f32x16 sa, sb;
#pragma unroll
        for (int e = 0; e < 16; ++e) { sa[e] = 0.f; sb[e] = 0.f; }
#pragma unroll
        for (int s = 0; s < 6; ++s) { sa = __builtin_amdgcn_mfma_f32_32x32x16_bf16(kf[s], qA[s], sa, 0, 0, 0); sb = __builtin_amdgcn_mfma_f32_32x32x16_bf16(kf[s], qB[s], sb, 0, 0, 0); }
#pragma unroll
        for (int s = 0; s < 6; ++s) kf[s] = s >= 4 ? ldg16(kpe + (size_t)pt * 2048 + (s - 4) * 1024) : ldg16(kfh + (size_t)pt * 4096 + s * 1024);
        sm_pv(sa, oA0, oA1, mA, lA, vf, sc);
        sm_pv(sb, oB0, oB1, mB, lB, vf, sc);
#pragma unroll
        for (int j = 0; j < 4; ++j) vf[j] = ldg16(vfh + (size_t)pt * 4096 + j * 1024);
    }
    lA += __shfl_xor(lA, 32); lB += __shfl_xor(lB, 32);
    const float iA = 1.0f / lA, iB = 1.0f / lB;
    float sqA = 0.f, sqB = 0.f;
#pragma unroll
    for (int e = 0; e < 16; ++e) { oA0[e] *= iA; oA1[e] *= iA; oB0[e] *= iB; oB1[e] *= iB; sqA += oA0[e] * oA0[e] + oA1[e] * oA1[e]; sqB += oB0[e] * oB0[e] + oB1[e] * oB1[e]; }
    sqA += __shfl_xor(sqA, 32); sqB += __shfl_xor(sqB, 32);
    if (hh == 0) { xch[w * 64 + ql] = sqA; xch[w * 64 + 32 + ql] = sqB; }
    __syncthreads();
    const LAS float* xq = xch + qs * 256 + ql;
    const float rA = rsqrtf(((xq[0] + xq[64]) + (xq[128] + xq[192])) * (1.0f / 256.0f) + EPS);
    const float rB = rsqrtf(((xq[32] + xq[96]) + (xq[160] + xq[224])) * (1.0f / 256.0f) + EPS);
    bf16_t* yA = (bf16_t*)(ws + OFF_XBA) + (tokbase + q0 + ql) * D + 3 * 256 + h * 64 + 4 * hh;
    bf16_t* yB = yA + 32 * D;
#pragma unroll
    for (int j = 0; j < 4; ++j) {
        u32x2 w0; w0.x = cvt_pk_bf16(oA0[4 * j] * rA, oA0[4 * j + 1] * rA); w0.y = cvt_pk_bf16(oA0[4 * j + 2] * rA, oA0[4 * j + 3] * rA);
        u32x2 w1; w1.x = cvt_pk_bf16(oA1[4 * j] * rA, oA1[4 * j + 1] * rA); w1.y = cvt_pk_bf16(oA1[4 * j + 2] * rA, oA1[4 * j + 3] * rA);
        *(u32x2*)(yA + 8 * j) = w0; *(u32x2*)(yA + 32 + 8 * j) = w1;
        u32x2 w2; w2.x = cvt_pk_bf16(oB0[4 * j] * rB, oB0[4 * j + 1] * rB); w2.y = cvt_pk_bf16(oB0[4 * j + 2] * rB, oB0[4 * j + 3] * rB);
        u32x2 w3; w3.x = cvt_pk_bf16(oB1[4 * j] * rB, oB1[4 * j + 1] * rB); w3.y = cvt_pk_bf16(oB1[4 * j + 2] * rB, oB1[4 * j + 3] * rB);
        *(u32x2*)(yB + 8 * j) = w2; *(u32x2*)(yB + 32 + 8 * j) = w3;
    }
}

__device__ __forceinline__ void attn_phase(KA a, int layer, LAS unsigned char* lds, int wv) {
    AttnP P; P.ws = a->ws; P.nab = a->in[8] + (size_t)layer * 4 * 15 * 31; P.sink = a->in[9] + layer * 4;
    LAS float* xch = (LAS float*)lds;
    for (int i = ltid(wv); i < 4 * 15 * 31; i += 512) xch[1024 + i] = P.nab[i] * LOG2E;
    __syncthreads();
    int it = 0;
    const int G_ = lgrid(), bid_ = lbid();
    const int vcu = (G_ & 7) == 0 ? (bid_ & 7) * (G_ >> 3) + (bid_ >> 3) : bid_;
    for (int u = vcu; u < 256 + 3 * 512; u += G_, ++it) {
        LAS float* x = xch + (it & 1) * 512;
        if (u < 256) attn_mla(P, u, x, wv);
        else {
            const int mode = 1 + ((u - 256) >> 9), unit = (u - 256) & 511;
            if (mode == 1) attn_unit<1>(P, unit, x, xch + 1024, wv);
            else if (mode == 2) attn_unit<2>(P, unit, x, xch + 1024, wv);
            else attn_unit<3>(P, unit, x, xch + 1024, wv);
        }
    }
    __syncthreads();
}

__device__ __forceinline__ void grid_bar(unsigned* bar, unsigned seq, int wv) {
    asm volatile("s_waitcnt vmcnt(0) lgkmcnt(0)" ::: "memory");
    __builtin_amdgcn_s_barrier();
    if (wv == 0) {
        if (vlane() == 0) {
            const unsigned G = (unsigned)lgrid(), b = (unsigned)lbid(), g = b & 7u;
            const unsigned ng = (G - g + 7u) >> 3, ngroups = G < 8u ? G : 8u;
            unsigned* flag = bar + 64 * 9;
            __builtin_amdgcn_fence(__ATOMIC_RELEASE, "agent");
            asm volatile("s_waitcnt vmcnt(0)" ::: "memory");
            const unsigned old = __hip_atomic_fetch_add(bar + 64 * g, 1u, __ATOMIC_RELAXED, __HIP_MEMORY_SCOPE_AGENT);
            bool waitf = true;
            if (old + 1u == seq * ng) {
                __builtin_amdgcn_fence(__ATOMIC_SEQ_CST, "agent");
                const unsigned old2 = __hip_atomic_fetch_add(bar + 64 * 8, 1u, __ATOMIC_RELAXED, __HIP_MEMORY_SCOPE_AGENT);
                if (old2 + 1u == seq * ngroups) { __builtin_amdgcn_fence(__ATOMIC_SEQ_CST, "agent"); __hip_atomic_store(flag, seq, __ATOMIC_RELAXED, __HIP_MEMORY_SCOPE_AGENT); waitf = false; }
            }
            if (waitf) { unsigned spins = 0; while (__hip_atomic_load(flag, __ATOMIC_RELAXED, __HIP_MEMORY_SCOPE_AGENT) < seq) { __builtin_amdgcn_s_sleep(1); if (++spins > (1u << 26)) break; } }
            __builtin_amdgcn_fence(__ATOMIC_ACQUIRE, "agent");
            asm volatile("s_waitcnt vmcnt(0)" ::: "memory");
        }
    }
    __builtin_amdgcn_s_barrier();
    asm volatile("" ::: "memory");
}

template <int PH, bool ZERO = false>
__device__ __forceinline__ void run_phase(LAS unsigned char* lds, int wv) {
    KA a = kargs();
    unsigned char* ws = a->ws; asm volatile("" : "+s"(ws));
    bf16_t* Wbase = (bf16_t*)(ws + OFF_W);
    bf16_t* xbA = (bf16_t*)(ws + OFF_XBA); bf16_t* xbB = (bf16_t*)(ws + OFF_XBB);
    bf16_t* Hb = (bf16_t*)(ws + OFF_H); bf16_t* zl = (bf16_t*)(ws + OFF_ZL); bf16_t* qm = (bf16_t*)(ws + OFF_QM);
    unsigned char* vf = ws + OFF_VT;
    bf16_t* pb = (bf16_t*)(ws + OFF_VT);
    float* ssA = (float*)(ws + OFF_SSA); float* ssB = (float*)(ws + OFF_SSB); float* mst = (float*)(ws + OFF_MST);
    const float* cs64 = (const float*)(ws + OFF_CS64); const float* cs32 = (const float*)(ws + OFF_CS32);
    if constexpr (PH == 0) { if (PH_ON(0)) prologue(a, lds, wv); }
    else if constexpr (PH == NPH - 1) { if (PH_ON(1)) final_norm(a, wv); }
    else {
        constexpr int l = (PH - 1) / 9, k = (PH - 1) % 9;
        bf16_t* WL = Wbase + (size_t)l * WL_SIZE;
        if constexpr (k == 0) { if (PH_ON(2)) { EpiGU E{ssA, Hb}; run_gemm(wv, lds, xbA, D, M, WL + WL_GU1, D, 5632, D, 0, E); } }
        else if constexpr (k == 1) { if (PH_ON(3)) { EpiRes E{a->out, xbB, ssB, ZERO ? 0.f : 0.5f}; run_gemm(wv, lds, Hb, FF, M, WL + WL_D1, FF, D, FF, 0, E); } }
        else if constexpr (k == 2) {
            if (PH_ON(4)) { EpiIn E{ssB, ws, mst, cs64, cs32}; run_gemm(wv, lds, xbB, D, M, WL + WL_IN, D, 2048, D, 0, E); }
            if (PH_ON(5)) { EpiVT E{ssB, vf}; run_gemm(wv, lds, WL + WL_IN + (size_t)2048 * D, D, 512, xbB, D, M, D, 0, E); }
        }
        else if constexpr (k == 3) {
            if (PH_ON(6)) { EpiQ E{mst, qm, cs32}; run_gemm(wv, lds, zl, ZLLD, M, WL + WL_UQ, 256, 512, 256, 0, E); }
            if (PH_ON(7)) { EpiK E{mst, ws}; run_gemm(wv, lds, zl + 256, ZLLD, M, WL + WL_UKV, 128, 256, 128, 0, E); }
            if (PH_ON(8)) { EpiVTM E{mst, vf}; run_gemm(wv, lds, WL + WL_UKV + (size_t)256 * 128, 128, 256, zl + 256, ZLLD, M, 128, 128, E); }
        }
        else if constexpr (k == 4) { if (PH_ON(9)) attn_phase(a, l, lds, wv); }
        else if constexpr (k == 5) { if (PH_ON(3)) { EpiRes E{a->out, xbB, ssB, ZERO ? 0.f : 1.0f}; run_gemm(wv, lds, xbA, D, M, WL + WL_O, D, D, D, 0, E); } }
        else if constexpr (k == 6) { if (PH_ON(2)) { convert_p(a, l, wv); EpiGU E{ssB, Hb}; run_gemm(wv, lds, xbB, D, M, WL + WL_GU2, D, 5632, D, 0, E); } }
        else if constexpr (k == 7) {
            if (PH_ON(3)) { EpiRes E{a->out, xbB, ssB, ZERO ? 0.f : 0.5f}; run_gemm(wv, lds, Hb, FF, M, WL + WL_D2, FF, D, FF, 0, E); }
            if (PH_ON(10)) { EpiPP E{xbA}; run_gemm(wv, lds, pb, PLE, M, WL + WL_PP, PLE, D, PLE, 0, E); }
        }
        else { if (PH_ON(11)) { EpiGate E{a->out, ssB, xbA, ssA, ZERO ? 0.f : 1.0f}; run_gemm(wv, lds, xbB, D, M, WL + WL_PG, D, D, D, 0, E); } }
    }
}
template <int PH>
__device__ __forceinline__ void run_from(LAS unsigned char* lds, int ph_lo, int ph_hi, int wv) {
    if constexpr (PH < NPH) {
        if (PH >= ph_lo && PH < ph_hi) {
            run_phase<PH>(lds, wv);
            if constexpr (PH > 0 && PH < NPH - 1) { if constexpr ((DUPM >> ((PH - 1) % 9)) & 1) { __syncthreads(); run_phase<PH, true>(lds, wv); } }
            if constexpr (PH == 0 && ((DUPM >> 9) & 1)) { __syncthreads(); run_phase<PH>(lds, wv); }
            if (PH + 1 < ph_hi && kargs()->coop) {
                if constexpr (PH == 0) cg::this_grid().sync();
                else { for (int r_ = 0; r_ < BARREP; ++r_) grid_bar((unsigned*)(kargs()->ws + OFF_BAR), (unsigned)((PH - 1) * BARREP + r_ + 1), wv); }
            }
        }
        run_from<PH + 1>(lds, ph_lo, ph_hi, wv);
    }
}
__global__ void __launch_bounds__(512, 2) mega(Args a_unused) {
    extern __shared__ __attribute__((aligned(16))) unsigned char lds_raw[];
    LAS unsigned char* lds = (LAS unsigned char*)lds_raw;
    const int ph_lo = kargs()->ph_lo, ph_hi = kargs()->ph_hi;
    const int wv = __builtin_amdgcn_readfirstlane((int)threadIdx.x >> 6);
    run_from<0>(lds, ph_lo, ph_hi, wv);
}

extern "C" void kernel_launch(void* const* d_in, const int* in_sizes, int n_in, void* d_out, int out_size, void* d_ws, size_t ws_size, hipStream_t stream) {
    static int grid = 0;
    if (grid == 0) {
        if (n_in != 24 || ws_size < WS_END) { fprintf(stderr, "kernel_launch: n_in %d ws %zu (need %zu)\n", n_in, ws_size, (size_t)WS_END); grid = -1; return; }
        int dev = 0, cus = 0, per_cu = 0;
        hipGetDevice(&dev); hipDeviceGetAttribute(&cus, hipDeviceAttributeMultiprocessorCount, dev);
        if (hipFuncSetAttribute((const void*)mega, hipFuncAttributeMaxDynamicSharedMemorySize, LDS_BYTES) != hipSuccess) { fprintf(stderr, "hipFuncSetAttribute failed\n"); grid = -1; return; }
        if (hipOccupancyMaxActiveBlocksPerMultiprocessor(&per_cu, (const void*)mega, 512, LDS_BYTES) != hipSuccess || per_cu < 1) per_cu = 1;
        (void)hipGetLastError();
        grid = cus * per_cu;
    }
    if (grid < 0) return;
    (void)hipMemsetAsync((char*)d_ws + OFF_BAR, 0, 4096, stream);
    Args a{};
    for (int i = 0; i < 24; ++i) a.in[i] = (const float*)d_in[i];
    a.out = (float*)d_out; a.ws = (unsigned char*)d_ws;
#if MULTI_LAUNCH
    for (int ph = 0; ph < NPH; ++ph) {
        a.ph_lo = ph; a.ph_hi = ph + 1; a.coop = 0;
        hipLaunchKernelGGL(mega, dim3(grid), dim3(512), LDS_BYTES, stream, a);
    }
#else
    a.ph_lo = 0; a.ph_hi = NPH; a.coop = 1;
    void* args[] = {&a};
    hipError_t e = hipLaunchCooperativeKernel((void*)mega, dim3(grid), dim3(512), args, LDS_BYTES, stream);
    if (e != hipSuccess) fprintf(stderr, "cooperative launch failed: %s (grid %d)\n", hipGetErrorString(e), grid);
#endif
}
```

```cpp
#include <hip/hip_runtime.h>
#include <hip/hip_cooperative_groups.h>
#include <cstdio>
#include <cstdint>
namespace cg = cooperative_groups;

#ifndef MULTI_LAUNCH
#define MULTI_LAUNCH 0
#endif

#ifndef DEPHASE
#define DEPHASE 20
#endif
#ifndef BARREP
#define BARREP 1
#endif
#ifndef DUPM
#define DUPM 0
#endif
#ifndef PRO_PARTS
#define PRO_PARTS 7
#endif
#ifndef PHM
#define PHM 0xffff
#endif
#define PH_ON(b) (((PHM) >> (b)) & 1)
#define LAS __attribute__((address_space(3)))
typedef unsigned short bf16_t;
typedef short bf16x8 __attribute__((ext_vector_type(8)));
typedef float f32x4 __attribute__((ext_vector_type(4)));
typedef float f32x16 __attribute__((ext_vector_type(16)));
typedef unsigned u32x4 __attribute__((ext_vector_type(4)));
typedef unsigned u32x2 __attribute__((ext_vector_type(2)));

constexpr int M = 32768, T = 2048, D = 1024, FF = 2816, DEPTH = 4, PLE = 256;
constexpr int ZQLD = 768, ZLLD = 384, QLD = 384;
constexpr size_t HEADB = (size_t)16 * 64 * 4096;
constexpr float EPS = 1e-6f;
constexpr float LOG2E = 1.4426950408889634f;

constexpr size_t WL_GU1 = 0, WL_D1 = WL_GU1 + (size_t)5632 * 1024, WL_IN = WL_D1 + (size_t)1024 * 2816, WL_UQ = WL_IN + (size_t)2816 * 1024,
                 WL_UKV = WL_UQ + (size_t)512 * 256, WL_O = WL_UKV + (size_t)512 * 128, WL_GU2 = WL_O + (size_t)1024 * 1024, WL_D2 = WL_GU2 + (size_t)5632 * 1024,
                 WL_PG = WL_D2 + (size_t)1024 * 2816, WL_PP = WL_PG + (size_t)1024 * 1024, WL_SIZE = WL_PP + (size_t)1024 * 256;
constexpr size_t OFF_W = 0;
constexpr size_t OFF_XBA = OFF_W + WL_SIZE * 2 * DEPTH;
constexpr size_t OFF_XBB = OFF_XBA + (size_t)M * D * 2;
constexpr size_t OFF_H = OFF_XBB + (size_t)M * D * 2;
constexpr size_t OFF_ZQ = OFF_H;
constexpr size_t OFF_ZL = OFF_ZQ + (size_t)M * ZQLD * 2;
constexpr size_t OFF_KF = OFF_ZL + (size_t)M * ZLLD * 2;
constexpr size_t OFF_KPE = OFF_KF + 22 * HEADB;
constexpr size_t OFF_VT = OFF_H + (size_t)M * FF * 2;
constexpr size_t OFF_SSA = OFF_VT + 22 * HEADB;
constexpr size_t OFF_SSB = OFF_SSA + (size_t)M * 16 * 4;
constexpr size_t OFF_MST = OFF_SSB + (size_t)M * 16 * 4;
constexpr size_t OFF_CS64 = OFF_MST + (size_t)M * 8 * 4;
constexpr size_t OFF_CS32 = OFF_CS64 + (size_t)T * 64 * 4;
constexpr size_t OFF_BAR = OFF_CS32 + (size_t)T * 32 * 4;
constexpr size_t OFF_QM = OFF_BAR + 4096;
constexpr size_t WS_END = OFF_QM + (size_t)M * QLD * 2;
static_assert(OFF_KPE + (size_t)16 * 64 * 2048 <= OFF_VT, "zq|zl|KF|KPE inside the H region");
static_assert(WS_END <= 626121856, "workspace budget");

constexpr int LDS_BYTES = 147456;
constexpr int NPH = 2 + 9 * DEPTH;

__device__ __forceinline__ unsigned cvt_pk_bf16(float lo, float hi) { unsigned r; asm("v_cvt_pk_bf16_f32 %0, %1, %2" : "=v"(r) : "v"(lo), "v"(hi)); return r; }
__device__ __forceinline__ float bf_lo(unsigned u) { return __uint_as_float(u << 16); }
__device__ __forceinline__ float bf_hi(unsigned u) { return __uint_as_float(u & 0xffff0000u); }
__device__ __forceinline__ float sum4(f32x4 a) { return (a.x + a.y) + (a.z + a.w); }
__device__ __forceinline__ float dot4(f32x4 a) { return (a.x * a.x + a.y * a.y) + (a.z * a.z + a.w * a.w); }
__device__ __forceinline__ float rs16(const float* ss, int row) {
    const f32x4* p = (const f32x4*)(ss + (size_t)row * 16);
    const f32x4 a = p[0], b = p[1], c = p[2], d = p[3];
    return rsqrtf(((sum4(a) + sum4(b)) + (sum4(c) + sum4(d))) * (1.0f / 1024.0f) + EPS);
}
__device__ __forceinline__ int vlane() { int l; asm volatile("v_mbcnt_lo_u32_b32 %0, -1, 0\n\tv_mbcnt_hi_u32_b32 %0, -1, %0" : "=v"(l)); return l; }
__device__ __forceinline__ int ltid(int wv) { return (wv << 6) | vlane(); }
__device__ __forceinline__ int lbid() { int b = blockIdx.x; asm volatile("" : "+s"(b)); return b; }
__device__ __forceinline__ int lgrid() { int g = gridDim.x; asm volatile("" : "+s"(g)); return g; }
#define GAS __attribute__((address_space(1)))
__device__ __forceinline__ bf16x8 ldg16(const void* p) { return *(const GAS bf16x8*)p; }
__device__ __forceinline__ float xh_max(float x) { auto r = __builtin_amdgcn_permlane32_swap(__float_as_uint(x), __float_as_uint(x), false, false); return fmaxf(__uint_as_float(r[0]), __uint_as_float(r[1])); }
__device__ __forceinline__ float sigmoidf_(float v) { return __builtin_amdgcn_rcpf(1.0f + __expf(-v)); }

namespace pg8 {
constexpr int BM = 256, BK = 64, HALF = 128, HTB = HALF * BK * 2, STAGE_BYTES = 8 * HTB, NXCD = 8, WGM = 8;
__host__ __device__ __forceinline__ int lds_byte(int r, int c) { const int st = (r >> 4) * 2 + (c >> 5), rr = r & 15, cc = c & 31, ob = rr * 64 + cc * 2; return st * 1024 + (ob ^ (((ob >> 9) & 1) << 5)); }
__host__ __device__ __forceinline__ void stage_rc(int b, int& R, int& C) { const int st = b / 1024, sb = b % 1024, swz = sb ^ (((sb >> 9) & 1) << 5); R = (st >> 1) * 16 + swz / 64; C = (st & 1) * 32 + (swz % 64) / 2; }
__host__ __device__ __forceinline__ int perm32(int rho) { const int n = rho >> 4, i = rho & 15; return 8 * (i >> 2) + 4 * n + (i & 3); }

struct Unit { int pm, pn; };
struct Gemm { const bf16_t* A; const bf16_t* Bt; int lda, ldb, K; };

struct StaticOrder {
    int nM, nN, nwg, G, c;
    __device__ void init(int Mr, int Nc, int G_, int c_) { nM = Mr / BM; nN = Nc / BM; nwg = nM * nN; G = G_; c = c_; }
    __device__ bool next(int i, Unit& u) const {
        const long L = (long)i * G + c; if (L >= nwg) return false;
        int wgid = (int)L; { const int q = nwg / NXCD, r = nwg % NXCD, xcd = wgid % NXCD, off = wgid / NXCD; wgid = (xcd < r ? xcd * (q + 1) : r * (q + 1) + (xcd - r) * q) + off; }
        const int nig = WGM * nN, gid = wgid / nig, fm = gid * WGM, gsz = (nM - fm) < WGM ? (nM - fm) : WGM;
        u.pm = fm + ((wgid % nig) % gsz); u.pn = (wgid % nig) / gsz; return true;
    }
};

template <class Epi>
__device__ __forceinline__ void gemm_phase(LAS unsigned char* lds, const Gemm g, const StaticOrder& S, const Epi& E, int wv) {
    const int tid = ltid(wv);
    const int wid = wv, lane = tid & 63, wr = wid >> 2, wc = wid & 3, fr = lane & 15, fq = lane >> 4;
    const int K = g.K, nt = K / BK;
    unsigned voffA[2], voffB[2];
#pragma unroll
    for (int i = 0; i < 2; ++i) { int R, C; stage_rc(tid * 16 + i * 8192, R, C); const int Rb = (R & ~31) + perm32(R & 31);
        voffA[i] = (unsigned)(R * g.lda + C) * 2u; voffB[i] = (unsigned)(Rb * g.ldb + C) * 2u; }
    const size_t kstep = (size_t)(BK * 2);
    const size_t hstepA = (size_t)HALF * g.lda * 2, hstepB = (size_t)HALF * g.ldb * 2;
    const size_t tstepA = 2 * hstepA, tstepB = 2 * hstepB;
    const unsigned ldsw = (unsigned)wid * 1024u;
    const int aoff = lds_byte(wr * 64 + fr, fq * 8), boff = lds_byte(wc * 32 + fr, fq * 8);
#define PG8_SA(b, h) (((b) * 2 + (h)) * HTB)
#define PG8_SB(b, h) ((4 + (b) * 2 + (h)) * HTB)
#define PG8_STAGE(bufoff, gbase, voff) do { _Pragma("unroll") for (int _i = 0; _i < 2; ++_i) \
        __builtin_amdgcn_global_load_lds((const unsigned*)((const char*)(gbase) + (voff)[_i]), (LAS unsigned*)(lds + (bufoff) + ldsw + _i * 8192), 16, 0, 0); } while (0)
#define PG8_LDA(dst, b, h) do { _Pragma("unroll") for (int m = 0; m < 4; ++m) _Pragma("unroll") for (int k = 0; k < 2; ++k) dst[m][k] = *(const LAS bf16x8*)(lds + PG8_SA(b, h) + aoff + m * 2048 + k * 1024); } while (0)
#define PG8_LDB(dst, b, h) do { _Pragma("unroll") for (int n = 0; n < 2; ++n) _Pragma("unroll") for (int k = 0; k < 2; ++k) dst[n][k] = *(const LAS bf16x8*)(lds + PG8_SB(b, h) + boff + n * 2048 + k * 1024); } while (0)
#define PG8_MMA(ai, bj, At, Bt) do { __builtin_amdgcn_s_setprio(1); _Pragma("unroll") for (int m = 0; m < 4; ++m) _Pragma("unroll") for (int n = 0; n < 2; ++n) _Pragma("unroll") for (int k = 0; k < 2; ++k) \
        acc[ai][bj][m][n] = __builtin_amdgcn_mfma_f32_16x16x32_bf16(Bt[n][k], At[m][k], acc[ai][bj][m][n], 0, 0, 0); __builtin_amdgcn_s_setprio(0); } while (0)
#define PG8_WAIT_V(n) asm volatile("s_waitcnt vmcnt(" #n ")" ::: "memory")
#define PG8_WAIT_L(n) asm volatile("s_waitcnt lgkmcnt(" #n ")" ::: "memory")
#define PG8_BAR __builtin_amdgcn_s_barrier()
#define PG8_SCHED __builtin_amdgcn_sched_barrier(0)
    Unit cur, nxt; int ui = 0;
    if (!S.next(0, cur)) return;
    f32x4 acc[2][2][4][2];
#pragma unroll
    for (int a = 0; a < 2; ++a)
#pragma unroll
        for (int b = 0; b < 2; ++b)
#pragma unroll
            for (int m = 0; m < 4; ++m)
#pragma unroll
                for (int n = 0; n < 2; ++n) acc[a][b][m][n] = (f32x4){0.f, 0.f, 0.f, 0.f};
    bf16x8 At[4][2], B0[2][2], B1[2][2];
    const char* cA = (const char*)g.A + (size_t)cur.pm * tstepA; const char* cB = (const char*)g.Bt + (size_t)cur.pn * tstepB;
    PG8_STAGE(PG8_SB(0, 0), cB, voffB); PG8_STAGE(PG8_SB(0, 1), cB + hstepB, voffB); PG8_STAGE(PG8_SA(0, 0), cA, voffA); PG8_STAGE(PG8_SA(0, 1), cA + hstepA, voffA);
    if (wr == 1) PG8_BAR;
    PG8_WAIT_V(2); PG8_BAR;
    PG8_STAGE(PG8_SB(1, 0), cB + kstep, voffB); PG8_STAGE(PG8_SA(1, 0), cA + kstep, voffA); PG8_STAGE(PG8_SB(1, 1), cB + hstepB + kstep, voffB);
    PG8_WAIT_V(6); PG8_BAR;
    for (;;) {
        const bool has_next = S.next(ui + 1, nxt);
        const char* nA = has_next ? (const char*)g.A + (size_t)nxt.pm * tstepA : cA; const char* nB = has_next ? (const char*)g.Bt + (size_t)nxt.pn * tstepB : cB;
        for (int t = 0; t < nt; t += 2) {
            const bool last = (t == nt - 2);
            const char* a1 = cA + (size_t)(t + 1) * kstep;
            const char* a2 = last ? nA : cA + (size_t)(t + 2) * kstep; const char* b2 = last ? nB : cB + (size_t)(t + 2) * kstep;
            const char* a3 = a2 + kstep; const char* b3 = b2 + kstep;
            PG8_LDB(B0, 0, 0); PG8_LDB(B1, 0, 1); PG8_SCHED; PG8_LDA(At, 0, 0); PG8_STAGE(PG8_SA(1, 1), a1 + hstepA, voffA);
            PG8_WAIT_V(8); PG8_WAIT_L(0); PG8_BAR; PG8_MMA(0, 0, At, B0); PG8_MMA(0, 1, At, B1); PG8_BAR; PG8_SCHED;
            PG8_LDA(At, 0, 1); PG8_STAGE(PG8_SB(0, 0), b2, voffB); PG8_STAGE(PG8_SB(0, 1), b2 + hstepB, voffB); PG8_STAGE(PG8_SA(0, 0), a2, voffA);
            PG8_WAIT_V(8); PG8_WAIT_L(0); PG8_BAR; PG8_MMA(1, 0, At, B0); PG8_MMA(1, 1, At, B1); PG8_BAR; PG8_SCHED;
            PG8_LDB(B0, 1, 0); PG8_LDB(B1, 1, 1); PG8_SCHED; PG8_LDA(At, 1, 0); PG8_STAGE(PG8_SA(0, 1), a2 + hstepA, voffA);
            PG8_WAIT_V(8); PG8_WAIT_L(0); PG8_BAR; PG8_MMA(0, 0, At, B0); PG8_MMA(0, 1, At, B1); PG8_BAR; PG8_SCHED;
            PG8_LDA(At, 1, 1); PG8_STAGE(PG8_SB(1, 0), b3, voffB); PG8_STAGE(PG8_SB(1, 1), b3 + hstepB, voffB); PG8_STAGE(PG8_SA(1, 0), a3, voffA);
            PG8_WAIT_V(8); PG8_WAIT_L(0); PG8_BAR; PG8_MMA(1, 0, At, B0); PG8_MMA(1, 1, At, B1); PG8_BAR; PG8_SCHED;
        }
        if (wr == 0) PG8_BAR;
        E(acc, cur, wr, wc, fr, fq);
        if (!has_next) break;
#pragma unroll
        for (int a = 0; a < 2; ++a)
#pragma unroll
            for (int b = 0; b < 2; ++b)
#pragma unroll
                for (int m = 0; m < 4; ++m)
#pragma unroll
                    for (int n = 0; n < 2; ++n) acc[a][b][m][n] = (f32x4){0.f, 0.f, 0.f, 0.f};
        cur = nxt; cA = nA; cB = nB; ++ui;
        if (wr == 1) PG8_BAR;
    }
    PG8_WAIT_V(0);
    PG8_BAR;
#undef PG8_SA
#undef PG8_SB
#undef PG8_STAGE
#undef PG8_LDA
#undef PG8_LDB
#undef PG8_MMA
#undef PG8_WAIT_V
#undef PG8_WAIT_L
#undef PG8_BAR
#undef PG8_SCHED
}
}
using pg8::Unit;
typedef const f32x4 (&AccRef)[2][2][4][2];

struct EpiGU {
    const float* ss; bf16_t* H;
    __device__ __forceinline__ void operator()(AccRef acc, const Unit& u, int wr, int wc, int, int) const { const int lane_ = vlane(); const int fr = lane_ & 15, fq = lane_ >> 4;
#pragma unroll
        for (int ai = 0; ai < 2; ++ai)
#pragma unroll
            for (int m = 0; m < 4; ++m) {
                const int row = u.pm * 256 + ai * 128 + wr * 64 + m * 16 + fr;
                asm volatile("" ::: "memory");
                const float r = rs16(ss, row);
                const f32x4 g0 = acc[ai][0][m][0] * r, g1 = acc[ai][0][m][1] * r, v0 = acc[ai][1][m][0] * r, v1 = acc[ai][1][m][1] * r;
                u32x4 w;
                w.x = cvt_pk_bf16(g0.x * sigmoidf_(g0.x) * v0.x, g0.y * sigmoidf_(g0.y) * v0.y); w.y = cvt_pk_bf16(g0.z * sigmoidf_(g0.z) * v0.z, g0.w * sigmoidf_(g0.w) * v0.w);
                w.z = cvt_pk_bf16(g1.x * sigmoidf_(g1.x) * v1.x, g1.y * sigmoidf_(g1.y) * v1.y); w.w = cvt_pk_bf16(g1.z * sigmoidf_(g1.z) * v1.z, g1.w * sigmoidf_(g1.w) * v1.w);
                *(u32x4*)(H + (size_t)row * FF + u.pn * 128 + wc * 32 + fq * 8) = w;
            }
    }
};
struct EpiRes {
    const float* Xin; float* X; bf16_t* xb; float* ssOut; float alpha;
    __device__ __forceinline__ void operator()(AccRef acc, const Unit& u, int wr, int wc, int, int) const { const int lane_ = vlane(); const int fr = lane_ & 15, fq = lane_ >> 4;
#pragma unroll
        for (int ai = 0; ai < 2; ++ai)
#pragma unroll
            for (int m = 0; m < 4; ++m) {
                const int row = u.pm * 256 + ai * 128 + wr * 64 + m * 16 + fr;
                asm volatile("" ::: "memory");
                float sq = 0.f;
#pragma unroll
                for (int bj = 0; bj < 2; ++bj) {
                    const size_t off = (size_t)row * D + u.pn * 256 + bj * 128 + wc * 32 + fq * 8;
                    f32x4 x0 = *(const f32x4*)(Xin + off), x1 = *(const f32x4*)(Xin + off + 4);
                    x0 += acc[ai][bj][m][0] * alpha; x1 += acc[ai][bj][m][1] * alpha;
                    *(f32x4*)(X + off) = x0; *(f32x4*)(X + off + 4) = x1;
                    sq += dot4(x0) + dot4(x1);
                    u32x4 w; w.x = cvt_pk_bf16(x0.x, x0.y); w.y = cvt_pk_bf16(x0.z, x0.w); w.z = cvt_pk_bf16(x1.x, x1.y); w.w = cvt_pk_bf16(x1.z, x1.w);
                    *(u32x4*)(xb + off) = w;
                }
                sq += __shfl_xor(sq, 16); sq += __shfl_xor(sq, 32);
                if (fq == 0) ssOut[(size_t)row * 16 + u.pn * 4 + wc] = sq;
            }
    }
};
struct EpiGate {
    float* X; const float* ssIn; bf16_t* ppxb; float* ssOut; float gsc;
    __device__ __forceinline__ void operator()(AccRef acc, const Unit& u, int wr, int wc, int, int) const { const int lane_ = vlane(); const int fr = lane_ & 15, fq = lane_ >> 4;
#pragma unroll
        for (int ai = 0; ai < 2; ++ai)
#pragma unroll
            for (int m = 0; m < 4; ++m) {
                const int row = u.pm * 256 + ai * 128 + wr * 64 + m * 16 + fr;
                asm volatile("" ::: "memory");
                const float r = rs16(ssIn, row);
                float sq = 0.f;
#pragma unroll
                for (int bj = 0; bj < 2; ++bj) {
                    const size_t off = (size_t)row * D + u.pn * 256 + bj * 128 + wc * 32 + fq * 8;
                    f32x4 x0 = *(const f32x4*)(X + off), x1 = *(const f32x4*)(X + off + 4);
                    const u32x4 pp = *(const u32x4*)(ppxb + off); const float gs = gsc;
                    const f32x4 a0 = acc[ai][bj][m][0] * r, a1 = acc[ai][bj][m][1] * r;
                    x0.x += sigmoidf_(a0.x) * (bf_lo(pp.x) * gs); x0.y += sigmoidf_(a0.y) * (bf_hi(pp.x) * gs); x0.z += sigmoidf_(a0.z) * (bf_lo(pp.y) * gs); x0.w += sigmoidf_(a0.w) * (bf_hi(pp.y) * gs);
                    x1.x += sigmoidf_(a1.x) * (bf_lo(pp.z) * gs); x1.y += sigmoidf_(a1.y) * (bf_hi(pp.z) * gs); x1.z += sigmoidf_(a1.z) * (bf_lo(pp.w) * gs); x1.w += sigmoidf_(a1.w) * (bf_hi(pp.w) * gs);
                    *(f32x4*)(X + off) = x0; *(f32x4*)(X + off + 4) = x1;
                    sq += dot4(x0) + dot4(x1);
                    u32x4 w; w.x = cvt_pk_bf16(x0.x, x0.y); w.y = cvt_pk_bf16(x0.z, x0.w); w.z = cvt_pk_bf16(x1.x, x1.y); w.w = cvt_pk_bf16(x1.z, x1.w);
                    *(u32x4*)(ppxb + off) = w;
                }
                sq += __shfl_xor(sq, 16); sq += __shfl_xor(sq, 32);
                if (fq == 0) ssOut[(size_t)row * 16 + u.pn * 4 + wc] = sq;
            }
    }
};
__device__ __forceinline__ void rope_rot(f32x4& v0, f32x4& v1, const float* cs) {
    const f32x4 c = *(const f32x4*)cs, s = *(const f32x4*)(cs + 4);
    const f32x4 a = v0 * c - v1 * s, b = v1 * c + v0 * s; v0 = a; v1 = b;
}
__device__ __forceinline__ void vstore1(unsigned char* vf, int vhead, int dd, int b, int ppos, bf16_t val);
struct EpiIn {
    const float* ss; unsigned char* ws; float* mst; const float* cs64; const float* cs32;
    __device__ __forceinline__ void operator()(AccRef acc, const Unit& u, int wr, int wc, int, int) const { const int lane_ = vlane(); const int fr = lane_ & 15, fq = lane_ >> 4;
#pragma unroll
        for (int ai = 0; ai < 2; ++ai)
#pragma unroll
            for (int m = 0; m < 4; ++m) {
                const int row = u.pm * 256 + ai * 128 + wr * 64 + m * 16 + fr;
                asm volatile("" ::: "memory");
                const float r = rs16(ss, row);
                const int pos = row & (T - 1), b = row >> 11;
                float sq = 0.f;
#pragma unroll
                for (int bj = 0; bj < 2; ++bj) {
                    const int gcol = u.pn * 256 + bj * 128 + wc * 32;
                    f32x4 v0 = acc[ai][bj][m][0] * r, v1 = acc[ai][bj][m][1] * r;
                    const bool r64 = (gcol >= 512 && gcol < 896) || (gcol >= 1024 && gcol < 1536);
                    if (r64) rope_rot(v0, v1, cs64 + ((size_t)pos * 8 + 4 * ((gcol >> 5) & 1) + fq) * 8);
                    if (gcol == 1920) rope_rot(v0, v1, cs32 + ((size_t)pos * 4 + fq) * 8);
                    if (u.pn == 6 || (u.pn == 7 && bj == 0)) sq += dot4(v0) + dot4(v1);
                    u32x4 w; w.x = cvt_pk_bf16(v0.x, v0.y); w.y = cvt_pk_bf16(v0.z, v0.w); w.z = cvt_pk_bf16(v1.x, v1.y); w.w = cvt_pk_bf16(v1.z, v1.w);
                    const int c8 = ((gcol & 63) >> 3) + fq;
                    const size_t frag = (size_t)(c8 >> 1) * 1024 + (size_t)((pos & 31) + 32 * (c8 & 1)) * 16;
                    const size_t rec = ((size_t)b * 64 + (pos >> 5)) * 4096;
                    if (gcol < 256) *(u32x4*)(ws + OFF_ZQ + ((size_t)row * ZQLD + gcol + fq * 8) * 2) = w;
                    else if (gcol < 512) *(u32x4*)(ws + OFF_KF + (size_t)((gcol - 256) >> 6) * HEADB + rec + frag) = w;
                    else if (gcol < 768) *(u32x4*)(ws + OFF_ZQ + ((size_t)row * ZQLD + (gcol - 256) + fq * 8) * 2) = w;
                    else if (gcol < 896) *(u32x4*)(ws + OFF_KF + (size_t)(4 + ((gcol - 768) >> 6)) * HEADB + rec + frag) = w;
                    else if (gcol < 1024) {
                        const int dd0 = (gcol - 896) + fq * 8; const unsigned ww[4] = {w.x, w.y, w.z, w.w};
#pragma unroll
                        for (int e = 0; e < 8; ++e) vstore1(ws + OFF_VT, 4 + (dd0 >> 6), (dd0 & 63) + e, b, pos, (bf16_t)((e & 1) ? (ww[e >> 1] >> 16) : (ww[e >> 1] & 0xffffu)));
                    }
                    else if (gcol < 1280) *(u32x4*)(ws + OFF_ZQ + ((size_t)row * ZQLD + (gcol - 512) + fq * 8) * 2) = w;
                    else if (gcol < 1536) {
                        const int hd = (gcol - 1280) >> 6;
                        *(u32x4*)(ws + OFF_KF + (size_t)(6 + hd) * HEADB + rec + frag) = w;
                        const int p4 = (pos & 3) * 512 + (pos >> 2), p16 = (pos & 15) * 128 + (pos >> 4);
                        *(u32x4*)(ws + OFF_KF + (size_t)(10 + hd) * HEADB + ((size_t)b * 64 + (p4 >> 5)) * 4096 + (size_t)(c8 >> 1) * 1024 + (size_t)((p4 & 31) + 32 * (c8 & 1)) * 16) = w;
                        *(u32x4*)(ws + OFF_KF + (size_t)(14 + hd) * HEADB + ((size_t)b * 64 + (p16 >> 5)) * 4096 + (size_t)(c8 >> 1) * 1024 + (size_t)((p16 & 31) + 32 * (c8 & 1)) * 16) = w;
                    }
                    else if (gcol < 1920) *(u32x4*)(ws + OFF_ZL + ((size_t)row * ZLLD + (gcol - 1536) + fq * 8) * 2) = w;
                    else if (gcol == 1920) *(u32x4*)(ws + OFF_KPE + ((size_t)b * 64 + (pos >> 5)) * 2048 + (size_t)(fq >> 1) * 1024 + (size_t)((pos & 31) + 32 * (fq & 1)) * 16) = w;
                }
                if (u.pn >= 6) {
                    sq += __shfl_xor(sq, 16); sq += __shfl_xor(sq, 32);
                    if (fq == 0) mst[(size_t)row * 8 + (u.pn - 6) * 4 + wc] = sq;
                }
            }
    }
};
__device__ __forceinline__ void vstore8(unsigned char* vf, int vhead, int dd, int tok0, u32x4 w) {
    const int b = tok0 >> 11, pos0 = tok0 & (T - 1), idx0 = pos0 & 31;
    unsigned char* p = vf + (size_t)vhead * HEADB + ((size_t)b * 64 + (pos0 >> 5)) * 4096 + (size_t)((dd >> 5) * 2 + (idx0 >> 4)) * 1024 + (size_t)(dd & 31) * 16 + ((idx0 >> 3) & 1) * 8;
    u32x2 lo; lo.x = w.x; lo.y = w.y; u32x2 hi; hi.x = w.z; hi.y = w.w;
    *(u32x2*)p = lo; *(u32x2*)(p + 512) = hi;
}
__device__ __forceinline__ void vstore1(unsigned char* vf, int vhead, int dd, int b, int ppos, bf16_t val) {
    const int idx = ppos & 31, r16 = idx & 15;
    unsigned char* p = vf + (size_t)vhead * HEADB + ((size_t)b * 64 + (ppos >> 5)) * 4096 + (size_t)((dd >> 5) * 2 + (idx >> 4)) * 1024 + (size_t)((dd & 31) + 32 * ((r16 >> 2) & 1)) * 16 + (r16 >> 3) * 8 + (r16 & 3) * 2;
    *(bf16_t*)p = val;
}
struct EpiVT {
    const float* ss; unsigned char* vf;
    __device__ __forceinline__ void operator()(AccRef acc, const Unit& u, int wr, int wc, int, int) const { const int lane_ = vlane(); const int fr = lane_ & 15, fq = lane_ >> 4;
#pragma unroll
        for (int bj = 0; bj < 2; ++bj) {
            const int tok0 = u.pn * 256 + bj * 128 + wc * 32 + fq * 8;
            float rs[8];
#pragma unroll
            for (int e = 0; e < 8; ++e) rs[e] = rs16(ss, tok0 + e);
#pragma unroll
            for (int ai = 0; ai < 2; ++ai) {
                const int rbase = u.pm * 256 + ai * 128;
                const bool dil = rbase >= 256;
#pragma unroll
                for (int m = 0; m < 4; ++m) {
                    const int row = rbase + wr * 64 + m * 16 + fr;
                    asm volatile("" ::: "memory");
                    const f32x4 a0 = acc[ai][bj][m][0], a1 = acc[ai][bj][m][1];
                    u32x4 w; w.x = cvt_pk_bf16(a0.x * rs[0], a0.y * rs[1]); w.y = cvt_pk_bf16(a0.z * rs[2], a0.w * rs[3]);
                    w.z = cvt_pk_bf16(a1.x * rs[4], a1.y * rs[5]); w.w = cvt_pk_bf16(a1.z * rs[6], a1.w * rs[7]);
                    const int vhead = (row >> 6) + (dil ? 2 : 0), dd = row & 63;
                    vstore8(vf, vhead, dd, tok0, w);
                    if (dil) {
                        const int b = tok0 >> 11, t0 = tok0 & (T - 1);
                        const unsigned ww[4] = {w.x, w.y, w.z, w.w};
#pragma unroll
                        for (int e = 0; e < 8; ++e) {
                            const int t = t0 + e; const bf16_t val = (bf16_t)((e & 1) ? (ww[e >> 1] >> 16) : (ww[e >> 1] & 0xffffu));
                            vstore1(vf, vhead + 4, dd, b, (t & 3) * 512 + (t >> 2), val);
                            vstore1(vf, vhead + 8, dd, b, (t & 15) * 128 + (t >> 4), val);
                        }
                    }
                }
            }
        }
    }
};
struct EpiQ {
    const float* mst; bf16_t* qm; const float* cs32;
    __device__ __forceinline__ void operator()(AccRef acc, const Unit& u, int wr, int wc, int, int) const { const int lane_ = vlane(); const int fr = lane_ & 15, fq = lane_ >> 4;
#pragma unroll
        for (int ai = 0; ai < 2; ++ai)
#pragma unroll
            for (int m = 0; m < 4; ++m) {
                const int row = u.pm * 256 + ai * 128 + wr * 64 + m * 16 + fr;
                asm volatile("" ::: "memory");
                const f32x4 st = *(const f32x4*)(mst + (size_t)row * 8);
                const float r = rsqrtf(sum4(st) * (1.0f / 256.0f) + EPS);
                const int pos = row & (T - 1);
#pragma unroll
                for (int bj = 0; bj < 2; ++bj) {
                    const int gcol = u.pn * 256 + bj * 128 + wc * 32;
                    if (gcol >= 384) continue;
                    f32x4 v0 = acc[ai][bj][m][0] * r, v1 = acc[ai][bj][m][1] * r;
                    if (((gcol >> 5) % 3) == 2) rope_rot(v0, v1, cs32 + ((size_t)pos * 4 + fq) * 8);
                    u32x4 w; w.x = cvt_pk_bf16(v0.x, v0.y); w.y = cvt_pk_bf16(v0.z, v0.w); w.z = cvt_pk_bf16(v1.x, v1.y); w.w = cvt_pk_bf16(v1.z, v1.w);
                    *(u32x4*)(qm + (size_t)row * QLD + gcol + fq * 8) = w;
                }
            }
    }
};
struct EpiK {
    const float* mst; unsigned char* ws;
    __device__ __forceinline__ void operator()(AccRef acc, const Unit& u, int wr, int wc, int, int) const { const int lane_ = vlane(); const int fr = lane_ & 15, fq = lane_ >> 4;
#pragma unroll
        for (int ai = 0; ai < 2; ++ai)
#pragma unroll
            for (int m = 0; m < 4; ++m) {
                const int row = u.pm * 256 + ai * 128 + wr * 64 + m * 16 + fr;
                asm volatile("" ::: "memory");
                const f32x4 st = *(const f32x4*)(mst + (size_t)row * 8 + 4);
                const float r = rsqrtf(sum4(st) * (1.0f / 128.0f) + EPS);
#pragma unroll
                for (int bj = 0; bj < 2; ++bj) {
                    const f32x4 v0 = acc[ai][bj][m][0] * r, v1 = acc[ai][bj][m][1] * r;
                    u32x4 w; w.x = cvt_pk_bf16(v0.x, v0.y); w.y = cvt_pk_bf16(v0.z, v0.w); w.z = cvt_pk_bf16(v1.x, v1.y); w.w = cvt_pk_bf16(v1.z, v1.w);
                    const int col0 = bj * 128 + wc * 32, c8 = ((col0 & 63) >> 3) + fq, pos = row & (T - 1);
                    *(u32x4*)(ws + OFF_KF + (size_t)(18 + (col0 >> 6)) * HEADB + ((size_t)(row >> 11) * 64 + (pos >> 5)) * 4096 + (size_t)(c8 >> 1) * 1024 + (size_t)((pos & 31) + 32 * (c8 & 1)) * 16) = w;
                }
            }
    }
};
struct EpiVTM {
    const float* mst; unsigned char* vf;
    __device__ __forceinline__ void operator()(AccRef acc, const Unit& u, int wr, int wc, int, int) const { const int lane_ = vlane(); const int fr = lane_ & 15, fq = lane_ >> 4;
#pragma unroll
        for (int bj = 0; bj < 2; ++bj) {
            const int tok0 = u.pn * 256 + bj * 128 + wc * 32 + fq * 8;
            float rs[8];
#pragma unroll
            for (int e = 0; e < 8; ++e) { const f32x4 st = *(const f32x4*)(mst + (size_t)(tok0 + e) * 8 + 4); rs[e] = rsqrtf(sum4(st) * (1.0f / 128.0f) + EPS); }
#pragma unroll
            for (int ai = 0; ai < 2; ++ai)
#pragma unroll
                for (int m = 0; m < 4; ++m) {
                    const int row = ai * 128 + wr * 64 + m * 16 + fr;
                    asm volatile("" ::: "memory");
                    const f32x4 a0 = acc[ai][bj][m][0], a1 = acc[ai][bj][m][1];
                    u32x4 w; w.x = cvt_pk_bf16(a0.x * rs[0], a0.y * rs[1]); w.y = cvt_pk_bf16(a0.z * rs[2], a0.w * rs[3]);
                    w.z = cvt_pk_bf16(a1.x * rs[4], a1.y * rs[5]); w.w = cvt_pk_bf16(a1.z * rs[6], a1.w * rs[7]);
                    vstore8(vf, 18 + (row >> 6), row & 63, tok0, w);
                }
        }
    }
};
struct EpiPP {
    bf16_t* O;
    __device__ __forceinline__ void operator()(AccRef acc, const Unit& u, int wr, int wc, int, int) const { const int lane_ = vlane(); const int fr = lane_ & 15, fq = lane_ >> 4;
#pragma unroll
        for (int ai = 0; ai < 2; ++ai)
#pragma unroll
            for (int m = 0; m < 4; ++m) {
                const int row = u.pm * 256 + ai * 128 + wr * 64 + m * 16 + fr;
                asm volatile("" ::: "memory");
#pragma unroll
                for (int bj = 0; bj < 2; ++bj) {
                    const f32x4 v0 = acc[ai][bj][m][0], v1 = acc[ai][bj][m][1];
                    u32x4 w; w.x = cvt_pk_bf16(v0.x, v0.y); w.y = cvt_pk_bf16(v0.z, v0.w); w.z = cvt_pk_bf16(v1.x, v1.y); w.w = cvt_pk_bf16(v1.z, v1.w);
                    *(u32x4*)(O + (size_t)row * D + u.pn * 256 + bj * 128 + wc * 32 + fq * 8) = w;
                }
            }
    }
};

template <class Epi>
__device__ __forceinline__ void run_gemm(int wv, LAS unsigned char* lds, const bf16_t* A, int lda, int rows, const bf16_t* Bt, int ldb, int cols, int K, int cshift, const Epi& E) {
    pg8::Gemm g{A, Bt, lda, ldb, K};
    pg8::StaticOrder S; const int G_ = lgrid(); S.init(rows, cols, G_, (lbid() + cshift) % G_);
    pg8::gemm_phase<Epi>(lds, g, S, E, wv);
}

__device__ __forceinline__ int p64(int d) { return d < 32 ? 8 * (d >> 2) + (d & 3) : 8 * ((d - 32) >> 2) + 4 + (d & 3); }
__device__ __forceinline__ int p32(int d) { return d < 16 ? 8 * (d >> 2) + (d & 3) : 8 * ((d - 16) >> 2) + 4 + (d & 3); }
__device__ __forceinline__ int maprow(int mapid, int c) {
    switch (mapid) {
        case 0: return c;
        case 1: return (c >> 7) * 256 + (c & 127);
        case 2: return (c >> 7) * 256 + 128 + (c & 127);
        case 3: {
            if (c < 768) return c < 512 ? c : 2048 + (c - 512);
            c -= 768;
            if (c < 512) return c < 384 ? 512 + (c >> 6) * 64 + p64(c & 63) : 896 + (c - 384);
            c -= 512;
            if (c < 768) return c < 512 ? 1024 + (c >> 6) * 64 + p64(c & 63) : 2048 + 256 + (c - 512);
            c -= 768;
            if (c < 256) return 1536 + c;
            if (c < 384) return 1792 + (c - 256);
            return 1920 + p32(c - 384);
        }
        case 4: { const int h = c / 96, e = c % 96; return e < 64 ? 96 * h + e : 96 * h + 64 + p32(e - 64); }
        default: { const int h = c >> 7, e = c & 127; return e < 64 ? 64 * h + e : 256 + 64 * h + (e - 64); }
    }
}
__device__ __forceinline__ void tr_item(const float* W, int K, int N, const float* gain, bf16_t* dst, int mapid, int item, LAS float* s, int wv) {
    const int tid = ltid(wv);
    const int ncb = (N + 255) >> 8, kb = item / ncb, cb = item % ncb, k0 = kb * 64, c0 = cb * 256;
#pragma unroll
    for (int i = 0; i < 8; ++i) {
        const int kk = i * 8 + (tid >> 6), col = (tid & 63) * 4;
        f32x4 v = (f32x4){0.f, 0.f, 0.f, 0.f};
        if (c0 + col < N) v = *(const f32x4*)(W + (size_t)(k0 + kk) * N + c0 + col);
        if (gain) v *= gain[k0 + kk];
        *(LAS f32x4*)(s + kk * 260 + col) = v;
    }
    __syncthreads();
    const int cc = tid & 255, kh = tid >> 8, c = c0 + cc;
    if (c < N) {
        const int drow = maprow(mapid, c);
        bf16_t* o = dst + (size_t)drow * K + k0 + kh * 32;
#pragma unroll
        for (int q = 0; q < 4; ++q) {
            const LAS float* sp = s + (kh * 32 + q * 8) * 260 + cc;
            u32x4 w; w.x = cvt_pk_bf16(sp[0], sp[260]); w.y = cvt_pk_bf16(sp[2 * 260], sp[3 * 260]); w.z = cvt_pk_bf16(sp[4 * 260], sp[5 * 260]); w.w = cvt_pk_bf16(sp[6 * 260], sp[7 * 260]);
            *(u32x4*)(o + q * 8) = w;
        }
    }
    __syncthreads();
}

struct Args { const float* in[24]; float* out; unsigned char* ws; int ph_lo, ph_hi, coop, pad; };
typedef const __attribute__((address_space(4))) Args* KA;
__device__ __forceinline__ KA kargs() { KA p = (KA)__builtin_amdgcn_kernarg_segment_ptr(); asm volatile("" : "+s"(p)); return p; }

__device__ __forceinline__ void zero_rows(bf16_t* base, int row0, int nrows, int K, int gt, int ngt) {
    const size_t n16 = (size_t)nrows * K / 8; u32x4* p = (u32x4*)(base + (size_t)row0 * K);
    for (size_t i = gt; i < n16; i += ngt) p[i] = (u32x4){0u, 0u, 0u, 0u};
}

__device__ __forceinline__ void prologue(KA a, LAS unsigned char* lds, int wv) {
    LAS float* s = (LAS float*)lds;
    const int G = lgrid(), bid = lbid(), tid = ltid(wv);
    bf16_t* Wbase = (bf16_t*)(a->ws + OFF_W);
#if PRO_PARTS & 1
    constexpr int I_FFN = 16 * 11, I_DN = 44 * 4, I_IN = 16 * 10, I_UQ = 4 * 2, I_UKV = 2 * 2, I_O = 16 * 4, I_PP = 4 * 4;
    constexpr int I_LAYER = 4 * I_FFN + 2 * I_DN + I_IN + I_UQ + I_UKV + 2 * I_O + I_PP;
    for (int it = bid; it < I_LAYER * DEPTH; it += G) {
        const int l = it / I_LAYER; int r = it % I_LAYER;
        int sel = 0;
        if (r >= I_FFN) { r -= I_FFN; sel = 1;
        if (r >= I_FFN) { r -= I_FFN; sel = 2;
        if (r >= I_DN) { r -= I_DN; sel = 3;
        if (r >= I_IN) { r -= I_IN; sel = 4;
        if (r >= I_UQ) { r -= I_UQ; sel = 5;
        if (r >= I_UKV) { r -= I_UKV; sel = 6;
        if (r >= I_O) { r -= I_O; sel = 7;
        if (r >= I_FFN) { r -= I_FFN; sel = 8;
        if (r >= I_FFN) { r -= I_FFN; sel = 9;
        if (r >= I_DN) { r -= I_DN; sel = 10;
        if (r >= I_O) { r -= I_O; sel = 11; } } } } } } } } } } }
        const float* W0; const float* g0 = nullptr; int K, N, mapid; size_t doff;
        switch (sel) {
            case 0: W0 = a->in[3]; g0 = a->in[2]; K = D; N = FF; doff = WL_GU1; mapid = 1; break;
            case 1: W0 = a->in[4]; g0 = a->in[2]; K = D; N = FF; doff = WL_GU1; mapid = 2; break;
            case 2: W0 = a->in[5]; K = FF; N = D; doff = WL_D1; mapid = 0; break;
            case 3: W0 = a->in[7]; g0 = a->in[6]; K = D; N = 2464; doff = WL_IN; mapid = 3; break;
            case 4: W0 = a->in[11]; g0 = a->in[10]; K = 256; N = 384; doff = WL_UQ; mapid = 4; break;
            case 5: W0 = a->in[13]; g0 = a->in[12]; K = 128; N = 512; doff = WL_UKV; mapid = 5; break;
            case 6: W0 = a->in[15]; g0 = a->in[14]; K = D; N = D; doff = WL_O; mapid = 0; break;
            case 7: W0 = a->in[17]; g0 = a->in[16]; K = D; N = FF; doff = WL_GU2; mapid = 1; break;
            case 8: W0 = a->in[18]; g0 = a->in[16]; K = D; N = FF; doff = WL_GU2; mapid = 2; break;
            case 9: W0 = a->in[19]; K = FF; N = D; doff = WL_D2; mapid = 0; break;
            case 10: W0 = a->in[21]; g0 = a->in[20]; K = D; N = D; doff = WL_PG; mapid = 0; break;
            default: W0 = a->in[22]; K = PLE; N = D; doff = WL_PP; mapid = 0; break;
        }
        const float* W = W0 + (size_t)l * K * N;
        const float* gain = g0 ? g0 + (size_t)l * K : nullptr;
        tr_item(W, K, N, gain, Wbase + (size_t)l * WL_SIZE + doff, mapid, r, s, wv);
    }
#endif
    const int gt = bid * 512 + tid, ngt = G * 512;
    for (int l = 0; l < DEPTH; ++l) {
        bf16_t* WL = Wbase + (size_t)l * WL_SIZE;
        zero_rows(WL + WL_IN, 1952, 96, D, gt, ngt);
        zero_rows(WL + WL_UQ, 384, 128, 256, gt, ngt);
    }
#if PRO_PARTS & 2
    float* cs64 = (float*)(a->ws + OFF_CS64); float* cs32 = (float*)(a->ws + OFF_CS32);
    for (int i = gt; i < T * 32; i += ngt) {
        const int pos = i >> 5, j = i & 31;
        const float inv = __builtin_amdgcn_exp2f(-(float)j * (13.287712379549449f / 32.0f)); const float ang = (float)pos * inv;
        const float rev = ang * 0.15915494309189535f, fr_ = rev - floorf(rev);
        float* p = cs64 + ((size_t)pos * 8 + (j >> 2)) * 8 + (j & 3);
        p[0] = __builtin_amdgcn_cosf(fr_); p[4] = __builtin_amdgcn_sinf(fr_);
    }
    for (int i = gt; i < T * 16; i += ngt) {
        const int pos = i >> 4, j = i & 15;
        const float inv = __builtin_amdgcn_exp2f(-(float)j * (13.287712379549449f / 16.0f)); const float ang = (float)pos * inv;
        const float rev = ang * 0.15915494309189535f, fr_ = rev - floorf(rev);
        float* p = cs32 + ((size_t)pos * 4 + (j >> 2)) * 8 + (j & 3);
        p[0] = __builtin_amdgcn_cosf(fr_); p[4] = __builtin_amdgcn_sinf(fr_);
    }
#endif
#if PRO_PARTS & 4
    const int lane = tid & 63, gw = bid * 8 + (tid >> 6), ngw = G * 8;
    bf16_t* xb = (bf16_t*)(a->ws + OFF_XBA); float* ss = (float*)(a->ws + OFF_SSA);
    for (int row = gw; row < M; row += ngw) {
        const f32x4* xr = (const f32x4*)(a->in[0] + (size_t)row * D) + lane;
        float sq = 0.f;
#pragma unroll
        for (int j = 0; j < 4; ++j) {
            const f32x4 v = xr[64 * j]; sq += dot4(v);
            u32x2 w; w.x = cvt_pk_bf16(v.x, v.y); w.y = cvt_pk_bf16(v.z, v.w);
            *(u32x2*)(xb + (size_t)row * D + 256 * j + lane * 4) = w;
        }
#pragma unroll
        for (int o = 1; o < 64; o <<= 1) sq += __shfl_xor(sq, o);
        if (lane < 16) ss[(size_t)row * 16 + lane] = lane == 0 ? sq : 0.f;
    }
#endif
}

__device__ __forceinline__ void convert_p(KA a, int layer, int wv) {
    const f32x4* src = (const f32x4*)(a->in[1] + (size_t)layer * M * PLE); u32x2* dst = (u32x2*)(a->ws + OFF_VT);
    const size_t n = (size_t)M * PLE / 4;
    const int tid_ = ltid(wv), bid_ = lbid(), G_ = lgrid();
    for (size_t i = (size_t)bid_ * 512 + tid_; i < n; i += (size_t)G_ * 512) {
        const f32x4 v = src[i]; u32x2 w; w.x = cvt_pk_bf16(v.x, v.y); w.y = cvt_pk_bf16(v.z, v.w); dst[i] = w;
    }
}

__device__ __forceinline__ void final_norm(KA a, int wv) {
    const int tid_ = ltid(wv); const int lane = tid_ & 63, gw = lbid() * 8 + (tid_ >> 6), ngw = lgrid() * 8;
    const float* ss = (const float*)(a->ws + OFF_SSA);
    f32x4 g[4];
#pragma unroll
    for (int j = 0; j < 4; ++j) g[j] = ((const f32x4*)a->in[23])[64 * j + lane];
    for (int row = gw; row < M; row += ngw) {
        const float r = rs16(ss, row);
        f32x4* orow = (f32x4*)(a->out + (size_t)row * D) + lane;
#pragma unroll
        for (int j = 0; j < 4; ++j) orow[64 * j] = orow[64 * j] * r * g[j];
    }
}

struct AttnP { const unsigned char* ws; const float* nab; const float* sink; };

template <int MODE>
__device__ __forceinline__ void attn_unit(const AttnP& P0, int unit, LAS float* xch, const LAS float* nabl, int wv) {
    const unsigned char* ws = P0.ws; asm volatile("" : "+s"(ws));
    constexpr int NS = MODE == 0 ? 6 : 4;
    const int lane = vlane(), w = wv, qs = w >> 2, h = w & 3, ql = lane & 31, hh = lane >> 5;
    const int lane16 = lane * 16;
    const int b = unit >> 5, rem = unit & 31;
    int qt, T0 = 0, rr = 0, qmin, qmax;
    if (MODE == 1) { T0 = 512 * (rem >> 3); rr = 2 * (rem & 7) + qs; qt = T0 + rr + 16 * ql; qmin = T0 + rr; qmax = qmin + 496; }
    else { qmin = 64 * rem + 32 * qs; qt = qmin + ql; qmax = qmin + 31; }
    const size_t tokbase = (size_t)b * T;
    const bf16_t* qrow; int khead, group;
    if (MODE == 0) { qrow = (const bf16_t*)(ws + OFF_QM) + (tokbase + qt) * QLD + 96 * h; khead = 18 + h; group = 3; }
    else if (MODE == 1) { qrow = (const bf16_t*)(ws + OFF_ZQ) + (tokbase + qt) * ZQLD + 512 + 64 * h; khead = 6 + h; group = 2; }
    else if (MODE == 2) { qrow = (const bf16_t*)(ws + OFF_ZQ) + (tokbase + qt) * ZQLD + 64 * h; khead = h; group = 0; }
    else { qrow = (const bf16_t*)(ws + OFF_ZQ) + (tokbase + qt) * ZQLD + 256 + 64 * h; khead = 4 + (h >> 1); group = 1; }
    const unsigned char* kfb = ws + OFF_KF + (size_t)b * 64 * 4096 + lane16;
    const unsigned char* vfb = ws + OFF_VT + (size_t)b * 64 * 4096 + lane16;
    const unsigned char* kpe = ws + OFF_KPE + (size_t)b * 64 * 2048 + lane16;
    bf16x8 qf[NS];
#pragma unroll
    for (int s = 0; s < NS; ++s) qf[s] = *(const bf16x8*)(qrow + 16 * s + 8 * hh);
    const float sc = (MODE == 0 ? 0.10206207261596577f : 0.125f) * LOG2E;
    f32x16 o0, o1;
#pragma unroll
    for (int e = 0; e < 16; ++e) { o0[e] = 0.f; o1[e] = 0.f; }
    float mrun = -1e20f, lrun = 0.f;
    if (MODE == 3) { mrun = P0.sink[h] * LOG2E; lrun = hh == 0 ? 1.f : 0.f; }
    const int qcol = qt & 63;
    const int nseg = MODE == 1 ? 3 : 1;
    for (int seg = 0; seg < nseg; ++seg) {
        int ntile, kb0, kstr, vb0, win, hd = khead;
        if (MODE == 0) { ntile = 64; kb0 = 0; kstr = 1; vb0 = 0; win = 1 << 20; }
        else if (MODE == 2) { ntile = 16; kb0 = 64 * min(max(rem - 4, 0), 24); kstr = 1; vb0 = kb0; win = 0; }
        else if (MODE == 3) { ntile = 9; kb0 = qmin - 128; kstr = 1; vb0 = kb0; win = 128; }
        else {
            if (seg == 0) { ntile = 20; kb0 = T0 - 64; kstr = 1; vb0 = kb0; win = 64; }
            else if (seg == 1) { ntile = 8; const int us = (T0 >> 2) - 64, r4 = rr & 3; kb0 = 4 * us + r4; kstr = 4; vb0 = r4 * 512 + us; win = 256; hd = khead + 4; }
            else { ntile = 5; const int nst = (T0 >> 4) - 64; kb0 = 16 * nst + rr; kstr = 16; vb0 = rr * 128 + nst; win = 1024; hd = khead + 8; }
        }
        const int kstep = 32 * kstr;
        int tlo = 0, thi = ntile;
        if (MODE == 1 || MODE == 3) { tlo = kb0 < 0 ? (-kb0 + kstep - 1) / kstep : 0; thi = min(ntile, (T - kb0 + kstep - 1) / kstep); }
        const unsigned char* kfh = kfb + (size_t)hd * HEADB; const unsigned char* vfh = vfb + (size_t)hd * HEADB;
        bf16x8 kf[NS], vf[4];
        {
            const int pt = (vb0 >> 5) + tlo;
#pragma unroll
            for (int s = 0; s < NS; ++s) kf[s] = (MODE == 0 && s >= 4) ? *(const bf16x8*)(kpe + (size_t)pt * 2048 + (s - 4) * 1024) : *(const bf16x8*)(kfh + (size_t)pt * 4096 + s * 1024);
#pragma unroll
            for (int j = 0; j < 4; ++j) vf[j] = *(const bf16x8*)(vfh + (size_t)pt * 4096 + j * 1024);
        }
        if (qs && seg == 0) __builtin_amdgcn_s_sleep(DEPHASE / 2);
        for (int tau = tlo; tau < thi; ++tau) {
            const int kb = kb0 + kstep * tau;
            bf16x8 kn[NS], vn[4];
            {
                const int pt = (vb0 >> 5) + min(tau + 1, thi - 1);
#pragma unroll
                for (int s = 0; s < NS; ++s) kn[s] = (MODE == 0 && s >= 4) ? *(const bf16x8*)(kpe + (size_t)pt * 2048 + (s - 4) * 1024) : *(const bf16x8*)(kfh + (size_t)pt * 4096 + s * 1024);
#pragma unroll
                for (int j = 0; j < 4; ++j) vn[j] = *(const bf16x8*)(vfh + (size_t)pt * 4096 + j * 1024);
            }
            f32x16 sacc;
#pragma unroll
            for (int e = 0; e < 16; ++e) sacc[e] = 0.f;
#pragma unroll
            for (int s = 0; s < NS; ++s) sacc = __builtin_amdgcn_mfma_f32_32x32x16_bf16(kf[s], qf[s], sacc, 0, 0, 0);
            if (MODE == 2) {
                const int c0 = 32 * (tau & 1), wsx = min(max(qcol - 8, 0), 48);
                const int mb = c0 - wsx + 4 * hh;
                const int drow = (kb >> 6) - rem + 7;
                const LAS float* bp = nabl + (h * 15 + drow) * 31 + c0 - qcol + 15 + 4 * hh;
#pragma unroll
                for (int e = 0; e < 16; ++e) {
                    const int o = 8 * (e >> 2) + (e & 3);
                    const float v = sacc[e] * sc + bp[o];
                    sacc[e] = (unsigned)(mb + o) < 16u ? v : -1e30f;
                }
            } else if (MODE != 0) {
                const bool full = (kb + 31 * kstr - qmin <= win) && (qmax - kb <= win);
                if (!full) {
                    const int mb = kb - qt + win + 4 * hh * kstr;
#pragma unroll
                    for (int e = 0; e < 16; ++e) {
                        const int o = (8 * (e >> 2) + (e & 3)) * kstr;
                        sacc[e] = (unsigned)(mb + o) <= (unsigned)(2 * win) ? sacc[e] : -1e30f;
                    }
                }
            }
            float tmax = fmaxf(fmaxf(sacc[0], sacc[1]), fmaxf(sacc[2], sacc[3]));
#pragma unroll
            for (int e = 4; e < 16; e += 4) tmax = fmaxf(tmax, fmaxf(fmaxf(sacc[e], sacc[e + 1]), fmaxf(sacc[e + 2], sacc[e + 3])));
            tmax = fmaxf(tmax, __shfl_xor(tmax, 32));
            if (MODE != 2) tmax *= sc;
            const float mnew = fmaxf(mrun, tmax);
            const bool grow = mnew > mrun;
            const float alpha = __builtin_amdgcn_exp2f(mrun - mnew);
            mrun = mnew;
            float psum = 0.f;
#pragma unroll
            for (int e = 0; e < 16; ++e) {
                const float p = MODE == 2 ? __builtin_amdgcn_exp2f(sacc[e] - mnew) : __builtin_amdgcn_exp2f(__builtin_fmaf(sacc[e], sc, -mnew));
                sacc[e] = p; psum += p;
            }
            lrun = lrun * alpha + psum;
            if (__builtin_amdgcn_ballot_w64(grow) != 0ull) {
#pragma unroll
                for (int e = 0; e < 16; ++e) { o0[e] *= alpha; o1[e] *= alpha; }
            }
            bf16x8 pb[2];
#pragma unroll
            for (int t = 0; t < 2; ++t) {
                u32x4 v; v.x = cvt_pk_bf16(sacc[8 * t + 0], sacc[8 * t + 1]); v.y = cvt_pk_bf16(sacc[8 * t + 2], sacc[8 * t + 3]);
                v.z = cvt_pk_bf16(sacc[8 * t + 4], sacc[8 * t + 5]); v.w = cvt_pk_bf16(sacc[8 * t + 6], sacc[8 * t + 7]);
                pb[t] = __builtin_bit_cast(bf16x8, v);
            }
            o0 = __builtin_amdgcn_mfma_f32_32x32x16_bf16(vf[0], pb[0], o0, 0, 0, 0);
            o0 = __builtin_amdgcn_mfma_f32_32x32x16_bf16(vf[1], pb[1], o0, 0, 0, 0);
            o1 = __builtin_amdgcn_mfma_f32_32x32x16_bf16(vf[2], pb[0], o1, 0, 0, 0);
            o1 = __builtin_amdgcn_mfma_f32_32x32x16_bf16(vf[3], pb[1], o1, 0, 0, 0);
#pragma unroll
            for (int s = 0; s < NS; ++s) kf[s] = kn[s];
#pragma unroll
            for (int j = 0; j < 4; ++j) vf[j] = vn[j];
        }
    }
    lrun += __shfl_xor(lrun, 32);
    const float inv = 1.0f / lrun;
    float sq = 0.f;
#pragma unroll
    for (int e = 0; e < 16; ++e) { o0[e] *= inv; o1[e] *= inv; sq += o0[e] * o0[e] + o1[e] * o1[e]; }
    sq += __shfl_xor(sq, 32);
    if (hh == 0) xch[w * 32 + ql] = sq;
    __syncthreads();
    const float tot = (xch[(qs * 4 + 0) * 32 + ql] + xch[(qs * 4 + 1) * 32 + ql]) + (xch[(qs * 4 + 2) * 32 + ql] + xch[(qs * 4 + 3) * 32 + ql]);
    const float rg = rsqrtf(tot * (1.0f / 256.0f) + EPS);
    bf16_t* yrow = (bf16_t*)(ws + OFF_XBA) + (tokbase + qt) * D + group * 256 + h * 64 + 4 * hh;
#pragma unroll
    for (int j = 0; j < 4; ++j) {
        u32x2 w0; w0.x = cvt_pk_bf16(o0[4 * j] * rg, o0[4 * j + 1] * rg); w0.y = cvt_pk_bf16(o0[4 * j + 2] * rg, o0[4 * j + 3] * rg);
        u32x2 w1; w1.x = cvt_pk_bf16(o1[4 * j] * rg, o1[4 * j + 1] * rg); w1.y = cvt_pk_bf16(o1[4 * j + 2] * rg, o1[4 * j + 3] * rg);
        *(u32x2*)(yrow + 8 * j) = w0; *(u32x2*)(yrow + 32 + 8 * j) = w1;
    }
}

__device__ __forceinline__ void sm_pv(f32x16& sacc, f32x16& o0, f32x16& o1, float& mrun, float& lrun, const bf16x8 (&vf)[4], float sc) {
    float tmax = fmaxf(fmaxf(sacc[0], sacc[1]), fmaxf(sacc[2], sacc[3]));
#pragma unroll
    for (int e = 4; e < 16; e += 4) tmax = fmaxf(tmax, fmaxf(fmaxf(sacc[e], sacc[e + 1]), fmaxf(sacc[e + 2], sacc[e + 3])));
    tmax = xh_max(tmax) * sc;
    if (__builtin_amdgcn_ballot_w64(tmax - mrun > 11.541560327111707f) != 0ull) {
        const float mnew = fmaxf(mrun, tmax), alpha = __builtin_amdgcn_exp2f(mrun - mnew);
        mrun = mnew; lrun *= alpha;
#pragma unroll
        for (int e = 0; e < 16; ++e) { o0[e] *= alpha; o1[e] *= alpha; }
    }
    const float nm = -mrun;
    float psum = 0.f;
#pragma unroll
    for (int e = 0; e < 16; ++e) { const float p = __builtin_amdgcn_exp2f(__builtin_fmaf(sacc[e], sc, nm)); sacc[e] = p; psum += p; }
    lrun += psum;
    bf16x8 pb[2];
#pragma unroll
    for (int t = 0; t < 2; ++t) {
        u32x4 v; v.x = cvt_pk_bf16(sacc[8 * t + 0], sacc[8 * t + 1]); v.y = cvt_pk_bf16(sacc[8 * t + 2], sacc[8 * t + 3]);
        v.z = cvt_pk_bf16(sacc[8 * t + 4], sacc[8 * t + 5]); v.w = cvt_pk_bf16(sacc[8 * t + 6], sacc[8 * t + 7]);
        pb[t] = __builtin_bit_cast(bf16x8, v);
    }
    o0 = __builtin_amdgcn_mfma_f32_32x32x16_bf16(vf[0], pb[0], o0, 0, 0, 0);
    o0 = __builtin_amdgcn_mfma_f32_32x32x16_bf16(vf[1], pb[1], o0, 0, 0, 0);
    o1 = __builtin_amdgcn_mfma_f32_32x32x16_bf16(vf[2], pb[0], o1, 0, 0, 0);
    o1 = __builtin_amdgcn_mfma_f32_32x32x16_bf16(vf[3], pb[1], o1, 0, 0, 0);
}
__device__ __forceinline__ void attn_mla(const AttnP& P0, int unit, LAS float* xch, int wv) {
    const unsigned char* ws = P0.ws; asm volatile("" : "+s"(ws));
    const int lane = vlane(), w = wv, qs = w >> 2, h = w & 3, ql = lane & 31, hh = lane >> 5;
    const int lane16 = lane * 16;
    const int b = unit >> 4, q0 = 128 * (unit & 15) + 64 * qs;
    const size_t tokbase = (size_t)b * T;
    const bf16_t* qrA = (const bf16_t*)(ws + OFF_QM) + (tokbase + q0 + ql) * QLD + 96 * h;
    const bf16_t* qrB = qrA + 32 * QLD;
    const unsigned char* kfh = ws + OFF_KF + (size_t)(18 + h) * HEADB + (size_t)b * 64 * 4096 + lane16;
    const unsigned char* vfh = ws + OFF_VT + (size_t)(18 + h) * HEADB + (size_t)b * 64 * 4096 + lane16;
    const unsigned char* kpe = ws + OFF_KPE + (size_t)b * 64 * 2048 + lane16;
    bf16x8 qA[6], qB[6];
#pragma unroll
    for (int s = 0; s < 6; ++s) { qA[s] = *(const bf16x8*)(qrA + 16 * s + 8 * hh); qB[s] = *(const bf16x8*)(qrB + 16 * s + 8 * hh); }
    const float sc = 0.10206207261596577f * LOG2E;
    f32x16 oA0, oA1, oB0, oB1;
#pragma unroll
    for (int e = 0; e < 16; ++e) { oA0[e] = 0.f; oA1[e] = 0.f; oB0[e] = 0.f; oB1[e] = 0.f; }
    float mA = -1e20f, lA = 0.f, mB = -1e20f, lB = 0.f;
    bf16x8 kf[6], vf[4];
#pragma unroll
    for (int s = 0; s < 6; ++s) kf[s] = s >= 4 ? ldg16(kpe + (s - 4) * 1024) : ldg16(kfh + s * 1024);
#pragma unroll
    for (int j = 0; j < 4; ++j) vf[j] = ldg16(vfh + j * 1024);
    if (qs) __builtin_amdgcn_s_sleep(DEPHASE);
    for (int tau = 0; tau < 64; ++tau) {
        const int pt = min(tau + 1, 63);
        f32x16 sa, sb;
#pragma unroll
        for (int e = 0; e < 16; ++e) { sa[e] = 0.f; sb[e] = 0.f; }
#pragma unroll
        for (int s = 0; s < 6; ++s) { sa = __builtin_amdgcn_mfma_f32_32x32x16_bf16(kf[s], qA[s], sa, 0, 0, 0); sb = __builtin_amdgcn_mfma_f32_32x32x16_bf16(kf[s], qB[s], sb, 0, 0, 0); }
#pragma unroll
        for (int s = 0; s < 6; ++s) kf[s] = s >= 4 ? ldg16(kpe + (size_t)pt * 2048 + (s - 4) * 1024) : ldg16(kfh + (size_t)pt * 4096 + s * 1024);
        sm_pv(sa, oA0, oA1, mA, lA, vf, sc);
        sm_pv(sb, oB0, oB1, mB, lB, vf, sc);
#pragma unroll
        for (int j = 0; j < 4; ++j) vf[j] = ldg16(vfh + (size_t)pt * 4096 + j * 1024);
    }
    lA += __shfl_xor(lA, 32); lB += __shfl_xor(lB, 32);
    const float iA = 1.0f / lA, iB = 1.0f / lB;
    float sqA = 0.f, sqB = 0.f;
#pragma unroll
    for (int e = 0; e < 16; ++e) { oA0[e] *= iA; oA1[e] *= iA; oB0[e] *= iB; oB1[e] *= iB; sqA += oA0[e] * oA0[e] + oA1[e] * oA1[e]; sqB += oB0[e] * oB0[e] + oB1[e] * oB1[e]; }
    sqA += __shfl_xor(sqA, 32); sqB += __shfl_xor(sqB, 32);
    if (hh == 0) { xch[w * 64 + ql] = sqA; xch[w * 64 + 32 + ql] = sqB; }
    __syncthreads();
    const LAS float* xq = xch + qs * 256 + ql;
    const float rA = rsqrtf(((xq[0] + xq[64]) + (xq[128] + xq[192])) * (1.0f / 256.0f) + EPS);
    const float rB = rsqrtf(((xq[32] + xq[96]) + (xq[160] + xq[224])) * (1.0f / 256.0f) + EPS);
    bf16_t* yA = (bf16_t*)(ws + OFF_XBA) + (tokbase + q0 + ql) * D + 3 * 256 + h * 64 + 4 * hh;
    bf16_t* yB = yA + 32 * D;
#pragma unroll
    for (int j = 0; j < 4; ++j) {
        u32x2 w0; w0.x = cvt_pk_bf16(oA0[4 * j] * rA, oA0[4 * j + 1] * rA); w0.y = cvt_pk_bf16(oA0[4 * j + 2] * rA, oA0[4 * j + 3] * rA);
        u32x2 w1; w1.x = cvt_pk_bf16(oA1[4 * j] * rA, oA1[4 * j + 1] * rA); w1.y = cvt_pk_bf16(oA1[4 * j + 2] * rA, oA1[4 * j + 3] * rA);
        *(u32x2*)(yA + 8 * j) = w0; *(u32x2*)(yA + 32 + 8 * j) = w1;
        u32x2 w2; w2.x = cvt_pk_bf16(oB0[4 * j] * rB, oB0[4 * j + 1] * rB); w2.y = cvt_pk_bf16(oB0[4 * j + 2] * rB, oB0[4 * j + 3] * rB);
        u32x2 w3; w3.x = cvt_pk_bf16(oB1[4 * j] * rB, oB1[4 * j + 1] * rB); w3.y = cvt_pk_bf16(oB1[4 * j + 2] * rB, oB1[4 * j + 3] * rB);
        *(u32x2*)(yB + 8 * j) = w2; *(u32x2*)(yB + 32 + 8 * j) = w3;
    }
}

__device__ __forceinline__ void attn_phase(KA a, int layer, LAS unsigned char* lds, int wv) {
    AttnP P; P.ws = a->ws; P.nab = a->in[8] + (size_t)layer * 4 * 15 * 31; P.sink = a->in[9] + layer * 4;
    LAS float* xch = (LAS float*)lds;
    for (int i = ltid(wv); i < 4 * 15 * 31; i += 512) xch[1024 + i] = P.nab[i] * LOG2E;
    __syncthreads();
    int it = 0;
    const int G_ = lgrid(), bid_ = lbid();
    const int vcu = (G_ & 7) == 0 ? (bid_ & 7) * (G_ >> 3) + (bid_ >> 3) : bid_;
    for (int u = vcu; u < 256 + 3 * 512; u += G_, ++it) {
        LAS float* x = xch + (it & 1) * 512;
        if (u < 256) attn_mla(P, u, x, wv);
        else {
            const int mode = 1 + ((u - 256) >> 9), unit = (u - 256) & 511;
            if (mode == 1) attn_unit<1>(P, unit, x, xch + 1024, wv);
            else if (mode == 2) attn_unit<2>(P, unit, x, xch + 1024, wv);
            else attn_unit<3>(P, unit, x, xch + 1024, wv);
        }
    }
    __syncthreads();
}

__device__ __forceinline__ void grid_bar(unsigned* bar, unsigned seq, int wv) {
    asm volatile("s_waitcnt vmcnt(0) lgkmcnt(0)" ::: "memory");
    __builtin_amdgcn_s_barrier();
    if (wv == 0) {
        if (vlane() == 0) {
            const unsigned G = (unsigned)lgrid(), b = (unsigned)lbid(), g = b & 7u;
            const unsigned ng = (G - g + 7u) >> 3, ngroups = G < 8u ? G : 8u;
            unsigned* flag = bar + 64 * 9;
            __builtin_amdgcn_fence(__ATOMIC_RELEASE, "agent");
            asm volatile("s_waitcnt vmcnt(0)" ::: "memory");
            const unsigned old = __hip_atomic_fetch_add(bar + 64 * g, 1u, __ATOMIC_RELAXED, __HIP_MEMORY_SCOPE_AGENT);
            bool waitf = true;
            if (old + 1u == seq * ng) {
                __builtin_amdgcn_fence(__ATOMIC_SEQ_CST, "agent");
                const unsigned old2 = __hip_atomic_fetch_add(bar + 64 * 8, 1u, __ATOMIC_RELAXED, __HIP_MEMORY_SCOPE_AGENT);
                if (old2 + 1u == seq * ngroups) { __builtin_amdgcn_fence(__ATOMIC_SEQ_CST, "agent"); __hip_atomic_store(flag, seq, __ATOMIC_RELAXED, __HIP_MEMORY_SCOPE_AGENT); waitf = false; }
            }
            if (waitf) { unsigned spins = 0; while (__hip_atomic_load(flag, __ATOMIC_RELAXED, __HIP_MEMORY_SCOPE_AGENT) < seq) { __builtin_amdgcn_s_sleep(1); if (++spins > (1u << 26)) break; } }
            __builtin_amdgcn_fence(__ATOMIC_ACQUIRE, "agent");
            asm volatile("s_waitcnt vmcnt(0)" ::: "memory");
        }
    }
    __builtin_amdgcn_s_barrier();
    asm volatile("" ::: "memory");
}

template <int PH, bool ZERO = false>
__device__ __forceinline__ void run_phase(LAS unsigned char* lds, int wv) {
    KA a = kargs();
    unsigned char* ws = a->ws; asm volatile("" : "+s"(ws));
    bf16_t* Wbase = (bf16_t*)(ws + OFF_W);
    bf16_t* xbA = (bf16_t*)(ws + OFF_XBA); bf16_t* xbB = (bf16_t*)(ws + OFF_XBB);
    bf16_t* Hb = (bf16_t*)(ws + OFF_H); bf16_t* zl = (bf16_t*)(ws + OFF_ZL); bf16_t* qm = (bf16_t*)(ws + OFF_QM);
    unsigned char* vf = ws + OFF_VT;
    bf16_t* pb = (bf16_t*)(ws + OFF_VT);
    float* ssA = (float*)(ws + OFF_SSA); float* ssB = (float*)(ws + OFF_SSB); float* mst = (float*)(ws + OFF_MST);
    const float* cs64 = (const float*)(ws + OFF_CS64); const float* cs32 = (const float*)(ws + OFF_CS32);
    if constexpr (PH == 0) { if (PH_ON(0)) prologue(a, lds, wv); }
    else if constexpr (PH == NPH - 1) { if (PH_ON(1)) final_norm(a, wv); }
    else {
        constexpr int l = (PH - 1) / 9, k = (PH - 1) % 9;
        bf16_t* WL = Wbase + (size_t)l * WL_SIZE;
        if constexpr (k == 0) { if (PH_ON(2)) { EpiGU E{ssA, Hb}; run_gemm(wv, lds, xbA, D, M, WL + WL_GU1, D, 5632, D, 0, E); } }
        else if constexpr (k == 1) { if (PH_ON(3)) { EpiRes E{(l == 0 && !ZERO) ? a->in[0] : (const float*)a->out, a->out, xbB, ssB, ZERO ? 0.f : 0.5f}; run_gemm(wv, lds, Hb, FF, M, WL + WL_D1, FF, D, FF, 0, E); } }
        else if constexpr (k == 2) {
            if (PH_ON(4)) { EpiIn E{ssB, ws, mst, cs64, cs32}; run_gemm(wv, lds, xbB, D, M, WL + WL_IN, D, 2048, D, 0, E); }
            if (PH_ON(5)) { EpiVT E{ssB, vf}; run_gemm(wv, lds, WL + WL_IN + (size_t)2048 * D, D, 512, xbB, D, M, D, 0, E); }
        }
        else if constexpr (k == 3) {
            if (PH_ON(6)) { EpiQ E{mst, qm, cs32}; run_gemm(wv, lds, zl, ZLLD, M, WL + WL_UQ, 256, 512, 256, 0, E); }
            if (PH_ON(7)) { EpiK E{mst, ws}; run_gemm(wv, lds, zl + 256, ZLLD, M, WL + WL_UKV, 128, 256, 128, 0, E); }
            if (PH_ON(8)) { EpiVTM E{mst, vf}; run_gemm(wv, lds, WL + WL_UKV + (size_t)256 * 128, 128, 256, zl + 256, ZLLD, M, 128, 128, E); }
        }
        else if constexpr (k == 4) { if (PH_ON(9)) attn_phase(a, l, lds, wv); }
        else if constexpr (k == 5) { if (PH_ON(3)) { EpiRes E{a->out, a->out, xbB, ssB, ZERO ? 0.f : 1.0f}; run_gemm(wv, lds, xbA, D, M, WL + WL_O, D, D, D, 0, E); } }
        else if constexpr (k == 6) { if (PH_ON(2)) { convert_p(a, l, wv); EpiGU E{ssB, Hb}; run_gemm(wv, lds, xbB, D, M, WL + WL_GU2, D, 5632, D, 0, E); } }
        else if constexpr (k == 7) {
            if (PH_ON(3)) { EpiRes E{a->out, a->out, xbB, ssB, ZERO ? 0.f : 0.5f}; run_gemm(wv, lds, Hb, FF, M, WL + WL_D2, FF, D, FF, 0, E); }
            if (PH_ON(10)) { EpiPP E{xbA}; run_gemm(wv, lds, pb, PLE, M, WL + WL_PP, PLE, D, PLE, 0, E); }
        }
        else { if (PH_ON(11)) { EpiGate E{a->out, ssB, xbA, ssA, ZERO ? 0.f : 1.0f}; run_gemm(wv, lds, xbB, D, M, WL + WL_PG, D, D, D, 0, E); } }
    }
}
template <int PH>
__device__ __forceinline__ void run_from(LAS unsigned char* lds, int ph_lo, int ph_hi, int wv) {
    if constexpr (PH < NPH) {
        if (PH >= ph_lo && PH < ph_hi) {
            run_phase<PH>(lds, wv);
            if constexpr (PH > 0 && PH < NPH - 1) { if constexpr ((DUPM >> ((PH - 1) % 9)) & 1) { __syncthreads(); run_phase<PH, true>(lds, wv); } }
            if constexpr (PH == 0 && ((DUPM >> 9) & 1)) { __syncthreads(); run_phase<PH>(lds, wv); }
            if (PH + 1 < ph_hi && kargs()->coop) {
                if constexpr (PH == 0) cg::this_grid().sync();
                else { for (int r_ = 0; r_ < BARREP; ++r_) grid_bar((unsigned*)(kargs()->ws + OFF_BAR), (unsigned)((PH - 1) * BARREP + r_ + 1), wv); }
            }
        }
        run_from<PH + 1>(lds, ph_lo, ph_hi, wv);
    }
}
__global__ void __launch_bounds__(512, 2) mega(Args a_unused) {
    extern __shared__ __attribute__((aligned(16))) unsigned char lds_raw[];
    LAS unsigned char* lds = (LAS unsigned char*)lds_raw;
    const int ph_lo = kargs()->ph_lo, ph_hi = kargs()->ph_hi;
    const int wv = __builtin_amdgcn_readfirstlane((int)threadIdx.x >> 6);
    run_from<0>(lds, ph_lo, ph_hi, wv);
}

extern "C" void kernel_launch(void* const* d_in, const int* in_sizes, int n_in, void* d_out, int out_size, void* d_ws, size_t ws_size, hipStream_t stream) {
    static int grid = 0;
    if (grid == 0) {
        if (n_in != 24 || ws_size < WS_END) { fprintf(stderr, "kernel_launch: n_in %d ws %zu (need %zu)\n", n_in, ws_size, (size_t)WS_END); grid = -1; return; }
        int dev = 0, cus = 0, per_cu = 0;
        hipGetDevice(&dev); hipDeviceGetAttribute(&cus, hipDeviceAttributeMultiprocessorCount, dev);
        if (hipFuncSetAttribute((const void*)mega, hipFuncAttributeMaxDynamicSharedMemorySize, LDS_BYTES) != hipSuccess) { fprintf(stderr, "hipFuncSetAttribute failed\n"); grid = -1; return; }
        if (hipOccupancyMaxActiveBlocksPerMultiprocessor(&per_cu, (const void*)mega, 512, LDS_BYTES) != hipSuccess || per_cu < 1) per_cu = 1;
        (void)hipGetLastError();
        grid = cus * per_cu;
    }
    if (grid < 0) return;
    (void)hipMemsetAsync((char*)d_ws + OFF_BAR, 0, 4096, stream);
    Args a{};
    for (int i = 0; i < 24; ++i) a.in[i] = (const float*)d_in[i];
    a.out = (float*)d_out; a.ws = (unsigned char*)d_ws;
#if MULTI_LAUNCH
    for (int ph = 0; ph < NPH; ++ph) {
        a.ph_lo = ph; a.ph_hi = ph + 1; a.coop = 0;
        hipLaunchKernelGGL(mega, dim3(grid), dim3(512), LDS_BYTES, stream, a);
    }
#else
    a.ph_lo = 0; a.ph_hi = NPH; a.coop = 1;
    void* args[] = {&a};
    hipError_t e = hipLaunchCooperativeKernel((void*)mega, dim3(grid), dim3(512), args, LDS_BYTES, stream);
    if (e != hipSuccess) fprintf(stderr, "cooperative launch failed: %s (grid %d)\n", hipGetErrorString(e), grid);
#endif
}
```
